# Optimizing an MI355X kernel written in HIP

```python
import math
import jax
import jax.numpy as jnp
from jax import lax
import numpy as np

D_MODEL = 2048
BATCH = 16
SEQ = 256
DEPTH = 2
DEC_BATCH = 4
DEC_SEQ = 4096
PAST_LEN = 512

GRID_W = 64
POS_BASE = 10000.0
N_EVEN = (DEPTH + 1) // 2
N_ODD = DEPTH // 2
N_DIR = 2
EPS = 1e-6

MIX_W_EVEN = 2 * D_MODEL
S5_W = MIX_W_EVEN // 4
S5_GROUP_CH = 16
S5_GROUPS = S5_W // S5_GROUP_CH
S5_STATE = 64
GLA_DV_W = MIX_W_EVEN - S5_W
GLA_HEADS = 6
GLA_DV = GLA_DV_W // GLA_HEADS
GLA_DK = GLA_DV // 2
GLA_DK_W = GLA_HEADS * GLA_DK
GLA_RANK = 16
GLA_NORMALIZER = 16.0
GLA_CHUNK = 64
GLA_LOG_DECAY_MIN = -1.0
EVEN_SIZES = (S5_W, S5_W, GLA_DK_W, GLA_DK_W, GLA_DV_W, GLA_DV_W, N_DIR * GLA_RANK)
EVEN_IN = 2 * S5_W + 2 * GLA_DK_W + 2 * GLA_DV_W + N_DIR * GLA_RANK

RWKV_W = D_MODEL
RWKV_HEAD = 64
RWKV_HEADS = RWKV_W // RWKV_HEAD
RWKV_DECAY_RANK = 96
RWKV_ICLR_RANK = 96
RWKV_LNX_EPS = 64e-5
ODD_SIZES = (RWKV_W, RWKV_W, RWKV_W, RWKV_W, N_DIR * RWKV_DECAY_RANK, N_DIR * RWKV_ICLR_RANK)
ODD_IN = 4 * RWKV_W + N_DIR * (RWKV_DECAY_RANK + RWKV_ICLR_RANK)

kernel_name = 'bidir_s5_gla_rwkv7_prefix_diffusion_step'


def _split_cols(t, sizes):
    offsets, acc = [], 0
    for s in sizes[:-1]:
        acc += s
        offsets.append(acc)
    return jnp.split(t, offsets, axis=-1)


def _rev(t):
    return jnp.flip(t, axis=1)


def _rms(x, w):
    xf = x.astype(jnp.float32)
    return xf * lax.rsqrt(jnp.mean(xf * xf, axis=-1, keepdims=True) + EPS) * w.astype(jnp.float32)


def _adaln(cond, w, b):
    m = jax.nn.silu(cond.astype(jnp.float32)) @ w.astype(jnp.float32) + b.astype(jnp.float32)
    shift, scale, gate = jnp.split(m, 3, axis=-1)
    return shift[..., None, :], scale[..., None, :], gate[..., None, :]


def _grid_pos_embed(n_tokens):
    rows = n_tokens // GRID_W
    row_id = jnp.broadcast_to(jnp.arange(rows, dtype=jnp.float32)[:, None], (rows, GRID_W)).reshape(-1)
    col_id = jnp.broadcast_to(jnp.arange(GRID_W, dtype=jnp.float32)[None, :], (rows, GRID_W)).reshape(-1)
    quarter = D_MODEL // 4
    omega = 1.0 / (POS_BASE ** (jnp.arange(quarter, dtype=jnp.float32) / quarter))
    def axis_emb(pos):
        ang = pos[:, None] * omega[None, :]
        return jnp.concatenate([jnp.sin(ang), jnp.cos(ang)], axis=-1)
    return jnp.concatenate([axis_emb(row_id), axis_emb(col_id)], axis=-1)


def _complex_affine_combine(e1, e2):
    a1r, a1i, b1r, b1i = e1
    a2r, a2i, b2r, b2i = e2
    return (a1r * a2r - a1i * a2i,
            a1r * a2i + a1i * a2r,
            a2r * b1r - a2i * b1i + b2r,
            a2r * b1i + a2i * b1r + b2i)


def _s5_direction(u, lam_re, lam_im, log_step, b_re, b_im, c_re, c_im, h0_re, h0_im):
    lam_re = lam_re.astype(jnp.float32)
    lam_im = lam_im.astype(jnp.float32)
    dt = jnp.exp(log_step.astype(jnp.float32))[:, None]
    mag = jnp.exp(lam_re * dt)
    ab_re, ab_im = mag * jnp.cos(lam_im * dt), mag * jnp.sin(lam_im * dt)
    den = lam_re * lam_re + lam_im * lam_im
    f_re = ((ab_re - 1.0) * lam_re + ab_im * lam_im) / den
    f_im = (ab_im * lam_re - (ab_re - 1.0) * lam_im) / den
    bb_re = f_re[..., None] * b_re - f_im[..., None] * b_im
    bb_im = f_re[..., None] * b_im + f_im[..., None] * b_re
    bu_re = jnp.einsum('blgh,gph->blgp', u, bb_re)
    bu_im = jnp.einsum('blgh,gph->blgp', u, bb_im)
    a_re = jnp.broadcast_to(ab_re, bu_re.shape)
    a_im = jnp.broadcast_to(ab_im, bu_im.shape)
    pw_re, pw_im, s_re, s_im = lax.associative_scan(_complex_affine_combine, (a_re, a_im, bu_re, bu_im), axis=1)
    h0r, h0i = h0_re[:, None], h0_im[:, None]
    h_re = s_re + pw_re * h0r - pw_im * h0i
    h_im = s_im + pw_re * h0i + pw_im * h0r
    y = jnp.einsum('blgp,ghp->blgh', h_re, c_re) - jnp.einsum('blgp,ghp->blgh', h_im, c_im)
    return y, h_re[:, -1], h_im[:, -1]


def _gla_direction(q, k, v, log_a, s0):
    bsz, L, H, _ = q.shape
    n = L // GLA_CHUNK
    def chunks(t):
        return t.reshape(bsz, n, GLA_CHUNK, H, t.shape[-1]).transpose(1, 0, 3, 2, 4)
    causal = jnp.tril(jnp.ones((GLA_CHUNK, GLA_CHUNK), dtype=bool))
    def step(S, xs):
        qc, kc, vc, gc = xs
        b = jnp.cumsum(gc, axis=-2)
        b_last = b[..., -1:, :]
        q_dec = qc * jnp.exp(b)
        k_inv = kc * jnp.exp(-b)
        k_end = kc * jnp.exp(b_last - b)
        att = jnp.where(causal, jnp.einsum('bhcd,bhsd->bhcs', q_dec, k_inv), 0.0)
        o = jnp.einsum('bhcs,bhse->bhce', att, vc) + jnp.einsum('bhcd,bhde->bhce', q_dec, S)
        S = jnp.exp(b_last[..., 0, :])[..., None] * S + jnp.einsum('bhcd,bhce->bhde', k_end, vc)
        return S, o
    S, o = lax.scan(step, s0, (chunks(q), chunks(k), chunks(v), chunks(log_a)))
    return o.transpose(1, 0, 3, 2, 4).reshape(bsz, L, H, -1), S


def _rwkv_direction(r, w, k, v, a, b, s0):
    def tm(t):
        return jnp.swapaxes(t, 0, 1)
    def step(S, xs):
        r_t, w_t, k_t, v_t, a_t, b_t = xs
        sa = jnp.einsum('bhij,bhj->bhi', S, a_t)
        S = S * w_t[:, :, None, :] + sa[..., None] * b_t[:, :, None, :] + v_t[..., None] * k_t[:, :, None, :]
        return S, jnp.einsum('bhij,bhj->bhi', S, r_t)
    S, y = lax.scan(step, s0, tuple(tm(t) for t in (r, w, k, v, a, b)))
    return tm(y), S


def _even_mixer(h, s5_re0, s5_im0, gla0, w_in, w_out, lam_re, lam_im, log_step, b_re, b_im, c_re, c_im,
                d_skip, glu_w, glu_b, dec_up, dec_b, gla_nw):
    bsz, L, _ = h.shape
    u, s5_g, q, k, v, gla_g, dec_lr = _split_cols(h @ w_in, EVEN_SIZES)
    u_g = u.reshape(bsz, L, S5_GROUPS, S5_GROUP_CH)
    y = d_skip * u
    fin_re, fin_im = [], []
    for d in range(N_DIR):
        u_d = _rev(u_g) if d else u_g
        y_d, hr, hi = _s5_direction(u_d, lam_re[d], lam_im[d], log_step[d], b_re[d], b_im[d], c_re[d], c_im[d],
                                    s5_re0[:, d].astype(jnp.float32), s5_im0[:, d].astype(jnp.float32))
        y = y + (_rev(y_d) if d else y_d).reshape(bsz, L, S5_W)
        fin_re.append(hr)
        fin_im.append(hi)
    gy = jax.nn.gelu(y)
    s5_out = gy * jax.nn.sigmoid(gy @ glu_w + glu_b) * jax.nn.silu(s5_g)
    q = q.reshape(bsz, L, GLA_HEADS, GLA_DK) * (GLA_DK ** -0.5)
    k = k.reshape(bsz, L, GLA_HEADS, GLA_DK)
    v = v.reshape(bsz, L, GLA_HEADS, GLA_DV)
    dec_lr = dec_lr.reshape(bsz, L, N_DIR, GLA_RANK)
    o = 0.0
    fin_gla = []
    for d in range(N_DIR):
        z = dec_lr[:, :, d] @ dec_up[d] + dec_b[d]
        log_a = jnp.maximum(jax.nn.log_sigmoid(z) / GLA_NORMALIZER, GLA_LOG_DECAY_MIN)
        seq = (q, k, v, log_a.reshape(bsz, L, GLA_HEADS, GLA_DK))
        if d:
            seq = tuple(_rev(t) for t in seq)
        o_d, S = _gla_direction(*seq, gla0[:, d].astype(jnp.float32))
        o = o + (_rev(o_d) if d else o_d)
        fin_gla.append(S)
    o = o * lax.rsqrt(jnp.mean(o * o, axis=-1, keepdims=True) + EPS) * gla_nw.reshape(GLA_HEADS, GLA_DV)
    gla_out = o.reshape(bsz, L, GLA_DV_W) * jax.nn.silu(gla_g)
    out = jnp.concatenate([s5_out, gla_out], axis=-1) @ w_out
    return out, jnp.stack(fin_re, axis=1), jnp.stack(fin_im, axis=1), jnp.stack(fin_gla, axis=1)


def _odd_mixer(h, rwkv0, w_in, w_out, mu, w0, w2, a0, a2, k_k, k_a, r_k, lnx_w, lnx_b):
    bsz, L, _ = h.shape
    zero = jnp.zeros_like(h[:, :1])
    h_prev = jnp.concatenate([zero, h[:, :-1]], axis=1)
    h_next = jnp.concatenate([h[:, 1:], zero], axis=1)
    xs = h + mu[0] * (h_prev - h) + mu[1] * (h_next - h)
    r, k, v, g, w_lr, a_lr = _split_cols(xs @ w_in, ODD_SIZES)
    w_lr = jnp.tanh(w_lr).reshape(bsz, L, N_DIR, RWKV_DECAY_RANK)
    a_lr = a_lr.reshape(bsz, L, N_DIR, RWKV_ICLR_RANK)
    def heads(t):
        return t.reshape(bsz, L, RWKV_HEADS, RWKV_HEAD)
    kk = heads(k * k_k)
    kk = kk / jnp.maximum(jnp.sqrt(jnp.sum(kk * kk, axis=-1, keepdims=True)), 1e-12)
    r_h, v_h = heads(r), heads(v)
    wkv, bonus = 0.0, 0.0
    finals = []
    for d in range(N_DIR):
        w_log = -jax.nn.softplus(-(w0[d] + w_lr[:, :, d] @ w2[d])) - 0.5
        decay = jnp.exp(-jnp.exp(w_log))
        a = jax.nn.sigmoid(a0[d] + a_lr[:, :, d] @ a2[d])
        k_d = heads(k * (1.0 + (a - 1.0) * k_a))
        seq = (r_h, heads(decay), k_d, v_h, -kk, kk * heads(a))
        if d:
            seq = tuple(_rev(t) for t in seq)
        y_d, S = _rwkv_direction(*seq, rwkv0[:, d].astype(jnp.float32))
        wkv = wkv + (_rev(y_d) if d else y_d)
        bonus = bonus + jnp.sum(r_h * k_d * r_k, axis=-1, keepdims=True) * v_h
        finals.append(S)
    mean = jnp.mean(wkv, axis=-1, keepdims=True)
    var = jnp.mean(jnp.square(wkv - mean), axis=-1, keepdims=True)
    ln = ((wkv - mean) * lax.rsqrt(var + RWKV_LNX_EPS) * lnx_w.reshape(RWKV_HEADS, RWKV_HEAD)
          + lnx_b.reshape(RWKV_HEADS, RWKV_HEAD))
    out = (ln + bonus).reshape(bsz, L, RWKV_W) * jax.nn.silu(g)
    return out @ w_out, jnp.stack(finals, axis=1)


def setup_inputs(seed: int = 0) -> dict:
    key = jax.random.key(seed)
    ks = jax.random.split(key, 40)
    f32 = jnp.float32
    def nrm(i, shape, scale):
        return jax.random.normal(ks[i], shape, f32) * scale
    def uni(i, shape, lo, hi):
        return jax.random.uniform(ks[i], shape, f32, lo, hi)
    return {
        'x_prompt': nrm(0, (BATCH, SEQ, D_MODEL), 1.0),
        'x_sample': nrm(1, (DEC_BATCH, DEC_SEQ, D_MODEL), 1.0),
        'state_s5_re': nrm(2, (DEC_BATCH, N_EVEN, N_DIR, S5_GROUPS, S5_STATE), 0.1),
        'state_s5_im': nrm(3, (DEC_BATCH, N_EVEN, N_DIR, S5_GROUPS, S5_STATE), 0.1),
        'state_gla': nrm(4, (DEC_BATCH, N_EVEN, N_DIR, GLA_HEADS, GLA_DK, GLA_DV), 1.0),
        'state_rwkv': nrm(5, (DEC_BATCH, N_ODD, N_DIR, RWKV_HEADS, RWKV_HEAD, RWKV_HEAD), 0.5),
        'c': nrm(6, (DEC_BATCH, D_MODEL), 1.0),
        'c_ctx': nrm(7, (D_MODEL,), 1.0),
        'norm_w': 1.0 + nrm(8, (DEPTH, D_MODEL), 0.02),
        'ada_w': nrm(9, (DEPTH, D_MODEL, 3 * D_MODEL), 0.5 * D_MODEL ** -0.5),
        'ada_b': nrm(10, (DEPTH, 3 * D_MODEL), 0.02),
        'final_norm_w': 1.0 + nrm(11, (D_MODEL,), 0.02),
        'e_w_in': nrm(12, (N_EVEN, D_MODEL, EVEN_IN), D_MODEL ** -0.5),
        'e_w_out': nrm(13, (N_EVEN, MIX_W_EVEN, D_MODEL), MIX_W_EVEN ** -0.5),
        's5_lambda_re': -0.5 + nrm(14, (N_EVEN, N_DIR, S5_GROUPS, S5_STATE), 0.01),
        's5_lambda_im': math.pi * jnp.arange(S5_STATE, dtype=f32) + nrm(15, (N_EVEN, N_DIR, S5_GROUPS, S5_STATE), 0.01),
        's5_log_step': uni(16, (N_EVEN, N_DIR, S5_GROUPS), math.log(1e-3), math.log(1e-1)),
        's5_b_re': nrm(17, (N_EVEN, N_DIR, S5_GROUPS, S5_STATE, S5_GROUP_CH), (2 * S5_GROUP_CH) ** -0.5),
        's5_b_im': nrm(18, (N_EVEN, N_DIR, S5_GROUPS, S5_STATE, S5_GROUP_CH), (2 * S5_GROUP_CH) ** -0.5),
        's5_c_re': nrm(19, (N_EVEN, N_DIR, S5_GROUPS, S5_GROUP_CH, S5_STATE), (2 * S5_STATE) ** -0.5),
        's5_c_im': nrm(20, (N_EVEN, N_DIR, S5_GROUPS, S5_GROUP_CH, S5_STATE), (2 * S5_STATE) ** -0.5),
        's5_d': nrm(21, (N_EVEN, S5_W), 1.0),
        's5_glu_w': nrm(22, (N_EVEN, S5_W, S5_W), S5_W ** -0.5),
        's5_glu_b': nrm(23, (N_EVEN, S5_W), 0.02),
        'gla_decay_up': nrm(24, (N_EVEN, N_DIR, GLA_RANK, GLA_DK_W), GLA_RANK ** -0.5),
        'gla_decay_b': nrm(25, (N_EVEN, N_DIR, GLA_DK_W), 0.1),
        'gla_norm_w': 1.0 + nrm(26, (N_EVEN, GLA_DV_W), 0.02),
        'o_w_in': nrm(27, (N_ODD, D_MODEL, ODD_IN), D_MODEL ** -0.5),
        'o_w_out': nrm(28, (N_ODD, RWKV_W, D_MODEL), RWKV_W ** -0.5),
        'rwkv_mu': uni(29, (N_ODD, 2, D_MODEL), 0.0, 0.5),
        'rwkv_w0': jnp.linspace(-6.5, -1.5, RWKV_W, dtype=f32) + nrm(30, (N_ODD, N_DIR, RWKV_W), 0.1),
        'rwkv_w2': nrm(31, (N_ODD, N_DIR, RWKV_DECAY_RANK, RWKV_W), 0.1 * RWKV_DECAY_RANK ** -0.5),
        'rwkv_a0': nrm(32, (N_ODD, N_DIR, RWKV_W), 0.1),
        'rwkv_a2': nrm(33, (N_ODD, N_DIR, RWKV_ICLR_RANK, RWKV_W), 0.1 * RWKV_ICLR_RANK ** -0.5),
        'rwkv_k_k': 0.85 + nrm(34, (N_ODD, RWKV_W), 0.05),
        'rwkv_k_a': 1.0 + nrm(35, (N_ODD, RWKV_W), 0.05),
        'rwkv_r_k': nrm(36, (N_ODD, RWKV_HEADS, RWKV_HEAD), 0.1),
        'rwkv_lnx_w': 1.0 + nrm(37, (N_ODD, RWKV_W), 0.02),
        'rwkv_lnx_b': nrm(38, (N_ODD, RWKV_W), 0.02),
    }


def reference(x_prompt, x_sample, state_s5_re, state_s5_im, state_gla, state_rwkv, c,
              c_ctx, norm_w, ada_w, ada_b, final_norm_w,
              e_w_in, e_w_out, s5_lambda_re, s5_lambda_im, s5_log_step, s5_b_re, s5_b_im, s5_c_re, s5_c_im,
              s5_d, s5_glu_w, s5_glu_b, gla_decay_up, gla_decay_b, gla_norm_w,
              o_w_in, o_w_out, rwkv_mu, rwkv_w0, rwkv_w2, rwkv_a0, rwkv_a2, rwkv_k_k, rwkv_k_a, rwkv_r_k,
              rwkv_lnx_w, rwkv_lnx_b):
    f32 = jnp.float32
    bp = x_prompt.shape[0]
    x_ctx = x_prompt
    x_lat = (x_sample.astype(f32) + _grid_pos_embed(x_sample.shape[1])[None]).astype(x_sample.dtype)
    z_s5 = jnp.zeros((bp, N_DIR, S5_GROUPS, S5_STATE), f32)
    z_gla = jnp.zeros((bp, N_DIR, GLA_HEADS, GLA_DK, GLA_DV), f32)
    z_rwkv = jnp.zeros((bp, N_DIR, RWKV_HEADS, RWKV_HEAD, RWKV_HEAD), f32)
    new_s5_re, new_s5_im, new_gla, new_rwkv = [], [], [], []
    for i in range(DEPTH):
        j = i // 2
        sh_c, sc_c, gt_c = _adaln(c_ctx, ada_w[i], ada_b[i])
        sh_l, sc_l, gt_l = _adaln(c, ada_w[i], ada_b[i])
        h_ctx = _rms(x_ctx, norm_w[i]) * (1.0 + sc_c) + sh_c
        h_lat = _rms(x_lat, norm_w[i]) * (1.0 + sc_l) + sh_l
        if i % 2 == 0:
            p = (e_w_in[j], e_w_out[j], s5_lambda_re[j], s5_lambda_im[j], s5_log_step[j], s5_b_re[j], s5_b_im[j],
                 s5_c_re[j], s5_c_im[j], s5_d[j], s5_glu_w[j], s5_glu_b[j], gla_decay_up[j], gla_decay_b[j],
                 gla_norm_w[j])
            o_ctx, fr, fi, fg = _even_mixer(h_ctx, z_s5, z_s5, z_gla, *p)
            o_lat, _, _, _ = _even_mixer(h_lat, state_s5_re[:, j], state_s5_im[:, j], state_gla[:, j], *p)
            new_s5_re.append(fr)
            new_s5_im.append(fi)
            new_gla.append(fg)
        else:
            p = (o_w_in[j], o_w_out[j], rwkv_mu[j], rwkv_w0[j], rwkv_w2[j], rwkv_a0[j], rwkv_a2[j],
                 rwkv_k_k[j], rwkv_k_a[j], rwkv_r_k[j], rwkv_lnx_w[j], rwkv_lnx_b[j])
            o_ctx, fw = _odd_mixer(h_ctx, z_rwkv, *p)
            o_lat, _ = _odd_mixer(h_lat, state_rwkv[:, j], *p)
            new_rwkv.append(fw)
        x_ctx = x_ctx + (gt_c * o_ctx).astype(x_ctx.dtype)
        x_lat = x_lat + (gt_l * o_lat).astype(x_lat.dtype)
    y_prompt = _rms(x_ctx, final_norm_w).astype(x_prompt.dtype)
    y_sample = _rms(x_lat, final_norm_w).astype(x_sample.dtype)
    return (y_prompt, y_sample, jnp.stack(new_s5_re, axis=1), jnp.stack(new_s5_im, axis=1),
            jnp.stack(new_gla, axis=1), jnp.stack(new_rwkv, axis=1))
```

```cpp
#include <hip/hip_runtime.h>
#include <cstdio>
#include <cstdint>
#include <cstring>
namespace pg8 {
#define PG8_LAS __attribute__((address_space(3)))
typedef unsigned short bf16_t;
typedef short bf16x8 __attribute__((ext_vector_type(8)));
typedef float f32x4 __attribute__((ext_vector_type(4)));
typedef unsigned u32x4 __attribute__((ext_vector_type(4)));
constexpr int BM = 256, BK = 64, HALF = 128, HTB = HALF * BK * 2  , STAGE_BYTES = 8 * HTB, NXCD = 8, WGM = 8;

__host__ __device__ __forceinline__ int lds_byte(int r, int c) { const int st = (r >> 4) * 2 + (c >> 5), rr = r & 15, cc = c & 31, ob = rr * 64 + cc * 2; return st * 1024 + (ob ^ (((ob >> 9) & 1) << 5)); }
__host__ __device__ __forceinline__ void stage_rc(int b, int& R, int& C) { const int st = b / 1024, sb = b % 1024, swz = sb ^ (((sb >> 9) & 1) << 5); R = (st >> 1) * 16 + swz / 64; C = (st & 1) * 32 + (swz % 64) / 2; }
__host__ __device__ __forceinline__ int perm32(int rho) { const int n = rho >> 4, i = rho & 15; return 8 * (i >> 2) + 4 * n + (i & 3); }

struct Unit { int pm, pn; };
struct Gemm { const bf16_t* A; const bf16_t* Bt; int M, N, K; };

struct StaticOrder {
    int nM, nN, nwg, G, c;
    __host__ __device__ void init(int M, int N, int G_, int c_) { nM = M / BM; nN = N / BM; nwg = nM * nN; G = G_; c = c_; }
    __host__ __device__ bool next(int i, Unit& u) const {
        const long L = (long)i * G + c; if (L >= nwg) return false;
        int wgid = (int)L; { const int q = nwg / NXCD, r = nwg % NXCD, xcd = wgid % NXCD, off = wgid / NXCD; wgid = (xcd < r ? xcd * (q + 1) : r * (q + 1) + (xcd - r) * q) + off; }
        const int nig = WGM * nN, gid = wgid / nig, fm = gid * WGM, gsz = (nM - fm) < WGM ? (nM - fm) : WGM;
        u.pm = fm + ((wgid % nig) % gsz); u.pn = (wgid % nig) / gsz; return true;
    }
    __device__ __forceinline__ void a_ready(const Unit&) const {}
    __device__ __forceinline__ void done(const Unit&) const {}
};
__device__ __forceinline__ unsigned cvt_pk_bf16(float lo, float hi) { unsigned r; asm volatile("v_cvt_pk_bf16_f32 %0, %1, %2" : "=v"(r) : "v"(lo), "v"(hi)); return r; }
template <class Epi, class Sched, bool STAMP = false>
__device__ __forceinline__ void gemm_phase(PG8_LAS unsigned char* lds, const Gemm g, const Sched& S, const Epi& E, unsigned long long* stamps) {
    const int tid = threadIdx.x, wid = __builtin_amdgcn_readfirstlane(tid >> 6), lane = tid & 63, wr = wid >> 2, wc = wid & 3, fr = lane & 15, fq = lane >> 4;
    const int K = g.K, nt = K / BK;
    int ts_lo = 0, ts_hi = 0, nts = 0; const unsigned long long rt_entry = STAMP ? (unsigned long long)wall_clock64() : 0ull;
#define PG8_STAMP() do { if (STAMP && wid == 0 && nts < 64) { const unsigned long long _c = (unsigned long long)clock64(); \
        ts_lo = (lane == nts) ? (int)(unsigned)_c : ts_lo; ts_hi = (lane == nts) ? (int)(unsigned)(_c >> 32) : ts_hi; ++nts; } } while (0)
    PG8_STAMP();
    unsigned voffA[2], voffB[2];
#pragma unroll
    for (int i = 0; i < 2; ++i) { int R, C; stage_rc(tid * 16 + i * 8192, R, C); const int Rb = Epi::PERM ? ((R & ~31) + perm32(R & 31)) : R;
        voffA[i] = (unsigned)(R * K + C) * 2u; voffB[i] = (unsigned)(Rb * K + C) * 2u; }
    const size_t kstep = (size_t)(BK * 2);
    const size_t hstep = (size_t)HALF * K * 2;
    const size_t tstep = 2 * hstep;
    const unsigned ldsw = (unsigned)wid * 1024u;
    const int aoff = lds_byte(wr * 64 + fr, fq * 8), boff = lds_byte(wc * 32 + fr, fq * 8);
#define PG8_SA(b, h) (((b) * 2 + (h)) * HTB)
#define PG8_SB(b, h) ((4 + (b) * 2 + (h)) * HTB)
#define PG8_STAGE(bufoff, gbase, voff) do { _Pragma("unroll") for (int _i = 0; _i < 2; ++_i) \
        __builtin_amdgcn_global_load_lds((const unsigned*)((const char*)(gbase) + (voff)[_i]), (PG8_LAS unsigned*)(lds + (bufoff) + ldsw + _i * 8192), 16, 0, 0); } while (0)
#define PG8_LDA(dst, b, h) do { _Pragma("unroll") for (int m = 0; m < 4; ++m) _Pragma("unroll") for (int k = 0; k < 2; ++k) dst[m][k] = *(const PG8_LAS bf16x8*)(lds + PG8_SA(b, h) + aoff + m * 2048 + k * 1024); } while (0)
#define PG8_LDB(dst, b, h) do { _Pragma("unroll") for (int n = 0; n < 2; ++n) _Pragma("unroll") for (int k = 0; k < 2; ++k) dst[n][k] = *(const PG8_LAS bf16x8*)(lds + PG8_SB(b, h) + boff + n * 2048 + k * 1024); } while (0)
#define PG8_MMA(ai, bj, At, Bt) do { __builtin_amdgcn_s_setprio(1); _Pragma("unroll") for (int m = 0; m < 4; ++m) _Pragma("unroll") for (int n = 0; n < 2; ++n) _Pragma("unroll") for (int k = 0; k < 2; ++k) \
        acc[ai][bj][m][n] = __builtin_amdgcn_mfma_f32_16x16x32_bf16(Bt[n][k], At[m][k], acc[ai][bj][m][n], 0, 0, 0); __builtin_amdgcn_s_setprio(0); } while (0)
#define PG8_WAIT_V(n) asm volatile("s_waitcnt vmcnt(" #n ")" ::: "memory")
#define PG8_WAIT_L(n) asm volatile("s_waitcnt lgkmcnt(" #n ")" ::: "memory")
#define PG8_BAR __builtin_amdgcn_s_barrier()
#define PG8_SCHED __builtin_amdgcn_sched_barrier(0)
    Unit cur, nxt; int ui = 0;
    if (!S.next(0, cur)) return;
    f32x4 acc[2][2][4][2];
#pragma unroll
    for (int a = 0; a < 2; ++a)
#pragma unroll
        for (int b = 0; b < 2; ++b)
#pragma unroll
            for (int m = 0; m < 4; ++m)
#pragma unroll
                for (int n = 0; n < 2; ++n) acc[a][b][m][n] = (f32x4){0.f, 0.f, 0.f, 0.f};
    bf16x8 At[4][2], B0[2][2], B1[2][2];
    const char* cA = (const char*)g.A + (size_t)cur.pm * tstep; const char* cB = (const char*)g.Bt + (size_t)cur.pn * tstep;
    S.a_ready(cur);
    PG8_STAGE(PG8_SB(0, 0), cB, voffB); PG8_STAGE(PG8_SA(0, 0), cA, voffA); PG8_STAGE(PG8_SB(0, 1), cB + hstep, voffB); PG8_STAGE(PG8_SA(0, 1), cA + hstep, voffA);
    if (wr == 1) PG8_BAR;
    PG8_WAIT_V(4); PG8_BAR;
    PG8_STAGE(PG8_SB(1, 0), cB + kstep, voffB); PG8_STAGE(PG8_SA(1, 0), cA + kstep, voffA); PG8_STAGE(PG8_SB(1, 1), cB + hstep + kstep, voffB);
    PG8_WAIT_V(6); PG8_BAR;
    PG8_STAMP();
    for (;;) {
        const bool has_next = S.next(ui + 1, nxt);
        const char* nA = has_next ? (const char*)g.A + (size_t)nxt.pm * tstep : cA; const char* nB = has_next ? (const char*)g.Bt + (size_t)nxt.pn * tstep : cB;
        for (int t = 0; t < nt; t += 2) {
            const bool last = (t == nt - 2);
            const char* a1 = cA + (size_t)(t + 1) * kstep;
            const char* a2 = last ? nA : cA + (size_t)(t + 2) * kstep; const char* b2 = last ? nB : cB + (size_t)(t + 2) * kstep;
            const char* a3 = a2 + kstep; const char* b3 = b2 + kstep;
            if (last && has_next) S.a_ready(nxt);
            PG8_LDB(B0, 0, 0); PG8_SCHED; PG8_LDA(At, 0, 0); PG8_STAGE(PG8_SA(1, 1), a1 + hstep, voffA);
            PG8_WAIT_L(8); PG8_BAR; PG8_WAIT_L(0); PG8_MMA(0, 0, At, B0); PG8_BAR; PG8_SCHED;
            PG8_LDB(B1, 0, 1); PG8_STAGE(PG8_SB(0, 0), b2, voffB);
            PG8_BAR; PG8_WAIT_L(0); PG8_MMA(0, 1, At, B1); PG8_BAR;
            PG8_LDA(At, 0, 1); PG8_STAGE(PG8_SA(0, 0), a2, voffA);
            PG8_BAR; PG8_WAIT_L(0); PG8_MMA(1, 0, At, B0); PG8_BAR; PG8_SCHED;
            PG8_STAGE(PG8_SB(0, 1), b2 + hstep, voffB);
            PG8_WAIT_V(6); PG8_BAR; PG8_MMA(1, 1, At, B1); PG8_BAR;
            PG8_LDB(B0, 1, 0); PG8_SCHED; PG8_LDA(At, 1, 0); PG8_STAGE(PG8_SA(0, 1), a2 + hstep, voffA);
            PG8_WAIT_L(8); PG8_BAR; PG8_WAIT_L(0); PG8_MMA(0, 0, At, B0); PG8_BAR; PG8_SCHED;
            PG8_LDB(B1, 1, 1); PG8_STAGE(PG8_SB(1, 0), b3, voffB);
            PG8_BAR; PG8_WAIT_L(0); PG8_MMA(0, 1, At, B1); PG8_BAR;
            PG8_LDA(At, 1, 1); PG8_STAGE(PG8_SA(1, 0), a3, voffA);
            PG8_BAR; PG8_WAIT_L(0); PG8_MMA(1, 0, At, B0); PG8_BAR; PG8_SCHED;
            PG8_STAGE(PG8_SB(1, 1), b3 + hstep, voffB);
            PG8_WAIT_V(6); PG8_BAR; PG8_MMA(1, 1, At, B1); PG8_BAR;
        }
        PG8_STAMP();
        if constexpr (!Epi::AFTER_DRAIN) { E(acc, cur, wr, wc, fr, fq); S.done(cur); }
        PG8_STAMP();
        if (!has_next) break;
#pragma unroll
        for (int a = 0; a < 2; ++a)
#pragma unroll
            for (int b = 0; b < 2; ++b)
#pragma unroll
                for (int m = 0; m < 4; ++m)
#pragma unroll
                    for (int n = 0; n < 2; ++n) acc[a][b][m][n] = (f32x4){0.f, 0.f, 0.f, 0.f};
        cur = nxt; cA = nA; cB = nB; ++ui;
    }
    PG8_WAIT_V(0);
    if (wr == 0) PG8_BAR;
    PG8_BAR;
    if constexpr (Epi::AFTER_DRAIN) { E.fused(acc, cur, wr, wc, fr, fq, lds, wid, lane); S.done(cur); }
    PG8_STAMP();
    if (STAMP && wid == 0) { stamps[lane] = lane < nts ? (((unsigned long long)(unsigned)ts_hi << 32) | (unsigned)ts_lo) : 0ull;
        if (lane == 62) stamps[62] = rt_entry; if (lane == 63) stamps[63] = (unsigned long long)wall_clock64(); }
#undef PG8_STAMP
#undef PG8_SA
#undef PG8_SB
#undef PG8_STAGE
#undef PG8_LDA
#undef PG8_LDB
#undef PG8_MMA
#undef PG8_WAIT_V
#undef PG8_WAIT_L
#undef PG8_BAR
#undef PG8_SCHED
}
}

#define XB_TMO      128
#define XB_XCNT(j)  (256  + 64 * (j))
#define XB_XSUB(j)  (1280 + 64 * (j))
#define XB_XGEN(j)  (2304 + 64 * (j))
#define XB_TOP      3328
#define XB_TOPGEN   3392
#define XCD_BAR_WORDS 3456
#define XB_SPIN_CAP (1u << 18)
#define LAS __attribute__((address_space(3)))

__device__ __forceinline__ unsigned xb_ld(unsigned* p)              { return __hip_atomic_load(p, __ATOMIC_RELAXED, __HIP_MEMORY_SCOPE_AGENT); }
__device__ __forceinline__ unsigned xb_add(unsigned* p, unsigned v) { return __hip_atomic_fetch_add(p, v, __ATOMIC_RELAXED, __HIP_MEMORY_SCOPE_AGENT); }
__device__ __forceinline__ unsigned xb_xcc_id() { return (unsigned)__builtin_amdgcn_s_getreg((3 << 11) | 20) & 0xFu; }
#define XB_SPIN(cond, bar) do { unsigned _sp = 0; while (cond) { __builtin_amdgcn_s_sleep(1); \
    if ((++_sp & 255u) == 0u) { if (xb_ld(&(bar)[XB_TMO])) break; if (_sp > XB_SPIN_CAP) { atomicAdd(&(bar)[XB_TMO], 1u); break; } } } } while (0)

struct XcdBarrier {
    unsigned* bar; unsigned x;
    volatile LAS unsigned* st;
};

__device__ __forceinline__ XcdBarrier xcd_barrier_post(unsigned* bar, volatile LAS unsigned* st) {
    XcdBarrier b; b.bar = bar; b.x = xb_xcc_id(); b.st = st;
    if (threadIdx.x == 0) (void)xb_add(&bar[XB_XCNT(b.x)], 1u);
    return b;
}
__device__ __forceinline__ void xcd_barrier_complete(unsigned* bar, unsigned x, unsigned& nloc, unsigned& nx) {
    const unsigned G = gridDim.x * gridDim.y * gridDim.z;
    unsigned sum, cnt, mine, sp = 0u;
    for (;;) {
        sum = 0u; cnt = 0u; mine = 0u;
#pragma unroll
        for (unsigned j = 0; j < 16; ++j) { const unsigned c = xb_ld(&bar[XB_XCNT(j)]); sum += c; cnt += (c > 0u) ? 1u : 0u; mine = (j == x) ? c : mine; }
        if (sum == G) break;
        __builtin_amdgcn_s_sleep(1);
        if ((++sp & 255u) == 0u) { if (xb_ld(&bar[XB_TMO])) break; if (sp > XB_SPIN_CAP) { atomicAdd(&bar[XB_TMO], 1u); break; } }
    }
    nloc = mine > 0u ? mine : 1u; nx = cnt > 0u ? cnt : 1u;
}

__device__ __forceinline__ void xcd_barrier(const XcdBarrier& b) {
    asm volatile("s_waitcnt vmcnt(0)" ::: "memory");
    __syncthreads();
    if (threadIdx.x == 0) {
        unsigned* bar = b.bar;
        __builtin_amdgcn_s_waitcnt(0);
        unsigned nloc = b.st[0], nx = b.st[1];
        if (nloc == 0u) { xcd_barrier_complete(bar, b.x, nloc, nx); b.st[0] = nloc; b.st[1] = nx; }
        const unsigned old = xb_add(&bar[XB_XSUB(b.x)], 1u);
        const unsigned gen = old / nloc;
        if (old + 1u == (gen + 1u) * nloc) {
            __builtin_amdgcn_fence(__ATOMIC_RELEASE, "agent");
            asm volatile("s_waitcnt vmcnt(0)" ::: "memory");
            const unsigned og = xb_add(&bar[XB_TOP], 1u);
            const unsigned tg = og / nx;
            if (og + 1u == (tg + 1u) * nx) xb_add(&bar[XB_TOPGEN], 1u);
            else XB_SPIN(xb_ld(&bar[XB_TOPGEN]) == tg, bar);
            __builtin_amdgcn_fence(__ATOMIC_ACQUIRE, "agent");
            xb_add(&bar[XB_XGEN(b.x)], 1u);
            asm volatile("s_waitcnt vmcnt(0)" ::: "memory");
        } else {
            XB_SPIN(xb_ld(&bar[XB_XGEN(b.x)]) == gen, bar);
            __builtin_amdgcn_fence(__ATOMIC_ACQUIRE, "agent");
            asm volatile("s_waitcnt vmcnt(0)" ::: "memory");
        }
    }
    __syncthreads();
}

using pg8::bf16_t; using pg8::f32x4; using pg8::u32x4; using pg8::Unit; using pg8::cvt_pk_bf16;
typedef unsigned u32x2 __attribute__((ext_vector_type(2)));

constexpr int DM = 2048, MTOK = 20480, NCTXR = 4096;
constexpr int LDS_BYTES = 147456;
constexpr int LDS_BAR_OFF = 131072;

enum { I_XP = 0, I_XS, I_S5RE, I_S5IM, I_SGLA, I_SRWKV, I_C, I_CCTX, I_NORMW, I_ADAW, I_ADAB, I_FNW, I_EWIN, I_EWOUT, I_LRE, I_LIM, I_LSTEP, I_BRE, I_BIM, I_CRE, I_CIM,
       I_S5D, I_GLUW, I_GLUB, I_DECUP, I_DECB, I_GNW, I_OWIN, I_OWOUT, I_MU, I_W0, I_W2, I_A0, I_A2, I_KK, I_KA, I_RK, I_LNXW, I_LNXB, N_IN };

struct Params { const float* in[N_IN]; float* out; unsigned char* ws; int ph_lo, ph_hi; };
typedef const float* cfptr_t;
__device__ __forceinline__ const float* pin(const Params&, int i) { int z; asm volatile("s_mov_b32 %0, 0" : "=s"(z));
    const __attribute__((address_space(4))) cfptr_t* kp = (const __attribute__((address_space(4))) cfptr_t*)__builtin_amdgcn_kernarg_segment_ptr(); return kp[i + z]; }

constexpr size_t OUT_Y = 0, OUT_S5RE = 41943040, OUT_S5IM = 42074112, OUT_GLA = 42205184, OUT_RWKV = 67371008, OUT_TOTAL = 71565312;
constexpr size_t WS_U = 0, WS_SG = 41943040, WS_Q = 83886080, WS_K = 146800640, WS_V = 209715200, WS_GG = 335544320, WS_DLR = 461373440,
                 WS_WT_E_IN = 463994880, WS_WT_E_OUT = 511180800, WS_WT_GLU = 527958016;
constexpr size_t WS_X1 = 0, WS_R = 167772160, WS_K1 = 251658240, WS_V1 = 335544320, WS_G1 = 419430400, WS_LR = 503316480, WS_WT_O_OUT = 519045120, WS_BON = 527433728;
constexpr size_t WS_SMALL = 533725184, WS_MOD = WS_SMALL, WS_POSTAB = WS_MOD + 245760, WS_BAR = WS_POSTAB + 262144, WS_W2T = WS_BAR + 16384, WS_A2T = WS_W2T + 786432, WS_END = WS_A2T + 786432;
static_assert(WS_END <= 536870912ull, "workspace map");
static_assert(WS_BON + 5242880 <= WS_SMALL, "workspace map");
constexpr size_t OY_WT_O_IN_B = 83886080;

__device__ __forceinline__ float bf2f(bf16_t b) { return __uint_as_float(((unsigned)b) << 16); }
__device__ __forceinline__ float bflo(unsigned w) { return __uint_as_float(w << 16); }
__device__ __forceinline__ float bfhi(unsigned w) { return __uint_as_float(w & 0xffff0000u); }
__device__ __forceinline__ bf16_t f2bf(float f) { return (bf16_t)(cvt_pk_bf16(f, 0.f) & 0xffffu); }
__device__ __forceinline__ float sigm(float x) { return 1.f / (1.f + __expf(-x)); }
__device__ __forceinline__ float silu(float x) { return x / (1.f + __expf(-x)); }
__device__ __forceinline__ float wave_sum(float v) {
#pragma unroll
    for (int o = 32; o >= 1; o >>= 1) v += __shfl_xor(v, o);
    return v;
}
__device__ __forceinline__ int row_ci(int row) { return row < NCTXR ? 0 : 1 + ((row - NCTXR) >> 12); }

#define P_MOD(p)    ((float*)((p).ws + WS_MOD))
#define P_POSTAB(p) ((float*)((p).ws + WS_POSTAB))

__device__ __forceinline__ f32x4 x0_load4(const Params& p, int row, int col) {
    if (row < NCTXR) return *(const f32x4*)(pin(p, I_XP) + (size_t)row * DM + col);
    const int rr = row - NCTXR, t = rr & 4095;
    const f32x4 a = *(const f32x4*)(pin(p, I_XS) + (size_t)rr * DM + col);
    const int pos = col < 1024 ? (t >> 6) : (t & 63);
    const f32x4 e = *(const f32x4*)(P_POSTAB(p) + pos * 1024 + (col & 1023));
    return a + e;
}

__device__ __forceinline__ void transpose_tiles(const float* src, int K, int N, bf16_t* dst, int Npad, LAS float* t, int rot) {
    const int tid = threadIdx.x, tk = K / 64, tn = Npad / 64, nwg = gridDim.x;
    for (int tile = (blockIdx.x + rot) % nwg; tile < tk * tn; tile += nwg) {
        const int kt = tile % tk, nt = tile / tk, k0 = kt * 64, n0 = nt * 64;
#pragma unroll
        for (int ps = 0; ps < 8; ++ps) { const int kk = ps * 8 + (tid >> 6), n = n0 + (tid & 63); t[kk * 65 + (tid & 63)] = (n < N) ? src[(size_t)(k0 + kk) * N + n] : 0.f; }
        __syncthreads();
        { const int nn = tid >> 3, kk0 = (tid & 7) * 8; float v[8];
#pragma unroll
          for (int i = 0; i < 8; ++i) v[i] = t[(kk0 + i) * 65 + nn];
          u32x4 o; o.x = cvt_pk_bf16(v[0], v[1]); o.y = cvt_pk_bf16(v[2], v[3]); o.z = cvt_pk_bf16(v[4], v[5]); o.w = cvt_pk_bf16(v[6], v[7]);
          *(u32x4*)(dst + (size_t)(n0 + nn) * K + k0 + kk0) = o; }
        __syncthreads();
    }
}

__device__ __forceinline__ void p0_prologue(const Params& p, LAS unsigned char* lds) {
    const int tid = threadIdx.x, wg = blockIdx.x, nwg = gridDim.x;
    {
        LAS float* sl = (LAS float*)lds;
        LAS float* red = (LAS float*)(lds + 40960);
        if (wg < 192 || nwg < 192) {
            for (int i = tid; i < 5 * 2048; i += 512) { const int ci = i >> 11, k = i & 2047; const float c = ci == 0 ? pin(p, I_CCTX)[k] : pin(p, I_C)[(ci - 1) * 2048 + k]; sl[i] = c / (1.f + expf(-c)); }
            __syncthreads();
            for (int blk = wg; blk < 192; blk += nwg) {
                const int l = blk / 96, nb = blk % 96, col = nb * 64 + (tid & 63), kg = tid >> 6;
                const float* W = pin(p, I_ADAW) + (size_t)l * 2048 * 6144 + col;
                float acc[5] = {0.f, 0.f, 0.f, 0.f, 0.f};
#pragma unroll 8
                for (int k = kg * 256; k < kg * 256 + 256; ++k) { const float w = W[(size_t)k * 6144];
#pragma unroll
                    for (int ci = 0; ci < 5; ++ci) acc[ci] += sl[ci * 2048 + k] * w; }
#pragma unroll
                for (int ci = 0; ci < 5; ++ci) red[(kg * 5 + ci) * 64 + (tid & 63)] = acc[ci];
                __syncthreads();
                if (tid < 320) { const int ci = tid >> 6, c = tid & 63; float s = 0.f;
#pragma unroll
                    for (int k2 = 0; k2 < 8; ++k2) s += red[(k2 * 5 + ci) * 64 + c];
                    P_MOD(p)[((size_t)l * 5 + ci) * 6144 + nb * 64 + c] = s + pin(p, I_ADAB)[l * 6144 + nb * 64 + c]; }
                __syncthreads();
            }
        }
    }
    __syncthreads();
    transpose_tiles(pin(p, I_EWIN), 2048, 11296, (bf16_t*)(p.ws + WS_WT_E_IN), 11520, (LAS float*)lds, 0);
    transpose_tiles(pin(p, I_EWOUT), 4096, 2048, (bf16_t*)(p.ws + WS_WT_E_OUT), 2048, (LAS float*)lds, 128);
    transpose_tiles(pin(p, I_GLUW), 1024, 1024, (bf16_t*)(p.ws + WS_WT_GLU), 1024, (LAS float*)lds, 64);
    const int gtid = wg * 512 + tid, gth = nwg * 512;
    for (int idx = gtid; idx < 64 * 512; idx += gth) { const int pos = idx >> 9, i = idx & 511;
        const float om = (float)(1.0 / pow(10000.0, (double)i / 512.0)); const float ang = (float)pos * om;
        P_POSTAB(p)[pos * 1024 + i] = (float)sin((double)ang); P_POSTAB(p)[pos * 1024 + 512 + i] = (float)cos((double)ang); }
    { float* AB = p.out + OUT_RWKV; float* BBRE = AB + 16384; float* BBIM = BBRE + 131072;
      for (int idx = gtid; idx < 2 * 64 * 64; idx += gth) {
        const double lr = pin(p, I_LRE)[idx], li = pin(p, I_LIM)[idx], dt = exp((double)pin(p, I_LSTEP)[idx >> 6]);
        const double mag = exp(lr * dt), abr = mag * cos(li * dt), abi = mag * sin(li * dt), den = lr * lr + li * li;
        const double fr = ((abr - 1.0) * lr + abi * li) / den, fi = (abi * lr - (abr - 1.0) * li) / den;
        AB[idx * 2] = (float)abr; AB[idx * 2 + 1] = (float)abi;
        for (int h = 0; h < 16; ++h) { const double br = pin(p, I_BRE)[idx * 16 + h], bi = pin(p, I_BIM)[idx * 16 + h];
            BBRE[idx * 16 + h] = (float)(fr * br - fi * bi); BBIM[idx * 16 + h] = (float)(fr * bi + fi * br); } } }
}

__device__ __forceinline__ void p1_h0(const Params& p) {
    const int lane = threadIdx.x & 63, gw = blockIdx.x * 8 + (threadIdx.x >> 6), nw = gridDim.x * 8;
    bf16_t* H0 = (bf16_t*)(p.out + OUT_GLA); const float* mod = P_MOD(p); const float* nwt = pin(p, I_NORMW);
    for (int row = gw; row < MTOK; row += nw) {
        const int ci = row_ci(row); f32x4 x[8]; float ss = 0.f;
#pragma unroll
        for (int it = 0; it < 4; ++it) { const int col = it * 512 + lane * 8; x[2 * it] = x0_load4(p, row, col); x[2 * it + 1] = x0_load4(p, row, col + 4);
#pragma unroll
            for (int j = 0; j < 4; ++j) ss += x[2 * it][j] * x[2 * it][j] + x[2 * it + 1][j] * x[2 * it + 1][j]; }
        ss = wave_sum(ss); const float rstd = rsqrtf(ss * (1.f / 2048.f) + 1e-6f);
        const float* sh = mod + (size_t)ci * 6144; const float* sc = sh + 2048;
#pragma unroll
        for (int it = 0; it < 4; ++it) { const int col = it * 512 + lane * 8; float h[8];
#pragma unroll
            for (int q = 0; q < 2; ++q) { const f32x4 w = *(const f32x4*)(nwt + col + 4 * q), s1 = *(const f32x4*)(sc + col + 4 * q), s0 = *(const f32x4*)(sh + col + 4 * q);
#pragma unroll
                for (int j = 0; j < 4; ++j) h[4 * q + j] = x[2 * it + q][j] * rstd * w[j] * (1.f + s1[j]) + s0[j]; }
            u32x4 o; o.x = cvt_pk_bf16(h[0], h[1]); o.y = cvt_pk_bf16(h[2], h[3]); o.z = cvt_pk_bf16(h[4], h[5]); o.w = cvt_pk_bf16(h[6], h[7]);
            *(u32x4*)(H0 + (size_t)row * DM + col) = o; }
    }
}

struct EpiProj0 {
    static constexpr bool PERM = true, AFTER_DRAIN = false;
    unsigned char* ws;
    __device__ __forceinline__ void operator()(const f32x4 (&acc)[2][2][4][2], const Unit& u, int wr, int wc, int fr, int fq) const {
        const int row0 = u.pm * 256 + wr * 64 + fr; const int colt = u.pn * 256;
        if (u.pn == 44) {
            if (wc == 0) { float* D = (float*)(ws + WS_DLR);
#pragma unroll
                for (int ai = 0; ai < 2; ++ai)
#pragma unroll
                    for (int m = 0; m < 4; ++m) { float* d = D + (size_t)(row0 + ai * 128 + m * 16) * 32 + 8 * fq; *(f32x4*)d = acc[ai][0][m][0]; *(f32x4*)(d + 4) = acc[ai][0][m][1]; } }
            return; }
        bf16_t* base; int ldc, c0;
        if (colt < 1024) { base = (bf16_t*)(ws + WS_U); ldc = 1024; c0 = colt; }
        else if (colt < 2048) { base = (bf16_t*)(ws + WS_SG); ldc = 1024; c0 = colt - 1024; }
        else if (colt < 3584) { base = (bf16_t*)(ws + WS_Q); ldc = 1536; c0 = colt - 2048; }
        else if (colt < 5120) { base = (bf16_t*)(ws + WS_K); ldc = 1536; c0 = colt - 3584; }
        else if (colt < 8192) { base = (bf16_t*)(ws + WS_V); ldc = 3072; c0 = colt - 5120; }
        else { base = (bf16_t*)(ws + WS_GG); ldc = 3072; c0 = colt - 8192; }
        const int col0 = c0 + wc * 32 + 8 * fq;
#pragma unroll
        for (int ai = 0; ai < 2; ++ai)
#pragma unroll
            for (int m = 0; m < 4; ++m) { bf16_t* rowp = base + (size_t)(row0 + ai * 128 + m * 16) * ldc + col0;
#pragma unroll
                for (int bj = 0; bj < 2; ++bj) { const f32x4 v0 = acc[ai][bj][m][0], v1 = acc[ai][bj][m][1];
                    u32x4 w; w.x = cvt_pk_bf16(v0[0], v0[1]); w.y = cvt_pk_bf16(v0[2], v0[3]); w.z = cvt_pk_bf16(v1[0], v1[1]); w.w = cvt_pk_bf16(v1[2], v1[3]);
                    *(u32x4*)(rowp + bj * 128) = w; } }
    }
};
struct EpiGlu {
    static constexpr bool PERM = true, AFTER_DRAIN = false;
    const bf16_t* GY; const bf16_t* SG; const float* glu_b; bf16_t* CAT;
    __device__ __forceinline__ void operator()(const f32x4 (&acc)[2][2][4][2], const Unit& u, int wr, int wc, int fr, int fq) const {
        const int row0 = u.pm * 256 + wr * 64 + fr, col0 = u.pn * 256 + wc * 32 + 8 * fq;
#pragma unroll
        for (int ai = 0; ai < 2; ++ai)
#pragma unroll
            for (int m = 0; m < 4; ++m) { const size_t row = (size_t)(row0 + ai * 128 + m * 16);
#pragma unroll
                for (int bj = 0; bj < 2; ++bj) { const int col = col0 + bj * 128;
                    const u32x4 g4 = *(const u32x4*)(GY + row * 1024 + col), s4 = *(const u32x4*)(SG + row * 1024 + col);
                    const f32x4 b0 = *(const f32x4*)(glu_b + col), b1 = *(const f32x4*)(glu_b + col + 4);
                    float o[8];
#pragma unroll
                    for (int j = 0; j < 4; ++j) { const float gy0 = (j & 1) ? bfhi(g4[j >> 1]) : bflo(g4[j >> 1]), sg0 = (j & 1) ? bfhi(s4[j >> 1]) : bflo(s4[j >> 1]);
                        const float gy1 = (j & 1) ? bfhi(g4[2 + (j >> 1)]) : bflo(g4[2 + (j >> 1)]), sg1 = (j & 1) ? bfhi(s4[2 + (j >> 1)]) : bflo(s4[2 + (j >> 1)]);
                        o[j] = gy0 * sigm(acc[ai][bj][m][0][j] + b0[j]) * silu(sg0); o[4 + j] = gy1 * sigm(acc[ai][bj][m][1][j] + b1[j]) * silu(sg1); }
                    u32x4 w; w.x = cvt_pk_bf16(o[0], o[1]); w.y = cvt_pk_bf16(o[2], o[3]); w.z = cvt_pk_bf16(o[4], o[5]); w.w = cvt_pk_bf16(o[6], o[7]);
                    *(u32x4*)(CAT + row * 4096 + col) = w; } }
    }
};
struct EpiRes {
    static constexpr bool PERM = false, AFTER_DRAIN = false;
    const float* xp; const float* xsm; const float* postab; const float* gatebase; const float* X1; int layer; float* xout;
    __device__ __forceinline__ void operator()(const f32x4 (&acc)[2][2][4][2], const Unit& u, int wr, int wc, int fr, int fq) const {
        const int row0 = u.pm * 256 + wr * 64 + fr, col0 = u.pn * 256 + wc * 32 + 4 * fq;
#pragma unroll
        for (int ai = 0; ai < 2; ++ai)
#pragma unroll
            for (int m = 0; m < 4; ++m) { const int row = row0 + ai * 128 + m * 16; const float* gate = gatebase + (size_t)row_ci(row) * 6144;
#pragma unroll
                for (int bj = 0; bj < 2; ++bj)
#pragma unroll
                    for (int n = 0; n < 2; ++n) { const int col = col0 + bj * 128 + n * 16;
                        f32x4 xi;
                        if (layer == 0) { if (row < NCTXR) xi = *(const f32x4*)(xp + (size_t)row * DM + col);
                            else { const int rr = row - NCTXR, t = rr & 4095, pos = col < 1024 ? (t >> 6) : (t & 63); xi = *(const f32x4*)(xsm + (size_t)rr * DM + col) + *(const f32x4*)(postab + pos * 1024 + (col & 1023)); } }
                        else xi = *(const f32x4*)(X1 + (size_t)row * DM + col);
                        const f32x4 g = *(const f32x4*)(gate + col);
                        *(f32x4*)(xout + (size_t)row * DM + col) = xi + g * acc[ai][bj][m][n]; } }
    }
};
struct EpiProj1 {
    static constexpr bool PERM = true, AFTER_DRAIN = false;
    unsigned char* ws;
    __device__ __forceinline__ void operator()(const f32x4 (&acc)[2][2][4][2], const Unit& u, int wr, int wc, int fr, int fq) const {
        const int row0 = u.pm * 256 + wr * 64 + fr;
        if (u.pn >= 32) { bf16_t* LR = (bf16_t*)(ws + WS_LR); const int cbase = (u.pn - 32) * 256 + wc * 32 + 8 * fq;
#pragma unroll
            for (int ai = 0; ai < 2; ++ai)
#pragma unroll
                for (int m = 0; m < 4; ++m) { const size_t row = (size_t)(row0 + ai * 128 + m * 16);
#pragma unroll
                    for (int bj = 0; bj < 2; ++bj) { const int col = cbase + bj * 128; if (col < 384) { f32x4 v0 = acc[ai][bj][m][0], v1 = acc[ai][bj][m][1];
                        if (col < 192) {
#pragma unroll
                            for (int j = 0; j < 4; ++j) { v0[j] = tanhf(v0[j]); v1[j] = tanhf(v1[j]); } }
                        u32x4 w; w.x = cvt_pk_bf16(v0[0], v0[1]); w.y = cvt_pk_bf16(v0[2], v0[3]); w.z = cvt_pk_bf16(v1[0], v1[1]); w.w = cvt_pk_bf16(v1[2], v1[3]);
                        *(u32x4*)(LR + row * 384 + col) = w; } } }
            return; }
        bf16_t* base = (bf16_t*)(ws + WS_R + (size_t)(u.pn >> 3) * 83886080ull); const int col0 = (u.pn & 7) * 256 + wc * 32 + 8 * fq;
#pragma unroll
        for (int ai = 0; ai < 2; ++ai)
#pragma unroll
            for (int m = 0; m < 4; ++m) { bf16_t* rowp = base + (size_t)(row0 + ai * 128 + m * 16) * DM + col0;
#pragma unroll
                for (int bj = 0; bj < 2; ++bj) { const f32x4 v0 = acc[ai][bj][m][0], v1 = acc[ai][bj][m][1];
                    u32x4 w; w.x = cvt_pk_bf16(v0[0], v0[1]); w.y = cvt_pk_bf16(v0[2], v0[3]); w.z = cvt_pk_bf16(v1[0], v1[1]); w.w = cvt_pk_bf16(v1[2], v1[3]);
                    *(u32x4*)(rowp + bj * 128) = w; } }
    }
};

__device__ __forceinline__ void seq_info(int s, int& base, int& L, int& b, bool& lat) { lat = s >= 16; b = lat ? s - 16 : s; base = lat ? NCTXR + b * 4096 : b * 256; L = lat ? 4096 : 256; }

__device__ __forceinline__ void s5_simple_item(const Params& p, int s, int g, int dir) {
    const int lane = threadIdx.x & 63; int base, L, b; bool lat; seq_info(s, base, L, b, lat);
    const float* AB = p.out + OUT_RWKV; const float* BBRE = AB + 16384; const float* BBIM = BBRE + 131072;
    const bf16_t* U = (const bf16_t*)(p.ws + WS_U); float* Y5 = p.out + OUT_Y + (size_t)dir * MTOK * 1024;
    const int sidx = (dir * 64 + g) * 64 + lane;
    const float ar = AB[sidx * 2], ai = AB[sidx * 2 + 1];
    float bbr[16], bbi[16], cr[16], cim[16];
#pragma unroll
    for (int h = 0; h < 16; ++h) { bbr[h] = BBRE[sidx * 16 + h]; bbi[h] = BBIM[sidx * 16 + h]; cr[h] = pin(p, I_CRE)[((dir * 64 + g) * 16 + h) * 64 + lane]; cim[h] = pin(p, I_CIM)[((dir * 64 + g) * 16 + h) * 64 + lane]; }
    float hr = 0.f, hi = 0.f;
    if (lat) { hr = pin(p, I_S5RE)[((b * 2 + dir) * 64 + g) * 64 + lane]; hi = pin(p, I_S5IM)[((b * 2 + dir) * 64 + g) * 64 + lane]; }
    const int t0 = dir ? L - 1 : 0, dtk = dir ? -1 : 1;
    const u32x4* up = (const u32x4*)(U + (size_t)(base + t0) * 1024 + g * 16);
    u32x4 ua = up[0], ub = up[1];
    for (int i = 0; i < L; ++i) {
        const int t = t0 + i * dtk; const size_t row = (size_t)(base + t);
        u32x4 na = ua, nb = ub;
        if (i + 1 < L) { const u32x4* np = (const u32x4*)(U + (size_t)(base + t + dtk) * 1024 + g * 16); na = np[0]; nb = np[1]; }
        float uu[16];
#pragma unroll
        for (int j = 0; j < 4; ++j) { uu[2 * j] = bflo(ua[j]); uu[2 * j + 1] = bfhi(ua[j]); uu[8 + 2 * j] = bflo(ub[j]); uu[8 + 2 * j + 1] = bfhi(ub[j]); }
        float bur = 0.f, bui = 0.f;
#pragma unroll
        for (int h = 0; h < 16; ++h) { bur += bbr[h] * uu[h]; bui += bbi[h] * uu[h]; }
        const float nr = ar * hr - ai * hi + bur, ni = ar * hi + ai * hr + bui; hr = nr; hi = ni;
        float z[16];
#pragma unroll
        for (int h = 0; h < 16; ++h) z[h] = hr * cr[h] - hi * cim[h];
        float z8[8], z4[4], z2[2], z1;
        { const bool up_ = lane & 32;
#pragma unroll
          for (int k = 0; k < 8; ++k) { const float keep = up_ ? z[k + 8] : z[k], send = up_ ? z[k] : z[k + 8]; z8[k] = keep + __shfl_xor(send, 32); } }
        { const bool up_ = lane & 16;
#pragma unroll
          for (int k = 0; k < 4; ++k) { const float keep = up_ ? z8[k + 4] : z8[k], send = up_ ? z8[k] : z8[k + 4]; z4[k] = keep + __shfl_xor(send, 16); } }
        { const bool up_ = lane & 8;
#pragma unroll
          for (int k = 0; k < 2; ++k) { const float keep = up_ ? z4[k + 2] : z4[k], send = up_ ? z4[k] : z4[k + 2]; z2[k] = keep + __shfl_xor(send, 8); } }
        { const bool up_ = lane & 4; const float keep = up_ ? z2[1] : z2[0], send = up_ ? z2[0] : z2[1]; z1 = keep + __shfl_xor(send, 4); }
        z1 += __shfl_xor(z1, 1); z1 += __shfl_xor(z1, 2);
        if ((lane & 3) == 0) { const int h = ((lane >> 5) & 1) * 8 + ((lane >> 4) & 1) * 4 + ((lane >> 3) & 1) * 2 + ((lane >> 2) & 1); Y5[row * 1024 + g * 16 + h] = z1; }
        ua = na; ub = nb;
    }
    if (!lat) { p.out[OUT_S5RE + ((b * 2 + dir) * 64 + g) * 64 + lane] = hr; p.out[OUT_S5IM + ((b * 2 + dir) * 64 + g) * 64 + lane] = hi; }
}
__device__ __forceinline__ void p_s5_simple(const Params& p) {
    const int wave = threadIdx.x >> 6, wg = blockIdx.x, nwg = gridDim.x;
    if (wave < 2) { for (int li = wg * 2 + wave; li < 512; li += nwg * 2) { const int b = li >> 7, g = (li >> 1) & 63, dir = li & 1; s5_simple_item(p, 16 + b, g, dir); } }
    else { for (int ci = wg * 6 + (wave - 2); ci < 2048; ci += nwg * 6) { const int b = ci >> 7, g = (ci >> 1) & 63, dir = ci & 1; s5_simple_item(p, b, g, dir); } }
}
__device__ __forceinline__ void p_s5_gelu(const Params& p) {
    bf16_t* U = (bf16_t*)(p.ws + WS_U); const float* Y5F = p.out + OUT_Y; const float* Y5B = Y5F + (size_t)MTOK * 1024; const float* dsk = pin(p, I_S5D);
    const size_t n8 = (size_t)MTOK * 1024 / 8;
    for (size_t i = (size_t)blockIdx.x * 512 + threadIdx.x; i < n8; i += (size_t)gridDim.x * 512) {
        const size_t e0 = i * 8; const int col = (int)(e0 & 1023);
        const u32x4 u4 = *(const u32x4*)(U + e0); float o[8];
#pragma unroll
        for (int q = 0; q < 2; ++q) { const f32x4 yf = *(const f32x4*)(Y5F + e0 + 4 * q), yb = *(const f32x4*)(Y5B + e0 + 4 * q), d4 = *(const f32x4*)(dsk + col + 4 * q);
#pragma unroll
            for (int j = 0; j < 4; ++j) { const unsigned w = u4[2 * q + (j >> 1)]; const float uu = (j & 1) ? bfhi(w) : bflo(w);
                const float y = d4[j] * uu + yf[j] + yb[j];
                o[4 * q + j] = 0.5f * y * (1.f + tanhf(0.7978845608028654f * (y + 0.044715f * y * y * y))); } }
        u32x4 w; w.x = cvt_pk_bf16(o[0], o[1]); w.y = cvt_pk_bf16(o[2], o[3]); w.z = cvt_pk_bf16(o[4], o[5]); w.w = cvt_pk_bf16(o[6], o[7]);
        *(u32x4*)(U + e0) = w;
    }
}

__device__ __forceinline__ void p_gla_simple(const Params& p, LAS unsigned char* lds) {
    const int tid = threadIdx.x, e = tid & 63, dg = tid >> 6, wg = blockIdx.x;
    LAS float* decb = (LAS float*)lds; LAS float* qb = decb + 512; LAS float* kb = qb + 512; LAS float* red = kb + 512;
    const bf16_t* Q = (const bf16_t*)(p.ws + WS_Q); const bf16_t* K = (const bf16_t*)(p.ws + WS_K); const bf16_t* V = (const bf16_t*)(p.ws + WS_V);
    const float* DLR = (const float*)(p.ws + WS_DLR); bf16_t* CAT = (bf16_t*)(p.out + OUT_Y);
    const int stride = wg < 192 ? 1000000 : 64;
    for (int u = wg; u < 960; u += stride) {
        int s, h, eb; if (u < 192) { s = 16 + u / 48; h = (u % 48) / 8; eb = u & 7; } else { const int v = u - 192; s = v / 48; h = (v % 48) / 8; eb = v & 7; }
        int base, L, b; bool lat; seq_info(s, base, L, b, lat);
        for (int dir = 0; dir < 2; ++dir) {
            float upw[16]; float bias = 0.f;
            if (tid < 256) {
#pragma unroll
                for (int r = 0; r < 16; ++r) upw[r] = pin(p, I_DECUP)[(size_t)(dir * 16 + r) * 1536 + h * 256 + tid];
                bias = pin(p, I_DECB)[dir * 1536 + h * 256 + tid]; }
            float S[32];
            const size_t sbase = ((size_t)((b * 2 + dir) * 6 + h) * 256 + dg * 32) * 512 + eb * 64 + e;
#pragma unroll
            for (int i = 0; i < 32; ++i) S[i] = lat ? pin(p, I_SGLA)[sbase + (size_t)i * 512] : 0.f;
            for (int i = 0; i < L; ++i) {
                const int t = dir ? L - 1 - i : i; const size_t row = (size_t)(base + t); const int pb = i & 1;
                if (tid < 256) {
                    const float* dl = DLR + row * 32 + dir * 16; float z = bias;
#pragma unroll
                    for (int r = 0; r < 16; ++r) z += dl[r] * upw[r];
                    const float ls = fminf(z, 0.f) - log1pf(expf(-fabsf(z)));
                    const float la = fmaxf(ls * 0.0625f, -1.f);
                    decb[pb * 256 + tid] = expf(la);
                    qb[pb * 256 + tid] = bf2f(Q[row * 1536 + h * 256 + tid]) * 0.0625f;
                    kb[pb * 256 + tid] = bf2f(K[row * 1536 + h * 256 + tid]);
                }
                const float ve = bf2f(V[row * 3072 + h * 512 + eb * 64 + e]);
                __syncthreads();
                float po = 0.f;
#pragma unroll
                for (int i2 = 0; i2 < 32; i2 += 4) {
                    const f32x4 d4 = *(LAS f32x4*)(decb + pb * 256 + dg * 32 + i2), q4 = *(LAS f32x4*)(qb + pb * 256 + dg * 32 + i2), k4 = *(LAS f32x4*)(kb + pb * 256 + dg * 32 + i2);
#pragma unroll
                    for (int j = 0; j < 4; ++j) { S[i2 + j] = S[i2 + j] * d4[j] + k4[j] * ve; po += q4[j] * S[i2 + j]; } }
                red[(pb * 8 + dg) * 64 + e] = po;
                __syncthreads();
                if (tid < 64) { float o = 0.f;
#pragma unroll
                    for (int g2 = 0; g2 < 8; ++g2) o += red[(pb * 8 + g2) * 64 + tid];
                    bf16_t* op = CAT + row * 4096 + 1024 + h * 512 + eb * 64 + tid; if (dir) o += bf2f(*op); *op = f2bf(o); }
            }
            if (!lat) {
#pragma unroll
                for (int i = 0; i < 32; ++i) p.out[OUT_GLA + sbase + (size_t)i * 512] = S[i]; }
            __syncthreads();
        }
    }
}
__device__ __forceinline__ void p_gla_norm(const Params& p) {
    const int lane = threadIdx.x & 63, gw = blockIdx.x * 8 + (threadIdx.x >> 6), nw = gridDim.x * 8;
    bf16_t* CAT = (bf16_t*)(p.out + OUT_Y); const bf16_t* GG = (const bf16_t*)(p.ws + WS_GG); const float* gnw = pin(p, I_GNW);
    for (int it = gw; it < MTOK * 6; it += nw) { const int row = it / 6, h = it % 6;
        bf16_t* op = CAT + (size_t)row * 4096 + 1024 + h * 512 + lane * 8; const u32x4 o4 = *(const u32x4*)op, g4 = *(const u32x4*)(GG + (size_t)row * 3072 + h * 512 + lane * 8);
        float o[8], g[8];
#pragma unroll
        for (int j = 0; j < 4; ++j) { o[2 * j] = bflo(o4[j]); o[2 * j + 1] = bfhi(o4[j]); g[2 * j] = bflo(g4[j]); g[2 * j + 1] = bfhi(g4[j]); }
        float ss = 0.f;
#pragma unroll
        for (int j = 0; j < 8; ++j) ss += o[j] * o[j];
        ss = wave_sum(ss); const float rstd = rsqrtf(ss * (1.f / 512.f) + 1e-6f);
        const f32x4 w0 = *(const f32x4*)(gnw + h * 512 + lane * 8), w1 = *(const f32x4*)(gnw + h * 512 + lane * 8 + 4);
        float r[8];
#pragma unroll
        for (int j = 0; j < 8; ++j) r[j] = o[j] * rstd * (j < 4 ? w0[j] : w1[j - 4]) * silu(g[j]);
        u32x4 w; w.x = cvt_pk_bf16(r[0], r[1]); w.y = cvt_pk_bf16(r[2], r[3]); w.z = cvt_pk_bf16(r[4], r[5]); w.w = cvt_pk_bf16(r[6], r[7]);
        *(u32x4*)op = w;
    }
}

__device__ __forceinline__ float xs_rstd(const Params& p, int row, int lane) {
    if (row < 0 || row >= MTOK) return 0.f;
    const float* X1 = (const float*)(p.ws + WS_X1) + (size_t)row * DM; float ss = 0.f;
#pragma unroll
    for (int it = 0; it < 8; ++it) { const f32x4 x = *(const f32x4*)(X1 + it * 256 + lane * 4);
#pragma unroll
        for (int j = 0; j < 4; ++j) ss += x[j] * x[j]; }
    ss = wave_sum(ss); return rsqrtf(ss * (1.f / 2048.f) + 1e-6f);
}
__device__ __forceinline__ void xs_h16(const Params& p, int row, float rstd, int lane, int hf, float (&h)[16]) {
    if (row < 0 || row >= MTOK) {
#pragma unroll
        for (int j = 0; j < 16; ++j) h[j] = 0.f;
        return; }
    const float* X1 = (const float*)(p.ws + WS_X1) + (size_t)row * DM; const float* mod = P_MOD(p) + ((size_t)5 + row_ci(row)) * 6144; const float* nwt = pin(p, I_NORMW) + 2048;
#pragma unroll
    for (int i2 = 0; i2 < 2; ++i2)
#pragma unroll
        for (int q = 0; q < 2; ++q) { const int col = (hf * 2 + i2) * 512 + lane * 8 + 4 * q;
            const f32x4 x = *(const f32x4*)(X1 + col), w = *(const f32x4*)(nwt + col), s0 = *(const f32x4*)(mod + col), s1 = *(const f32x4*)(mod + 2048 + col);
#pragma unroll
            for (int j = 0; j < 4; ++j) h[i2 * 8 + q * 4 + j] = x[j] * rstd * w[j] * (1.f + s1[j]) + s0[j]; }
}
__device__ __forceinline__ void p7_xs(const Params& p, LAS unsigned char* lds) {
    const int lane = threadIdx.x & 63, gw = blockIdx.x * 8 + (threadIdx.x >> 6), nw = gridDim.x * 8;
    bf16_t* XS = (bf16_t*)(p.out + OUT_Y); const float* mu = pin(p, I_MU);
    for (int item = gw; item < MTOK / 10; item += nw) {
        const int r0 = item * 10; LAS float* rs = (LAS float*)lds + (threadIdx.x >> 6) * 16;
#pragma unroll 1
        for (int k = 0; k < 12; ++k) { const float v = xs_rstd(p, r0 - 1 + k, lane); if (lane == 0) rs[k] = v; }
#pragma unroll 1
        for (int hf = 0; hf < 2; ++hf) {
            float hp[16], hc[16], hn[16];
            xs_h16(p, r0 - 1, rs[0], lane, hf, hp); xs_h16(p, r0, rs[1], lane, hf, hc);
#pragma unroll 1
            for (int k = 0; k < 10; ++k) { const int r = r0 + k;
                const int L = r < NCTXR ? 256 : 4096, tin = r < NCTXR ? (r & 255) : ((r - NCTXR) & 4095);
                const bool first = tin == 0, last = tin == L - 1;
                xs_h16(p, r + 1, rs[k + 2], lane, hf, hn);
#pragma unroll
                for (int i2 = 0; i2 < 2; ++i2) { const int col = (hf * 2 + i2) * 512 + lane * 8; float o[8];
#pragma unroll
                    for (int q = 0; q < 2; ++q) { const f32x4 m0 = *(const f32x4*)(mu + col + 4 * q), m1 = *(const f32x4*)(mu + 2048 + col + 4 * q);
#pragma unroll
                        for (int j = 0; j < 4; ++j) { const int kk = i2 * 8 + q * 4 + j; const float c = hc[kk], pv = first ? 0.f : hp[kk], nv = last ? 0.f : hn[kk];
                            o[q * 4 + j] = c + m0[j] * (pv - c) + m1[j] * (nv - c); } }
                    u32x4 w; w.x = cvt_pk_bf16(o[0], o[1]); w.y = cvt_pk_bf16(o[2], o[3]); w.z = cvt_pk_bf16(o[4], o[5]); w.w = cvt_pk_bf16(o[6], o[7]);
                    *(u32x4*)(XS + (size_t)r * DM + col) = w; }
#pragma unroll
                for (int j = 0; j < 16; ++j) { hp[j] = hc[j]; hc[j] = hn[j]; }
            }
        }
    }
    __syncthreads();
    transpose_tiles(pin(p, I_OWIN), 2048, 8576, (bf16_t*)((unsigned char*)(p.out + OUT_Y) + OY_WT_O_IN_B), 8704, (LAS float*)lds, 0);
    transpose_tiles(pin(p, I_OWOUT), 2048, 2048, (bf16_t*)(p.ws + WS_WT_O_OUT), 2048, (LAS float*)lds, 128);
}

template <int N> __device__ __forceinline__ float dppb(float x) { return __int_as_float(__builtin_amdgcn_update_dpp(0, __float_as_int(x), 0x150 + N, 0xf, 0xf, false)); }
__device__ __forceinline__ float red4(float x) { x += __shfl_xor(x, 16); x += __shfl_xor(x, 32); return x; }
#define RW16(X) X(0) X(1) X(2) X(3) X(4) X(5) X(6) X(7) X(8) X(9) X(10) X(11) X(12) X(13) X(14) X(15)

constexpr int RW_HALF_BYTES = 53248;
__device__ __forceinline__ void p9_rwkv(const Params& p, LAS unsigned char* lds) {
    const int tid = threadIdx.x, half = tid >> 8, htid = tid & 255, hw = (tid >> 6) & 3, lane = tid & 63, m = lane & 15, q = lane >> 4, wg = blockIdx.x, nwg = gridDim.x;
    LAS unsigned char* hl = lds + half * RW_HALF_BYTES;
    LAS bf16_t* W2L = (LAS bf16_t*)hl; LAS bf16_t* A2L = (LAS bf16_t*)(hl + 12288); LAS float* ARR = (LAS float*)(hl + 24576); LAS float* YO = (LAS float*)(hl + 49152);
    const bf16_t* R = (const bf16_t*)(p.ws + WS_R); const bf16_t* K1 = (const bf16_t*)(p.ws + WS_K1); const bf16_t* V1 = (const bf16_t*)(p.ws + WS_V1); const bf16_t* LR = (const bf16_t*)(p.ws + WS_LR);
    float* BON = (float*)(p.ws + WS_BON); bf16_t* YD = (bf16_t*)(p.out + OUT_Y);
    const int nun = half == 0 ? (256 - wg + nwg - 1) / nwg : (1024 - wg + nwg - 1) / nwg;
    const int bpu = half == 0 ? 256 : 16;
    const int my_steps = nun * bpu;
    const int n0 = (256 - wg + nwg - 1) / nwg * 256, n1 = (1024 - wg + nwg - 1) / nwg * 16;
    const int nsteps = n0 > n1 ? n0 : n1;
    float S[16];
    int base = 0, L = 0, b = 0, head = 0, dir = 0; bool lat = false;
    for (int step = 0; step < nsteps; ++step) {
        const bool active = step < my_steps; const int blk = step % bpu;
        if (active && blk == 0) {
            const int un = wg + (step / bpu) * nwg; int s;
            if (half == 0) { s = 16 + (un >> 6); head = (un >> 1) & 31; dir = un & 1; } else { s = un >> 6; head = (un >> 1) & 31; dir = un & 1; }
            seq_info(s, base, L, b, lat);
            for (int i = htid; i < 96 * 64; i += 256) { const int k = i >> 6, c = i & 63;
                W2L[i] = f2bf(pin(p, I_W2)[(size_t)(dir * 96 + k) * 2048 + head * 64 + c]); A2L[i] = f2bf(pin(p, I_A2)[(size_t)(dir * 96 + k) * 2048 + head * 64 + c]); }
            const size_t sb = ((size_t)((b * 2 + dir) * 32 + head) * 64 + hw * 16 + m) * 64 + q * 16;
#pragma unroll
            for (int n = 0; n < 16; ++n) S[n] = lat ? pin(p, I_SRWKV)[sb + n] : 0.f;
        }
        __syncthreads();
        if (active) {
            const int tok = htid >> 4, c4 = (htid & 15) * 4, tau = blk * 16 + tok, t = dir ? L - 1 - tau : tau; const size_t row = (size_t)(base + t);
            const int ch = head * 64 + c4;
            float dw[4] = {0.f, 0.f, 0.f, 0.f}, da[4] = {0.f, 0.f, 0.f, 0.f};
            const bf16_t* lrw = LR + row * 384 + dir * 96; const bf16_t* lra = lrw + 192;
#pragma unroll 1
            for (int k8 = 0; k8 < 96; k8 += 8) { const u32x4 tw = *(const u32x4*)(lrw + k8), ta = *(const u32x4*)(lra + k8);
#pragma unroll
                for (int j = 0; j < 8; ++j) { const float twj = (j & 1) ? bfhi(tw[j >> 1]) : bflo(tw[j >> 1]), taj = (j & 1) ? bfhi(ta[j >> 1]) : bflo(ta[j >> 1]);
                    const u32x2 w2v = *(LAS u32x2*)(W2L + (k8 + j) * 64 + c4), a2v = *(LAS u32x2*)(A2L + (k8 + j) * 64 + c4);
                    dw[0] += twj * bflo(w2v.x); dw[1] += twj * bfhi(w2v.x); dw[2] += twj * bflo(w2v.y); dw[3] += twj * bfhi(w2v.y);
                    da[0] += taj * bflo(a2v.x); da[1] += taj * bfhi(a2v.x); da[2] += taj * bflo(a2v.y); da[3] += taj * bfhi(a2v.y); } }
            const u32x2 r2 = *(const u32x2*)(R + row * DM + ch), k2 = *(const u32x2*)(K1 + row * DM + ch), v2 = *(const u32x2*)(V1 + row * DM + ch);
            const float rr[4] = {bflo(r2.x), bfhi(r2.x), bflo(r2.y), bfhi(r2.y)}, kk0[4] = {bflo(k2.x), bfhi(k2.x), bflo(k2.y), bfhi(k2.y)}, vv[4] = {bflo(v2.x), bfhi(v2.x), bflo(v2.y), bfhi(v2.y)};
            const f32x4 w0 = *(const f32x4*)(pin(p, I_W0) + dir * 2048 + ch), a0 = *(const f32x4*)(pin(p, I_A0) + dir * 2048 + ch), kkw = *(const f32x4*)(pin(p, I_KK) + ch), kaw = *(const f32x4*)(pin(p, I_KA) + ch), rkw = *(const f32x4*)(pin(p, I_RK) + ch);
            float kk[4], ss = 0.f;
#pragma unroll
            for (int j = 0; j < 4; ++j) { kk[j] = kk0[j] * kkw[j]; ss += kk[j] * kk[j]; }
            ss += __shfl_xor(ss, 1); ss += __shfl_xor(ss, 2); ss += __shfl_xor(ss, 4); ss += __shfl_xor(ss, 8);
            const float inv = 1.f / fmaxf(sqrtf(ss), 1e-12f);
            f32x4 oW, oA, oB, oK, oR, oV; float bon = 0.f;
#pragma unroll
            for (int j = 0; j < 4; ++j) {
                const float xw = -(w0[j] + dw[j]);
                const float sp = fmaxf(xw, 0.f) + log1pf(expf(-fabsf(xw)));
                const float wl = -sp - 0.5f; const float dec = expf(-expf(wl));
                const float a = 1.f / (1.f + expf(-(a0[j] + da[j])));
                const float kn = kk[j] * inv; const float kd = kk0[j] * (1.f + (a - 1.f) * kaw[j]);
                oW[j] = dec; oA[j] = -kn; oB[j] = kn * a; oK[j] = kd; oR[j] = rr[j]; oV[j] = vv[j];
                bon += rr[j] * kd * rkw[j]; }
            bon += __shfl_xor(bon, 1); bon += __shfl_xor(bon, 2); bon += __shfl_xor(bon, 4); bon += __shfl_xor(bon, 8);
            if ((htid & 15) == 0) BON[((size_t)dir * MTOK + row) * 32 + head] = bon;
            LAS float* ap = ARR + tok * 64 + c4;
            *(LAS f32x4*)(ap) = oW; *(LAS f32x4*)(ap + 1024) = oA; *(LAS f32x4*)(ap + 2048) = oB; *(LAS f32x4*)(ap + 3072) = oK; *(LAS f32x4*)(ap + 4096) = oR; *(LAS f32x4*)(ap + 5120) = oV;
        }
        __syncthreads();
        if (active) {
            for (int tau = 0; tau < 16; ++tau) {
                const float W = ARR[tau * 64 + lane], A = ARR[1024 + tau * 64 + lane], B = ARR[2048 + tau * 64 + lane], KD = ARR[3072 + tau * 64 + lane], RR = ARR[4096 + tau * 64 + lane];
                const float vi = ARR[5120 + tau * 64 + hw * 16 + m];
                float sa = 0.f;
#define RW_SA(n) sa += S[n] * dppb<n>(A);
                RW16(RW_SA)
#undef RW_SA
                sa = red4(sa);
                float yp = 0.f;
#define RW_UP(n) { const float s_ = S[n] * dppb<n>(W) + sa * dppb<n>(B) + vi * dppb<n>(KD); S[n] = s_; yp += s_ * dppb<n>(RR); }
                RW16(RW_UP)
#undef RW_UP
                yp = red4(yp);
                if (q == 0) YO[tau * 64 + hw * 16 + m] = yp;
            }
            if (blk == bpu - 1 && !lat) { const size_t sb = ((size_t)((b * 2 + dir) * 32 + head) * 64 + hw * 16 + m) * 64 + q * 16;
#pragma unroll
                for (int n = 0; n < 16; ++n) p.out[OUT_RWKV + sb + n] = S[n]; }
        }
        __syncthreads();
        if (active) {
            const int tok = htid >> 4, c4 = (htid & 15) * 4, tau = blk * 16 + tok, t = dir ? L - 1 - tau : tau; const size_t row = (size_t)(base + t);
            const f32x4 y = *(LAS f32x4*)(YO + tok * 64 + c4); u32x2 w; w.x = cvt_pk_bf16(y[0], y[1]); w.y = cvt_pk_bf16(y[2], y[3]);
            *(u32x2*)(YD + (size_t)dir * MTOK * DM + row * DM + head * 64 + c4) = w;
        }
    }
}
__device__ __forceinline__ void p10_combine(const Params& p) {
    const int lane = threadIdx.x & 63, gw = blockIdx.x * 8 + (threadIdx.x >> 6), nw = gridDim.x * 8;
    const bf16_t* YF = (const bf16_t*)(p.out + OUT_Y); const bf16_t* YB = YF + (size_t)MTOK * DM; const bf16_t* V1 = (const bf16_t*)(p.ws + WS_V1); const bf16_t* G1 = (const bf16_t*)(p.ws + WS_G1);
    const float* BON = (const float*)(p.ws + WS_BON); bf16_t* O1 = (bf16_t*)(p.ws + WS_R);
    for (int row = gw; row < MTOK; row += nw) {
#pragma unroll 2
        for (int it = 0; it < 8; ++it) { const int ch = it * 256 + lane * 4, head = ch >> 6; const size_t e = (size_t)row * DM + ch;
            const u32x2 f2 = *(const u32x2*)(YF + e), b2 = *(const u32x2*)(YB + e), v2 = *(const u32x2*)(V1 + e), g2 = *(const u32x2*)(G1 + e);
            float y[4] = {bflo(f2.x) + bflo(b2.x), bfhi(f2.x) + bfhi(b2.x), bflo(f2.y) + bflo(b2.y), bfhi(f2.y) + bfhi(b2.y)};
            const float vv[4] = {bflo(v2.x), bfhi(v2.x), bflo(v2.y), bfhi(v2.y)}, gg[4] = {bflo(g2.x), bfhi(g2.x), bflo(g2.y), bfhi(g2.y)};
            float s = y[0] + y[1] + y[2] + y[3]; s += __shfl_xor(s, 1); s += __shfl_xor(s, 2); s += __shfl_xor(s, 4); s += __shfl_xor(s, 8);
            const float mean = s * (1.f / 64.f); float v = 0.f;
#pragma unroll
            for (int j = 0; j < 4; ++j) { y[j] -= mean; v += y[j] * y[j]; }
            v += __shfl_xor(v, 1); v += __shfl_xor(v, 2); v += __shfl_xor(v, 4); v += __shfl_xor(v, 8);
            const float rstd = rsqrtf(v * (1.f / 64.f) + 64e-5f);
            const float bon = BON[(size_t)row * 32 + head] + BON[((size_t)MTOK + row) * 32 + head];
            const f32x4 lw = *(const f32x4*)(pin(p, I_LNXW) + ch), lb = *(const f32x4*)(pin(p, I_LNXB) + ch);
            float o[4];
#pragma unroll
            for (int j = 0; j < 4; ++j) o[j] = (y[j] * rstd * lw[j] + lb[j] + bon * vv[j]) * silu(gg[j]);
            u32x2 w; w.x = cvt_pk_bf16(o[0], o[1]); w.y = cvt_pk_bf16(o[2], o[3]); *(u32x2*)(O1 + e) = w; }
    }
}
__device__ __forceinline__ void p12_final(const Params& p) {
    const int lane = threadIdx.x & 63, gw = blockIdx.x * 8 + (threadIdx.x >> 6), nw = gridDim.x * 8; const float* fw = pin(p, I_FNW);
    for (int row = gw; row < MTOK; row += nw) { float* xr = p.out + OUT_Y + (size_t)row * DM; f32x4 x[8]; float ss = 0.f;
#pragma unroll
        for (int it = 0; it < 8; ++it) { x[it] = *(const f32x4*)(xr + it * 256 + lane * 4);
#pragma unroll
            for (int j = 0; j < 4; ++j) ss += x[it][j] * x[it][j]; }
        ss = wave_sum(ss); const float rstd = rsqrtf(ss * (1.f / 2048.f) + 1e-6f);
#pragma unroll
        for (int it = 0; it < 8; ++it) { const f32x4 w = *(const f32x4*)(fw + it * 256 + lane * 4); *(f32x4*)(xr + it * 256 + lane * 4) = x[it] * rstd * w; }
    }
}

constexpr int NPHASE = 15;
__global__ void __launch_bounds__(512, 2) mk_fwd(Params p) {
    extern __shared__ __attribute__((aligned(16))) unsigned char shm[];
    LAS unsigned char* lds = (LAS unsigned char*)shm;
    const int lo = p.ph_lo, hi = p.ph_hi;
    volatile LAS unsigned* st = (volatile LAS unsigned*)(lds + LDS_BAR_OFF);
    if (threadIdx.x == 0) { st[0] = 0u; st[1] = 0u; st[2] = 0u; st[3] = 0u; }
    __syncthreads();
    XcdBarrier bar; bar.bar = (unsigned*)(p.ws + WS_BAR); bar.x = 0; bar.st = st;
    if (hi - lo > 1) bar = xcd_barrier_post((unsigned*)(p.ws + WS_BAR), st);
#ifndef PHMASK
#define PHMASK 0x7fff
#endif
#define IN(k) (((PHMASK >> (k)) & 1) && lo <= (k) && (k) < hi)
#define SEAM(k) do { if (IN((k) + 1)) xcd_barrier(bar); } while (0)
    unsigned char* ws = p.ws;
    if (IN(0)) { p0_prologue(p, lds); SEAM(0); }
    if (IN(1)) { p1_h0(p); SEAM(1); }
    if (IN(2)) { pg8::Gemm g{(const bf16_t*)(p.out + OUT_GLA), (const bf16_t*)(ws + WS_WT_E_IN), MTOK, 11520, 2048}; pg8::StaticOrder S; S.init(MTOK, 11520, gridDim.x, blockIdx.x);
        EpiProj0 E{ws}; pg8::gemm_phase<EpiProj0, pg8::StaticOrder>(lds, g, S, E, nullptr); SEAM(2); }
    if (IN(3)) { p_s5_simple(p); SEAM(3); }
    if (IN(4)) { p_s5_gelu(p); SEAM(4); }
    if (IN(5)) { p_gla_simple(p, lds); SEAM(5); }
    if (IN(6)) { p_gla_norm(p); SEAM(6); }
    if (IN(7)) { pg8::Gemm g{(const bf16_t*)(ws + WS_U), (const bf16_t*)(ws + WS_WT_GLU), MTOK, 1024, 1024}; pg8::StaticOrder S; S.init(MTOK, 1024, gridDim.x, blockIdx.x);
        EpiGlu E{(const bf16_t*)(ws + WS_U), (const bf16_t*)(ws + WS_SG), pin(p, I_GLUB), (bf16_t*)(p.out + OUT_Y)}; pg8::gemm_phase<EpiGlu, pg8::StaticOrder>(lds, g, S, E, nullptr); SEAM(7); }
    if (IN(8)) { pg8::Gemm g{(const bf16_t*)(p.out + OUT_Y), (const bf16_t*)(ws + WS_WT_E_OUT), MTOK, 2048, 4096}; pg8::StaticOrder S; S.init(MTOK, 2048, gridDim.x, blockIdx.x);
        EpiRes E{pin(p, I_XP), pin(p, I_XS), P_POSTAB(p), P_MOD(p) + 4096, nullptr, 0, (float*)(ws + WS_X1)}; pg8::gemm_phase<EpiRes, pg8::StaticOrder>(lds, g, S, E, nullptr); SEAM(8); }
    if (IN(9)) { p7_xs(p, lds); SEAM(9); }
    if (IN(10)) { pg8::Gemm g{(const bf16_t*)(p.out + OUT_Y), (const bf16_t*)((unsigned char*)(p.out + OUT_Y) + OY_WT_O_IN_B), MTOK, 8704, 2048}; pg8::StaticOrder S; S.init(MTOK, 8704, gridDim.x, blockIdx.x);
        EpiProj1 E{ws}; pg8::gemm_phase<EpiProj1, pg8::StaticOrder>(lds, g, S, E, nullptr); SEAM(10); }
    if (IN(11)) { p9_rwkv(p, lds); SEAM(11); }
    if (IN(12)) { p10_combine(p); SEAM(12); }
    if (IN(13)) { pg8::Gemm g{(const bf16_t*)(ws + WS_R), (const bf16_t*)(ws + WS_WT_O_OUT), MTOK, 2048, 2048}; pg8::StaticOrder S; S.init(MTOK, 2048, gridDim.x, blockIdx.x);
        EpiRes E{nullptr, nullptr, nullptr, P_MOD(p) + 5 * 6144 + 4096, (const float*)(ws + WS_X1), 1, p.out + OUT_Y}; pg8::gemm_phase<EpiRes, pg8::StaticOrder>(lds, g, S, E, nullptr); SEAM(13); }
    if (IN(14)) { p12_final(p); }
#undef IN
#undef SEAM
}

#ifndef MK_FUSED
#define MK_FUSED 0
#endif
extern "C" void kernel_launch(void* const* d_in, const int* in_sizes, int n_in, void* d_out, int out_size, void* d_ws, size_t ws_size, hipStream_t stream) {
    static int grid = 0;
    if (grid == 0) {
        if (n_in != N_IN || out_size != (int)OUT_TOTAL || ws_size < WS_END) { fprintf(stderr, "kernel_launch: unexpected shapes: n_in %d out %d ws %zu; nothing launched\n", n_in, out_size, ws_size); grid = -1; return; }
        int dev = 0, cus = 0, per_cu = 0;
        if (hipGetDevice(&dev) != hipSuccess || hipDeviceGetAttribute(&cus, hipDeviceAttributeMultiprocessorCount, dev) != hipSuccess) { grid = -1; return; }
        if (hipFuncSetAttribute((const void*)mk_fwd, hipFuncAttributeMaxDynamicSharedMemorySize, LDS_BYTES) != hipSuccess) { fprintf(stderr, "kernel_launch: hipFuncSetAttribute failed\n"); grid = -1; return; }
        if (hipOccupancyMaxActiveBlocksPerMultiprocessor(&per_cu, (const void*)mk_fwd, 512, LDS_BYTES) != hipSuccess || per_cu < 1) fprintf(stderr, "kernel_launch: occupancy query reports %d per CU\n", per_cu);
        (void)hipGetLastError();
        if (cus != 256) { fprintf(stderr, "kernel_launch: built for 256 CUs, device has %d; nothing launched\n", cus); grid = -1; return; }
        grid = 256;
    }
    if (grid < 0) return;
    Params p; memset(&p, 0, sizeof(p));
    for (int i = 0; i < N_IN; ++i) p.in[i] = (const float*)d_in[i];
    p.out = (float*)d_out; p.ws = (unsigned char*)d_ws;
#if MK_FUSED
    (void)hipMemsetAsync((unsigned char*)d_ws + WS_BAR, 0, 16384, stream);
    p.ph_lo = 0; p.ph_hi = NPHASE;
    hipLaunchKernelGGL(mk_fwd, dim3(grid), dim3(512), LDS_BYTES, stream, p);
#else
    for (int k = 0; k < NPHASE; ++k) { p.ph_lo = k; p.ph_hi = k + 1; hipLaunchKernelGGL(mk_fwd, dim3(grid), dim3(512), LDS_BYTES, stream, p); }
#endif
}
```

```cpp
#include <hip/hip_runtime.h>
#include <cstdio>
#include <cstdint>
#include <cstring>
__device__ __forceinline__ int tidx() { int t = threadIdx.x; asm volatile("" : "+v"(t)); return t; }
typedef __bf16 mk_bf16x2_t __attribute__((ext_vector_type(2)));
typedef float mk_f32x2_t __attribute__((ext_vector_type(2)));
__device__ __forceinline__ unsigned cvtpk(float lo, float hi) { const mk_f32x2_t v = {lo, hi}; return __builtin_bit_cast(unsigned, __builtin_convertvector(v, mk_bf16x2_t)); }
namespace pg8 {
#define PG8_LAS __attribute__((address_space(3)))
typedef unsigned short bf16_t;
typedef short bf16x8 __attribute__((ext_vector_type(8)));
typedef float f32x4 __attribute__((ext_vector_type(4)));
typedef unsigned u32x4 __attribute__((ext_vector_type(4)));
constexpr int BM = 256, BK = 64, HALF = 128, HTB = HALF * BK * 2  , STAGE_BYTES = 8 * HTB, NXCD = 8, WGM = 8;

__host__ __device__ __forceinline__ int lds_byte(int r, int c) { const int st = (r >> 4) * 2 + (c >> 5), rr = r & 15, cc = c & 31, ob = rr * 64 + cc * 2; return st * 1024 + (ob ^ (((ob >> 9) & 1) << 5)); }
__host__ __device__ __forceinline__ void stage_rc(int b, int& R, int& C) { const int st = b / 1024, sb = b % 1024, swz = sb ^ (((sb >> 9) & 1) << 5); R = (st >> 1) * 16 + swz / 64; C = (st & 1) * 32 + (swz % 64) / 2; }
__host__ __device__ __forceinline__ int perm32(int rho) { const int n = rho >> 4, i = rho & 15; return 8 * (i >> 2) + 4 * n + (i & 3); }

struct Unit { int pm, pn, k0, nt, role, pair; };
struct Gemm { const bf16_t* A; const bf16_t* Bt; int M, N, K; };

struct StaticOrder {
    int nM, nN, nwg, G, c, split_round, split_nt; f32x4* part; unsigned* flags;
    __host__ __device__ void init(int M, int N, int G_, int c_) { nM = M / BM; nN = N / BM; nwg = nM * nN; G = G_; c = c_; split_round = -1; split_nt = 0; part = nullptr; flags = nullptr; }
    __host__ __device__ void set_split(int round, int K, f32x4* part_, unsigned* flags_) { split_round = round; split_nt = K / BK / 2; part = part_; flags = flags_; }
    __host__ __device__ bool next(int i, Unit& u) const {
        const bool sp = i == split_round; if (split_round >= 0 && i > split_round) return false;
        const int hc = sp ? c % (G / 2) : c, kh = sp ? c / (G / 2) : 0;
        const long L = (long)i * G + hc; if (L >= nwg) return false;
        u.k0 = kh * split_nt; u.nt = sp ? split_nt : 0; u.role = sp ? 1 + kh : 0; u.pair = hc;
        int wgid = (int)L; { const int q = nwg / NXCD, r = nwg % NXCD, xcd = wgid % NXCD, off = wgid / NXCD; wgid = (xcd < r ? xcd * (q + 1) : r * (q + 1) + (xcd - r) * q) + off; }
        const int nig = WGM * nN, gid = wgid / nig, fm = gid * WGM, gsz = (nM - fm) < WGM ? (nM - fm) : WGM;
        u.pm = fm + ((wgid % nig) % gsz); u.pn = (wgid % nig) / gsz; return true;
    }
    __device__ __forceinline__ void dump(const f32x4 (&acc)[2][2][4][2], const Unit& u, int wid, int lane) const {
        float* dst = (float*)part + ((size_t)(u.pair * 8 + wid) * 128) * 64 + lane;
#pragma unroll
        for (int a = 0; a < 2; ++a)
#pragma unroll
            for (int b = 0; b < 2; ++b)
#pragma unroll
                for (int m = 0; m < 4; ++m)
#pragma unroll
                    for (int n = 0; n < 2; ++n)
#pragma unroll
                        for (int e = 0; e < 4; ++e) __hip_atomic_store(dst + ((((a * 2 + b) * 4 + m) * 2 + n) * 4 + e) * 64, acc[a][b][m][n][e], __ATOMIC_RELAXED, __HIP_MEMORY_SCOPE_AGENT);
        __builtin_amdgcn_fence(__ATOMIC_RELEASE, "workgroup");
        if (lane == 0) __hip_atomic_fetch_add(flags + u.pair, 1u, __ATOMIC_RELAXED, __HIP_MEMORY_SCOPE_AGENT);
    }
    __device__ __forceinline__ void fetch_add(f32x4 (&acc)[2][2][4][2], const Unit& u, int wid, int lane) const {
        while (__hip_atomic_load(flags + u.pair, __ATOMIC_RELAXED, __HIP_MEMORY_SCOPE_AGENT) < 8u) __builtin_amdgcn_s_sleep(2);
        __builtin_amdgcn_fence(__ATOMIC_ACQUIRE, "workgroup");
        const float* src = (const float*)part + ((size_t)(u.pair * 8 + wid) * 128) * 64 + lane;
#pragma unroll
        for (int a = 0; a < 2; ++a)
#pragma unroll
            for (int b = 0; b < 2; ++b)
#pragma unroll
                for (int m = 0; m < 4; ++m)
#pragma unroll
                    for (int n = 0; n < 2; ++n)
#pragma unroll
                        for (int e = 0; e < 4; ++e) acc[a][b][m][n][e] += __hip_atomic_load(src + ((((a * 2 + b) * 4 + m) * 2 + n) * 4 + e) * 64, __ATOMIC_RELAXED, __HIP_MEMORY_SCOPE_AGENT);
    }
    __device__ __forceinline__ void a_ready(const Unit&) const {}
    __device__ __forceinline__ void done(const Unit&) const {}
};
__device__ __forceinline__ unsigned cvt_pk_bf16(float lo, float hi) { unsigned r; asm volatile("v_cvt_pk_bf16_f32 %0, %1, %2" : "=v"(r) : "v"(lo), "v"(hi)); return r; }
template <class Epi, class Sched, bool STAMP = false>
__device__ __forceinline__ void gemm_phase(PG8_LAS unsigned char* lds, const Gemm g, const Sched& S, const Epi& E, unsigned long long* stamps) {
    const int tid = tidx(), wid = __builtin_amdgcn_readfirstlane(tid >> 6), lane = tid & 63, wr = wid >> 2, wc = wid & 3, fr = lane & 15, fq = lane >> 4;
    const int K = g.K, nt = K / BK;
    int ts_lo = 0, ts_hi = 0, nts = 0; const unsigned long long rt_entry = STAMP ? (unsigned long long)wall_clock64() : 0ull;
#define PG8_STAMP() do { if (STAMP && wid == 0 && nts < 64) { const unsigned long long _c = (unsigned long long)clock64(); \
        ts_lo = (lane == nts) ? (int)(unsigned)_c : ts_lo; ts_hi = (lane == nts) ? (int)(unsigned)(_c >> 32) : ts_hi; ++nts; } } while (0)
    PG8_STAMP();
    unsigned voffA[2], voffB[2];
#pragma unroll
    for (int i = 0; i < 2; ++i) { int R, C; stage_rc(tid * 16 + i * 8192, R, C); const int Rb = Epi::PERM ? ((R & ~31) + perm32(R & 31)) : R;
        voffA[i] = (unsigned)(R * K + C) * 2u; voffB[i] = (unsigned)(Rb * K + C) * 2u; }
    const size_t kstep = (size_t)(BK * 2);
    const size_t hstep = (size_t)HALF * K * 2;
    const size_t tstep = 2 * hstep;
    const unsigned ldsw = (unsigned)wid * 1024u;
    const int aoff = lds_byte(wr * 64 + fr, fq * 8), boff = lds_byte(wc * 32 + fr, fq * 8);
#define PG8_SA(b, h) (((b) * 2 + (h)) * HTB)
#define PG8_SB(b, h) ((4 + (b) * 2 + (h)) * HTB)
#define PG8_STAGE(bufoff, gbase, voff) do { _Pragma("unroll") for (int _i = 0; _i < 2; ++_i) \
        __builtin_amdgcn_global_load_lds((const unsigned*)((const char*)(gbase) + (voff)[_i]), (PG8_LAS unsigned*)(lds + (bufoff) + ldsw + _i * 8192), 16, 0, 0); } while (0)
#define PG8_LDA(dst, b, h) do { _Pragma("unroll") for (int m = 0; m < 4; ++m) _Pragma("unroll") for (int k = 0; k < 2; ++k) dst[m][k] = *(const PG8_LAS bf16x8*)(lds + PG8_SA(b, h) + aoff + m * 2048 + k * 1024); } while (0)
#define PG8_LDB(dst, b, h) do { _Pragma("unroll") for (int n = 0; n < 2; ++n) _Pragma("unroll") for (int k = 0; k < 2; ++k) dst[n][k] = *(const PG8_LAS bf16x8*)(lds + PG8_SB(b, h) + boff + n * 2048 + k * 1024); } while (0)
#define PG8_MMA(ai, bj, At, Bt) do { __builtin_amdgcn_s_setprio(1); _Pragma("unroll") for (int m = 0; m < 4; ++m) _Pragma("unroll") for (int n = 0; n < 2; ++n) _Pragma("unroll") for (int k = 0; k < 2; ++k) \
        acc[ai][bj][m][n] = __builtin_amdgcn_mfma_f32_16x16x32_bf16(Bt[n][k], At[m][k], acc[ai][bj][m][n], 0, 0, 0); __builtin_amdgcn_s_setprio(0); } while (0)
#define PG8_WAIT_V(n) asm volatile("s_waitcnt vmcnt(" #n ")" ::: "memory")
#define PG8_WAIT_L(n) asm volatile("s_waitcnt lgkmcnt(" #n ")" ::: "memory")
#define PG8_BAR __builtin_amdgcn_s_barrier()
#define PG8_SCHED __builtin_amdgcn_sched_barrier(0)
    Unit cur, nxt; int ui = 0;
    if (!S.next(0, cur)) return;
    f32x4 acc[2][2][4][2];
#pragma unroll
    for (int a = 0; a < 2; ++a)
#pragma unroll
        for (int b = 0; b < 2; ++b)
#pragma unroll
            for (int m = 0; m < 4; ++m)
#pragma unroll
                for (int n = 0; n < 2; ++n) acc[a][b][m][n] = (f32x4){0.f, 0.f, 0.f, 0.f};
    bf16x8 At[4][2], B0[2][2], B1[2][2];
    const char* cA = (const char*)g.A + (size_t)cur.pm * tstep + (size_t)cur.k0 * kstep; const char* cB = (const char*)g.Bt + (size_t)cur.pn * tstep + (size_t)cur.k0 * kstep;
    S.a_ready(cur);
    PG8_STAGE(PG8_SB(0, 0), cB, voffB); PG8_STAGE(PG8_SA(0, 0), cA, voffA); PG8_STAGE(PG8_SB(0, 1), cB + hstep, voffB); PG8_STAGE(PG8_SA(0, 1), cA + hstep, voffA);
    if (wr == 1) PG8_BAR;
    PG8_WAIT_V(4); PG8_BAR;
    PG8_STAGE(PG8_SB(1, 0), cB + kstep, voffB); PG8_STAGE(PG8_SA(1, 0), cA + kstep, voffA); PG8_STAGE(PG8_SB(1, 1), cB + hstep + kstep, voffB);
    PG8_WAIT_V(6); PG8_BAR;
    PG8_STAMP();
    for (;;) {
        const bool has_next = S.next(ui + 1, nxt);
        const char* nA = has_next ? (const char*)g.A + (size_t)nxt.pm * tstep + (size_t)nxt.k0 * kstep : cA; const char* nB = has_next ? (const char*)g.Bt + (size_t)nxt.pn * tstep + (size_t)nxt.k0 * kstep : cB;
        const int cnt = cur.nt ? cur.nt : nt;
        for (int t = 0; t < cnt; t += 2) {
            const bool last = (t == cnt - 2);
            const char* a1 = cA + (size_t)(t + 1) * kstep;
            const char* a2 = last ? nA : cA + (size_t)(t + 2) * kstep; const char* b2 = last ? nB : cB + (size_t)(t + 2) * kstep;
            const char* a3 = a2 + kstep; const char* b3 = b2 + kstep;
            if (last && has_next) S.a_ready(nxt);
            PG8_LDB(B0, 0, 0); PG8_SCHED; PG8_LDA(At, 0, 0); PG8_STAGE(PG8_SA(1, 1), a1 + hstep, voffA);
            PG8_WAIT_L(8); PG8_BAR; PG8_WAIT_L(0); PG8_MMA(0, 0, At, B0); PG8_BAR; PG8_SCHED;
            PG8_LDB(B1, 0, 1); PG8_STAGE(PG8_SB(0, 0), b2, voffB);
            PG8_BAR; PG8_WAIT_L(0); PG8_MMA(0, 1, At, B1); PG8_BAR;
            PG8_LDA(At, 0, 1); PG8_STAGE(PG8_SA(0, 0), a2, voffA);
            PG8_BAR; PG8_WAIT_L(0); PG8_MMA(1, 0, At, B0); PG8_BAR; PG8_SCHED;
            PG8_STAGE(PG8_SB(0, 1), b2 + hstep, voffB);
            PG8_WAIT_V(6); PG8_BAR; PG8_MMA(1, 1, At, B1); PG8_BAR;
            PG8_LDB(B0, 1, 0); PG8_SCHED; PG8_LDA(At, 1, 0); PG8_STAGE(PG8_SA(0, 1), a2 + hstep, voffA);
            PG8_WAIT_L(8); PG8_BAR; PG8_WAIT_L(0); PG8_MMA(0, 0, At, B0); PG8_BAR; PG8_SCHED;
            PG8_LDB(B1, 1, 1); PG8_STAGE(PG8_SB(1, 0), b3, voffB);
            PG8_BAR; PG8_WAIT_L(0); PG8_MMA(0, 1, At, B1); PG8_BAR;
            PG8_LDA(At, 1, 1); PG8_STAGE(PG8_SA(1, 0), a3, voffA);
            PG8_BAR; PG8_WAIT_L(0); PG8_MMA(1, 0, At, B0); PG8_BAR; PG8_SCHED;
            PG8_STAGE(PG8_SB(1, 1), b3 + hstep, voffB);
            PG8_WAIT_V(6); PG8_BAR; PG8_MMA(1, 1, At, B1); PG8_BAR;
        }
        PG8_STAMP();
        if constexpr (!Epi::AFTER_DRAIN) { if (cur.role == 2) S.dump(acc, cur, wid, lane); else { if (cur.role == 1) S.fetch_add(acc, cur, wid, lane); E(acc, cur, wr, wc, fr, fq); } S.done(cur); }
        PG8_STAMP();
        if (!has_next) break;
#pragma unroll
        for (int a = 0; a < 2; ++a)
#pragma unroll
            for (int b = 0; b < 2; ++b)
#pragma unroll
                for (int m = 0; m < 4; ++m)
#pragma unroll
                    for (int n = 0; n < 2; ++n) acc[a][b][m][n] = (f32x4){0.f, 0.f, 0.f, 0.f};
        cur = nxt; cA = nA; cB = nB; ++ui;
    }
    PG8_WAIT_V(0);
    if (wr == 0) PG8_BAR;
    PG8_BAR;
    if constexpr (Epi::AFTER_DRAIN) { E.fused(acc, cur, wr, wc, fr, fq, lds, wid, lane); S.done(cur); }
    PG8_STAMP();
    if (STAMP && wid == 0) { stamps[lane] = lane < nts ? (((unsigned long long)(unsigned)ts_hi << 32) | (unsigned)ts_lo) : 0ull;
        if (lane == 62) stamps[62] = rt_entry; if (lane == 63) stamps[63] = (unsigned long long)wall_clock64(); }
#undef PG8_STAMP
#undef PG8_SA
#undef PG8_SB
#undef PG8_STAGE
#undef PG8_LDA
#undef PG8_LDB
#undef PG8_MMA
#undef PG8_WAIT_V
#undef PG8_WAIT_L
#undef PG8_BAR
#undef PG8_SCHED
}
}

#define XB_TMO      128
#define XB_XCNT(j)  (256  + 64 * (j))
#define XB_XSUB(j)  (1280 + 64 * (j))
#define XB_XGEN(j)  (2304 + 64 * (j))
#define XB_TOP      3328
#define XB_TOPGEN   3392
#define XCD_BAR_WORDS 3456
#define XB_SPIN_CAP (1u << 18)
#define LAS __attribute__((address_space(3)))

__device__ __forceinline__ unsigned xb_ld(unsigned* p)              { return __hip_atomic_load(p, __ATOMIC_RELAXED, __HIP_MEMORY_SCOPE_AGENT); }
__device__ __forceinline__ unsigned xb_add(unsigned* p, unsigned v) { return __hip_atomic_fetch_add(p, v, __ATOMIC_RELAXED, __HIP_MEMORY_SCOPE_AGENT); }
__device__ __forceinline__ unsigned xb_xcc_id() { return (unsigned)__builtin_amdgcn_s_getreg((3 << 11) | 20) & 0xFu; }
#define XB_SPIN(cond, bar) do { unsigned _sp = 0; while (cond) { __builtin_amdgcn_s_sleep(1); \
    if ((++_sp & 255u) == 0u) { if (xb_ld(&(bar)[XB_TMO])) break; if (_sp > XB_SPIN_CAP) { atomicAdd(&(bar)[XB_TMO], 1u); break; } } } } while (0)

struct XcdBarrier {
    unsigned* bar; unsigned x;
    volatile LAS unsigned* st;
};

__device__ __forceinline__ XcdBarrier xcd_barrier_post(unsigned* bar, volatile LAS unsigned* st) {
    XcdBarrier b; b.bar = bar; b.x = xb_xcc_id(); b.st = st;
    if (threadIdx.x == 0) (void)xb_add(&bar[XB_XCNT(b.x)], 1u);
    return b;
}
__device__ __forceinline__ void xcd_barrier_complete(unsigned* bar, unsigned x, unsigned& nloc, unsigned& nx) {
    const unsigned G = gridDim.x * gridDim.y * gridDim.z;
    unsigned sum, cnt, mine, sp = 0u;
    for (;;) {
        sum = 0u; cnt = 0u; mine = 0u;
#pragma unroll
        for (unsigned j = 0; j < 16; ++j) { const unsigned c = xb_ld(&bar[XB_XCNT(j)]); sum += c; cnt += (c > 0u) ? 1u : 0u; mine = (j == x) ? c : mine; }
        if (sum == G) break;
        __builtin_amdgcn_s_sleep(1);
        if ((++sp & 255u) == 0u) { if (xb_ld(&bar[XB_TMO])) break; if (sp > XB_SPIN_CAP) { atomicAdd(&bar[XB_TMO], 1u); break; } }
    }
    nloc = mine > 0u ? mine : 1u; nx = cnt > 0u ? cnt : 1u;
}

__device__ __forceinline__ void xcd_barrier(const XcdBarrier& b) {
    asm volatile("s_waitcnt vmcnt(0)" ::: "memory");
    __syncthreads();
    if (threadIdx.x == 0) {
        unsigned* bar = b.bar;
        __builtin_amdgcn_s_waitcnt(0);
        unsigned nloc = b.st[0], nx = b.st[1];
        if (nloc == 0u) { xcd_barrier_complete(bar, b.x, nloc, nx); b.st[0] = nloc; b.st[1] = nx; }
        const unsigned old = xb_add(&bar[XB_XSUB(b.x)], 1u);
        const unsigned gen = old / nloc;
        if (old + 1u == (gen + 1u) * nloc) {
            __builtin_amdgcn_fence(__ATOMIC_RELEASE, "agent");
            asm volatile("s_waitcnt vmcnt(0)" ::: "memory");
            const unsigned og = xb_add(&bar[XB_TOP], 1u);
            const unsigned tg = og / nx;
            if (og + 1u == (tg + 1u) * nx) xb_add(&bar[XB_TOPGEN], 1u);
            else XB_SPIN(xb_ld(&bar[XB_TOPGEN]) == tg, bar);
            __builtin_amdgcn_fence(__ATOMIC_ACQUIRE, "agent");
            xb_add(&bar[XB_XGEN(b.x)], 1u);
            asm volatile("s_waitcnt vmcnt(0)" ::: "memory");
        } else {
            XB_SPIN(xb_ld(&bar[XB_XGEN(b.x)]) == gen, bar);
            __builtin_amdgcn_fence(__ATOMIC_ACQUIRE, "agent");
            asm volatile("s_waitcnt vmcnt(0)" ::: "memory");
        }
    }
    __syncthreads();
}

using pg8::bf16_t; using pg8::f32x4; using pg8::u32x4; using pg8::Unit; using pg8::cvt_pk_bf16;
typedef unsigned u32x2 __attribute__((ext_vector_type(2)));

constexpr int DM = 2048, MTOK = 20480, NCTXR = 4096;
constexpr int LDS_BYTES = 163840;
constexpr int LDS_BAR_OFF = 163824;

enum { I_XP = 0, I_XS, I_S5RE, I_S5IM, I_SGLA, I_SRWKV, I_C, I_CCTX, I_NORMW, I_ADAW, I_ADAB, I_FNW, I_EWIN, I_EWOUT, I_LRE, I_LIM, I_LSTEP, I_BRE, I_BIM, I_CRE, I_CIM,
       I_S5D, I_GLUW, I_GLUB, I_DECUP, I_DECB, I_GNW, I_OWIN, I_OWOUT, I_MU, I_W0, I_W2, I_A0, I_A2, I_KK, I_KA, I_RK, I_LNXW, I_LNXB, N_IN };

struct Params { const float* in[N_IN]; float* out; unsigned char* ws; int ph_lo, ph_hi; };
typedef const float* cfptr_t;
__device__ __forceinline__ const float* pin(const Params&, int i) { int z; asm volatile("s_mov_b32 %0, 0" : "=s"(z));
    const __attribute__((address_space(4))) cfptr_t* kp = (const __attribute__((address_space(4))) cfptr_t*)__builtin_amdgcn_kernarg_segment_ptr(); return kp[i + z]; }

constexpr size_t OUT_Y = 0, OUT_S5RE = 41943040, OUT_S5IM = 42074112, OUT_GLA = 42205184, OUT_RWKV = 67371008, OUT_TOTAL = 71565312;
constexpr size_t WS_U = 0, WS_SG = 41943040, WS_Q = 83886080, WS_K = 146800640, WS_V = 209715200, WS_GG = 335544320, WS_DLR = 461373440,
                 WS_WT_E_IN = 463994880, WS_WT_E_OUT = 511180800, WS_WT_GLU = 527958016;
constexpr size_t WS_X1 = 0, WS_R = 167772160, WS_K1 = 251658240, WS_V1 = 335544320, WS_G1 = 419430400, WS_LR = 503316480, WS_WT_O_OUT = 519045120, WS_BON = 527433728;
constexpr size_t WS_SMALL = 533725184, WS_MOD = WS_SMALL, WS_POSTAB = WS_MOD + 245760, WS_BAR = WS_POSTAB + 262144, WS_W2T = WS_BAR + 16384, WS_A2T = WS_W2T + 786432, WS_END = WS_A2T + 786432;
static_assert(WS_END <= 536870912ull, "workspace map");
static_assert(WS_BON + 5242880 <= WS_SMALL, "workspace map");
constexpr size_t OY_WT_O_IN_B = 83886080;

__device__ __forceinline__ float bf2f(bf16_t b) { return __uint_as_float(((unsigned)b) << 16); }
__device__ __forceinline__ float bflo(unsigned w) { return __uint_as_float(w << 16); }
__device__ __forceinline__ float bfhi(unsigned w) { return __uint_as_float(w & 0xffff0000u); }
__device__ __forceinline__ bf16_t f2bf(float f) { return (bf16_t)(cvtpk(f, 0.f) & 0xffffu); }
__device__ __forceinline__ float sigm(float x) { return __builtin_amdgcn_rcpf(1.f + __builtin_amdgcn_exp2f(-1.4426950409f * x)); }
__device__ __forceinline__ float silu(float x) { return x * __builtin_amdgcn_rcpf(1.f + __builtin_amdgcn_exp2f(-1.4426950409f * x)); }
__device__ __forceinline__ float ftanh(float x) { return 1.f - 2.f * __builtin_amdgcn_rcpf(1.f + __builtin_amdgcn_exp2f(2.8853900818f * x)); }
__device__ __forceinline__ float wave_sum(float v) {
#pragma unroll
    for (int o = 32; o >= 1; o >>= 1) v += __shfl_xor(v, o);
    return v;
}
__device__ __forceinline__ int row_ci(int row) { return row < NCTXR ? 0 : 1 + ((row - NCTXR) >> 12); }

#define P_MOD(p)    ((float*)((p).ws + WS_MOD))
#define P_POSTAB(p) ((float*)((p).ws + WS_POSTAB))

__device__ __forceinline__ f32x4 x0_load4(const Params& p, int row, int col) {
    if (row < NCTXR) return *(const f32x4*)(pin(p, I_XP) + (size_t)row * DM + col);
    const int rr = row - NCTXR, t = rr & 4095;
    const f32x4 a = *(const f32x4*)(pin(p, I_XS) + (size_t)rr * DM + col);
    const int pos = col < 1024 ? (t >> 6) : (t & 63);
    const f32x4 e = *(const f32x4*)(P_POSTAB(p) + pos * 1024 + (col & 1023));
    return a + e;
}

__device__ __forceinline__ void transpose_tiles(const float* src, int K, int N, bf16_t* dst, int Npad, LAS float* t, int rot) {
    const int tid = tidx(), tk = K / 64, tn = Npad / 64, nwg = gridDim.x;
    for (int tile = (blockIdx.x + rot) % nwg; tile < tk * tn; tile += nwg) {
        const int kt = tile % tk, nt = tile / tk, k0 = kt * 64, n0 = nt * 64;
#pragma unroll
        for (int ps = 0; ps < 8; ++ps) { const int kk = ps * 8 + (tid >> 6), n = n0 + (tid & 63); t[kk * 65 + (tid & 63)] = (n < N) ? src[(size_t)(k0 + kk) * N + n] : 0.f; }
        __syncthreads();
        { const int nn = tid >> 3, kk0 = (tid & 7) * 8; float v[8];
#pragma unroll
          for (int i = 0; i < 8; ++i) v[i] = t[(kk0 + i) * 65 + nn];
          u32x4 o; o.x = cvtpk(v[0], v[1]); o.y = cvtpk(v[2], v[3]); o.z = cvtpk(v[4], v[5]); o.w = cvtpk(v[6], v[7]);
          *(u32x4*)(dst + (size_t)(n0 + nn) * K + k0 + kk0) = o; }
        __syncthreads();
    }
}

__device__ __forceinline__ void p0_prologue(const Params& p, LAS unsigned char* lds) {
    const int tid = tidx(), wg = blockIdx.x, nwg = gridDim.x;
    {
        LAS float* sl = (LAS float*)lds;
        LAS float* red = (LAS float*)(lds + 40960);
        if (wg < 192 || nwg < 192) {
            for (int i = tid; i < 5 * 2048; i += 512) { const int ci = i >> 11, k = i & 2047; const float c = ci == 0 ? pin(p, I_CCTX)[k] : pin(p, I_C)[(ci - 1) * 2048 + k]; sl[i] = c / (1.f + expf(-c)); }
            __syncthreads();
            for (int blk = wg; blk < 192; blk += nwg) {
                const int l = blk / 96, nb = blk % 96, col = nb * 64 + (tid & 63), kg = tid >> 6;
                const float* W = pin(p, I_ADAW) + (size_t)l * 2048 * 6144 + col;
                float acc[5] = {0.f, 0.f, 0.f, 0.f, 0.f};
#pragma unroll 8
                for (int k = kg * 256; k < kg * 256 + 256; ++k) { const float w = W[(size_t)k * 6144];
#pragma unroll
                    for (int ci = 0; ci < 5; ++ci) acc[ci] += sl[ci * 2048 + k] * w; }
#pragma unroll
                for (int ci = 0; ci < 5; ++ci) red[(kg * 5 + ci) * 64 + (tid & 63)] = acc[ci];
                __syncthreads();
                if (tid < 320) { const int ci = tid >> 6, c = tid & 63; float s = 0.f;
#pragma unroll
                    for (int k2 = 0; k2 < 8; ++k2) s += red[(k2 * 5 + ci) * 64 + c];
                    P_MOD(p)[((size_t)l * 5 + ci) * 6144 + nb * 64 + c] = s + pin(p, I_ADAB)[l * 6144 + nb * 64 + c]; }
                __syncthreads();
            }
        }
    }
    __syncthreads();
    transpose_tiles(pin(p, I_EWIN), 2048, 11296, (bf16_t*)(p.ws + WS_WT_E_IN), 11520, (LAS float*)lds, 0);
    transpose_tiles(pin(p, I_EWOUT), 4096, 2048, (bf16_t*)(p.ws + WS_WT_E_OUT), 2048, (LAS float*)lds, 128);
    transpose_tiles(pin(p, I_GLUW), 1024, 1024, (bf16_t*)(p.ws + WS_WT_GLU), 1024, (LAS float*)lds, 64);
    const int gtid = wg * 512 + tid, gth = nwg * 512;
    for (int idx = gtid; idx < 64 * 512; idx += gth) { const int pos = idx >> 9, i = idx & 511;
        const float om = (float)(1.0 / pow(10000.0, (double)i / 512.0)); const float ang = (float)pos * om;
        P_POSTAB(p)[pos * 1024 + i] = (float)sin((double)ang); P_POSTAB(p)[pos * 1024 + 512 + i] = (float)cos((double)ang); }
    { float* AB = p.out + OUT_RWKV; float* BBRE = AB + 16384; float* BBIM = BBRE + 131072;
      for (int idx = gtid; idx < 2 * 64 * 64; idx += gth) {
        const double lr = pin(p, I_LRE)[idx], li = pin(p, I_LIM)[idx], dt = exp((double)pin(p, I_LSTEP)[idx >> 6]);
        const double mag = exp(lr * dt), abr = mag * cos(li * dt), abi = mag * sin(li * dt), den = lr * lr + li * li;
        const double fr = ((abr - 1.0) * lr + abi * li) / den, fi = (abi * lr - (abr - 1.0) * li) / den;
        AB[idx * 2] = (float)abr; AB[idx * 2 + 1] = (float)abi;
        for (int h = 0; h < 16; ++h) { const double br = pin(p, I_BRE)[idx * 16 + h], bi = pin(p, I_BIM)[idx * 16 + h];
            BBRE[idx * 16 + h] = (float)(fr * br - fi * bi); BBIM[idx * 16 + h] = (float)(fr * bi + fi * br); } } }
}

__device__ __forceinline__ void p1_h0(const Params& p) {
    const int lane = tidx() & 63, gw = blockIdx.x * 8 + (tidx() >> 6), nw = gridDim.x * 8;
    bf16_t* H0 = (bf16_t*)(p.out + OUT_GLA); const float* mod = P_MOD(p); const float* nwt = pin(p, I_NORMW);
    for (int row0 = gw; row0 < MTOK; row0 += 2 * nw) {
        f32x4 x[2][8]; float ss[2] = {0.f, 0.f};
#pragma unroll
        for (int rr = 0; rr < 2; ++rr)
#pragma unroll
            for (int it = 0; it < 4; ++it) { const int col = it * 512 + lane * 8; x[rr][2 * it] = x0_load4(p, row0 + rr * nw, col); x[rr][2 * it + 1] = x0_load4(p, row0 + rr * nw, col + 4); }
#pragma unroll
        for (int rr = 0; rr < 2; ++rr) {
#pragma unroll
            for (int it = 0; it < 8; ++it)
#pragma unroll
                for (int j = 0; j < 4; ++j) ss[rr] += x[rr][it][j] * x[rr][it][j];
            ss[rr] = wave_sum(ss[rr]); }
#pragma unroll
        for (int rr = 0; rr < 2; ++rr) { const int row = row0 + rr * nw; const float rstd = rsqrtf(ss[rr] * (1.f / 2048.f) + 1e-6f);
            const float* sh = mod + (size_t)row_ci(row) * 6144; const float* sc = sh + 2048;
#pragma unroll
            for (int it = 0; it < 4; ++it) { const int col = it * 512 + lane * 8; float h[8];
#pragma unroll
                for (int q = 0; q < 2; ++q) { const f32x4 w = *(const f32x4*)(nwt + col + 4 * q), s1 = *(const f32x4*)(sc + col + 4 * q), s0 = *(const f32x4*)(sh + col + 4 * q);
#pragma unroll
                    for (int j = 0; j < 4; ++j) h[4 * q + j] = x[rr][2 * it + q][j] * rstd * w[j] * (1.f + s1[j]) + s0[j]; }
                u32x4 o; o.x = cvtpk(h[0], h[1]); o.y = cvtpk(h[2], h[3]); o.z = cvtpk(h[4], h[5]); o.w = cvtpk(h[6], h[7]);
                *(u32x4*)(H0 + (size_t)row * DM + col) = o; } }
    }
}

struct EpiProj0 {
    static constexpr bool PERM = true, AFTER_DRAIN = false;
    unsigned char* ws;
    __device__ __forceinline__ void operator()(const f32x4 (&acc)[2][2][4][2], const Unit& u, int wr, int wc, int fr, int fq) const {
        const int row0 = u.pm * 256 + wr * 64 + fr; const int colt = u.pn * 256;
        if (u.pn == 44) {
            if (wc == 0) { bf16_t* D = (bf16_t*)(ws + WS_DLR);
#pragma unroll
                for (int ai = 0; ai < 2; ++ai)
#pragma unroll
                    for (int m = 0; m < 4; ++m) { const f32x4 v0 = acc[ai][0][m][0], v1 = acc[ai][0][m][1];
                        u32x4 w; w.x = cvtpk(v0[0], v0[1]); w.y = cvtpk(v0[2], v0[3]); w.z = cvtpk(v1[0], v1[1]); w.w = cvtpk(v1[2], v1[3]);
                        *(u32x4*)(D + (size_t)(row0 + ai * 128 + m * 16) * 32 + 8 * fq) = w; } }
            return; }
        bf16_t* base; int ldc, c0;
        if (colt < 1024) { base = (bf16_t*)(ws + WS_U); ldc = 1024; c0 = colt; }
        else if (colt < 2048) { base = (bf16_t*)(ws + WS_SG); ldc = 1024; c0 = colt - 1024; }
        else if (colt < 3584) { base = (bf16_t*)(ws + WS_Q); ldc = 1536; c0 = colt - 2048; }
        else if (colt < 5120) { base = (bf16_t*)(ws + WS_K); ldc = 1536; c0 = colt - 3584; }
        else if (colt < 8192) { base = (bf16_t*)(ws + WS_V); ldc = 3072; c0 = colt - 5120; }
        else { base = (bf16_t*)(ws + WS_GG); ldc = 3072; c0 = colt - 8192; }
        const int col0 = c0 + wc * 32 + 8 * fq;
#pragma unroll
        for (int ai = 0; ai < 2; ++ai)
#pragma unroll
            for (int m = 0; m < 4; ++m) { bf16_t* rowp = base + (size_t)(row0 + ai * 128 + m * 16) * ldc + col0;
#pragma unroll
                for (int bj = 0; bj < 2; ++bj) { const f32x4 v0 = acc[ai][bj][m][0], v1 = acc[ai][bj][m][1];
                    u32x4 w; w.x = cvtpk(v0[0], v0[1]); w.y = cvtpk(v0[2], v0[3]); w.z = cvtpk(v1[0], v1[1]); w.w = cvtpk(v1[2], v1[3]);
                    *(u32x4*)(rowp + bj * 128) = w; } }
    }
};
struct EpiDlr {
    static constexpr bool PERM = true, AFTER_DRAIN = false;
    unsigned char* ws;
    __device__ __forceinline__ void operator()(const f32x4 (&acc)[2][2][4][2], const Unit& u, int wr, int wc, int fr, int fq) const {
        const int row0 = u.pm * 256 + wr * 64 + fr;
        if (wc == 0) { bf16_t* D = (bf16_t*)(ws + WS_DLR);
#pragma unroll
            for (int ai = 0; ai < 2; ++ai)
#pragma unroll
                for (int m = 0; m < 4; ++m) { const f32x4 v0 = acc[ai][0][m][0], v1 = acc[ai][0][m][1];
                    u32x4 w; w.x = cvtpk(v0[0], v0[1]); w.y = cvtpk(v0[2], v0[3]); w.z = cvtpk(v1[0], v1[1]); w.w = cvtpk(v1[2], v1[3]);
                    *(u32x4*)(D + (size_t)(row0 + ai * 128 + m * 16) * 32 + 8 * fq) = w; } }
    }
};
struct EpiGlu {
    static constexpr bool PERM = true, AFTER_DRAIN = false;
    const bf16_t* GY; const bf16_t* SG; const float* glu_b; bf16_t* CAT;
    __device__ __forceinline__ void operator()(const f32x4 (&acc)[2][2][4][2], const Unit& u, int wr, int wc, int fr, int fq) const {
        const int row0 = u.pm * 256 + wr * 64 + fr, col0 = u.pn * 256 + wc * 32 + 8 * fq;
#pragma unroll
        for (int ai = 0; ai < 2; ++ai)
#pragma unroll
            for (int m = 0; m < 4; ++m) { const size_t row = (size_t)(row0 + ai * 128 + m * 16);
#pragma unroll
                for (int bj = 0; bj < 2; ++bj) { const int col = col0 + bj * 128;
                    const u32x4 g4 = *(const u32x4*)(GY + row * 1024 + col), s4 = *(const u32x4*)(SG + row * 1024 + col);
                    const f32x4 b0 = *(const f32x4*)(glu_b + col), b1 = *(const f32x4*)(glu_b + col + 4);
                    float o[8];
#pragma unroll
                    for (int j = 0; j < 4; ++j) { const float gy0 = (j & 1) ? bfhi(g4[j >> 1]) : bflo(g4[j >> 1]), sg0 = (j & 1) ? bfhi(s4[j >> 1]) : bflo(s4[j >> 1]);
                        const float gy1 = (j & 1) ? bfhi(g4[2 + (j >> 1)]) : bflo(g4[2 + (j >> 1)]), sg1 = (j & 1) ? bfhi(s4[2 + (j >> 1)]) : bflo(s4[2 + (j >> 1)]);
                        o[j] = gy0 * sigm(acc[ai][bj][m][0][j] + b0[j]) * silu(sg0); o[4 + j] = gy1 * sigm(acc[ai][bj][m][1][j] + b1[j]) * silu(sg1); }
                    u32x4 w; w.x = cvtpk(o[0], o[1]); w.y = cvtpk(o[2], o[3]); w.z = cvtpk(o[4], o[5]); w.w = cvtpk(o[6], o[7]);
                    *(u32x4*)(CAT + row * 4096 + col) = w; } }
    }
};
struct EpiRes {
    static constexpr bool PERM = false, AFTER_DRAIN = false;
    const float* xp; const float* xsm; const float* postab; const float* gatebase; const float* X1; int layer; float* xout;
    __device__ __forceinline__ void operator()(const f32x4 (&acc)[2][2][4][2], const Unit& u, int wr, int wc, int fr, int fq) const {
        const int row0 = u.pm * 256 + wr * 64 + fr, col0 = u.pn * 256 + wc * 32 + 4 * fq;
#pragma unroll
        for (int ai = 0; ai < 2; ++ai)
#pragma unroll
            for (int m = 0; m < 4; ++m) { const int row = row0 + ai * 128 + m * 16; const float* gate = gatebase + (size_t)row_ci(row) * 6144;
#pragma unroll
                for (int bj = 0; bj < 2; ++bj)
#pragma unroll
                    for (int n = 0; n < 2; ++n) { const int col = col0 + bj * 128 + n * 16;
                        f32x4 xi;
                        if (layer == 0) { if (row < NCTXR) xi = *(const f32x4*)(xp + (size_t)row * DM + col);
                            else { const int rr = row - NCTXR, t = rr & 4095, pos = col < 1024 ? (t >> 6) : (t & 63); xi = *(const f32x4*)(xsm + (size_t)rr * DM + col) + *(const f32x4*)(postab + pos * 1024 + (col & 1023)); } }
                        else xi = *(const f32x4*)(X1 + (size_t)row * DM + col);
                        const f32x4 g = *(const f32x4*)(gate + col);
                        *(f32x4*)(xout + (size_t)row * DM + col) = xi + g * acc[ai][bj][m][n]; } }
    }
};
struct EpiProj1 {
    static constexpr bool PERM = true, AFTER_DRAIN = false;
    unsigned char* ws;
    __device__ __forceinline__ void operator()(const f32x4 (&acc)[2][2][4][2], const Unit& u, int wr, int wc, int fr, int fq) const {
        const int row0 = u.pm * 256 + wr * 64 + fr;
        if (u.pn >= 32) { bf16_t* LR = (bf16_t*)(ws + WS_LR); const int cbase = (u.pn - 32) * 256 + wc * 32 + 8 * fq;
#pragma unroll
            for (int ai = 0; ai < 2; ++ai)
#pragma unroll
                for (int m = 0; m < 4; ++m) { const size_t row = (size_t)(row0 + ai * 128 + m * 16);
#pragma unroll
                    for (int bj = 0; bj < 2; ++bj) { const int col = cbase + bj * 128; if (col < 384) { f32x4 v0 = acc[ai][bj][m][0], v1 = acc[ai][bj][m][1];
                        if (col < 192) {
#pragma unroll
                            for (int j = 0; j < 4; ++j) { v0[j] = ftanh(v0[j]); v1[j] = ftanh(v1[j]); } }
                        u32x4 w; w.x = cvtpk(v0[0], v0[1]); w.y = cvtpk(v0[2], v0[3]); w.z = cvtpk(v1[0], v1[1]); w.w = cvtpk(v1[2], v1[3]);
                        *(u32x4*)(LR + row * 384 + col) = w; } } }
            return; }
        bf16_t* base = (bf16_t*)(ws + WS_R + (size_t)(u.pn >> 3) * 83886080ull); const int col0 = (u.pn & 7) * 256 + wc * 32 + 8 * fq;
#pragma unroll
        for (int ai = 0; ai < 2; ++ai)
#pragma unroll
            for (int m = 0; m < 4; ++m) { bf16_t* rowp = base + (size_t)(row0 + ai * 128 + m * 16) * DM + col0;
#pragma unroll
                for (int bj = 0; bj < 2; ++bj) { const f32x4 v0 = acc[ai][bj][m][0], v1 = acc[ai][bj][m][1];
                    u32x4 w; w.x = cvtpk(v0[0], v0[1]); w.y = cvtpk(v0[2], v0[3]); w.z = cvtpk(v1[0], v1[1]); w.w = cvtpk(v1[2], v1[3]);
                    *(u32x4*)(rowp + bj * 128) = w; } }
    }
};

__device__ __forceinline__ void seq_info(int s, int& base, int& L, int& b, bool& lat) { lat = s >= 16; b = lat ? s - 16 : s; base = lat ? NCTXR + b * 4096 : b * 256; L = lat ? 4096 : 256; }

constexpr int S5_LC = 256;
constexpr size_t S5_E_OFF = OUT_RWKV + 524288;
template <bool OUTPUT>
__device__ __forceinline__ void s5_chunk_item(const Params& p, int s, int g, int dir, int j) {
    const int lane = tidx() & 63; int base, L, b; bool lat; seq_info(s, base, L, b, lat);
    const float* AB = p.out + OUT_RWKV; const float* BBRE = AB + 16384; const float* BBIM = BBRE + 131072;
    const bf16_t* U = (const bf16_t*)(p.ws + WS_U); float* Y5 = p.out + OUT_Y + (size_t)dir * MTOK * 1024;
    const int sidx = (dir * 64 + g) * 64 + lane;
    const float ar = AB[sidx * 2], ai = AB[sidx * 2 + 1];
    float bbr[16], bbi[16], cr[16], cim[16];
    const float* cre = pin(p, I_CRE); const float* cimp = pin(p, I_CIM);
#pragma unroll
    for (int h = 0; h < 16; ++h) { bbr[h] = BBRE[sidx * 16 + h]; bbi[h] = BBIM[sidx * 16 + h]; if (OUTPUT) { cr[h] = cre[((dir * 64 + g) * 16 + h) * 64 + lane]; cim[h] = cimp[((dir * 64 + g) * 16 + h) * 64 + lane]; } }
    float hr = 0.f, hi = 0.f;
    float* E = p.out + S5_E_OFF + (size_t)(((b * 2 + dir) * 64 + g) * 16) * 128;
    if (OUTPUT && lat) {
        hr = pin(p, I_S5RE)[((b * 2 + dir) * 64 + g) * 64 + lane]; hi = pin(p, I_S5IM)[((b * 2 + dir) * 64 + g) * 64 + lane];
        float pr = ar, pi = ai;
#pragma unroll
        for (int k = 0; k < 8; ++k) { const float nr = pr * pr - pi * pi, ni = 2.f * pr * pi; pr = nr; pi = ni; }
        for (int i = 0; i < j; ++i) { const float er = E[i * 128 + lane * 2], ei = E[i * 128 + lane * 2 + 1]; const float nr = pr * hr - pi * hi + er, ni = pr * hi + pi * hr + ei; hr = nr; hi = ni; }
    }
    const int tau0 = j * S5_LC, t0 = dir ? L - 1 - tau0 : tau0, dtk = dir ? -1 : 1;
    const u32x4* up = (const u32x4*)(U + (size_t)(base + t0) * 1024 + g * 16);
    u32x4 ua = up[0], ub = up[1];
    for (int i = 0; i < S5_LC; ++i) {
        const int t = t0 + i * dtk; const size_t row = (size_t)(base + t);
        u32x4 na = ua, nb = ub;
        if (i + 1 < S5_LC) { const u32x4* np = (const u32x4*)(U + (size_t)(base + t + dtk) * 1024 + g * 16); na = np[0]; nb = np[1]; }
        float uu[16];
#pragma unroll
        for (int k = 0; k < 4; ++k) { uu[2 * k] = bflo(ua[k]); uu[2 * k + 1] = bfhi(ua[k]); uu[8 + 2 * k] = bflo(ub[k]); uu[8 + 2 * k + 1] = bfhi(ub[k]); }
        float bur = 0.f, bui = 0.f;
#pragma unroll
        for (int h = 0; h < 16; ++h) { bur += bbr[h] * uu[h]; bui += bbi[h] * uu[h]; }
        const float nr = ar * hr - ai * hi + bur, ni = ar * hi + ai * hr + bui; hr = nr; hi = ni;
        if (OUTPUT) {
            float z[16];
#pragma unroll
            for (int h = 0; h < 16; ++h) z[h] = hr * cr[h] - hi * cim[h];
            float z8[8], z4[4], z2[2], z1;
#pragma unroll
            for (int k = 0; k < 8; ++k) { const auto r = __builtin_amdgcn_permlane32_swap(__float_as_uint(z[k]), __float_as_uint(z[k + 8]), false, false); z8[k] = __uint_as_float(r[0]) + __uint_as_float(r[1]); }
#pragma unroll
            for (int k = 0; k < 4; ++k) { const auto r = __builtin_amdgcn_permlane16_swap(__float_as_uint(z8[k]), __float_as_uint(z8[k + 4]), false, false); z4[k] = __uint_as_float(r[0]) + __uint_as_float(r[1]); }
            { const bool up_ = lane & 8;
#pragma unroll
              for (int k = 0; k < 2; ++k) { const float keep = up_ ? z4[k + 2] : z4[k], send = up_ ? z4[k] : z4[k + 2];
                  z2[k] = keep + __int_as_float(__builtin_amdgcn_update_dpp(0, __float_as_int(send), 0x128, 0xf, 0xf, false)); } }
            { const bool up_ = lane & 4; const float keep = up_ ? z2[1] : z2[0], send = up_ ? z2[0] : z2[1];
              const float dn = __int_as_float(__builtin_amdgcn_update_dpp(0, __float_as_int(send), 0x104, 0xf, 0xf, false));
              const float upv = __int_as_float(__builtin_amdgcn_update_dpp(0, __float_as_int(send), 0x114, 0xf, 0xf, false));
              z1 = keep + (up_ ? upv : dn); }
            z1 += __int_as_float(__builtin_amdgcn_update_dpp(0, __float_as_int(z1), 0xB1, 0xf, 0xf, false));
            z1 += __int_as_float(__builtin_amdgcn_update_dpp(0, __float_as_int(z1), 0x4E, 0xf, 0xf, false));
            if ((lane & 3) == 0) { const int h = ((lane >> 5) & 1) * 8 + ((lane >> 4) & 1) * 4 + ((lane >> 3) & 1) * 2 + ((lane >> 2) & 1); Y5[row * 1024 + g * 16 + h] = z1; }
        }
        ua = na; ub = nb;
    }
    if (!OUTPUT) { E[j * 128 + lane * 2] = hr; E[j * 128 + lane * 2 + 1] = hi; }
    if (OUTPUT && !lat) { p.out[OUT_S5RE + ((b * 2 + dir) * 64 + g) * 64 + lane] = hr; p.out[OUT_S5IM + ((b * 2 + dir) * 64 + g) * 64 + lane] = hi; }
}
__device__ __forceinline__ void p_s5_gelu(const Params& p) {
    bf16_t* U = (bf16_t*)(p.ws + WS_U); const float* Y5F = p.out + OUT_Y; const float* Y5B = Y5F + (size_t)MTOK * 1024; const float* dsk = pin(p, I_S5D);
    const size_t n8 = (size_t)MTOK * 1024 / 8;
    for (size_t i = (size_t)blockIdx.x * 512 + tidx(); i < n8; i += (size_t)gridDim.x * 512) {
        const size_t e0 = i * 8; const int col = (int)(e0 & 1023);
        const u32x4 u4 = *(const u32x4*)(U + e0); float o[8];
#pragma unroll
        for (int q = 0; q < 2; ++q) { const f32x4 yf = *(const f32x4*)(Y5F + e0 + 4 * q), yb = *(const f32x4*)(Y5B + e0 + 4 * q), d4 = *(const f32x4*)(dsk + col + 4 * q);
#pragma unroll
            for (int j = 0; j < 4; ++j) { const unsigned w = u4[2 * q + (j >> 1)]; const float uu = (j & 1) ? bfhi(w) : bflo(w);
                const float y = d4[j] * uu + yf[j] + yb[j];
                o[4 * q + j] = y * __builtin_amdgcn_rcpf(1.f + __builtin_amdgcn_exp2f(-2.3022082f * (y + 0.044715f * y * y * y))); } }
        u32x4 w; w.x = cvtpk(o[0], o[1]); w.y = cvtpk(o[2], o[3]); w.z = cvtpk(o[4], o[5]); w.w = cvtpk(o[6], o[7]);
        *(u32x4*)(U + e0) = w;
    }
}

__device__ __forceinline__ float xs_rstd(const Params& p, int row, int lane) {
    if (row < 0 || row >= MTOK) return 0.f;
    const float* X1 = (const float*)(p.ws + WS_X1) + (size_t)row * DM; float ss = 0.f;
#pragma unroll
    for (int it = 0; it < 8; ++it) { const f32x4 x = *(const f32x4*)(X1 + it * 256 + lane * 4);
#pragma unroll
        for (int j = 0; j < 4; ++j) ss += x[j] * x[j]; }
    ss = wave_sum(ss); return rsqrtf(ss * (1.f / 2048.f) + 1e-6f);
}
__device__ __forceinline__ void xs_h16(const Params& p, int row, float rstd, int lane, int hf, float (&h)[16]) {
    if (row < 0 || row >= MTOK) {
#pragma unroll
        for (int j = 0; j < 16; ++j) h[j] = 0.f;
        return; }
    const float* X1 = (const float*)(p.ws + WS_X1) + (size_t)row * DM; const float* mod = P_MOD(p) + ((size_t)5 + row_ci(row)) * 6144; const float* nwt = pin(p, I_NORMW) + 2048;
#pragma unroll
    for (int i2 = 0; i2 < 2; ++i2)
#pragma unroll
        for (int q = 0; q < 2; ++q) { const int col = (hf * 2 + i2) * 512 + lane * 8 + 4 * q;
            const f32x4 x = *(const f32x4*)(X1 + col), w = *(const f32x4*)(nwt + col), s0 = *(const f32x4*)(mod + col), s1 = *(const f32x4*)(mod + 2048 + col);
#pragma unroll
            for (int j = 0; j < 4; ++j) h[i2 * 8 + q * 4 + j] = x[j] * rstd * w[j] * (1.f + s1[j]) + s0[j]; }
}
__device__ __forceinline__ void rwkv_tables(const Params& p);
__device__ __forceinline__ void p7_xs(const Params& p, LAS unsigned char* lds) {
    const int lane = tidx() & 63, gw = blockIdx.x * 8 + (tidx() >> 6), nw = gridDim.x * 8;
    bf16_t* XS = (bf16_t*)(p.out + OUT_Y); const float* mu = pin(p, I_MU);
    for (int item = gw; item < MTOK / 10; item += nw) {
        const int r0 = item * 10; LAS float* rs = (LAS float*)lds + (tidx() >> 6) * 16;
#pragma unroll 1
        for (int k = 0; k < 12; ++k) { const float v = xs_rstd(p, r0 - 1 + k, lane); if (lane == 0) rs[k] = v; }
#pragma unroll 1
        for (int hf = 0; hf < 2; ++hf) {
            float hp[16], hc[16], hn[16];
            xs_h16(p, r0 - 1, rs[0], lane, hf, hp); xs_h16(p, r0, rs[1], lane, hf, hc);
#pragma unroll 1
            for (int k = 0; k < 10; ++k) { const int r = r0 + k;
                const int L = r < NCTXR ? 256 : 4096, tin = r < NCTXR ? (r & 255) : ((r - NCTXR) & 4095);
                const bool first = tin == 0, last = tin == L - 1;
                xs_h16(p, r + 1, rs[k + 2], lane, hf, hn);
#pragma unroll
                for (int i2 = 0; i2 < 2; ++i2) { const int col = (hf * 2 + i2) * 512 + lane * 8; float o[8];
#pragma unroll
                    for (int q = 0; q < 2; ++q) { const f32x4 m0 = *(const f32x4*)(mu + col + 4 * q), m1 = *(const f32x4*)(mu + 2048 + col + 4 * q);
#pragma unroll
                        for (int j = 0; j < 4; ++j) { const int kk = i2 * 8 + q * 4 + j; const float c = hc[kk], pv = first ? 0.f : hp[kk], nv = last ? 0.f : hn[kk];
                            o[q * 4 + j] = c + m0[j] * (pv - c) + m1[j] * (nv - c); } }
                    u32x4 w; w.x = cvtpk(o[0], o[1]); w.y = cvtpk(o[2], o[3]); w.z = cvtpk(o[4], o[5]); w.w = cvtpk(o[6], o[7]);
                    *(u32x4*)(XS + (size_t)r * DM + col) = w; }
#pragma unroll
                for (int j = 0; j < 16; ++j) { hp[j] = hc[j]; hc[j] = hn[j]; }
            }
        }
    }
    __syncthreads();
    transpose_tiles(pin(p, I_OWIN), 2048, 8576, (bf16_t*)((unsigned char*)(p.out + OUT_Y) + OY_WT_O_IN_B), 8704, (LAS float*)lds, 0);
    transpose_tiles(pin(p, I_OWOUT), 2048, 2048, (bf16_t*)(p.ws + WS_WT_O_OUT), 2048, (LAS float*)lds, 128);
    rwkv_tables(p);
}

typedef pg8::bf16x8 bf16x8;
typedef float f32x16 __attribute__((ext_vector_type(16)));
typedef float f32x2v __attribute__((ext_vector_type(2)));
constexpr int GL_QD = 0, GL_KI = 33792, GL_KET = 67584, GL_VT = 104448, GL_ATT = 122880, GL_SEG = 132096, GL_EBL = 136192, GL_UPF = 137216, GL_BIAS = 153600, GL_END = 154624;
constexpr int GL_QS = 528, GL_KS = 144;
static_assert(GL_END <= LDS_BAR_OFF, "GLA LDS map");
constexpr int OB_SPLIT = 13653;
__device__ __forceinline__ bf16_t* ob_row(unsigned char* ws, int row) { return row < OB_SPLIT ? (bf16_t*)(ws + WS_U) + (size_t)row * 3072 : (bf16_t*)(ws + WS_WT_E_IN) + (size_t)(row - OB_SPLIT) * 3072; }

#ifndef GL_DELAY
#define GL_DELAY 0
#endif
#define GLD_BEGIN(S) unsigned long long gld_t0_##S = 0; if (GL_DELAY == S) gld_t0_##S = clock64();
#define GLD_END(S) if (GL_DELAY == S) { asm volatile("s_waitcnt lgkmcnt(0)" ::: "memory"); const unsigned long long t1_ = clock64(), d_ = t1_ - gld_t0_##S; while ((unsigned long long)clock64() - t1_ < d_) { } }
__device__ __forceinline__ void p_gla_chunk(const Params& p, LAS unsigned char* lds) {
    const int tid = tidx(), w = __builtin_amdgcn_readfirstlane(tid >> 6), l = tid & 63, n = l & 31, hh = l >> 5, g = l >> 4, c16 = l & 15, wg = blockIdx.x;
    const int mb = w & 1, np = w >> 1, d0 = 64 * np + 2 * n;
    const int arow = w & 3, acol = w >> 2;
    const bf16_t* Q = (const bf16_t*)(p.ws + WS_Q); const bf16_t* K = (const bf16_t*)(p.ws + WS_K); const bf16_t* V = (const bf16_t*)(p.ws + WS_V);
    const bf16_t* DLR = (const bf16_t*)(p.ws + WS_DLR); bf16_t* CAT = (bf16_t*)(p.out + OUT_Y);
    const float* decup = pin(p, I_DECUP); const float* decb = pin(p, I_DECB); const float* sgla = pin(p, I_SGLA);
    const int stride = wg < 192 ? 1000000 : 64;
    for (int u = wg; u < 960; u += stride) {
        int s_, h, dir, es; if (u < 192) { s_ = 16 + u / 48; const int r = u % 48; h = r >> 3; dir = (r >> 2) & 1; es = r & 3; } else { const int v = u - 192; s_ = v / 48; const int r = v % 48; h = r >> 3; dir = (r >> 2) & 1; es = r & 3; }
        int base, L, b; bool lat; seq_info(s_, base, L, b, lat);
        const int nst = L >> 6;
        { float ua[8], ub[8];
#pragma unroll
          for (int j = 0; j < 8; ++j) { const f32x2v pu = *(const f32x2v*)((const char*)decup + (unsigned)((dir * 16 + 8 * hh + j) * 1536 + h * 256 + d0) * 4u); ua[j] = pu.x; ub[j] = pu.y; }
          u32x4 a4, b4; a4.x = cvtpk(ua[0], ua[1]); a4.y = cvtpk(ua[2], ua[3]); a4.z = cvtpk(ua[4], ua[5]); a4.w = cvtpk(ua[6], ua[7]);
          b4.x = cvtpk(ub[0], ub[1]); b4.y = cvtpk(ub[2], ub[3]); b4.z = cvtpk(ub[4], ub[5]); b4.w = cvtpk(ub[6], ub[7]);
          *(LAS u32x4*)(lds + GL_UPF + tid * 32) = a4; *(LAS u32x4*)(lds + GL_UPF + tid * 32 + 16) = b4;
          if (mb == 0 && hh == 0) *(LAS f32x2v*)(lds + GL_BIAS + d0 * 4) = *(const f32x2v*)((const char*)decb + (unsigned)(dir * 1536 + h * 256 + d0) * 4u); }
        f32x4 Sacc[16];
        const unsigned sb = (unsigned)(((b * 2 + dir) * 6 + h) * 256 + 4 * g) * 512u + (unsigned)(es * 128 + 16 * w + c16);
#pragma unroll
        for (int db = 0; db < 16; ++db) Sacc[db] = (f32x4){0.f, 0.f, 0.f, 0.f};
        if (lat) {
#pragma unroll
            for (int db = 0; db < 16; ++db)
#pragma unroll
                for (int r = 0; r < 4; ++r) Sacc[db][r] = *(const float*)((const char*)sgla + (sb + (unsigned)((16 * db + r) * 512)) * 4u); }
        u32x4 pfq[4], pfk[4], pfv[2], pfd;
        const int cR = 32 * mb + 16 * ((n >> 2) & 1) + (n & 3) + 4 * (n >> 3);
#define GLA_ROW(st, c) (base + (dir ? L - 1 - ((st) * 64 + (c)) : (st) * 64 + (c)))
#define GLA_PREFETCH(st) do { \
        _Pragma("unroll") for (int i = 0; i < 4; ++i) { const int pi = tid + 512 * i, c = pi >> 5, pc = pi & 31; const unsigned off = (unsigned)GLA_ROW(st, c) * 3072u + (unsigned)(h * 512 + pc * 16); \
            pfq[i] = *(const u32x4*)((const char*)Q + off); pfk[i] = *(const u32x4*)((const char*)K + off); } \
        _Pragma("unroll") for (int i = 0; i < 2; ++i) { const int pi = tid + 512 * i, c = pi & 63, pc = pi >> 6; const unsigned off = (unsigned)GLA_ROW(st, c) * 6144u + (unsigned)(h * 1024 + es * 256 + pc * 16); \
            pfv[i] = *(const u32x4*)((const char*)V + off); } \
        { const unsigned off = (unsigned)GLA_ROW(st, cR) * 64u + (unsigned)(dir * 32 + 16 * hh); pfd = *(const u32x4*)((const char*)DLR + off); } } while (0)
        GLA_PREFETCH(0);
        __syncthreads();
        for (int st = 0; st < nst; ++st) {
            GLD_BEGIN(1)
#pragma unroll
            for (int i = 0; i < 4; ++i) { const int pi = tid + 512 * i, c = pi >> 5, pc = pi & 31; *(LAS u32x4*)(lds + GL_QD + c * GL_QS + pc * 16) = pfq[i]; *(LAS u32x4*)(lds + GL_KI + c * GL_QS + pc * 16) = pfk[i]; }
#pragma unroll
            for (int i = 0; i < 2; ++i) { const int pi = tid + 512 * i, c = pi & 63, pc = pi >> 6;
#pragma unroll
                for (int j = 0; j < 4; ++j) { const unsigned wv = pfv[i][j];
                    *(LAS bf16_t*)(lds + GL_VT + (pc * 8 + 2 * j) * GL_KS + c * 2) = (bf16_t)(wv & 0xffffu); *(LAS bf16_t*)(lds + GL_VT + (pc * 8 + 2 * j + 1) * GL_KS + c * 2) = (bf16_t)(wv >> 16); } }
            __builtin_amdgcn_sched_barrier(0);
#ifndef GL_REPS_0
#define GL_REPS_0 1
#define GL_REPS_2 1
#endif
            float bA[16], bB[16];
            for (int rep0 = 0; rep0 < GL_REPS_0; ++rep0) { const bf16x8 af = __builtin_bit_cast(bf16x8, pfd);
              const bf16x8 upA = *(const LAS bf16x8*)(lds + GL_UPF + tid * 32), upB = *(const LAS bf16x8*)(lds + GL_UPF + tid * 32 + 16);
              f32x16 zA, zB;
#pragma unroll
              for (int i = 0; i < 16; ++i) { zA[i] = 0.f; zB[i] = 0.f; }
              zA = __builtin_amdgcn_mfma_f32_32x32x16_bf16(af, upA, zA, 0, 0, 0); zB = __builtin_amdgcn_mfma_f32_32x32x16_bf16(af, upB, zB, 0, 0, 0);
              const f32x2v bi = *(const LAS f32x2v*)(lds + GL_BIAS + d0 * 4);
              float ra = 0.f, rb = 0.f;
#pragma unroll
              for (int i = 0; i < 16; ++i) {
                  const float za = zA[i] + bi.x, zb = zB[i] + bi.y;
                  const float la = fmaxf(fminf(za, 0.f) * 0.0625f - 0.04332169878f * __builtin_amdgcn_logf(1.f + __builtin_amdgcn_exp2f(-1.4426950409f * fabsf(za))), -1.f),
                              lb = fmaxf(fminf(zb, 0.f) * 0.0625f - 0.04332169878f * __builtin_amdgcn_logf(1.f + __builtin_amdgcn_exp2f(-1.4426950409f * fabsf(zb))), -1.f);
                  ra += la; rb += lb; bA[i] = ra; bB[i] = rb; }
              *(LAS f32x2v*)(lds + GL_SEG + ((2 * mb + hh) * 256 + d0) * 4) = (f32x2v){ra, rb}; }
            GLD_END(1)
            __syncthreads();
            GLD_BEGIN(2)
            if (st + 1 < nst) GLA_PREFETCH(st + 1);
            { float offA = 0.f, offB = 0.f, totA = 0.f, totB = 0.f; const int myseg = 2 * mb + hh;
#pragma unroll
              for (int sg = 0; sg < 4; ++sg) { const f32x2v t = *(LAS f32x2v*)(lds + GL_SEG + (sg * 256 + d0) * 4); if (sg < myseg) { offA += t.x; offB += t.y; } totA += t.x; totB += t.y; }
              const float eblA = __expf(totA), eblB = __expf(totB);
              if (myseg == 0) *(LAS f32x2v*)(lds + GL_EBL + d0 * 4) = (f32x2v){eblA, eblB};
              unsigned ke0[8], ke1[8];
#pragma unroll
              for (int i2 = 0; i2 < 8; ++i2) { float kea[2], keb[2];
#pragma unroll
                  for (int q = 0; q < 2; ++q) { const int i = 2 * i2 + q, c = 32 * mb + 16 * hh + i;
                      const float e1A = __expf(offA + bA[i]), e1B = __expf(offB + bB[i]); const float e2A = __builtin_amdgcn_rcpf(e1A), e2B = __builtin_amdgcn_rcpf(e1B);
                      LAS unsigned* qp = (LAS unsigned*)(lds + GL_QD + c * GL_QS + d0 * 2); LAS unsigned* kp = (LAS unsigned*)(lds + GL_KI + c * GL_QS + d0 * 2);
                      const unsigned qw = *qp, kw = *kp;
                      const float kiA = bflo(kw) * e2A, kiB = bfhi(kw) * e2B;
                      *qp = cvtpk(bflo(qw) * e1A * 0.0625f, bfhi(qw) * e1B * 0.0625f); *kp = cvtpk(kiA, kiB);
                      kea[q] = kiA * eblA; keb[q] = kiB * eblB; }
                  ke0[i2] = cvtpk(kea[0], kea[1]); ke1[i2] = cvtpk(keb[0], keb[1]); if (i2 & 1) __builtin_amdgcn_sched_barrier(0); }
              LAS u32x4* k0p = (LAS u32x4*)(lds + GL_KET + d0 * GL_KS + (32 * mb + 16 * hh) * 2); LAS u32x4* k1p = (LAS u32x4*)(lds + GL_KET + (d0 + 1) * GL_KS + (32 * mb + 16 * hh) * 2);
              k0p[0] = (u32x4){ke0[0], ke0[1], ke0[2], ke0[3]}; k0p[1] = (u32x4){ke0[4], ke0[5], ke0[6], ke0[7]};
              k1p[0] = (u32x4){ke1[0], ke1[1], ke1[2], ke1[3]}; k1p[1] = (u32x4){ke1[4], ke1[5], ke1[6], ke1[7]}; }
            GLD_END(2)
            __syncthreads();
            GLD_BEGIN(3)
            f32x4 oacc[4];
            for (int rep2 = 0; rep2 < GL_REPS_2; ++rep2) {
            { f32x4 att[2] = {(f32x4){0.f, 0.f, 0.f, 0.f}, (f32x4){0.f, 0.f, 0.f, 0.f}};
              bf16x8 aF[2], bF[2][2];
              aF[0] = *(const LAS bf16x8*)(lds + GL_QD + (16 * arow + c16) * GL_QS + (8 * g) * 2);
#pragma unroll
              for (int nb = 0; nb < 2; ++nb) bF[0][nb] = *(const LAS bf16x8*)(lds + GL_KI + (32 * acol + 16 * nb + c16) * GL_QS + (8 * g) * 2);
#pragma unroll
              for (int ks = 0; ks < 8; ++ks) {
                  if (ks + 1 < 8) { aF[(ks + 1) & 1] = *(const LAS bf16x8*)(lds + GL_QD + (16 * arow + c16) * GL_QS + (32 * (ks + 1) + 8 * g) * 2);
#pragma unroll
                      for (int nb = 0; nb < 2; ++nb) bF[(ks + 1) & 1][nb] = *(const LAS bf16x8*)(lds + GL_KI + (32 * acol + 16 * nb + c16) * GL_QS + (32 * (ks + 1) + 8 * g) * 2); }
                  __builtin_amdgcn_sched_barrier(0);
#pragma unroll
                  for (int nb = 0; nb < 2; ++nb) att[nb] = __builtin_amdgcn_mfma_f32_16x16x32_bf16(aF[ks & 1], bF[ks & 1][nb], att[nb], 0, 0, 0);
                  __builtin_amdgcn_sched_barrier(0); }
#pragma unroll
              for (int nb = 0; nb < 2; ++nb)
#pragma unroll
                  for (int r = 0; r < 4; ++r) { const int c = 16 * arow + 4 * g + r, sc = 32 * acol + 16 * nb + c16;
                      *(LAS bf16_t*)(lds + GL_ATT + c * GL_KS + sc * 2) = f2bf(sc <= c ? att[nb][r] : 0.f); } }
            oacc[0] = (f32x4){0.f, 0.f, 0.f, 0.f}; oacc[1] = oacc[0]; oacc[2] = oacc[0]; oacc[3] = oacc[0];
            { u32x2 qlo[2][4], qhi[2][4];
#pragma unroll
              for (int m4 = 0; m4 < 4; ++m4) { const LAS unsigned char* qrow = lds + GL_QD + (16 * m4 + c16) * GL_QS + (4 * g) * 2; qlo[0][m4] = *(const LAS u32x2*)qrow; qhi[0][m4] = *(const LAS u32x2*)(qrow + 32); }
#pragma unroll
              for (int ks = 0; ks < 8; ++ks) {
                  if (ks + 1 < 8) {
#pragma unroll
                      for (int m4 = 0; m4 < 4; ++m4) { const LAS unsigned char* qrow = lds + GL_QD + (16 * m4 + c16) * GL_QS + (32 * (ks + 1) + 4 * g) * 2; qlo[(ks + 1) & 1][m4] = *(const LAS u32x2*)qrow; qhi[(ks + 1) & 1][m4] = *(const LAS u32x2*)(qrow + 32); } }
                  __builtin_amdgcn_sched_barrier(0);
                  u32x4 s4; s4.x = cvtpk(Sacc[2 * ks][0], Sacc[2 * ks][1]); s4.y = cvtpk(Sacc[2 * ks][2], Sacc[2 * ks][3]); s4.z = cvtpk(Sacc[2 * ks + 1][0], Sacc[2 * ks + 1][1]); s4.w = cvtpk(Sacc[2 * ks + 1][2], Sacc[2 * ks + 1][3]);
                  const bf16x8 sf = __builtin_bit_cast(bf16x8, s4);
#pragma unroll
                  for (int m4 = 0; m4 < 4; ++m4) { const u32x2 lo = qlo[ks & 1][m4], hi = qhi[ks & 1][m4];
                      oacc[m4] = __builtin_amdgcn_mfma_f32_16x16x32_bf16(sf, __builtin_bit_cast(bf16x8, (u32x4){lo.x, lo.y, hi.x, hi.y}), oacc[m4], 0, 0, 0); }
                  __builtin_amdgcn_sched_barrier(0); } }
            }
            GLD_END(3)
            __syncthreads();
            GLD_BEGIN(4)
            { bf16x8 vf[2];
#pragma unroll
              for (int ks = 0; ks < 2; ++ks) vf[ks] = *(const LAS bf16x8*)(lds + GL_VT + (16 * w + c16) * GL_KS + (32 * ks + 8 * g) * 2);
#pragma unroll
              for (int ks = 0; ks < 2; ++ks)
#pragma unroll
                  for (int m4 = 0; m4 < 4; ++m4) { const bf16x8 af = *(const LAS bf16x8*)(lds + GL_ATT + (16 * m4 + c16) * GL_KS + (32 * ks + 8 * g) * 2);
                      oacc[m4] = __builtin_amdgcn_mfma_f32_16x16x32_bf16(vf[ks], af, oacc[m4], 0, 0, 0); }
#pragma unroll
              for (int db = 0; db < 16; ++db) { const f32x4 eb = *(const LAS f32x4*)(lds + GL_EBL + (16 * db + 4 * g) * 4); Sacc[db] = Sacc[db] * eb;
#pragma unroll
                  for (int ks = 0; ks < 2; ++ks) { const bf16x8 kf = *(const LAS bf16x8*)(lds + GL_KET + (16 * db + c16) * GL_KS + (32 * ks + 8 * g) * 2);
                      Sacc[db] = __builtin_amdgcn_mfma_f32_16x16x32_bf16(kf, vf[ks], Sacc[db], 0, 0, 0); } } }
#pragma unroll
            for (int m4 = 0; m4 < 4; ++m4) { const int row = GLA_ROW(st, 16 * m4 + c16); u32x2 o2; o2.x = cvtpk(oacc[m4][0], oacc[m4][1]); o2.y = cvtpk(oacc[m4][2], oacc[m4][3]);
                bf16_t* dst = dir ? ob_row(p.ws, row) + h * 512 + es * 128 + 16 * w + 4 * g : CAT + (size_t)row * 4096 + 1024 + h * 512 + es * 128 + 16 * w + 4 * g;
                *(u32x2*)dst = o2; }
            GLD_END(4)
            __syncthreads();
        }
        if (!lat) {
#pragma unroll
            for (int db = 0; db < 16; ++db)
#pragma unroll
                for (int r = 0; r < 4; ++r) *(float*)((char*)p.out + ((unsigned)OUT_GLA + sb + (unsigned)((16 * db + r) * 512)) * 4u) = Sacc[db][r]; }
#undef GLA_PREFETCH
#undef GLA_ROW
    }
}
__device__ __forceinline__ void p_gla_norm2(const Params& p) {
    const int lane = tidx() & 63, gw = blockIdx.x * 8 + (tidx() >> 6), nw = gridDim.x * 8;
    bf16_t* CAT = (bf16_t*)(p.out + OUT_Y); const bf16_t* GG = (const bf16_t*)(p.ws + WS_GG); const float* gnw = pin(p, I_GNW);
    for (int it = gw; it < MTOK * 6; it += nw) { const int row = it / 6, h = it % 6;
        bf16_t* op = CAT + (size_t)row * 4096 + 1024 + h * 512 + lane * 8; const u32x4 o4 = *(const u32x4*)op, b4 = *(const u32x4*)(ob_row(p.ws, row) + h * 512 + lane * 8), g4 = *(const u32x4*)(GG + (size_t)row * 3072 + h * 512 + lane * 8);
        float o[8], g[8];
#pragma unroll
        for (int j = 0; j < 4; ++j) { o[2 * j] = bflo(o4[j]) + bflo(b4[j]); o[2 * j + 1] = bfhi(o4[j]) + bfhi(b4[j]); g[2 * j] = bflo(g4[j]); g[2 * j + 1] = bfhi(g4[j]); }
        float ss = 0.f;
#pragma unroll
        for (int j = 0; j < 8; ++j) ss += o[j] * o[j];
        ss = wave_sum(ss); const float rstd = rsqrtf(ss * (1.f / 512.f) + 1e-6f);
        const f32x4 w0 = *(const f32x4*)(gnw + h * 512 + lane * 8), w1 = *(const f32x4*)(gnw + h * 512 + lane * 8 + 4);
        float r[8];
#pragma unroll
        for (int j = 0; j < 8; ++j) r[j] = o[j] * rstd * (j < 4 ? w0[j] : w1[j - 4]) * silu(g[j]);
        u32x4 wv; wv.x = cvtpk(r[0], r[1]); wv.y = cvtpk(r[2], r[3]); wv.z = cvtpk(r[4], r[5]); wv.w = cvtpk(r[6], r[7]);
        *(u32x4*)op = wv;
    }
}

typedef float f32x16s __attribute__((ext_vector_type(16)));

constexpr int S5_HT_STRIDE = 528, S5_HT_BYTES = 32 * S5_HT_STRIDE;
__device__ __forceinline__ u32x2 split_pk_(float a, float b) { u32x2 r; r.x = cvtpk(a, b); r.y = cvtpk(a - bflo(r.x), b - bfhi(r.x)); return r; }
#define split_pk(a, b, hi, lo) do { const u32x2 sp_ = split_pk_((a), (b)); (hi) = sp_.x; (lo) = sp_.y; } while (0)
template <bool OUTPUT>
__device__ __forceinline__ void s5_mfma_item(const Params& p, LAS unsigned char* ht, int g, int dir, int cidx0, int cidx1) {
    const int lane = tidx() & 63, n = lane & 31, hh = lane >> 5, c16 = lane & 15, g4 = lane >> 4;
    const float* AB = p.out + OUT_RWKV; const float* BBRE = AB + 16384; const float* BBIM = BBRE + 131072;
    const bf16_t* U = (const bf16_t*)(p.ws + WS_U); float* Y5 = p.out + OUT_Y + (size_t)dir * MTOK * 1024;
    int cbase[2], cL[2], cj[2], cb[2]; bool clat[2];
#pragma unroll
    for (int c = 0; c < 2; ++c) { const int ci = c ? cidx1 : cidx0; clat[c] = ci < 64; cb[c] = clat[c] ? (ci >> 4) : ci - 64; cj[c] = clat[c] ? (ci & 15) : 0; cbase[c] = clat[c] ? NCTXR + cb[c] * 4096 : cb[c] * 256; cL[c] = clat[c] ? 4096 : 256; }
    const int sidx0 = (dir * 64 + g) * 64 + n, sidx1 = sidx0 + 32;
    const float ar0 = AB[sidx0 * 2], ai0 = AB[sidx0 * 2 + 1], ar1 = AB[sidx1 * 2], ai1 = AB[sidx1 * 2 + 1];
    bf16x8 bbf[4], bbl[4];
#pragma unroll
    for (int nb = 0; nb < 4; ++nb) { const float* src = ((nb >> 1) ? BBIM : BBRE) + ((nb & 1) ? sidx1 : sidx0) * 16 + 8 * hh; const f32x4 v0 = *(const f32x4*)src, v1 = *(const f32x4*)(src + 4);
        u32x4 w, wl; split_pk(v0[0], v0[1], w.x, wl.x); split_pk(v0[2], v0[3], w.y, wl.y); split_pk(v1[0], v1[1], w.z, wl.z); split_pk(v1[2], v1[3], w.w, wl.w);
        bbf[nb] = __builtin_bit_cast(bf16x8, w); bbl[nb] = __builtin_bit_cast(bf16x8, wl); }
    bf16x8 cmf[4], cml[4];
    if (OUTPUT) { const float* cre = pin(p, I_CRE) + ((dir * 64 + g) * 16 + c16) * 64; const float* cim = pin(p, I_CIM) + ((dir * 64 + g) * 16 + c16) * 64;
#pragma unroll
        for (int ks = 0; ks < 4; ++ks) { const int s0 = 8 * ks + 2 * g4;
            u32x4 w, wl; split_pk(cre[s0], -cim[s0], w.x, wl.x); split_pk(cre[s0 + 32], -cim[s0 + 32], w.y, wl.y); split_pk(cre[s0 + 1], -cim[s0 + 1], w.z, wl.z); split_pk(cre[s0 + 33], -cim[s0 + 33], w.w, wl.w);
            cmf[ks] = __builtin_bit_cast(bf16x8, w); cml[ks] = __builtin_bit_cast(bf16x8, wl); } }
    float hr0 = 0.f, hi0 = 0.f, hr1 = 0.f, hi1 = 0.f;
    const bool mylat = hh ? clat[1] : clat[0]; const int myb = hh ? cb[1] : cb[0], myj = hh ? cj[1] : cj[0];
    float* E = p.out + S5_E_OFF + (size_t)(((myb * 2 + dir) * 64 + g) * 16) * 128;
    if (OUTPUT && mylat) {
        const float* s5r = pin(p, I_S5RE); const float* s5i = pin(p, I_S5IM); const int hidx = ((myb * 2 + dir) * 64 + g) * 64 + n;
        hr0 = s5r[hidx]; hi0 = s5i[hidx]; hr1 = s5r[hidx + 32]; hi1 = s5i[hidx + 32];
        float pr0 = ar0, pi0 = ai0, pr1 = ar1, pi1 = ai1;
#pragma unroll
        for (int k = 0; k < 8; ++k) { const float a = pr0 * pr0 - pi0 * pi0, b2 = 2.f * pr0 * pi0; pr0 = a; pi0 = b2; const float c = pr1 * pr1 - pi1 * pi1, d = 2.f * pr1 * pi1; pr1 = c; pi1 = d; }
        for (int i = 0; i < myj; ++i) { const f32x2v e0 = *(const f32x2v*)(E + i * 128 + n * 2), e1 = *(const f32x2v*)(E + i * 128 + (n + 32) * 2);
            const float a = pr0 * hr0 - pi0 * hi0 + e0.x, b2 = pr0 * hi0 + pi0 * hr0 + e0.y; hr0 = a; hi0 = b2;
            const float c = pr1 * hr1 - pi1 * hi1 + e1.x, d = pr1 * hi1 + pi1 * hr1 + e1.y; hr1 = c; hi1 = d; }
    }
    const int ca = (n >> 2) & 1, ia = (n & 3) + 4 * (n >> 3);
    const int abase = ca ? cbase[1] : cbase[0], aL = ca ? cL[1] : cL[0], aj = ca ? cj[1] : cj[0];
#define S5_AROW(st) (abase + (dir ? aL - 1 - (aj * 256 + (st) * 16 + ia) : aj * 256 + (st) * 16 + ia))
    u32x4 anext = *(const u32x4*)(U + (size_t)S5_AROW(0) * 1024 + g * 16 + 8 * hh);
    for (int st = 0; st < 16; ++st) {
        const bf16x8 af = __builtin_bit_cast(bf16x8, anext);
        if (st + 1 < 16) anext = *(const u32x4*)(U + (size_t)S5_AROW(st + 1) * 1024 + g * 16 + 8 * hh);
        f32x16s acc[4];
#pragma unroll
        for (int nb = 0; nb < 4; ++nb) {
#pragma unroll
            for (int i = 0; i < 16; ++i) acc[nb][i] = 0.f;
            acc[nb] = __builtin_amdgcn_mfma_f32_32x32x16_bf16(af, bbf[nb], acc[nb], 0, 0, 0); acc[nb] = __builtin_amdgcn_mfma_f32_32x32x16_bf16(af, bbl[nb], acc[nb], 0, 0, 0); }
#pragma unroll
        for (int i = 0; i < 16; ++i) {
            const float a = ar0 * hr0 - ai0 * hi0 + acc[0][i], b2 = ar0 * hi0 + ai0 * hr0 + acc[2][i]; hr0 = a; hi0 = b2;
            const float c = ar1 * hr1 - ai1 * hi1 + acc[1][i], d = ar1 * hi1 + ai1 * hr1 + acc[3][i]; hr1 = c; hi1 = d;
            if (OUTPUT) { u32x2 w, wl; split_pk(hr0, hi0, w.x, wl.x); split_pk(hr1, hi1, w.y, wl.y); *(LAS u32x2*)(ht + (16 * hh + i) * S5_HT_STRIDE + n * 8) = w; *(LAS u32x2*)(ht + (16 * hh + i) * S5_HT_STRIDE + 256 + n * 8) = wl; } }
        if (OUTPUT) {
            asm volatile("s_waitcnt lgkmcnt(0)" ::: "memory");
#pragma unroll
            for (int mbk = 0; mbk < 2; ++mbk) { f32x4 y = (f32x4){0.f, 0.f, 0.f, 0.f};
#pragma unroll
                for (int ks = 0; ks < 4; ++ks) { const bf16x8 hf = *(const LAS bf16x8*)(ht + (16 * mbk + c16) * S5_HT_STRIDE + (32 * ks + 8 * g4) * 2), hl = *(const LAS bf16x8*)(ht + (16 * mbk + c16) * S5_HT_STRIDE + 256 + (32 * ks + 8 * g4) * 2);
                    y = __builtin_amdgcn_mfma_f32_16x16x32_bf16(cmf[ks], hf, y, 0, 0, 0); y = __builtin_amdgcn_mfma_f32_16x16x32_bf16(cmf[ks], hl, y, 0, 0, 0); y = __builtin_amdgcn_mfma_f32_16x16x32_bf16(cml[ks], hf, y, 0, 0, 0); }
                const int tau = cj[mbk] * 256 + st * 16 + c16, t = dir ? cL[mbk] - 1 - tau : tau;
                *(f32x4*)(Y5 + (size_t)(cbase[mbk] + t) * 1024 + g * 16 + 4 * g4) = y; }
            asm volatile("" ::: "memory"); }
    }
#undef S5_AROW
    if (!OUTPUT) { *(f32x2v*)(E + myj * 128 + n * 2) = (f32x2v){hr0, hi0}; *(f32x2v*)(E + myj * 128 + (n + 32) * 2) = (f32x2v){hr1, hi1}; }
    if (OUTPUT && !mylat) { const int o = ((myb * 2 + dir) * 64 + g) * 64 + n; p.out[OUT_S5RE + o] = hr0; p.out[OUT_S5IM + o] = hi0; p.out[OUT_S5RE + o + 32] = hr1; p.out[OUT_S5IM + o + 32] = hi1; }
}
__device__ __forceinline__ void p_s5_passA(const Params& p, LAS unsigned char* lds) {
    const int wv = tidx() >> 6, gw = blockIdx.x * 8 + wv, nw = gridDim.x * 8;
    for (int it = gw; it < 30 * 128; it += nw) { const int pi = it >> 7, dir = (it >> 6) & 1, g = it & 63; const int i0 = 2 * pi, i1 = 2 * pi + 1;
        s5_mfma_item<false>(p, lds + wv * S5_HT_BYTES, g, dir, (i0 / 15) * 16 + i0 % 15, (i1 / 15) * 16 + i1 % 15); }
}
__device__ __forceinline__ void p_s5_passC_lat(const Params& p, LAS unsigned char* lds) {
    const int wv = tidx() >> 6, gw = blockIdx.x * 8 + wv, nw = gridDim.x * 8;
    for (int it = gw; it < 32 * 128; it += nw) { const int pi = it >> 7, dir = (it >> 6) & 1, g = it & 63;
        s5_mfma_item<true>(p, lds + wv * S5_HT_BYTES, g, dir, 2 * pi, 2 * pi + 1); }
}
__device__ __forceinline__ void p_s5_passC_ctx(const Params& p) {
    const int wv = tidx() >> 6, gw = blockIdx.x * 8 + wv, nw = gridDim.x * 8;
    for (int c = gw; c < 2048; c += nw) { const int dir = c & 1, g = (c >> 1) & 63, b = c >> 7; s5_chunk_item<true>(p, b, g, dir, 0); }
}

__device__ __forceinline__ float red4(float x) {
    { const auto r = __builtin_amdgcn_permlane16_swap(__float_as_uint(x), __float_as_uint(x), false, false); x = __uint_as_float(r[0]) + __uint_as_float(r[1]); }
    { const auto r = __builtin_amdgcn_permlane32_swap(__float_as_uint(x), __float_as_uint(x), false, false); x = __uint_as_float(r[0]) + __uint_as_float(r[1]); }
    return x;
}
#define RW_DPP(n) " row_newbcast:" #n " row_mask:0xf bank_mask:0xf\n\t"
#define RW_B1_SA(n, acc) "v_fmac_f32_dpp %" #acc ", %24, %" #n RW_DPP(n)
#define RW_B1_MUL(n) "v_mul_f32_dpp %" #n ", %25, %" #n RW_DPP(n)
#define RW_B1_KD(n) "v_fmac_f32_dpp %" #n ", %26, %28" RW_DPP(n)
#define RW_B1_YT(n, acc) "v_fmac_f32_dpp %" #acc ", %27, %" #n RW_DPP(n)
__device__ __forceinline__ void rw_block1(float (&S)[16], float A, float W, float KD, float R, float vi, float& sa, float& yt) {
    float s0 = 0.f, s1 = 0.f, s2 = 0.f, s3 = 0.f, y0 = 0.f, y1 = 0.f, y2 = 0.f, y3 = 0.f;
    asm("s_nop 1\n\t"
        RW_B1_SA(0, 16) RW_B1_SA(1, 17) RW_B1_SA(2, 18) RW_B1_SA(3, 19) RW_B1_SA(4, 16) RW_B1_SA(5, 17) RW_B1_SA(6, 18) RW_B1_SA(7, 19)
        RW_B1_SA(8, 16) RW_B1_SA(9, 17) RW_B1_SA(10, 18) RW_B1_SA(11, 19) RW_B1_SA(12, 16) RW_B1_SA(13, 17) RW_B1_SA(14, 18) RW_B1_SA(15, 19)
        RW_B1_MUL(0) RW_B1_MUL(1) RW_B1_MUL(2) RW_B1_MUL(3) RW_B1_MUL(4) RW_B1_MUL(5) RW_B1_MUL(6) RW_B1_MUL(7) RW_B1_MUL(8) RW_B1_MUL(9) RW_B1_MUL(10) RW_B1_MUL(11) RW_B1_MUL(12) RW_B1_MUL(13) RW_B1_MUL(14) RW_B1_MUL(15)
        RW_B1_KD(0) RW_B1_KD(1) RW_B1_KD(2) RW_B1_KD(3) RW_B1_KD(4) RW_B1_KD(5) RW_B1_KD(6) RW_B1_KD(7) RW_B1_KD(8) RW_B1_KD(9) RW_B1_KD(10) RW_B1_KD(11) RW_B1_KD(12) RW_B1_KD(13) RW_B1_KD(14) RW_B1_KD(15)
        RW_B1_YT(0, 20) RW_B1_YT(1, 21) RW_B1_YT(2, 22) RW_B1_YT(3, 23) RW_B1_YT(4, 20) RW_B1_YT(5, 21) RW_B1_YT(6, 22) RW_B1_YT(7, 23)
        RW_B1_YT(8, 20) RW_B1_YT(9, 21) RW_B1_YT(10, 22) RW_B1_YT(11, 23) RW_B1_YT(12, 20) RW_B1_YT(13, 21) RW_B1_YT(14, 22) RW_B1_YT(15, 23)
        : "+v"(S[0]), "+v"(S[1]), "+v"(S[2]), "+v"(S[3]), "+v"(S[4]), "+v"(S[5]), "+v"(S[6]), "+v"(S[7]), "+v"(S[8]), "+v"(S[9]), "+v"(S[10]), "+v"(S[11]), "+v"(S[12]), "+v"(S[13]), "+v"(S[14]), "+v"(S[15]),
          "+v"(s0), "+v"(s1), "+v"(s2), "+v"(s3), "+v"(y0), "+v"(y1), "+v"(y2), "+v"(y3)
        : "v"(A), "v"(W), "v"(KD), "v"(R), "v"(vi));
    sa = (s0 + s1) + (s2 + s3); yt = (y0 + y1) + (y2 + y3);
}
#define RW_B2(n) "v_fmac_f32_dpp %" #n ", %16, %17" RW_DPP(n)
__device__ __forceinline__ void rw_block2(float (&S)[16], float B, float sa) {
    asm("s_nop 1\n\t"
        RW_B2(0) RW_B2(1) RW_B2(2) RW_B2(3) RW_B2(4) RW_B2(5) RW_B2(6) RW_B2(7) RW_B2(8) RW_B2(9) RW_B2(10) RW_B2(11) RW_B2(12) RW_B2(13) RW_B2(14) RW_B2(15)
        : "+v"(S[0]), "+v"(S[1]), "+v"(S[2]), "+v"(S[3]), "+v"(S[4]), "+v"(S[5]), "+v"(S[6]), "+v"(S[7]), "+v"(S[8]), "+v"(S[9]), "+v"(S[10]), "+v"(S[11]), "+v"(S[12]), "+v"(S[13]), "+v"(S[14]), "+v"(S[15])
        : "v"(B), "v"(sa));
}

constexpr int RW_W2 = 0, RW_A2 = 13312, RW_W = 26624, RW_A = 34816, RW_B = 38912, RW_KD = 43008, RW_R = 47104, RW_V = 51200, RW_YO = 55296, RW_BR = 63488, RW_CST = 63616, RW_HALF_BYTES = 64896, RW_TS = 208;
static_assert(2 * RW_HALF_BYTES <= LDS_BAR_OFF, "RWKV LDS map");
__device__ __forceinline__ void rwkv_tables(const Params& p) {
    const float* w2 = pin(p, I_W2); const float* a2 = pin(p, I_A2); bf16_t* W2T = (bf16_t*)(p.ws + WS_W2T); bf16_t* A2T = (bf16_t*)(p.ws + WS_A2T);
    for (int i = blockIdx.x * 512 + tidx(); i < 2 * 2048 * 96; i += gridDim.x * 512) { const int k = i % 96, c = (i / 96) & 2047, d = i / (96 * 2048);
        W2T[i] = f2bf(w2[(size_t)(d * 96 + k) * 2048 + c]); A2T[i] = f2bf(a2[(size_t)(d * 96 + k) * 2048 + c]); }
}
__device__ __forceinline__ void p9_rwkv(const Params& p, LAS unsigned char* lds) {
    const int tid = tidx(), half = tid >> 8, htid = tid & 255, hw = __builtin_amdgcn_readfirstlane((tid >> 6) & 3), lane = tid & 63, m = lane & 15, q = lane >> 4, wg = blockIdx.x, nwg = gridDim.x;
    LAS unsigned char* hl = lds + half * RW_HALF_BYTES;
    LAS float* AW = (LAS float*)(hl + RW_W); LAS float* YO = (LAS float*)(hl + RW_YO);
    const bf16_t* R = (const bf16_t*)(p.ws + WS_R); const bf16_t* K1 = (const bf16_t*)(p.ws + WS_K1); const bf16_t* V1 = (const bf16_t*)(p.ws + WS_V1); const bf16_t* LR = (const bf16_t*)(p.ws + WS_LR);
    const bf16_t* W2T = (const bf16_t*)(p.ws + WS_W2T); const bf16_t* A2T = (const bf16_t*)(p.ws + WS_A2T);
    float* BON = (float*)(p.ws + WS_BON); bf16_t* YD = (bf16_t*)(p.out + OUT_Y);
    const float* w0p = pin(p, I_W0); const float* a0p = pin(p, I_A0); const float* kkp = pin(p, I_KK); const float* kap = pin(p, I_KA); const float* rkp = pin(p, I_RK); const float* srw = pin(p, I_SRWKV);
    const int nun = half == 0 ? (256 - wg + nwg - 1) / nwg : (1024 - wg + nwg - 1) / nwg;
    const int bpu = half == 0 ? 128 : 8;
    const int my_steps = nun * bpu;
    const int n0 = (256 - wg + nwg - 1) / nwg * 128, n1 = (1024 - wg + nwg - 1) / nwg * 8;
    const int nsteps = n0 > n1 ? n0 : n1;
    float S[16];
    int base = 0, L = 0, b = 0, head = 0, dir = 0; bool lat = false;
    pg8::bf16x8 pftw[3], pfta[3]; u32x2 pfr[4], pfk[4], pfv[4];
#define RW_PREFETCH(bk) do { const int tau_ = (bk) * 32 + 16 * hw + m, t_ = dir ? L - 1 - tau_ : tau_; const unsigned row_ = (unsigned)(base + t_); \
        _Pragma("unroll") for (int ks = 0; ks < 3; ++ks) { pftw[ks] = *(const pg8::bf16x8*)((const char*)LR + row_ * 768u + (unsigned)(dir * 192 + (32 * ks + 8 * q) * 2)); \
            pfta[ks] = *(const pg8::bf16x8*)((const char*)LR + row_ * 768u + (unsigned)(384 + dir * 192 + (32 * ks + 8 * q) * 2)); } \
        _Pragma("unroll") for (int mb = 0; mb < 4; ++mb) { const unsigned ch_ = (unsigned)(head * 64 + 16 * mb + 4 * q); \
            pfr[mb] = *(const u32x2*)((const char*)R + (row_ * 2048u + ch_) * 2u); pfk[mb] = *(const u32x2*)((const char*)K1 + (row_ * 2048u + ch_) * 2u); pfv[mb] = *(const u32x2*)((const char*)V1 + (row_ * 2048u + ch_) * 2u); } } while (0)
    for (int step = 0; step < nsteps; ++step) {
        const bool active = step < my_steps; const int blk = step % bpu;
        if (active && blk == 0) {
            const int un = wg + (step / bpu) * nwg; int s;
            if (half == 0) { s = 16 + (un >> 6); head = (un >> 1) & 31; dir = un & 1; } else { s = un >> 6; head = (un >> 1) & 31; dir = un & 1; }
            seq_info(s, base, L, b, lat);
            for (int i = htid; i < 768; i += 256) { const int ch = i / 12, pc = i % 12; const size_t go = ((size_t)(dir * 2048 + head * 64 + ch) * 96 + pc * 8);
                *(LAS u32x4*)(hl + RW_W2 + ch * RW_TS + pc * 16) = *(const u32x4*)(W2T + go); *(LAS u32x4*)(hl + RW_A2 + ch * RW_TS + pc * 16) = *(const u32x4*)(A2T + go); }
            if (htid < 64) { LAS float* cst = (LAS float*)(hl + RW_CST); const int c = head * 64 + htid;
                cst[htid] = w0p[dir * 2048 + c]; cst[64 + htid] = a0p[dir * 2048 + c]; cst[128 + htid] = kkp[c]; cst[192 + htid] = kap[c]; cst[256 + htid] = rkp[c]; }
            if (hw < 2) RW_PREFETCH(0);
            const unsigned sb = (unsigned)((((b * 2 + dir) * 32 + head) * 64 + hw * 16 + m) * 64 + q * 16);
#pragma unroll
            for (int n = 0; n < 16; ++n) S[n] = 0.f;
            if (lat) {
#pragma unroll
                for (int n = 0; n < 16; ++n) S[n] = *(const float*)((const char*)srw + (sb + n) * 4u); }
        }
        __syncthreads();
        if (active && hw < 2) {
            const int tok = 16 * hw + m, tau = blk * 32 + tok, t = dir ? L - 1 - tau : tau; const unsigned row = (unsigned)(base + t);
            f32x4 dW[4], dA[4];
#pragma unroll
            for (int mb = 0; mb < 4; ++mb) { dW[mb] = (f32x4){0.f, 0.f, 0.f, 0.f}; dA[mb] = (f32x4){0.f, 0.f, 0.f, 0.f}; }
#pragma unroll
            for (int ks = 0; ks < 3; ++ks) {
                const pg8::bf16x8 tw = pftw[ks], ta = pfta[ks];
#pragma unroll
                for (int mb = 0; mb < 4; ++mb) { const pg8::bf16x8 wf = *(const LAS pg8::bf16x8*)(hl + RW_W2 + (16 * mb + m) * RW_TS + (32 * ks + 8 * q) * 2), af = *(const LAS pg8::bf16x8*)(hl + RW_A2 + (16 * mb + m) * RW_TS + (32 * ks + 8 * q) * 2);
                    dW[mb] = __builtin_amdgcn_mfma_f32_16x16x32_bf16(wf, tw, dW[mb], 0, 0, 0); dA[mb] = __builtin_amdgcn_mfma_f32_16x16x32_bf16(af, ta, dA[mb], 0, 0, 0); } }
            float kk[16], kd[16], av[16], ss = 0.f, bon = 0.f;
#pragma unroll
            for (int mb = 0; mb < 4; ++mb) {
                const u32x2 r2 = pfr[mb], k2 = pfk[mb], v2 = pfv[mb]; const LAS float* cst = (const LAS float*)(hl + RW_CST) + 16 * mb + 4 * q;
                const f32x4 w0 = *(const LAS f32x4*)cst, a0 = *(const LAS f32x4*)(cst + 64), kkw = *(const LAS f32x4*)(cst + 128), kaw = *(const LAS f32x4*)(cst + 192), rkw = *(const LAS f32x4*)(cst + 256);
                const float rr[4] = {bflo(r2.x), bfhi(r2.x), bflo(r2.y), bfhi(r2.y)}, k0[4] = {bflo(k2.x), bfhi(k2.x), bflo(k2.y), bfhi(k2.y)};
                f32x4 oW;
#pragma unroll
                for (int j = 0; j < 4; ++j) { const int e = 4 * mb + j;
                    const float xw = -(w0[j] + dW[mb][j]);
                    const float sp = fmaxf(xw, 0.f) + __logf(1.f + __expf(-fabsf(xw)));
                    oW[j] = __expf(-__expf(-sp - 0.5f));
                    const float a = 1.f / (1.f + __expf(-(a0[j] + dA[mb][j])));
                    kk[e] = k0[j] * kkw[j]; ss += kk[e] * kk[e]; av[e] = a;
                    kd[e] = k0[j] * (1.f + (a - 1.f) * kaw[j]); bon += rr[j] * kd[e] * rkw[j]; }
                *(LAS f32x4*)(hl + RW_W + (tok * 64 + 16 * mb + 4 * q) * 4) = oW;
                *(LAS u32x2*)(hl + RW_R + (tok * 64 + 16 * mb + 4 * q) * 2) = r2; *(LAS u32x2*)(hl + RW_V + (tok * 64 + 16 * mb + 4 * q) * 2) = v2;
                u32x2 kdp; kdp.x = cvtpk(kd[4 * mb], kd[4 * mb + 1]); kdp.y = cvtpk(kd[4 * mb + 2], kd[4 * mb + 3]); *(LAS u32x2*)(hl + RW_KD + (tok * 64 + 16 * mb + 4 * q) * 2) = kdp; }
            ss = red4(ss); bon = red4(bon);
            const float inv = 1.f / fmaxf(sqrtf(ss), 1e-12f);
            if (q == 0) BON[((size_t)dir * MTOK + row) * 32 + head] = bon;
            float br = 0.f;
#pragma unroll
            for (int mb = 0; mb < 4; ++mb) { u32x2 ap, bp; float kn[4];
#pragma unroll
                for (int j = 0; j < 4; ++j) kn[j] = kk[4 * mb + j] * inv;
                { const u32x2 r2 = *(LAS u32x2*)(hl + RW_R + (tok * 64 + 16 * mb + 4 * q) * 2); const u32x2 bq = (u32x2){cvtpk(kn[0] * av[4 * mb], kn[1] * av[4 * mb + 1]), cvtpk(kn[2] * av[4 * mb + 2], kn[3] * av[4 * mb + 3])};
                  br += bflo(bq.x) * bflo(r2.x) + bfhi(bq.x) * bfhi(r2.x) + bflo(bq.y) * bflo(r2.y) + bfhi(bq.y) * bfhi(r2.y); }
                ap.x = cvtpk(-kn[0], -kn[1]); ap.y = cvtpk(-kn[2], -kn[3]);
                bp.x = cvtpk(kn[0] * av[4 * mb], kn[1] * av[4 * mb + 1]); bp.y = cvtpk(kn[2] * av[4 * mb + 2], kn[3] * av[4 * mb + 3]);
                *(LAS u32x2*)(hl + RW_A + (tok * 64 + 16 * mb + 4 * q) * 2) = ap; *(LAS u32x2*)(hl + RW_B + (tok * 64 + 16 * mb + 4 * q) * 2) = bp; }
            br = red4(br); if (q == 0) *(LAS float*)(hl + RW_BR + tok * 4) = br;
        }
        __syncthreads();
        if (active && hw < 2 && blk + 1 < bpu) RW_PREFETCH(blk + 1);
        if (active) {
            const LAS bf16_t* LA = (const LAS bf16_t*)(hl + RW_A); const LAS bf16_t* LB = (const LAS bf16_t*)(hl + RW_B); const LAS bf16_t* LK = (const LAS bf16_t*)(hl + RW_KD);
            const LAS bf16_t* LRr = (const LAS bf16_t*)(hl + RW_R); const LAS bf16_t* LV = (const LAS bf16_t*)(hl + RW_V);
            float W = AW[lane], brt = *(LAS float*)(hl + RW_BR); unsigned A = LA[lane], B = LB[lane], KD = LK[lane], RR = LRr[lane], vi = LV[hw * 16 + m];
            for (int tau = 0; tau < 32; ++tau) {
                const int tn = tau < 31 ? tau + 1 : 31;
                const float Wn = AW[tn * 64 + lane], brn = *(LAS float*)(hl + RW_BR + tn * 4); const unsigned An = LA[tn * 64 + lane], Bn = LB[tn * 64 + lane], KDn = LK[tn * 64 + lane], RRn = LRr[tn * 64 + lane], vin = LV[tn * 64 + hw * 16 + m];
                float sa, yt;
                rw_block1(S, __uint_as_float(A << 16), W, __uint_as_float(KD << 16), __uint_as_float(RR << 16), __uint_as_float(vi << 16), sa, yt);
                sa = red4(sa);
                rw_block2(S, __uint_as_float(B << 16), sa);
                const float yp = red4(yt) + sa * brt;
                if (q == 0) YO[tau * 64 + hw * 16 + m] = yp;
                W = Wn; A = An; B = Bn; KD = KDn; RR = RRn; vi = vin; brt = brn;
            }
            if (blk == bpu - 1 && !lat) { const unsigned sb = (unsigned)((((b * 2 + dir) * 32 + head) * 64 + hw * 16 + m) * 64 + q * 16);
#pragma unroll
                for (int n = 0; n < 16; ++n) *(float*)((char*)p.out + ((unsigned)OUT_RWKV + sb + n) * 4u) = S[n]; }
        }
        __syncthreads();
        if (active) {
            const int tok = htid >> 3, c8 = (htid & 7) * 8, tau = blk * 32 + tok, t = dir ? L - 1 - tau : tau; const size_t row = (size_t)(base + t);
            const f32x4 y0 = *(LAS f32x4*)(YO + tok * 64 + c8), y1 = *(LAS f32x4*)(YO + tok * 64 + c8 + 4);
            u32x4 wv; wv.x = cvtpk(y0[0], y0[1]); wv.y = cvtpk(y0[2], y0[3]); wv.z = cvtpk(y1[0], y1[1]); wv.w = cvtpk(y1[2], y1[3]);
            *(u32x4*)(YD + (size_t)dir * MTOK * DM + row * DM + head * 64 + c8) = wv;
        }
    }
}

constexpr int RC_GL = 0, RC_MAB = 256, RC_MAK = 1536, RC_NBR = 2176, RC_NKR = 2816, RC_XT = 3456, RC_MD = 3456, RC_SSP = 3712, RC_BNP = 3968, RC_YO = 7808, RC_BH = 9856, RC_KH = 12416, RC_AT = 14976, RC_RT = 17280, RC_BT = 19584, RC_KT = 21888,
              RC_CST = 24192, RC_W = 25472, RC_A = 33664, RC_B = 37760, RC_KD = 41856, RC_R = 45952, RC_V = 50048, RC_W2 = 54144, RC_A2 = 67456, RC_HALF = 80768;
constexpr int RC_TS = 208, RC_TT = 144, RC_HS = 40, RC_MS = 80, RC_NS = 40, RC_XS = 68;
static_assert(2 * RC_HALF <= LDS_BAR_OFF, "RWKV chunk LDS map");
__device__ __forceinline__ bf16_t f2bf_rne(float f) { unsigned u = __float_as_uint(f); u += 0x7FFFu + ((u >> 16) & 1u); return (bf16_t)(u >> 16); }
__device__ __forceinline__ bf16x8 mk_frag(u32x2 lo, u32x2 hi) { return __builtin_bit_cast(bf16x8, (u32x4){lo.x, lo.y, hi.x, hi.y}); }

__device__ __forceinline__ int rw_sw(int tok, int ch) { return tok * 64 + ((((ch >> 2) ^ (tok & 15)) << 2) | (ch & 3)); }
__device__ __forceinline__ void p9_rwkv_chunk(const Params& p, LAS unsigned char* lds) {
    const int tid = tidx(), half = tid >> 8, htid = tid & 255, hw = __builtin_amdgcn_readfirstlane((tid >> 6) & 3), lane = tid & 63, c16 = lane & 15, g = lane >> 4, wg = blockIdx.x, nwg = gridDim.x;
    LAS unsigned char* hl = lds + half * RC_HALF;
    const bf16_t* R = (const bf16_t*)(p.ws + WS_R); const bf16_t* K1 = (const bf16_t*)(p.ws + WS_K1); const bf16_t* V1 = (const bf16_t*)(p.ws + WS_V1); const bf16_t* LR = (const bf16_t*)(p.ws + WS_LR);
    const bf16_t* W2T = (const bf16_t*)(p.ws + WS_W2T); const bf16_t* A2T = (const bf16_t*)(p.ws + WS_A2T);
    float* BON = (float*)(p.ws + WS_BON); bf16_t* YD = (bf16_t*)(p.out + OUT_Y);
    const float* w0p = pin(p, I_W0); const float* a0p = pin(p, I_A0); const float* kkp = pin(p, I_KK); const float* kap = pin(p, I_KA); const float* rkp = pin(p, I_RK); const float* srw = pin(p, I_SRWKV);
    const int nun = half == 0 ? (256 - wg + nwg - 1) / nwg : (1024 - wg + nwg - 1) / nwg;
    const int bpu = half == 0 ? 128 : 8;
    const int my_steps = nun * bpu;
    const int n0 = (256 - wg + nwg - 1) / nwg * 128, n1 = (1024 - wg + nwg - 1) / nwg * 8;
    const int nsteps = n0 > n1 ? n0 : n1;
    f32x4 Sacc[4];
    int base = 0, L = 0, b = 0, head = 0, dir = 0; bool lat = false;
    const int m = c16, q = g;
    pg8::bf16x8 pftw[3], pfta[3]; u32x2 pfr[2], pfk[2], pfv[2];
#define RC_PREFETCH(bk) do { const int tau_ = (bk) * 32 + 16 * (hw & 1) + m, t_ = dir ? L - 1 - tau_ : tau_; const unsigned row_ = (unsigned)(base + t_); \
        _Pragma("unroll") for (int ks = 0; ks < 3; ++ks) { pftw[ks] = *(const pg8::bf16x8*)((const char*)LR + row_ * 768u + (unsigned)(dir * 192 + (32 * ks + 8 * q) * 2)); \
            pfta[ks] = *(const pg8::bf16x8*)((const char*)LR + row_ * 768u + (unsigned)(384 + dir * 192 + (32 * ks + 8 * q) * 2)); } \
        _Pragma("unroll") for (int mi = 0; mi < 2; ++mi) { const unsigned ch_ = (unsigned)(head * 64 + 16 * (2 * (hw >> 1) + mi) + 4 * q); \
            pfr[mi] = *(const u32x2*)((const char*)R + (row_ * 2048u + ch_) * 2u); pfk[mi] = *(const u32x2*)((const char*)K1 + (row_ * 2048u + ch_) * 2u); pfv[mi] = *(const u32x2*)((const char*)V1 + (row_ * 2048u + ch_) * 2u); } } while (0)
    for (int step = 0; step < nsteps; ++step) {
        const bool active = step < my_steps; const int blk = step % bpu;
        if (active && blk == 0) {
            const int un = wg + (step / bpu) * nwg; int s;
            if (half == 0) { s = 16 + (un >> 6); head = (un >> 1) & 31; dir = un & 1; } else { s = un >> 6; head = (un >> 1) & 31; dir = un & 1; }
            seq_info(s, base, L, b, lat);
            for (int i = htid; i < 768; i += 256) { const int ch = i / 12, pc = i % 12; const size_t go = ((size_t)(dir * 2048 + head * 64 + ch) * 96 + pc * 8);
                *(LAS u32x4*)(hl + RC_W2 + ch * RC_TS + pc * 16) = *(const u32x4*)(W2T + go); *(LAS u32x4*)(hl + RC_A2 + ch * RC_TS + pc * 16) = *(const u32x4*)(A2T + go); }
            if (htid < 64) { LAS float* cst = (LAS float*)(hl + RC_CST); const int c = head * 64 + htid;
                cst[htid] = w0p[dir * 2048 + c]; cst[64 + htid] = a0p[dir * 2048 + c]; cst[128 + htid] = kkp[c]; cst[192 + htid] = kap[c]; cst[256 + htid] = rkp[c]; }
            RC_PREFETCH(0);
            const unsigned sb = (unsigned)((((b * 2 + dir) * 32 + head) * 64 + hw * 16 + c16) * 64 + 4 * g);
#pragma unroll
            for (int jb = 0; jb < 4; ++jb) Sacc[jb] = lat ? *(const f32x4*)((const char*)srw + (sb + 16 * jb) * 4u) : (f32x4){0.f, 0.f, 0.f, 0.f};
            __builtin_amdgcn_s_waitcnt(0x0F70);
        }
        __syncthreads();
#ifndef RW_REPS_A
#define RW_REPS_A 1
#define RW_REPS_C 1
#define RW_REPS_M 1
#endif
#ifndef RW_REPS_1
#define RW_REPS_1 1
#endif
#ifndef RW_REPS_W
#define RW_REPS_W 1
#endif
#ifndef RW_DELAY
#define RW_DELAY 0
#endif
#define RWD_BEGIN(S) unsigned long long rwd_t0_##S = 0; if (RW_DELAY == S) rwd_t0_##S = clock64();
#define RWD_END(S) if (RW_DELAY == S) { asm volatile("s_waitcnt lgkmcnt(0)" ::: "memory"); const unsigned long long t1_ = clock64(), d_ = t1_ - rwd_t0_##S; while ((unsigned long long)clock64() - t1_ < d_) { } }
        RWD_BEGIN(1)
        if (active) for (int repa = 0; repa < RW_REPS_A; ++repa) {
            const int tok = 16 * (hw & 1) + m, mb0 = 2 * (hw >> 1);
            f32x4 dW[2], dA[2];
#pragma unroll
            for (int mi = 0; mi < 2; ++mi) { dW[mi] = (f32x4){0.f, 0.f, 0.f, 0.f}; dA[mi] = (f32x4){0.f, 0.f, 0.f, 0.f}; }
#pragma unroll
            for (int ks = 0; ks < 3; ++ks) {
                const pg8::bf16x8 tw = pftw[ks], ta = pfta[ks];
#pragma unroll
                for (int mi = 0; mi < 2; ++mi) { const pg8::bf16x8 wf = *(const LAS pg8::bf16x8*)(hl + RC_W2 + (16 * (mb0 + mi) + m) * RC_TS + (32 * ks + 8 * q) * 2), af = *(const LAS pg8::bf16x8*)(hl + RC_A2 + (16 * (mb0 + mi) + m) * RC_TS + (32 * ks + 8 * q) * 2);
                    dW[mi] = __builtin_amdgcn_mfma_f32_16x16x32_bf16(wf, tw, dW[mi], 0, 0, 0); dA[mi] = __builtin_amdgcn_mfma_f32_16x16x32_bf16(af, ta, dA[mi], 0, 0, 0); } }
            float ss = 0.f, bon = 0.f;
#pragma unroll
            for (int mi = 0; mi < 2; ++mi) { const int mb = mb0 + mi;
                const u32x2 r2 = pfr[mi], k2 = pfk[mi], v2 = pfv[mi]; const LAS float* cst = (const LAS float*)(hl + RC_CST) + 16 * mb + 4 * q;
                const f32x4 w0 = *(const LAS f32x4*)cst, a0 = *(const LAS f32x4*)(cst + 64), kkw = *(const LAS f32x4*)(cst + 128), kaw = *(const LAS f32x4*)(cst + 192), rkw = *(const LAS f32x4*)(cst + 256);
                const float rr[4] = {bflo(r2.x), bfhi(r2.x), bflo(r2.y), bfhi(r2.y)}, k0[4] = {bflo(k2.x), bfhi(k2.x), bflo(k2.y), bfhi(k2.y)};
                f32x4 oW; float kd[4], kk[4], kb[4];
#pragma unroll
                for (int j = 0; j < 4; ++j) {
                    const float xw = -(w0[j] + dW[mi][j]);
                    const float sp = fmaxf(xw, 0.f) + 0.6931471806f * __builtin_amdgcn_logf(1.f + __builtin_amdgcn_exp2f(-1.4426950409f * fabsf(xw)));
                    oW[j] = __builtin_amdgcn_exp2f(-1.4426950409f * __builtin_amdgcn_exp2f(-1.4426950409f * (sp + 0.5f)));
                    const float a = __builtin_amdgcn_rcpf(1.f + __builtin_amdgcn_exp2f(-1.4426950409f * (a0[j] + dA[mi][j])));
                    kk[j] = k0[j] * kkw[j]; ss += kk[j] * kk[j]; kb[j] = kk[j] * a;
                    kd[j] = k0[j] * (1.f + (a - 1.f) * kaw[j]); bon += rr[j] * kd[j] * rkw[j]; }
                const int eo = rw_sw(tok, 16 * mb + 4 * q);
                *(LAS f32x4*)(hl + RC_W + eo * 4) = oW;
                *(LAS u32x2*)(hl + RC_R + eo * 2) = r2; *(LAS u32x2*)(hl + RC_V + eo * 2) = v2;
                *(LAS u32x2*)(hl + RC_KD + eo * 2) = (u32x2){cvtpk(kd[0], kd[1]), cvtpk(kd[2], kd[3])};
                *(LAS u32x2*)(hl + RC_A + eo * 2) = (u32x2){cvtpk(-kk[0], -kk[1]), cvtpk(-kk[2], -kk[3])};
                *(LAS u32x2*)(hl + RC_B + eo * 2) = (u32x2){cvtpk(kb[0], kb[1]), cvtpk(kb[2], kb[3])}; }
            ss = red4(ss); bon = red4(bon);
            if (q == 0) { *(LAS float*)(hl + RC_SSP + (tok * 2 + (hw >> 1)) * 4) = ss; *(LAS float*)(hl + RC_BNP + (tok * 2 + (hw >> 1)) * 4) = bon; }
        }
        RWD_END(1)
        __syncthreads();
        if (active && blk + 1 < bpu) RC_PREFETCH(blk + 1);
#pragma unroll 1
        for (int cc = 0; cc < 2; ++cc) {
            const int cb = 16 * cc;
            RWD_BEGIN(2)
            if (active) for (int repc = 0; repc < RW_REPS_C; ++repc) { int ln = lane; asm volatile("" : "+v"(ln));
                float wv[16], ow[4], bt[4], kt[4]; unsigned ra[4], rb[4], rk[4], rr[4];
#pragma unroll
                for (int t1 = 0; t1 < 16; ++t1) wv[t1] = *(const LAS float*)(hl + RC_W + rw_sw(cb + t1, ln) * 4);
#pragma unroll
                for (int e = 0; e < 4; ++e) { const unsigned o = (unsigned)rw_sw(cb + 4 * hw + e, ln); ow[e] = *(const LAS float*)(hl + RC_W + o * 4u);
                    ra[e] = *(const LAS bf16_t*)(hl + RC_A + o * 2u); rb[e] = *(const LAS bf16_t*)(hl + RC_B + o * 2u); rk[e] = *(const LAS bf16_t*)(hl + RC_KD + o * 2u); rr[e] = *(const LAS bf16_t*)(hl + RC_R + o * 2u); }
                f32x2v ssp[4];
#pragma unroll
                for (int e = 0; e < 4; ++e) ssp[e] = *(const LAS f32x2v*)(hl + RC_SSP + (cb + 4 * hw + e) * 8);
                const f32x2v bnp = *(const LAS f32x2v*)(hl + RC_BNP + (cb + 4 * hw + (ln & 3)) * 8);
                __builtin_amdgcn_sched_barrier(0);
                float inv[4];
#pragma unroll
                for (int e = 0; e < 4; ++e) inv[e] = __builtin_amdgcn_rcpf(fmaxf(__builtin_amdgcn_sqrtf(ssp[e].x + ssp[e].y), 1e-12f));
                if (ln < 4) { const int tau = blk * 32 + cb + 4 * hw + ln, t = dir ? L - 1 - tau : tau; BON[((size_t)dir * MTOK + (size_t)(base + t)) * 32 + head] = bnp.x + bnp.y; }
                const float p40 = (wv[0] * wv[1]) * (wv[2] * wv[3]), p41 = (wv[4] * wv[5]) * (wv[6] * wv[7]), p42 = (wv[8] * wv[9]) * (wv[10] * wv[11]), p43 = (wv[12] * wv[13]) * (wv[14] * wv[15]);
                const float c01 = p40 * p41, c012 = c01 * p42, gl = c012 * p43;
                float grun = hw == 0 ? 1.f : hw == 1 ? p40 : hw == 2 ? c01 : c012;
#pragma unroll
                for (int e = 0; e < 4; ++e) { const int t1 = 4 * hw + e; const float gprev = grun; grun *= ow[e];
                    const float a = __uint_as_float(ra[e] << 16) * inv[e], bv = __uint_as_float(rb[e] << 16) * inv[e], kd = __uint_as_float(rk[e] << 16), rv = __uint_as_float(rr[e] << 16);
                    const float ig = __builtin_amdgcn_rcpf(grun); bt[e] = bv * ig; kt[e] = kd * ig;
                    *(LAS bf16_t*)(hl + RC_AT + t1 * RC_TT + ln * 2) = f2bf(gprev * a); *(LAS bf16_t*)(hl + RC_RT + t1 * RC_TT + ln * 2) = f2bf(grun * rv);
                    *(LAS bf16_t*)(hl + RC_BT + t1 * RC_TT + ln * 2) = f2bf(bt[e]); *(LAS bf16_t*)(hl + RC_KT + t1 * RC_TT + ln * 2) = f2bf(kt[e]); }
                u32x2 bh, kh; bh.x = cvtpk(bt[0] * gl, bt[1] * gl); bh.y = cvtpk(bt[2] * gl, bt[3] * gl); kh.x = cvtpk(kt[0] * gl, kt[1] * gl); kh.y = cvtpk(kt[2] * gl, kt[3] * gl);
                *(LAS u32x2*)(hl + RC_BH + ln * RC_HS + hw * 8) = bh; *(LAS u32x2*)(hl + RC_KH + ln * RC_HS + hw * 8) = kh;
                if (hw == 0) *(LAS float*)(hl + RC_GL + ln * 4) = gl;
            }
            RWD_END(2)
            __syncthreads();
            RWD_BEGIN(3)
            if (active) for (int rep1 = 0; rep1 < RW_REPS_1; ++rep1) {
                const int xo = (hw & 1) ? RC_KT : RC_BT, yo = (hw & 2) ? RC_RT : RC_AT;
                f32x4 mm = (f32x4){0.f, 0.f, 0.f, 0.f};
#pragma unroll
                for (int ks = 0; ks < 2; ++ks) { const bf16x8 xf = *(const LAS bf16x8*)(hl + xo + c16 * RC_TT + (32 * ks + 8 * g) * 2), yf = *(const LAS bf16x8*)(hl + yo + c16 * RC_TT + (32 * ks + 8 * g) * 2);
                    mm = __builtin_amdgcn_mfma_f32_16x16x32_bf16(xf, yf, mm, 0, 0, 0); }
#pragma unroll
                for (int r = 0; r < 4; ++r) { const int s_ = 4 * g + r; const bool keep = (hw & 2) ? (s_ <= c16) : (s_ < c16); mm[r] = keep ? mm[r] : 0.f; }
                if (hw == 0) {
                    const int tb = c16 >> 2;
#pragma unroll
                    for (int r = 0; r < 4; ++r) *(LAS float*)(hl + RC_MAB + (4 * g + r) * RC_MS + c16 * 4) = g < tb ? mm[r] : 0.f;
                    if (g == tb) {
#pragma unroll
                        for (int r = 0; r < 4; ++r) *(LAS float*)(hl + RC_MD + (4 * g + r) * 16 + (c16 & 3) * 4) = mm[r]; } }
                else { u32x2 w; w.x = cvtpk(mm[0], mm[1]); w.y = cvtpk(mm[2], mm[3]); *(LAS u32x2*)(hl + (hw == 1 ? RC_MAK : hw == 2 ? RC_NBR : RC_NKR) + c16 * RC_NS + g * 8) = w; }
            }
            RWD_END(3)
            __syncthreads();
            RWD_BEGIN(4)
            if (active) for (int repm = 0; repm < RW_REPS_M; ++repm) {
                const u32x2 zz = (u32x2){0u, 0u};
                bf16x8 sfr[2];
#pragma unroll
                for (int ks = 0; ks < 2; ++ks) { u32x4 s4; s4.x = cvtpk(Sacc[2 * ks][0], Sacc[2 * ks][1]); s4.y = cvtpk(Sacc[2 * ks][2], Sacc[2 * ks][3]);
                    s4.z = cvtpk(Sacc[2 * ks + 1][0], Sacc[2 * ks + 1][1]); s4.w = cvtpk(Sacc[2 * ks + 1][2], Sacc[2 * ks + 1][3]); sfr[ks] = __builtin_bit_cast(bf16x8, s4); }
                bf16x8 vfr;
                { const LAS bf16_t* vp = (const LAS bf16_t*)(hl + RC_V); const int vi_ = 16 * hw + c16, vt_ = cb + 4 * g;
                  const unsigned v0 = vp[rw_sw(vt_, vi_)], v1 = vp[rw_sw(vt_ + 1, vi_)], v2 = vp[rw_sw(vt_ + 2, vi_)], v3 = vp[rw_sw(vt_ + 3, vi_)]; vfr = mk_frag((u32x2){v0 | (v1 << 16), v2 | (v3 << 16)}, zz); }
                f32x4 mx[12], md[3];
#pragma unroll
                for (int s1 = 0; s1 < 12; ++s1) mx[s1] = *(const LAS f32x4*)(hl + RC_MAB + s1 * RC_MS + g * 16);
#pragma unroll
                for (int e = 0; e < 3; ++e) md[e] = *(const LAS f32x4*)(hl + RC_MD + (4 * g + e) * 16);
                f32x4 xt = (f32x4){0.f, 0.f, 0.f, 0.f}, yt = (f32x4){0.f, 0.f, 0.f, 0.f};
#pragma unroll
                for (int ks = 0; ks < 2; ++ks) {
                    const LAS unsigned char* ap = hl + RC_AT + c16 * RC_TT + (32 * ks + 4 * g) * 2; const LAS unsigned char* rp = hl + RC_RT + c16 * RC_TT + (32 * ks + 4 * g) * 2;
                    xt = __builtin_amdgcn_mfma_f32_16x16x32_bf16(mk_frag(*(const LAS u32x2*)ap, *(const LAS u32x2*)(ap + 32)), sfr[ks], xt, 0, 0, 0);
                    yt = __builtin_amdgcn_mfma_f32_16x16x32_bf16(mk_frag(*(const LAS u32x2*)rp, *(const LAS u32x2*)(rp + 32)), sfr[ks], yt, 0, 0, 0); }
                xt = __builtin_amdgcn_mfma_f32_16x16x32_bf16(mk_frag(*(const LAS u32x2*)(hl + RC_MAK + c16 * RC_NS + g * 8), zz), vfr, xt, 0, 0, 0);
                yt = __builtin_amdgcn_mfma_f32_16x16x32_bf16(mk_frag(*(const LAS u32x2*)(hl + RC_NKR + c16 * RC_NS + g * 8), zz), vfr, yt, 0, 0, 0);
                float x[4] = {xt[0], xt[1], xt[2], xt[3]};
#pragma unroll
                for (int h = 0; h < 4; ++h) {
                    if (g == h) { x[1] += x[0] * md[0][1]; x[2] += x[0] * md[0][2]; x[3] += x[0] * md[0][3]; x[2] += x[1] * md[1][2]; x[3] += x[1] * md[1][3]; x[3] += x[2] * md[2][3]; }
                    if (h < 3) { float ub[4];
#pragma unroll
                        for (int e = 0; e < 4; ++e) { const unsigned xv = __float_as_uint(x[e]);
                            if (h == 2) { const auto r1 = __builtin_amdgcn_permlane16_swap(xv, xv, false, false); ub[e] = __uint_as_float(r1[0]); }
                            else { const auto r0 = __builtin_amdgcn_permlane32_swap(xv, xv, false, false); const auto r1 = __builtin_amdgcn_permlane16_swap(r0[0], r0[0], false, false); ub[e] = __uint_as_float(r1[h]); } }
#pragma unroll
                        for (int e2 = 0; e2 < 4; ++e2)
#pragma unroll
                            for (int e = 0; e < 4; ++e) x[e] += ub[e2] * mx[4 * h + e2][e]; } }
                const bf16x8 ufr = mk_frag((u32x2){cvtpk(x[0], x[1]), cvtpk(x[2], x[3])}, zz);
                yt = __builtin_amdgcn_mfma_f32_16x16x32_bf16(mk_frag(*(const LAS u32x2*)(hl + RC_NBR + c16 * RC_NS + g * 8), zz), ufr, yt, 0, 0, 0);
#pragma unroll
                for (int r = 0; r < 4; ++r) *(LAS bf16_t*)(hl + RC_YO + (4 * g + r) * 128 + (16 * hw + c16) * 2) = f2bf_rne(yt[r]);
                if (repm + 1 == RW_REPS_M)
#pragma unroll
                for (int jb = 0; jb < 4; ++jb) { const f32x4 gl4 = *(const LAS f32x4*)(hl + RC_GL + (16 * jb + 4 * g) * 4); Sacc[jb] = Sacc[jb] * gl4;
                    Sacc[jb] = __builtin_amdgcn_mfma_f32_16x16x32_bf16(mk_frag(*(const LAS u32x2*)(hl + RC_BH + (16 * jb + c16) * RC_HS + g * 8), zz), ufr, Sacc[jb], 0, 0, 0);
                    Sacc[jb] = __builtin_amdgcn_mfma_f32_16x16x32_bf16(mk_frag(*(const LAS u32x2*)(hl + RC_KH + (16 * jb + c16) * RC_HS + g * 8), zz), vfr, Sacc[jb], 0, 0, 0); }
                if (cc == 1 && blk == bpu - 1 && !lat && repm + 1 == RW_REPS_M) { const unsigned sb = (unsigned)((((b * 2 + dir) * 32 + head) * 64 + hw * 16 + c16) * 64 + 4 * g);
#pragma unroll
                    for (int jb = 0; jb < 4; ++jb) *(f32x4*)((char*)p.out + ((unsigned)OUT_RWKV + sb + 16 * jb) * 4u) = Sacc[jb]; }
            }
            RWD_END(4)
            __syncthreads();
            RWD_BEGIN(5)
            if (active && htid < 128) for (int repw = 0; repw < RW_REPS_W; ++repw) {
                const int tok = htid >> 3, c8 = (htid & 7) * 8, tau = blk * 32 + cb + tok, t = dir ? L - 1 - tau : tau; const size_t row = (size_t)(base + t);
                *(u32x4*)(YD + (size_t)dir * MTOK * DM + row * DM + head * 64 + c8) = *(const LAS u32x4*)(hl + RC_YO + tok * 128 + c8 * 2);
            }
            RWD_END(5)
        }
    }
#undef RC_PREFETCH
}

constexpr int RP_W2 = 0, RP_A2 = 13312, RP_CST = 26624, RP_W = 27904, RP_A = 32000, RP_B = 34048, RP_KD = 36096, RP_R = 38144, RP_SSP = 40192, RP_BNP = 40448, RP_XT = 40704, RP_YO = 45056, RP_BUF = 47104;
constexpr int RB_V = 0, RB_AT = 2048, RB_RT = 4352, RB_BT = 6656, RB_KT = 8960, RB_BH = 11264, RB_KH = 13824, RB_GL = 16384, RB_MAB = 16640, RB_MAK = 17920, RB_NBR = 18560, RB_NKR = 19200, RB_SIZE = 19840;
static_assert(RP_BUF + 2 * RB_SIZE <= LDS_BAR_OFF, "RWKV pipe LDS map");

struct RwkvUnit { int base, L, b, head, dir; bool lat; };
__device__ __forceinline__ void rwkv_unit_of(int n, int wg, RwkvUnit& u, int& c, int& nch) {
    int un, s;
    if (n < 256) { un = wg; s = 16 + (un >> 6); c = n; nch = 256; } else { const int k = (n - 256) >> 4; un = wg + 256 * k; s = un >> 6; c = (n - 256) & 15; nch = 16; }
    u.head = (un >> 1) & 31; u.dir = un & 1; seq_info(s, u.base, u.L, u.b, u.lat);
}

__device__ __forceinline__ void p9_rwkv_pipe(const Params& p, LAS unsigned char* lds) {
    const int tid = tidx(), half = __builtin_amdgcn_readfirstlane(tid >> 8), htid = tid & 255, pw = __builtin_amdgcn_readfirstlane((tid >> 6) & 3), lane = tid & 63, c16 = lane & 15, g = lane >> 4, wg = blockIdx.x;
    const bool producer = half == 1;
    const bf16_t* R = (const bf16_t*)(p.ws + WS_R); const bf16_t* K1 = (const bf16_t*)(p.ws + WS_K1); const bf16_t* V1 = (const bf16_t*)(p.ws + WS_V1); const bf16_t* LR = (const bf16_t*)(p.ws + WS_LR);
    const bf16_t* W2T = (const bf16_t*)(p.ws + WS_W2T); const bf16_t* A2T = (const bf16_t*)(p.ws + WS_A2T);
    float* BON = (float*)(p.ws + WS_BON); bf16_t* YD = (bf16_t*)(p.out + OUT_Y);
    const float* w0p = pin(p, I_W0); const float* a0p = pin(p, I_A0); const float* kkp = pin(p, I_KK); const float* kap = pin(p, I_KA); const float* rkp = pin(p, I_RK); const float* srw = pin(p, I_SRWKV);
    constexpr int NCH = 256 + 4 * 16;
    f32x4 Sacc[4];
    pg8::bf16x8 pftw[3], pfta[3]; u32x2 pfr, pfk, pfv;
#define RP_PREFETCH(U, cc) do { const int tau_ = (cc) * 16 + c16, t_ = (U).dir ? (U).L - 1 - tau_ : tau_; const unsigned row_ = (unsigned)((U).base + t_); \
        _Pragma("unroll") for (int ks = 0; ks < 3; ++ks) { pftw[ks] = *(const pg8::bf16x8*)((const char*)LR + row_ * 768u + (unsigned)((U).dir * 192 + (32 * ks + 8 * g) * 2)); \
            pfta[ks] = *(const pg8::bf16x8*)((const char*)LR + row_ * 768u + (unsigned)(384 + (U).dir * 192 + (32 * ks + 8 * g) * 2)); } \
        { const unsigned ch_ = (unsigned)((U).head * 64 + 16 * pw + 4 * g); \
          pfr = *(const u32x2*)((const char*)R + (row_ * 2048u + ch_) * 2u); pfk = *(const u32x2*)((const char*)K1 + (row_ * 2048u + ch_) * 2u); pfv = *(const u32x2*)((const char*)V1 + (row_ * 2048u + ch_) * 2u); } } while (0)
    for (int n = -1; n < NCH; ++n) {
        RwkvUnit up; int cp = 0, nchp = 0; const bool has_p = n + 1 < NCH;
        if (has_p) rwkv_unit_of(n + 1, wg, up, cp, nchp);
        if (has_p && cp == 0) {
            if (producer) {
                for (int i = htid; i < 768; i += 256) { const int ch = i / 12, pc = i % 12; const size_t go = ((size_t)(up.dir * 2048 + up.head * 64 + ch) * 96 + pc * 8);
                    *(LAS u32x4*)(lds + RP_W2 + ch * RC_TS + pc * 16) = *(const u32x4*)(W2T + go); *(LAS u32x4*)(lds + RP_A2 + ch * RC_TS + pc * 16) = *(const u32x4*)(A2T + go); }
                if (htid < 64) { LAS float* cst = (LAS float*)(lds + RP_CST); const int c = up.head * 64 + htid;
                    cst[htid] = w0p[up.dir * 2048 + c]; cst[64 + htid] = a0p[up.dir * 2048 + c]; cst[128 + htid] = kkp[c]; cst[192 + htid] = kap[c]; cst[256 + htid] = rkp[c]; }
                RP_PREFETCH(up, 0);
            }
            __syncthreads();
        }
        RwkvUnit uc; int cc = 0, nchc = 0; const bool has_c = n >= 0;
        if (has_c) rwkv_unit_of(n, wg, uc, cc, nchc);
        LAS unsigned char* bufp = lds + RP_BUF + ((n + 1) & 1) * RB_SIZE; LAS unsigned char* bufc = lds + RP_BUF + (n & 1) * RB_SIZE;
        bf16x8 ufr, vfr; f32x4 yt = (f32x4){0.f, 0.f, 0.f, 0.f};
        if (producer) {
            if (has_p) {
                f32x4 dW = (f32x4){0.f, 0.f, 0.f, 0.f}, dA = (f32x4){0.f, 0.f, 0.f, 0.f};
#pragma unroll
                for (int ks = 0; ks < 3; ++ks) { const pg8::bf16x8 wf = *(const LAS pg8::bf16x8*)(lds + RP_W2 + (16 * pw + c16) * RC_TS + (32 * ks + 8 * g) * 2), af = *(const LAS pg8::bf16x8*)(lds + RP_A2 + (16 * pw + c16) * RC_TS + (32 * ks + 8 * g) * 2);
                    dW = __builtin_amdgcn_mfma_f32_16x16x32_bf16(wf, pftw[ks], dW, 0, 0, 0); dA = __builtin_amdgcn_mfma_f32_16x16x32_bf16(af, pfta[ks], dA, 0, 0, 0); }
                const u32x2 r2 = pfr, k2 = pfk, v2 = pfv; const LAS float* cst = (const LAS float*)(lds + RP_CST) + 16 * pw + 4 * g;
                const f32x4 w0 = *(const LAS f32x4*)cst, a0 = *(const LAS f32x4*)(cst + 64), kkw = *(const LAS f32x4*)(cst + 128), kaw = *(const LAS f32x4*)(cst + 192), rkw = *(const LAS f32x4*)(cst + 256);
                const float rr[4] = {bflo(r2.x), bfhi(r2.x), bflo(r2.y), bfhi(r2.y)}, k0[4] = {bflo(k2.x), bfhi(k2.x), bflo(k2.y), bfhi(k2.y)};
                f32x4 oW; float kd[4], kk[4], kb[4], ss = 0.f, bon = 0.f;
#pragma unroll
                for (int j = 0; j < 4; ++j) {
                    const float xw = -(w0[j] + dW[j]);
                    const float sp = fmaxf(xw, 0.f) + __logf(1.f + __expf(-fabsf(xw)));
                    oW[j] = __expf(-__expf(-sp - 0.5f));
                    const float a = 1.f / (1.f + __expf(-(a0[j] + dA[j])));
                    kk[j] = k0[j] * kkw[j]; ss += kk[j] * kk[j]; kb[j] = kk[j] * a;
                    kd[j] = k0[j] * (1.f + (a - 1.f) * kaw[j]); bon += rr[j] * kd[j] * rkw[j]; }
                const int eo = c16 * 64 + 16 * pw + 4 * g;
                *(LAS f32x4*)(lds + RP_W + eo * 4) = oW;
                *(LAS u32x2*)(lds + RP_R + eo * 2) = r2; *(LAS u32x2*)(bufp + RB_V + eo * 2) = v2;
                *(LAS u32x2*)(lds + RP_KD + eo * 2) = (u32x2){cvtpk(kd[0], kd[1]), cvtpk(kd[2], kd[3])};
                *(LAS u32x2*)(lds + RP_A + eo * 2) = (u32x2){cvtpk(-kk[0], -kk[1]), cvtpk(-kk[2], -kk[3])};
                *(LAS u32x2*)(lds + RP_B + eo * 2) = (u32x2){cvtpk(kb[0], kb[1]), cvtpk(kb[2], kb[3])};
                ss = red4(ss); bon = red4(bon);
                if (g == 0) { *(LAS float*)(lds + RP_SSP + (c16 * 4 + pw) * 4) = ss; *(LAS float*)(lds + RP_BNP + (c16 * 4 + pw) * 4) = bon; }
                if (cp + 1 < nchp) RP_PREFETCH(up, cp + 1);
            }
        } else if (has_c) {
            if (cc == 0) {
                const unsigned sb = (unsigned)((((uc.b * 2 + uc.dir) * 32 + uc.head) * 64 + pw * 16 + c16) * 64 + 4 * g);
#pragma unroll
                for (int jb = 0; jb < 4; ++jb) Sacc[jb] = (f32x4){0.f, 0.f, 0.f, 0.f};
                if (uc.lat) {
#pragma unroll
                    for (int jb = 0; jb < 4; ++jb) Sacc[jb] = *(const f32x4*)((const char*)srw + (sb + 16 * jb) * 4u); }
            }
            const u32x2 zz = (u32x2){0u, 0u};
            bf16x8 sfr[2];
#pragma unroll
            for (int ks = 0; ks < 2; ++ks) { u32x4 s4; s4.x = cvtpk(Sacc[2 * ks][0], Sacc[2 * ks][1]); s4.y = cvtpk(Sacc[2 * ks][2], Sacc[2 * ks][3]);
                s4.z = cvtpk(Sacc[2 * ks + 1][0], Sacc[2 * ks + 1][1]); s4.w = cvtpk(Sacc[2 * ks + 1][2], Sacc[2 * ks + 1][3]); sfr[ks] = __builtin_bit_cast(bf16x8, s4); }
            { const LAS bf16_t* vp = (const LAS bf16_t*)(bufc + RB_V) + (4 * g) * 64 + 16 * pw + c16;
              const unsigned v0 = vp[0], v1 = vp[64], v2 = vp[128], v3 = vp[192]; vfr = mk_frag((u32x2){v0 | (v1 << 16), v2 | (v3 << 16)}, zz); }
            f32x4 xt = (f32x4){0.f, 0.f, 0.f, 0.f};
#pragma unroll
            for (int ks = 0; ks < 2; ++ks) {
                const LAS unsigned char* ap = bufc + RB_AT + c16 * RC_TT + (32 * ks + 4 * g) * 2; const LAS unsigned char* rp = bufc + RB_RT + c16 * RC_TT + (32 * ks + 4 * g) * 2;
                xt = __builtin_amdgcn_mfma_f32_16x16x32_bf16(mk_frag(*(const LAS u32x2*)ap, *(const LAS u32x2*)(ap + 32)), sfr[ks], xt, 0, 0, 0);
                yt = __builtin_amdgcn_mfma_f32_16x16x32_bf16(mk_frag(*(const LAS u32x2*)rp, *(const LAS u32x2*)(rp + 32)), sfr[ks], yt, 0, 0, 0); }
            xt = __builtin_amdgcn_mfma_f32_16x16x32_bf16(mk_frag(*(const LAS u32x2*)(bufc + RB_MAK + c16 * RC_NS + g * 8), zz), vfr, xt, 0, 0, 0);
            yt = __builtin_amdgcn_mfma_f32_16x16x32_bf16(mk_frag(*(const LAS u32x2*)(bufc + RB_NKR + c16 * RC_NS + g * 8), zz), vfr, yt, 0, 0, 0);
            LAS float* xs = (LAS float*)(lds + RP_XT + pw * (16 * RC_XS));
#pragma unroll
            for (int r = 0; r < 4; ++r) xs[(4 * g + r) * (RC_XS / 4) + c16] = xt[r];
            asm volatile("s_waitcnt lgkmcnt(0)" ::: "memory");
            float u[16];
#pragma unroll
            for (int t1 = 0; t1 < 16; ++t1) u[t1] = xs[t1 * (RC_XS / 4) + c16];
#pragma unroll
            for (int t1 = 1; t1 < 16; ++t1) { float acc = u[t1];
#pragma unroll
                for (int s4 = 0; s4 < (t1 + 3) / 4; ++s4) { const f32x4 mr = *(const LAS f32x4*)(bufc + RB_MAB + t1 * RC_MS + s4 * 16);
#pragma unroll
                    for (int e = 0; e < 4; ++e) if (4 * s4 + e < t1) acc += u[4 * s4 + e] * mr[e]; }
                u[t1] = acc; }
            { float us[4];
#pragma unroll
              for (int e = 0; e < 4; ++e) us[e] = g == 0 ? u[e] : g == 1 ? u[4 + e] : g == 2 ? u[8 + e] : u[12 + e];
              ufr = mk_frag((u32x2){cvtpk(us[0], us[1]), cvtpk(us[2], us[3])}, zz); }
        }
        __syncthreads();
        if (producer) {
            if (has_p) {
                float grun = 1.f; float bt[4], kt[4];
#pragma unroll
                for (int t1 = 0; t1 < 16; ++t1) { const float gprev = grun; grun *= *(const LAS float*)(lds + RP_W + (t1 * 64 + lane) * 4);
                    if ((t1 >> 2) == pw) { const int e = t1 & 3; const unsigned o = (unsigned)(t1 * 64 + lane) * 2u;
                        const f32x4 sp4 = *(const LAS f32x4*)(lds + RP_SSP + t1 * 16); const float inv = 1.f / fmaxf(sqrtf((sp4[0] + sp4[1]) + (sp4[2] + sp4[3])), 1e-12f);
                        const float a = bf2f(*(const LAS bf16_t*)(lds + RP_A + o)) * inv, bv = bf2f(*(const LAS bf16_t*)(lds + RP_B + o)) * inv, kd = bf2f(*(const LAS bf16_t*)(lds + RP_KD + o)), rv = bf2f(*(const LAS bf16_t*)(lds + RP_R + o));
                        const float ig = __builtin_amdgcn_rcpf(grun); bt[e] = bv * ig; kt[e] = kd * ig;
                        *(LAS bf16_t*)(bufp + RB_AT + t1 * RC_TT + lane * 2) = f2bf(gprev * a); *(LAS bf16_t*)(bufp + RB_RT + t1 * RC_TT + lane * 2) = f2bf(grun * rv);
                        *(LAS bf16_t*)(bufp + RB_BT + t1 * RC_TT + lane * 2) = f2bf(bt[e]); *(LAS bf16_t*)(bufp + RB_KT + t1 * RC_TT + lane * 2) = f2bf(kt[e]); } }
                const float gl = grun;
                *(LAS u32x2*)(bufp + RB_BH + lane * RC_HS + pw * 8) = (u32x2){cvtpk(bt[0] * gl, bt[1] * gl), cvtpk(bt[2] * gl, bt[3] * gl)};
                *(LAS u32x2*)(bufp + RB_KH + lane * RC_HS + pw * 8) = (u32x2){cvtpk(kt[0] * gl, kt[1] * gl), cvtpk(kt[2] * gl, kt[3] * gl)};
                if (pw == 0) *(LAS float*)(bufp + RB_GL + lane * 4) = gl;
                if (htid < 16) { const int tau = cp * 16 + htid, t = up.dir ? up.L - 1 - tau : tau; const f32x4 b4 = *(const LAS f32x4*)(lds + RP_BNP + htid * 16);
                    BON[((size_t)up.dir * MTOK + (size_t)(up.base + t)) * 32 + up.head] = (b4[0] + b4[1]) + (b4[2] + b4[3]); }
            }
        } else if (has_c) {
            const u32x2 zz = (u32x2){0u, 0u};
            yt = __builtin_amdgcn_mfma_f32_16x16x32_bf16(mk_frag(*(const LAS u32x2*)(bufc + RB_NBR + c16 * RC_NS + g * 8), zz), ufr, yt, 0, 0, 0);
#pragma unroll
            for (int r = 0; r < 4; ++r) *(LAS bf16_t*)(lds + RP_YO + (4 * g + r) * 128 + (16 * pw + c16) * 2) = f2bf_rne(yt[r]);
#pragma unroll
            for (int jb = 0; jb < 4; ++jb) { const f32x4 gl4 = *(const LAS f32x4*)(bufc + RB_GL + (16 * jb + 4 * g) * 4); Sacc[jb] = Sacc[jb] * gl4;
                Sacc[jb] = __builtin_amdgcn_mfma_f32_16x16x32_bf16(mk_frag(*(const LAS u32x2*)(bufc + RB_BH + (16 * jb + c16) * RC_HS + g * 8), zz), ufr, Sacc[jb], 0, 0, 0);
                Sacc[jb] = __builtin_amdgcn_mfma_f32_16x16x32_bf16(mk_frag(*(const LAS u32x2*)(bufc + RB_KH + (16 * jb + c16) * RC_HS + g * 8), zz), vfr, Sacc[jb], 0, 0, 0); }
            if (cc == nchc - 1 && !uc.lat) { const unsigned sb = (unsigned)((((uc.b * 2 + uc.dir) * 32 + uc.head) * 64 + pw * 16 + c16) * 64 + 4 * g);
#pragma unroll
                for (int jb = 0; jb < 4; ++jb) *(f32x4*)((char*)p.out + ((unsigned)OUT_RWKV + sb + 16 * jb) * 4u) = Sacc[jb]; }
        }
        __syncthreads();
        if (producer) {
            if (has_p) {
                const int xo = (pw & 1) ? RB_KT : RB_BT, yo = (pw & 2) ? RB_RT : RB_AT;
                f32x4 mm = (f32x4){0.f, 0.f, 0.f, 0.f};
#pragma unroll
                for (int ks = 0; ks < 2; ++ks) { const bf16x8 xf = *(const LAS bf16x8*)(bufp + xo + c16 * RC_TT + (32 * ks + 8 * g) * 2), yf = *(const LAS bf16x8*)(bufp + yo + c16 * RC_TT + (32 * ks + 8 * g) * 2);
                    mm = __builtin_amdgcn_mfma_f32_16x16x32_bf16(xf, yf, mm, 0, 0, 0); }
#pragma unroll
                for (int r = 0; r < 4; ++r) { const int s_ = 4 * g + r; const bool keep = (pw & 2) ? (s_ <= c16) : (s_ < c16); mm[r] = keep ? mm[r] : 0.f; }
                if (pw == 0) *(LAS f32x4*)(bufp + RB_MAB + c16 * RC_MS + g * 16) = mm;
                else { u32x2 w; w.x = cvtpk(mm[0], mm[1]); w.y = cvtpk(mm[2], mm[3]); *(LAS u32x2*)(bufp + (pw == 1 ? RB_MAK : pw == 2 ? RB_NBR : RB_NKR) + c16 * RC_NS + g * 8) = w; }
            }
        } else if (has_c && htid < 128) {
            const int tok = htid >> 3, c8 = (htid & 7) * 8, tau = cc * 16 + tok, t = uc.dir ? uc.L - 1 - tau : tau; const size_t row = (size_t)(uc.base + t);
            *(u32x4*)(YD + (size_t)uc.dir * MTOK * DM + row * DM + uc.head * 64 + c8) = *(const LAS u32x4*)(lds + RP_YO + tok * 128 + c8 * 2);
        }
        __syncthreads();
    }
#undef RP_PREFETCH
}

constexpr int RB2_GL = 0, RB2_MAB = 256, RB2_MD = 1536, RB2_MAK = 1792, RB2_NBR = 2432, RB2_NKR = 3072, RB2_V = 3712, RB2_AT = 5760, RB2_RT = 8064, RB2_BT = 10368, RB2_KT = 12672, RB2_BH = 14976, RB2_KH = 17536, RB2_SIZE = 20096;
constexpr int RQ_SSP = 2 * RB2_SIZE, RQ_BNP = RQ_SSP + 256, RQ_YO = RQ_BNP + 256, RQ_CST = RQ_YO + 2048, RQ_W = RQ_CST + 1280, RQ_A = RQ_W + 4096, RQ_B = RQ_A + 2048, RQ_KD = RQ_B + 2048, RQ_R = RQ_KD + 2048,
              RQ_W2 = RQ_R + 2048, RQ_A2 = RQ_W2 + 13312, RQ_RING = RQ_A2 + 13312, RQ_SLOT = 12288, RQ_END = RQ_RING + 4 * RQ_SLOT;
static_assert(RQ_END <= LDS_BAR_OFF, "RWKV pipe LDS map");
struct RwkvPf { pg8::bf16x8 tw[3], ta[3]; u32x2 r, k, v; };

#ifndef RQ_DELAY
#define RQ_DELAY 0
#endif
#define RQD_BEGIN(S) unsigned long long rqd_t0_##S = 0; if (RQ_DELAY == S) rqd_t0_##S = clock64();
#define RQD_END(S) if (RQ_DELAY == S) { asm volatile("s_waitcnt lgkmcnt(0)" ::: "memory"); const unsigned long long t1_ = clock64(), d_ = t1_ - rqd_t0_##S; while ((unsigned long long)clock64() - t1_ < d_) { } }
__device__ __forceinline__ void rwkv_dma(const unsigned char* ws, LAS unsigned char* lds, int wg, int pw, int lane, int c) {
    constexpr int NCH = 256 + 4 * 16;
    const int cq = c < NCH ? c : NCH - 1; RwkvUnit U; int ci, nch; rwkv_unit_of(cq, wg, U, ci, nch);
    LAS unsigned char* slot = lds + RQ_RING + (c & 3) * RQ_SLOT;
#pragma unroll
    for (int j = 0; j < 3; ++j) { const int q = pw * 3 + j; const unsigned char* ga;
        if (q < 6) { const int i = (q % 3) * 64 + lane, tok = i / 12, piece = i % 12, tau_ = ci * 16 + tok, t_ = U.dir ? U.L - 1 - tau_ : tau_;
            ga = ws + WS_LR + (size_t)((unsigned)(U.base + t_) * 768u + (unsigned)((q >= 3 ? 384 : 0) + U.dir * 192 + piece * 16)); }
        else { const int ten = (q - 6) >> 1, i = ((q - 6) & 1) * 64 + lane, tok = i >> 3, piece = (i & 7) ^ (tok & 7), tau_ = ci * 16 + tok, t_ = U.dir ? U.L - 1 - tau_ : tau_;
            const size_t tb = ten == 0 ? WS_R : ten == 1 ? WS_K1 : WS_V1;
            ga = ws + tb + (size_t)(((unsigned)(U.base + t_) * 2048u + (unsigned)(U.head * 64)) * 2u + (unsigned)(piece * 16)); }
        __builtin_amdgcn_global_load_lds((const unsigned*)ga, (LAS unsigned*)(slot + q * 1024), 16, 0, 0); }
}
#define RQ_BAR() do { asm volatile("s_waitcnt lgkmcnt(0)" ::: "memory"); __builtin_amdgcn_s_barrier(); asm volatile("" ::: "memory"); } while (0)
__device__ __forceinline__ void p9_rwkv_pipe2(const Params& p, LAS unsigned char* lds) {
    const int tid = tidx(), half = __builtin_amdgcn_readfirstlane(tid >> 8), htid = tid & 255, pw = __builtin_amdgcn_readfirstlane((tid >> 6) & 3), lane = tid & 63, c16 = lane & 15, g = lane >> 4, wg = blockIdx.x;
    const bool producer = half == 1;
    const bf16_t* R = (const bf16_t*)(p.ws + WS_R); const bf16_t* K1 = (const bf16_t*)(p.ws + WS_K1); const bf16_t* V1 = (const bf16_t*)(p.ws + WS_V1); const bf16_t* LR = (const bf16_t*)(p.ws + WS_LR);
    const bf16_t* W2T = (const bf16_t*)(p.ws + WS_W2T); const bf16_t* A2T = (const bf16_t*)(p.ws + WS_A2T);
    float* BON = (float*)(p.ws + WS_BON); bf16_t* YD = (bf16_t*)(p.out + OUT_Y);
    const float* w0p = pin(p, I_W0); const float* a0p = pin(p, I_A0); const float* kkp = pin(p, I_KK); const float* kap = pin(p, I_KA); const float* rkp = pin(p, I_RK); const float* srw = pin(p, I_SRWKV);
    constexpr int NCH = 256 + 4 * 16;
    f32x4 Sacc[4];
#pragma unroll
    for (int jb = 0; jb < 4; ++jb) Sacc[jb] = (f32x4){0.f, 0.f, 0.f, 0.f};
    if (producer) { rwkv_dma(p.ws, lds, wg, pw, lane, 0); rwkv_dma(p.ws, lds, wg, pw, lane, 1); rwkv_dma(p.ws, lds, wg, pw, lane, 2); asm volatile("s_waitcnt vmcnt(0)" ::: "memory"); }
    for (int n = -1; n < NCH; ++n) {
        const bool has_p = n + 1 < NCH, has_c = n >= 0;
        RwkvUnit up, uc; int cp = 0, nchp = 0, cc = 0, nchc = 0;
        if (has_p) rwkv_unit_of(n + 1, wg, up, cp, nchp);
        if (has_c) rwkv_unit_of(n, wg, uc, cc, nchc);
        if (has_p && cp == 0) {
            if (producer) {
                for (int i = htid; i < 768; i += 256) { const int ch = i / 12, pc = i % 12; const size_t go = ((size_t)(up.dir * 2048 + up.head * 64 + ch) * 96 + pc * 8);
                    *(LAS u32x4*)(lds + RQ_W2 + ch * RC_TS + pc * 16) = *(const u32x4*)(W2T + go); *(LAS u32x4*)(lds + RQ_A2 + ch * RC_TS + pc * 16) = *(const u32x4*)(A2T + go); }
                if (htid < 64) { LAS float* cst = (LAS float*)(lds + RQ_CST); const int c = up.head * 64 + htid;
                    cst[htid] = w0p[up.dir * 2048 + c]; cst[64 + htid] = a0p[up.dir * 2048 + c]; cst[128 + htid] = kkp[c]; cst[192 + htid] = kap[c]; cst[256 + htid] = rkp[c]; }
            }
            RQ_BAR();
        }
        LAS unsigned char* bufp = lds + ((n + 1) & 1) * RB2_SIZE; LAS unsigned char* bufc = lds + (n & 1) * RB2_SIZE;
        const u32x2 zz = (u32x2){0u, 0u};
        bf16x8 ufr = __builtin_bit_cast(bf16x8, (u32x4){0u, 0u, 0u, 0u}), vfr = ufr; f32x4 yt = (f32x4){0.f, 0.f, 0.f, 0.f};
        if (producer) {
            if (has_p) {
                RQD_BEGIN(1)
                const LAS unsigned char* slot = lds + RQ_RING + ((n + 1) & 3) * RQ_SLOT;
                f32x4 dW = (f32x4){0.f, 0.f, 0.f, 0.f}, dA = (f32x4){0.f, 0.f, 0.f, 0.f};
#pragma unroll
                for (int ks = 0; ks < 3; ++ks) { const pg8::bf16x8 wf = *(const LAS pg8::bf16x8*)(lds + RQ_W2 + (16 * pw + c16) * RC_TS + (32 * ks + 8 * g) * 2), af = *(const LAS pg8::bf16x8*)(lds + RQ_A2 + (16 * pw + c16) * RC_TS + (32 * ks + 8 * g) * 2);
                    const pg8::bf16x8 tw = *(const LAS pg8::bf16x8*)(slot + c16 * 192 + (32 * ks + 8 * g) * 2), ta = *(const LAS pg8::bf16x8*)(slot + 3072 + c16 * 192 + (32 * ks + 8 * g) * 2);
                    dW = __builtin_amdgcn_mfma_f32_16x16x32_bf16(wf, tw, dW, 0, 0, 0); dA = __builtin_amdgcn_mfma_f32_16x16x32_bf16(af, ta, dA, 0, 0, 0); }
                const int rko = (c16 * 8 + ((2 * pw + (g >> 1)) ^ (c16 & 7))) * 16 + (g & 1) * 8;
                const u32x2 r2 = *(const LAS u32x2*)(slot + 6144 + rko), k2 = *(const LAS u32x2*)(slot + 8192 + rko), v2 = *(const LAS u32x2*)(slot + 10240 + rko); const LAS float* cst = (const LAS float*)(lds + RQ_CST) + 16 * pw + 4 * g;
                const f32x4 w0 = *(const LAS f32x4*)cst, a0 = *(const LAS f32x4*)(cst + 64), kkw = *(const LAS f32x4*)(cst + 128), kaw = *(const LAS f32x4*)(cst + 192), rkw = *(const LAS f32x4*)(cst + 256);
                const float rr[4] = {bflo(r2.x), bfhi(r2.x), bflo(r2.y), bfhi(r2.y)}, k0[4] = {bflo(k2.x), bfhi(k2.x), bflo(k2.y), bfhi(k2.y)};
                f32x4 oW; float kd[4], kk[4], kb[4], ss = 0.f, bon = 0.f;
#pragma unroll
                for (int j = 0; j < 4; ++j) {
                    const float xw = -(w0[j] + dW[j]);
                    const float sp = fmaxf(xw, 0.f) + 0.6931471806f * __builtin_amdgcn_logf(1.f + __builtin_amdgcn_exp2f(-1.4426950409f * fabsf(xw)));
                    oW[j] = __builtin_amdgcn_exp2f(-1.4426950409f * __builtin_amdgcn_exp2f(-1.4426950409f * (sp + 0.5f)));
                    const float a = __builtin_amdgcn_rcpf(1.f + __builtin_amdgcn_exp2f(-1.4426950409f * (a0[j] + dA[j])));
                    kk[j] = k0[j] * kkw[j]; ss += kk[j] * kk[j]; kb[j] = kk[j] * a;
                    kd[j] = k0[j] * (1.f + (a - 1.f) * kaw[j]); bon += rr[j] * kd[j] * rkw[j]; }
                const int eo = rw_sw(c16, 16 * pw + 4 * g);
                *(LAS f32x4*)(lds + RQ_W + eo * 4) = oW;
                *(LAS u32x2*)(lds + RQ_R + eo * 2) = r2; *(LAS u32x2*)(bufp + RB2_V + eo * 2) = v2;
                *(LAS u32x2*)(lds + RQ_KD + eo * 2) = (u32x2){cvtpk(kd[0], kd[1]), cvtpk(kd[2], kd[3])};
                *(LAS u32x2*)(lds + RQ_A + eo * 2) = (u32x2){cvtpk(-kk[0], -kk[1]), cvtpk(-kk[2], -kk[3])};
                *(LAS u32x2*)(lds + RQ_B + eo * 2) = (u32x2){cvtpk(kb[0], kb[1]), cvtpk(kb[2], kb[3])};
                ss = red4(ss); bon = red4(bon);
                if (g == 0) { *(LAS float*)(lds + RQ_SSP + (c16 * 4 + pw) * 4) = ss; *(LAS float*)(lds + RQ_BNP + (c16 * 4 + pw) * 4) = bon; }
                rwkv_dma(p.ws, lds, wg, pw, lane, n + 4);
                RQD_END(1)
            }
        } else if (has_c) {
            RQD_BEGIN(2)
            if (cc == 0) {
                const unsigned sb = (unsigned)((((uc.b * 2 + uc.dir) * 32 + uc.head) * 64 + pw * 16 + c16) * 64 + 4 * g);
#pragma unroll
                for (int jb = 0; jb < 4; ++jb) Sacc[jb] = (f32x4){0.f, 0.f, 0.f, 0.f};
                if (uc.lat) {
#pragma unroll
                    for (int jb = 0; jb < 4; ++jb) Sacc[jb] = *(const f32x4*)((const char*)srw + (sb + 16 * jb) * 4u); }
                __builtin_amdgcn_s_waitcnt(0x0F70);
            }
            bf16x8 sfr[2];
#pragma unroll
            for (int ks = 0; ks < 2; ++ks) { u32x4 s4; s4.x = cvtpk(Sacc[2 * ks][0], Sacc[2 * ks][1]); s4.y = cvtpk(Sacc[2 * ks][2], Sacc[2 * ks][3]);
                s4.z = cvtpk(Sacc[2 * ks + 1][0], Sacc[2 * ks + 1][1]); s4.w = cvtpk(Sacc[2 * ks + 1][2], Sacc[2 * ks + 1][3]); sfr[ks] = __builtin_bit_cast(bf16x8, s4); }
            { const LAS bf16_t* vp = (const LAS bf16_t*)(bufc + RB2_V); const int vi_ = 16 * pw + c16, vt_ = 4 * g;
              const unsigned v0 = vp[rw_sw(vt_, vi_)], v1 = vp[rw_sw(vt_ + 1, vi_)], v2 = vp[rw_sw(vt_ + 2, vi_)], v3 = vp[rw_sw(vt_ + 3, vi_)]; vfr = mk_frag((u32x2){v0 | (v1 << 16), v2 | (v3 << 16)}, zz); }
            f32x4 mx[12], md[3];
#pragma unroll
            for (int s1 = 0; s1 < 12; ++s1) mx[s1] = *(const LAS f32x4*)(bufc + RB2_MAB + s1 * RC_MS + g * 16);
#pragma unroll
            for (int e = 0; e < 3; ++e) md[e] = *(const LAS f32x4*)(bufc + RB2_MD + (4 * g + e) * 16);
            f32x4 xt = (f32x4){0.f, 0.f, 0.f, 0.f};
#pragma unroll
            for (int ks = 0; ks < 2; ++ks) {
                const LAS unsigned char* ap = bufc + RB2_AT + c16 * RC_TT + (32 * ks + 4 * g) * 2; const LAS unsigned char* rp = bufc + RB2_RT + c16 * RC_TT + (32 * ks + 4 * g) * 2;
                xt = __builtin_amdgcn_mfma_f32_16x16x32_bf16(mk_frag(*(const LAS u32x2*)ap, *(const LAS u32x2*)(ap + 32)), sfr[ks], xt, 0, 0, 0);
                yt = __builtin_amdgcn_mfma_f32_16x16x32_bf16(mk_frag(*(const LAS u32x2*)rp, *(const LAS u32x2*)(rp + 32)), sfr[ks], yt, 0, 0, 0); }
            xt = __builtin_amdgcn_mfma_f32_16x16x32_bf16(mk_frag(*(const LAS u32x2*)(bufc + RB2_MAK + c16 * RC_NS + g * 8), zz), vfr, xt, 0, 0, 0);
            yt = __builtin_amdgcn_mfma_f32_16x16x32_bf16(mk_frag(*(const LAS u32x2*)(bufc + RB2_NKR + c16 * RC_NS + g * 8), zz), vfr, yt, 0, 0, 0);
            float x[4] = {xt[0], xt[1], xt[2], xt[3]};
#pragma unroll
            for (int h = 0; h < 4; ++h) {
                if (g == h) { x[1] += x[0] * md[0][1]; x[2] += x[0] * md[0][2]; x[3] += x[0] * md[0][3]; x[2] += x[1] * md[1][2]; x[3] += x[1] * md[1][3]; x[3] += x[2] * md[2][3]; }
                if (h < 3) { float ub[4];
#pragma unroll
                    for (int e = 0; e < 4; ++e) { const unsigned xv = __float_as_uint(x[e]);
                        if (h == 2) { const auto r1 = __builtin_amdgcn_permlane16_swap(xv, xv, false, false); ub[e] = __uint_as_float(r1[0]); }
                        else { const auto r0 = __builtin_amdgcn_permlane32_swap(xv, xv, false, false); const auto r1 = __builtin_amdgcn_permlane16_swap(r0[0], r0[0], false, false); ub[e] = __uint_as_float(r1[h]); } }
#pragma unroll
                    for (int e2 = 0; e2 < 4; ++e2)
#pragma unroll
                        for (int e = 0; e < 4; ++e) x[e] += ub[e2] * mx[4 * h + e2][e]; } }
            ufr = mk_frag((u32x2){cvtpk(x[0], x[1]), cvtpk(x[2], x[3])}, zz);
            RQD_END(2)
        }
        RQ_BAR();
        if (producer) {
            if (has_p) {
                RQD_BEGIN(3)
                int ln = lane; asm volatile("" : "+v"(ln));
                float wv[16], ow[4], bt[4], kt[4]; unsigned ra[4], rb[4], rk[4], rr[4]; f32x4 ssp[4];
#pragma unroll
                for (int t1 = 0; t1 < 16; ++t1) wv[t1] = *(const LAS float*)(lds + RQ_W + rw_sw(t1, ln) * 4);
#pragma unroll
                for (int e = 0; e < 4; ++e) { const unsigned o = (unsigned)rw_sw(4 * pw + e, ln); ow[e] = *(const LAS float*)(lds + RQ_W + o * 4u);
                    ra[e] = *(const LAS bf16_t*)(lds + RQ_A + o * 2u); rb[e] = *(const LAS bf16_t*)(lds + RQ_B + o * 2u); rk[e] = *(const LAS bf16_t*)(lds + RQ_KD + o * 2u); rr[e] = *(const LAS bf16_t*)(lds + RQ_R + o * 2u);
                    ssp[e] = *(const LAS f32x4*)(lds + RQ_SSP + (4 * pw + e) * 16); }
                const f32x4 bnp = *(const LAS f32x4*)(lds + RQ_BNP + (4 * pw + (ln & 3)) * 16);
                __builtin_amdgcn_sched_barrier(0);
                if (ln < 4) { const int tau = cp * 16 + 4 * pw + ln, t = up.dir ? up.L - 1 - tau : tau; BON[((size_t)up.dir * MTOK + (size_t)(up.base + t)) * 32 + up.head] = (bnp[0] + bnp[1]) + (bnp[2] + bnp[3]); }
                const float p40 = (wv[0] * wv[1]) * (wv[2] * wv[3]), p41 = (wv[4] * wv[5]) * (wv[6] * wv[7]), p42 = (wv[8] * wv[9]) * (wv[10] * wv[11]), p43 = (wv[12] * wv[13]) * (wv[14] * wv[15]);
                const float c01 = p40 * p41, c012 = c01 * p42, gl = c012 * p43;
                float grun = pw == 0 ? 1.f : pw == 1 ? p40 : pw == 2 ? c01 : c012;
#pragma unroll
                for (int e = 0; e < 4; ++e) { const int t1 = 4 * pw + e; const float gprev = grun; grun *= ow[e];
                    const float inv = __builtin_amdgcn_rcpf(fmaxf(__builtin_amdgcn_sqrtf((ssp[e][0] + ssp[e][1]) + (ssp[e][2] + ssp[e][3])), 1e-12f));
                    const float a = __uint_as_float(ra[e] << 16) * inv, bv = __uint_as_float(rb[e] << 16) * inv, kd = __uint_as_float(rk[e] << 16), rv = __uint_as_float(rr[e] << 16);
                    const float ig = __builtin_amdgcn_rcpf(grun); bt[e] = bv * ig; kt[e] = kd * ig;
                    *(LAS bf16_t*)(bufp + RB2_AT + t1 * RC_TT + ln * 2) = f2bf(gprev * a); *(LAS bf16_t*)(bufp + RB2_RT + t1 * RC_TT + ln * 2) = f2bf(grun * rv);
                    *(LAS bf16_t*)(bufp + RB2_BT + t1 * RC_TT + ln * 2) = f2bf(bt[e]); *(LAS bf16_t*)(bufp + RB2_KT + t1 * RC_TT + ln * 2) = f2bf(kt[e]); }
                *(LAS u32x2*)(bufp + RB2_BH + ln * RC_HS + pw * 8) = (u32x2){cvtpk(bt[0] * gl, bt[1] * gl), cvtpk(bt[2] * gl, bt[3] * gl)};
                *(LAS u32x2*)(bufp + RB2_KH + ln * RC_HS + pw * 8) = (u32x2){cvtpk(kt[0] * gl, kt[1] * gl), cvtpk(kt[2] * gl, kt[3] * gl)};
                if (pw == 0) *(LAS float*)(bufp + RB2_GL + ln * 4) = gl;
                RQD_END(3)
            }
        } else if (has_c) {
            RQD_BEGIN(4)
            yt = __builtin_amdgcn_mfma_f32_16x16x32_bf16(mk_frag(*(const LAS u32x2*)(bufc + RB2_NBR + c16 * RC_NS + g * 8), zz), ufr, yt, 0, 0, 0);
#pragma unroll
            for (int r = 0; r < 4; ++r) *(LAS bf16_t*)(lds + RQ_YO + (4 * g + r) * 128 + (16 * pw + c16) * 2) = f2bf_rne(yt[r]);
#pragma unroll
            for (int jb = 0; jb < 4; ++jb) { const f32x4 gl4 = *(const LAS f32x4*)(bufc + RB2_GL + (16 * jb + 4 * g) * 4); Sacc[jb] = Sacc[jb] * gl4;
                Sacc[jb] = __builtin_amdgcn_mfma_f32_16x16x32_bf16(mk_frag(*(const LAS u32x2*)(bufc + RB2_BH + (16 * jb + c16) * RC_HS + g * 8), zz), ufr, Sacc[jb], 0, 0, 0);
                Sacc[jb] = __builtin_amdgcn_mfma_f32_16x16x32_bf16(mk_frag(*(const LAS u32x2*)(bufc + RB2_KH + (16 * jb + c16) * RC_HS + g * 8), zz), vfr, Sacc[jb], 0, 0, 0); }
            if (cc == nchc - 1 && !uc.lat) { const unsigned sb = (unsigned)((((uc.b * 2 + uc.dir) * 32 + uc.head) * 64 + pw * 16 + c16) * 64 + 4 * g);
#pragma unroll
                for (int jb = 0; jb < 4; ++jb) *(f32x4*)((char*)p.out + ((unsigned)OUT_RWKV + sb + 16 * jb) * 4u) = Sacc[jb]; }
            RQD_END(4)
        }
        RQ_BAR();
        if (producer) {
            if (has_p) {
                RQD_BEGIN(5)
                const int xo = (pw & 1) ? RB2_KT : RB2_BT, yo = (pw & 2) ? RB2_RT : RB2_AT;
                f32x4 mm = (f32x4){0.f, 0.f, 0.f, 0.f};
#pragma unroll
                for (int ks = 0; ks < 2; ++ks) { const bf16x8 xf = *(const LAS bf16x8*)(bufp + xo + c16 * RC_TT + (32 * ks + 8 * g) * 2), yf = *(const LAS bf16x8*)(bufp + yo + c16 * RC_TT + (32 * ks + 8 * g) * 2);
                    mm = __builtin_amdgcn_mfma_f32_16x16x32_bf16(xf, yf, mm, 0, 0, 0); }
#pragma unroll
                for (int r = 0; r < 4; ++r) { const int s_ = 4 * g + r; const bool keep = (pw & 2) ? (s_ <= c16) : (s_ < c16); mm[r] = keep ? mm[r] : 0.f; }
                if (pw == 0) {
                    const int tb = c16 >> 2;
#pragma unroll
                    for (int r = 0; r < 4; ++r) *(LAS float*)(bufp + RB2_MAB + (4 * g + r) * RC_MS + c16 * 4) = g < tb ? mm[r] : 0.f;
                    if (g == tb) {
#pragma unroll
                        for (int r = 0; r < 4; ++r) *(LAS float*)(bufp + RB2_MD + (4 * g + r) * 16 + (c16 & 3) * 4) = mm[r]; } }
                else { u32x2 w; w.x = cvtpk(mm[0], mm[1]); w.y = cvtpk(mm[2], mm[3]); *(LAS u32x2*)(bufp + (pw == 1 ? RB2_MAK : pw == 2 ? RB2_NBR : RB2_NKR) + c16 * RC_NS + g * 8) = w; }
                RQD_END(5)
            }
        } else if (has_c && htid < 128) {
            const int tok = htid >> 3, c8 = (htid & 7) * 8, tau = cc * 16 + tok, t = uc.dir ? uc.L - 1 - tau : tau; const size_t row = (size_t)(uc.base + t);
            *(u32x4*)(YD + (size_t)uc.dir * MTOK * DM + row * DM + uc.head * 64 + c8) = *(const LAS u32x4*)(lds + RQ_YO + tok * 128 + c8 * 2);
        }
        if (producer) asm volatile("s_waitcnt vmcnt(9)" ::: "memory");
        RQ_BAR();
    }
}

#ifndef RQ3_DELAY
#define RQ3_DELAY 0
#endif
#define RQ3D_BEGIN(S) unsigned long long rq3_t0_##S = 0; if (RQ3_DELAY == S) rq3_t0_##S = clock64();
#define RQ3D_END(S) if (RQ3_DELAY == S) { asm volatile("s_waitcnt lgkmcnt(0)" ::: "memory"); const unsigned long long t1_ = clock64(), d_ = t1_ - rq3_t0_##S; while ((unsigned long long)clock64() - t1_ < d_) { } }
__device__ __forceinline__ void p9_rwkv_pipe3(const Params& p, LAS unsigned char* lds) {
    const int tid = tidx(), half = __builtin_amdgcn_readfirstlane(tid >> 8), htid = tid & 255, pw = __builtin_amdgcn_readfirstlane((tid >> 6) & 3), lane = tid & 63, c16 = lane & 15, g = lane >> 4, wg = blockIdx.x;
    const bool producer = half == 1;
    const bf16_t* W2T = (const bf16_t*)(p.ws + WS_W2T); const bf16_t* A2T = (const bf16_t*)(p.ws + WS_A2T);
    float* BON = (float*)(p.ws + WS_BON); bf16_t* YD = (bf16_t*)(p.out + OUT_Y);
    const float* w0p = pin(p, I_W0); const float* a0p = pin(p, I_A0); const float* kkp = pin(p, I_KK); const float* kap = pin(p, I_KA); const float* rkp = pin(p, I_RK); const float* srw = pin(p, I_SRWKV);
    constexpr int NCH = 256 + 4 * 16;
    const u32x2 zz = (u32x2){0u, 0u};
    f32x4 Sacc[4];
#pragma unroll
    for (int jb = 0; jb < 4; ++jb) Sacc[jb] = (f32x4){0.f, 0.f, 0.f, 0.f};
    if (producer) { rwkv_dma(p.ws, lds, wg, pw, lane, 0); rwkv_dma(p.ws, lds, wg, pw, lane, 1); rwkv_dma(p.ws, lds, wg, pw, lane, 2); rwkv_dma(p.ws, lds, wg, pw, lane, 3);
        { RwkvUnit UT; int c0, n0; rwkv_unit_of(0, wg, UT, c0, n0);
                for (int i = htid; i < 768; i += 256) { const int ch = i / 12, pc = i % 12; const size_t go = ((size_t)(UT.dir * 2048 + UT.head * 64 + ch) * 96 + pc * 8);
                    *(LAS u32x4*)(lds + RQ_W2 + ch * RC_TS + pc * 16) = *(const u32x4*)(W2T + go); *(LAS u32x4*)(lds + RQ_A2 + ch * RC_TS + pc * 16) = *(const u32x4*)(A2T + go); }
                if (htid < 64) { LAS float* cst = (LAS float*)(lds + RQ_CST); const int c = UT.head * 64 + htid;
                    cst[htid] = w0p[UT.dir * 2048 + c]; cst[64 + htid] = a0p[UT.dir * 2048 + c]; cst[128 + htid] = kkp[c]; cst[192 + htid] = kap[c]; cst[256 + htid] = rkp[c]; } }
        asm volatile("s_waitcnt vmcnt(0)" ::: "memory"); }
    RQ_BAR();
    if (producer) { const int ca = 0;
                const LAS unsigned char* slot = lds + RQ_RING + (ca & 3) * RQ_SLOT; LAS unsigned char* bufa = lds + (ca & 1) * RB2_SIZE;
                f32x4 dW = (f32x4){0.f, 0.f, 0.f, 0.f}, dA = (f32x4){0.f, 0.f, 0.f, 0.f};
#pragma unroll
                for (int ks = 0; ks < 3; ++ks) { const pg8::bf16x8 wf = *(const LAS pg8::bf16x8*)(lds + RQ_W2 + (16 * pw + c16) * RC_TS + (32 * ks + 8 * g) * 2), af = *(const LAS pg8::bf16x8*)(lds + RQ_A2 + (16 * pw + c16) * RC_TS + (32 * ks + 8 * g) * 2);
                    const pg8::bf16x8 tw = *(const LAS pg8::bf16x8*)(slot + c16 * 192 + (32 * ks + 8 * g) * 2), ta = *(const LAS pg8::bf16x8*)(slot + 3072 + c16 * 192 + (32 * ks + 8 * g) * 2);
                    dW = __builtin_amdgcn_mfma_f32_16x16x32_bf16(wf, tw, dW, 0, 0, 0); dA = __builtin_amdgcn_mfma_f32_16x16x32_bf16(af, ta, dA, 0, 0, 0); }
                const int rko = (c16 * 8 + ((2 * pw + (g >> 1)) ^ (c16 & 7))) * 16 + (g & 1) * 8;
                const u32x2 r2 = *(const LAS u32x2*)(slot + 6144 + rko), k2 = *(const LAS u32x2*)(slot + 8192 + rko), v2 = *(const LAS u32x2*)(slot + 10240 + rko); const LAS float* cst = (const LAS float*)(lds + RQ_CST) + 16 * pw + 4 * g;
                const f32x4 w0 = *(const LAS f32x4*)cst, a0 = *(const LAS f32x4*)(cst + 64), kkw = *(const LAS f32x4*)(cst + 128), kaw = *(const LAS f32x4*)(cst + 192), rkw = *(const LAS f32x4*)(cst + 256);
                const float rr[4] = {bflo(r2.x), bfhi(r2.x), bflo(r2.y), bfhi(r2.y)}, k0[4] = {bflo(k2.x), bfhi(k2.x), bflo(k2.y), bfhi(k2.y)};
                f32x4 oW; float kd[4], kk[4], kb[4], ss = 0.f, bon = 0.f;
#pragma unroll
                for (int j = 0; j < 4; ++j) {
                    const float xw = -(w0[j] + dW[j]);
                    const float sp = fmaxf(xw, 0.f) + 0.6931471806f * __builtin_amdgcn_logf(1.f + __builtin_amdgcn_exp2f(-1.4426950409f * fabsf(xw)));
                    oW[j] = __builtin_amdgcn_exp2f(-1.4426950409f * __builtin_amdgcn_exp2f(-1.4426950409f * (sp + 0.5f)));
                    const float a = __builtin_amdgcn_rcpf(1.f + __builtin_amdgcn_exp2f(-1.4426950409f * (a0[j] + dA[j])));
                    kk[j] = k0[j] * kkw[j]; ss += kk[j] * kk[j]; kb[j] = kk[j] * a;
                    kd[j] = k0[j] * (1.f + (a - 1.f) * kaw[j]); bon += rr[j] * kd[j] * rkw[j]; }
                const int eo = rw_sw(c16, 16 * pw + 4 * g);
                *(LAS f32x4*)(lds + RQ_W + eo * 4) = oW;
                *(LAS u32x2*)(lds + RQ_R + eo * 2) = r2; *(LAS u32x2*)(bufa + RB2_V + eo * 2) = v2;
                *(LAS u32x2*)(lds + RQ_KD + eo * 2) = (u32x2){cvtpk(kd[0], kd[1]), cvtpk(kd[2], kd[3])};
                *(LAS u32x2*)(lds + RQ_A + eo * 2) = (u32x2){cvtpk(-kk[0], -kk[1]), cvtpk(-kk[2], -kk[3])};
                *(LAS u32x2*)(lds + RQ_B + eo * 2) = (u32x2){cvtpk(kb[0], kb[1]), cvtpk(kb[2], kb[3])};
                ss = red4(ss); bon = red4(bon);
                if (g == 0) { *(LAS float*)(lds + RQ_SSP + (c16 * 4 + pw) * 4) = ss; *(LAS float*)(lds + RQ_BNP + (c16 * 4 + pw) * 4) = bon; }
    }
    RQ_BAR();
    for (int n = -1; n <= NCH; ++n) {
        const bool has_p = n + 1 < NCH, has_a = n + 2 < NCH, has_c = n >= 0 && n < NCH, has_w = n >= 1;
        RwkvUnit up, uc, ua, uw; int cp = 0, nchp = 0, cc = 0, nchc = 0, cia = 1, ncha = 0, cw = 0, nchw = 0;
        if (has_p) rwkv_unit_of(n + 1, wg, up, cp, nchp);
        if (has_c) rwkv_unit_of(n, wg, uc, cc, nchc);
        if (has_a) rwkv_unit_of(n + 2, wg, ua, cia, ncha);
        if (has_w) rwkv_unit_of(n - 1, wg, uw, cw, nchw);
        LAS unsigned char* bufp = lds + ((n + 1) & 1) * RB2_SIZE; LAS unsigned char* bufc = lds + (n & 1) * RB2_SIZE;
        bf16x8 ufr = __builtin_bit_cast(bf16x8, (u32x4){0u, 0u, 0u, 0u}), vfr = ufr; f32x4 yt = (f32x4){0.f, 0.f, 0.f, 0.f};
        if (producer) {
            if (has_p) {
                RQ3D_BEGIN(1)
                                const int ln = lane;
                float wv[16], ow[4], bt[4], kt[4]; unsigned ra[4], rb[4], rk[4], rr[4]; f32x4 ssp[4];
#pragma unroll
                for (int t1 = 0; t1 < 16; ++t1) wv[t1] = *(const LAS float*)(lds + RQ_W + rw_sw(t1, ln) * 4);
#pragma unroll
                for (int e = 0; e < 4; ++e) { const unsigned o = (unsigned)rw_sw(4 * pw + e, ln); ow[e] = *(const LAS float*)(lds + RQ_W + o * 4u);
                    ra[e] = *(const LAS bf16_t*)(lds + RQ_A + o * 2u); rb[e] = *(const LAS bf16_t*)(lds + RQ_B + o * 2u); rk[e] = *(const LAS bf16_t*)(lds + RQ_KD + o * 2u); rr[e] = *(const LAS bf16_t*)(lds + RQ_R + o * 2u);
                    ssp[e] = *(const LAS f32x4*)(lds + RQ_SSP + (4 * pw + e) * 16); }
                const f32x4 bnp = *(const LAS f32x4*)(lds + RQ_BNP + (4 * pw + (ln & 3)) * 16);
                __builtin_amdgcn_sched_barrier(0);
                if (ln < 4) { const int tau = cp * 16 + 4 * pw + ln, t = up.dir ? up.L - 1 - tau : tau; BON[((size_t)up.dir * MTOK + (size_t)(up.base + t)) * 32 + up.head] = (bnp[0] + bnp[1]) + (bnp[2] + bnp[3]); }
                const float p40 = (wv[0] * wv[1]) * (wv[2] * wv[3]), p41 = (wv[4] * wv[5]) * (wv[6] * wv[7]), p42 = (wv[8] * wv[9]) * (wv[10] * wv[11]), p43 = (wv[12] * wv[13]) * (wv[14] * wv[15]);
                const float c01 = p40 * p41, c012 = c01 * p42, gl = c012 * p43;
                float grun = pw == 0 ? 1.f : pw == 1 ? p40 : pw == 2 ? c01 : c012;
#pragma unroll
                for (int e = 0; e < 4; ++e) { const int t1 = 4 * pw + e; const float gprev = grun; grun *= ow[e];
                    const float inv = __builtin_amdgcn_rcpf(fmaxf(__builtin_amdgcn_sqrtf((ssp[e][0] + ssp[e][1]) + (ssp[e][2] + ssp[e][3])), 1e-12f));
                    const float a = __uint_as_float(ra[e] << 16) * inv, bv = __uint_as_float(rb[e] << 16) * inv, kd = __uint_as_float(rk[e] << 16), rv = __uint_as_float(rr[e] << 16);
                    const float ig = __builtin_amdgcn_rcpf(grun); bt[e] = bv * ig; kt[e] = kd * ig;
                    *(LAS bf16_t*)(bufp + RB2_AT + t1 * RC_TT + ln * 2) = f2bf(gprev * a); *(LAS bf16_t*)(bufp + RB2_RT + t1 * RC_TT + ln * 2) = f2bf(grun * rv);
                    *(LAS bf16_t*)(bufp + RB2_BT + t1 * RC_TT + ln * 2) = f2bf(bt[e]); *(LAS bf16_t*)(bufp + RB2_KT + t1 * RC_TT + ln * 2) = f2bf(kt[e]); }
                *(LAS u32x2*)(bufp + RB2_BH + ln * RC_HS + pw * 8) = (u32x2){cvtpk(bt[0] * gl, bt[1] * gl), cvtpk(bt[2] * gl, bt[3] * gl)};
                *(LAS u32x2*)(bufp + RB2_KH + ln * RC_HS + pw * 8) = (u32x2){cvtpk(kt[0] * gl, kt[1] * gl), cvtpk(kt[2] * gl, kt[3] * gl)};
                if (pw == 0) *(LAS float*)(bufp + RB2_GL + ln * 4) = gl;
                RQ3D_END(1)
            }
        } else {
            RQ3D_BEGIN(2)
            if (has_w && htid < 128) {
                const int tok = htid >> 3, c8 = (htid & 7) * 8, tau = cw * 16 + tok, t = uw.dir ? uw.L - 1 - tau : tau; const size_t row = (size_t)(uw.base + t);
                *(u32x4*)(YD + (size_t)uw.dir * MTOK * DM + row * DM + uw.head * 64 + c8) = *(const LAS u32x4*)(lds + RQ_YO + tok * 128 + c8 * 2); }
            if (has_c) {
            if (cc == 0) {
                const unsigned sb = (unsigned)((((uc.b * 2 + uc.dir) * 32 + uc.head) * 64 + pw * 16 + c16) * 64 + 4 * g);
#pragma unroll
                for (int jb = 0; jb < 4; ++jb) Sacc[jb] = (f32x4){0.f, 0.f, 0.f, 0.f};
                if (uc.lat) {
#pragma unroll
                    for (int jb = 0; jb < 4; ++jb) Sacc[jb] = *(const f32x4*)((const char*)srw + (sb + 16 * jb) * 4u); }
                __builtin_amdgcn_s_waitcnt(0x0F70);
            }
            bf16x8 sfr[2];
#pragma unroll
            for (int ks = 0; ks < 2; ++ks) { u32x4 s4; s4.x = cvtpk(Sacc[2 * ks][0], Sacc[2 * ks][1]); s4.y = cvtpk(Sacc[2 * ks][2], Sacc[2 * ks][3]);
                s4.z = cvtpk(Sacc[2 * ks + 1][0], Sacc[2 * ks + 1][1]); s4.w = cvtpk(Sacc[2 * ks + 1][2], Sacc[2 * ks + 1][3]); sfr[ks] = __builtin_bit_cast(bf16x8, s4); }
            { const LAS bf16_t* vp = (const LAS bf16_t*)(bufc + RB2_V); const int vi_ = 16 * pw + c16, vt_ = 4 * g;
              const unsigned v0 = vp[rw_sw(vt_, vi_)], v1 = vp[rw_sw(vt_ + 1, vi_)], v2 = vp[rw_sw(vt_ + 2, vi_)], v3 = vp[rw_sw(vt_ + 3, vi_)]; vfr = mk_frag((u32x2){v0 | (v1 << 16), v2 | (v3 << 16)}, zz); }
            f32x4 mx[12], md[3];
#pragma unroll
            for (int s1 = 0; s1 < 12; ++s1) mx[s1] = *(const LAS f32x4*)(bufc + RB2_MAB + s1 * RC_MS + g * 16);
#pragma unroll
            for (int e = 0; e < 3; ++e) md[e] = *(const LAS f32x4*)(bufc + RB2_MD + (4 * g + e) * 16);
            f32x4 xt = (f32x4){0.f, 0.f, 0.f, 0.f};
#pragma unroll
            for (int ks = 0; ks < 2; ++ks) {
                const LAS unsigned char* ap = bufc + RB2_AT + c16 * RC_TT + (32 * ks + 4 * g) * 2; const LAS unsigned char* rp = bufc + RB2_RT + c16 * RC_TT + (32 * ks + 4 * g) * 2;
                xt = __builtin_amdgcn_mfma_f32_16x16x32_bf16(mk_frag(*(const LAS u32x2*)ap, *(const LAS u32x2*)(ap + 32)), sfr[ks], xt, 0, 0, 0);
                yt = __builtin_amdgcn_mfma_f32_16x16x32_bf16(mk_frag(*(const LAS u32x2*)rp, *(const LAS u32x2*)(rp + 32)), sfr[ks], yt, 0, 0, 0); }
            xt = __builtin_amdgcn_mfma_f32_16x16x32_bf16(mk_frag(*(const LAS u32x2*)(bufc + RB2_MAK + c16 * RC_NS + g * 8), zz), vfr, xt, 0, 0, 0);
            yt = __builtin_amdgcn_mfma_f32_16x16x32_bf16(mk_frag(*(const LAS u32x2*)(bufc + RB2_NKR + c16 * RC_NS + g * 8), zz), vfr, yt, 0, 0, 0);
            float x[4] = {xt[0], xt[1], xt[2], xt[3]};
#pragma unroll
            for (int h = 0; h < 4; ++h) {
                if (g == h) { x[1] += x[0] * md[0][1]; x[2] += x[0] * md[0][2]; x[3] += x[0] * md[0][3]; x[2] += x[1] * md[1][2]; x[3] += x[1] * md[1][3]; x[3] += x[2] * md[2][3]; }
                if (h < 3) { float ub[4];
#pragma unroll
                    for (int e = 0; e < 4; ++e) { const unsigned xv = __float_as_uint(x[e]);
                        if (h == 2) { const auto r1 = __builtin_amdgcn_permlane16_swap(xv, xv, false, false); ub[e] = __uint_as_float(r1[0]); }
                        else { const auto r0 = __builtin_amdgcn_permlane32_swap(xv, xv, false, false); const auto r1 = __builtin_amdgcn_permlane16_swap(r0[0], r0[0], false, false); ub[e] = __uint_as_float(r1[h]); } }
#pragma unroll
                    for (int e2 = 0; e2 < 4; ++e2)
#pragma unroll
                        for (int e = 0; e < 4; ++e) x[e] += ub[e2] * mx[4 * h + e2][e]; } }
            ufr = mk_frag((u32x2){cvtpk(x[0], x[1]), cvtpk(x[2], x[3])}, zz);
            }
            RQ3D_END(2)
        }
        RQ_BAR();
        if (has_a && cia == 0) {
            if (producer) { const RwkvUnit UT = ua;
                for (int i = htid; i < 768; i += 256) { const int ch = i / 12, pc = i % 12; const size_t go = ((size_t)(UT.dir * 2048 + UT.head * 64 + ch) * 96 + pc * 8);
                    *(LAS u32x4*)(lds + RQ_W2 + ch * RC_TS + pc * 16) = *(const u32x4*)(W2T + go); *(LAS u32x4*)(lds + RQ_A2 + ch * RC_TS + pc * 16) = *(const u32x4*)(A2T + go); }
                if (htid < 64) { LAS float* cst = (LAS float*)(lds + RQ_CST); const int c = UT.head * 64 + htid;
                    cst[htid] = w0p[UT.dir * 2048 + c]; cst[64 + htid] = a0p[UT.dir * 2048 + c]; cst[128 + htid] = kkp[c]; cst[192 + htid] = kap[c]; cst[256 + htid] = rkp[c]; } }
            RQ_BAR();
        }
        if (producer) {
            RQ3D_BEGIN(3)
            if (has_p) {
                const int xo = (pw & 1) ? RB2_KT : RB2_BT, yo = (pw & 2) ? RB2_RT : RB2_AT;
                f32x4 mm = (f32x4){0.f, 0.f, 0.f, 0.f};
#pragma unroll
                for (int ks = 0; ks < 2; ++ks) { const bf16x8 xf = *(const LAS bf16x8*)(bufp + xo + c16 * RC_TT + (32 * ks + 8 * g) * 2), yf = *(const LAS bf16x8*)(bufp + yo + c16 * RC_TT + (32 * ks + 8 * g) * 2);
                    mm = __builtin_amdgcn_mfma_f32_16x16x32_bf16(xf, yf, mm, 0, 0, 0); }
#pragma unroll
                for (int r = 0; r < 4; ++r) { const int s_ = 4 * g + r; const bool keep = (pw & 2) ? (s_ <= c16) : (s_ < c16); mm[r] = keep ? mm[r] : 0.f; }
                if (pw == 0) {
                    const int tb = c16 >> 2;
#pragma unroll
                    for (int r = 0; r < 4; ++r) *(LAS float*)(bufp + RB2_MAB + (4 * g + r) * RC_MS + c16 * 4) = g < tb ? mm[r] : 0.f;
                    if (g == tb) {
#pragma unroll
                        for (int r = 0; r < 4; ++r) *(LAS float*)(bufp + RB2_MD + (4 * g + r) * 16 + (c16 & 3) * 4) = mm[r]; } }
                else { u32x2 w; w.x = cvtpk(mm[0], mm[1]); w.y = cvtpk(mm[2], mm[3]); *(LAS u32x2*)(bufp + (pw == 1 ? RB2_MAK : pw == 2 ? RB2_NBR : RB2_NKR) + c16 * RC_NS + g * 8) = w; }
            }
            if (has_a) { const int ca = n + 2;
                const LAS unsigned char* slot = lds + RQ_RING + (ca & 3) * RQ_SLOT; LAS unsigned char* bufa = lds + (ca & 1) * RB2_SIZE;
                f32x4 dW = (f32x4){0.f, 0.f, 0.f, 0.f}, dA = (f32x4){0.f, 0.f, 0.f, 0.f};
#pragma unroll
                for (int ks = 0; ks < 3; ++ks) { const pg8::bf16x8 wf = *(const LAS pg8::bf16x8*)(lds + RQ_W2 + (16 * pw + c16) * RC_TS + (32 * ks + 8 * g) * 2), af = *(const LAS pg8::bf16x8*)(lds + RQ_A2 + (16 * pw + c16) * RC_TS + (32 * ks + 8 * g) * 2);
                    const pg8::bf16x8 tw = *(const LAS pg8::bf16x8*)(slot + c16 * 192 + (32 * ks + 8 * g) * 2), ta = *(const LAS pg8::bf16x8*)(slot + 3072 + c16 * 192 + (32 * ks + 8 * g) * 2);
                    dW = __builtin_amdgcn_mfma_f32_16x16x32_bf16(wf, tw, dW, 0, 0, 0); dA = __builtin_amdgcn_mfma_f32_16x16x32_bf16(af, ta, dA, 0, 0, 0); }
                const int rko = (c16 * 8 + ((2 * pw + (g >> 1)) ^ (c16 & 7))) * 16 + (g & 1) * 8;
                const u32x2 r2 = *(const LAS u32x2*)(slot + 6144 + rko), k2 = *(const LAS u32x2*)(slot + 8192 + rko), v2 = *(const LAS u32x2*)(slot + 10240 + rko); const LAS float* cst = (const LAS float*)(lds + RQ_CST) + 16 * pw + 4 * g;
                const f32x4 w0 = *(const LAS f32x4*)cst, a0 = *(const LAS f32x4*)(cst + 64), kkw = *(const LAS f32x4*)(cst + 128), kaw = *(const LAS f32x4*)(cst + 192), rkw = *(const LAS f32x4*)(cst + 256);
                const float rr[4] = {bflo(r2.x), bfhi(r2.x), bflo(r2.y), bfhi(r2.y)}, k0[4] = {bflo(k2.x), bfhi(k2.x), bflo(k2.y), bfhi(k2.y)};
                f32x4 oW; float kd[4], kk[4], kb[4], ss = 0.f, bon = 0.f;
#pragma unroll
                for (int j = 0; j < 4; ++j) {
                    const float xw = -(w0[j] + dW[j]);
                    const float sp = fmaxf(xw, 0.f) + 0.6931471806f * __builtin_amdgcn_logf(1.f + __builtin_amdgcn_exp2f(-1.4426950409f * fabsf(xw)));
                    oW[j] = __builtin_amdgcn_exp2f(-1.4426950409f * __builtin_amdgcn_exp2f(-1.4426950409f * (sp + 0.5f)));
                    const float a = __builtin_amdgcn_rcpf(1.f + __builtin_amdgcn_exp2f(-1.4426950409f * (a0[j] + dA[j])));
                    kk[j] = k0[j] * kkw[j]; ss += kk[j] * kk[j]; kb[j] = kk[j] * a;
                    kd[j] = k0[j] * (1.f + (a - 1.f) * kaw[j]); bon += rr[j] * kd[j] * rkw[j]; }
                const int eo = rw_sw(c16, 16 * pw + 4 * g);
                *(LAS f32x4*)(lds + RQ_W + eo * 4) = oW;
                *(LAS u32x2*)(lds + RQ_R + eo * 2) = r2; *(LAS u32x2*)(bufa + RB2_V + eo * 2) = v2;
                *(LAS u32x2*)(lds + RQ_KD + eo * 2) = (u32x2){cvtpk(kd[0], kd[1]), cvtpk(kd[2], kd[3])};
                *(LAS u32x2*)(lds + RQ_A + eo * 2) = (u32x2){cvtpk(-kk[0], -kk[1]), cvtpk(-kk[2], -kk[3])};
                *(LAS u32x2*)(lds + RQ_B + eo * 2) = (u32x2){cvtpk(kb[0], kb[1]), cvtpk(kb[2], kb[3])};
                ss = red4(ss); bon = red4(bon);
                if (g == 0) { *(LAS float*)(lds + RQ_SSP + (c16 * 4 + pw) * 4) = ss; *(LAS float*)(lds + RQ_BNP + (c16 * 4 + pw) * 4) = bon; }
            }
            rwkv_dma(p.ws, lds, wg, pw, lane, n + 5);
            RQ3D_END(3)
            asm volatile("s_waitcnt vmcnt(8)" ::: "memory");
        } else if (has_c) {
            RQ3D_BEGIN(4)
            yt = __builtin_amdgcn_mfma_f32_16x16x32_bf16(mk_frag(*(const LAS u32x2*)(bufc + RB2_NBR + c16 * RC_NS + g * 8), zz), ufr, yt, 0, 0, 0);
#pragma unroll
            for (int r = 0; r < 4; ++r) *(LAS bf16_t*)(lds + RQ_YO + (4 * g + r) * 128 + (16 * pw + c16) * 2) = f2bf_rne(yt[r]);
#pragma unroll
            for (int jb = 0; jb < 4; ++jb) { const f32x4 gl4 = *(const LAS f32x4*)(bufc + RB2_GL + (16 * jb + 4 * g) * 4); Sacc[jb] = Sacc[jb] * gl4;
                Sacc[jb] = __builtin_amdgcn_mfma_f32_16x16x32_bf16(mk_frag(*(const LAS u32x2*)(bufc + RB2_BH + (16 * jb + c16) * RC_HS + g * 8), zz), ufr, Sacc[jb], 0, 0, 0);
                Sacc[jb] = __builtin_amdgcn_mfma_f32_16x16x32_bf16(mk_frag(*(const LAS u32x2*)(bufc + RB2_KH + (16 * jb + c16) * RC_HS + g * 8), zz), vfr, Sacc[jb], 0, 0, 0); }
            if (cc == nchc - 1 && !uc.lat) { const unsigned sb = (unsigned)((((uc.b * 2 + uc.dir) * 32 + uc.head) * 64 + pw * 16 + c16) * 64 + 4 * g);
#pragma unroll
                for (int jb = 0; jb < 4; ++jb) *(f32x4*)((char*)p.out + ((unsigned)OUT_RWKV + sb + 16 * jb) * 4u) = Sacc[jb]; }
            RQ3D_END(4)
        }
        RQ_BAR();
    }
}

constexpr int RS_GL = 0, RS_MAB = 256, RS_MD = 1536, RS_MAK = 1792, RS_NBR = 2432, RS_NKR = 3072, RS_AT = 3712, RS_RT = 6016, RS_BT = 8320, RS_KT = 10624, RS_BH = 12928, RS_KH = 15488, RD_SET = 18048;
constexpr int RD_INV = 2 * RD_SET, RD_SSP = RD_INV + 256, RD_BNP = RD_SSP + 256, RD_YO = RD_BNP + 256, RD_V = RD_YO + 4096, RD_CST = RD_V + 4096, RD_W2 = RD_CST + 1280, RD_A2 = RD_W2 + 13312, RD_HALF = RD_A2 + 13312;
static_assert(2 * RD_HALF <= LDS_BAR_OFF, "RWKV chunk2 LDS map");
template <int N> __device__ __forceinline__ float rw_shr1(float x) { return __int_as_float(__builtin_amdgcn_update_dpp(0x3f800000, __float_as_int(x), 0x110 + N, 0xf, 0xf, false)); }
__device__ __forceinline__ float rw_row15(float x) { return __int_as_float(__builtin_amdgcn_update_dpp(0, __float_as_int(x), 0x15F, 0xf, 0xf, false)); }

#ifndef RD_DELAY
#define RD_DELAY 0
#endif
#define RDD_BEGIN(S) unsigned long long rdd_t0_##S = 0; if (RD_DELAY == S) rdd_t0_##S = clock64();
#define RDD_END(S) if (RD_DELAY == S) { asm volatile("s_waitcnt lgkmcnt(0)" ::: "memory"); const unsigned long long t1_ = clock64(), d_ = t1_ - rdd_t0_##S; while ((unsigned long long)clock64() - t1_ < d_) { } }
__device__ __forceinline__ void p9_rwkv_chunk2(const Params& p, LAS unsigned char* lds) {
    const int tid = tidx(), half = tid >> 8, htid = tid & 255, hw = __builtin_amdgcn_readfirstlane((tid >> 6) & 3), lane = tid & 63, c16 = lane & 15, g = lane >> 4, wg = blockIdx.x, nwg = gridDim.x;
    LAS unsigned char* hl = lds + half * RD_HALF;
    const bf16_t* R = (const bf16_t*)(p.ws + WS_R); const bf16_t* K1 = (const bf16_t*)(p.ws + WS_K1); const bf16_t* V1 = (const bf16_t*)(p.ws + WS_V1); const bf16_t* LR = (const bf16_t*)(p.ws + WS_LR);
    const bf16_t* W2T = (const bf16_t*)(p.ws + WS_W2T); const bf16_t* A2T = (const bf16_t*)(p.ws + WS_A2T);
    float* BON = (float*)(p.ws + WS_BON); bf16_t* YD = (bf16_t*)(p.out + OUT_Y);
    const float* w0p = pin(p, I_W0); const float* a0p = pin(p, I_A0); const float* kkp = pin(p, I_KK); const float* kap = pin(p, I_KA); const float* rkp = pin(p, I_RK); const float* srw = pin(p, I_SRWKV);
    const int nun = half == 0 ? (256 - wg + nwg - 1) / nwg : (1024 - wg + nwg - 1) / nwg;
    const int bpu = half == 0 ? 128 : 8;
    const int my_steps = nun * bpu;
    const int n0 = (256 - wg + nwg - 1) / nwg * 128, n1 = (1024 - wg + nwg - 1) / nwg * 8;
    const int nsteps = n0 > n1 ? n0 : n1;
    f32x4 Sacc[4];
    int base = 0, L = 0, b = 0, head = 0, dir = 0; bool lat = false;
    const int m = c16, q = g;
    const u32x2 zz = (u32x2){0u, 0u};
    pg8::bf16x8 pftw[3], pfta[3]; u32x2 pfr[2], pfk[2], pfv[2];
#define RD_PREFETCH(bk) do { const int tau_ = (bk) * 32 + 16 * (hw & 1) + m, t_ = dir ? L - 1 - tau_ : tau_; const unsigned row_ = (unsigned)(base + t_); \
        _Pragma("unroll") for (int ks = 0; ks < 3; ++ks) { pftw[ks] = *(const pg8::bf16x8*)((const char*)LR + row_ * 768u + (unsigned)(dir * 192 + (32 * ks + 8 * q) * 2)); \
            pfta[ks] = *(const pg8::bf16x8*)((const char*)LR + row_ * 768u + (unsigned)(384 + dir * 192 + (32 * ks + 8 * q) * 2)); } \
        _Pragma("unroll") for (int mi = 0; mi < 2; ++mi) { const unsigned ch_ = (unsigned)(head * 64 + 16 * (2 * (hw >> 1) + mi) + 4 * q); \
            pfr[mi] = *(const u32x2*)((const char*)R + (row_ * 2048u + ch_) * 2u); pfk[mi] = *(const u32x2*)((const char*)K1 + (row_ * 2048u + ch_) * 2u); pfv[mi] = *(const u32x2*)((const char*)V1 + (row_ * 2048u + ch_) * 2u); } } while (0)
    for (int step = 0; step < nsteps; ++step) {
        const bool active = step < my_steps; const int blk = step % bpu;
        if (active && blk == 0) {
            const int un = wg + (step / bpu) * nwg; int s;
            if (half == 0) { s = 16 + (un >> 6); head = (un >> 1) & 31; dir = un & 1; } else { s = un >> 6; head = (un >> 1) & 31; dir = un & 1; }
            seq_info(s, base, L, b, lat);
            for (int i = htid; i < 768; i += 256) { const int ch = i / 12, pc = i % 12; const size_t go = ((size_t)(dir * 2048 + head * 64 + ch) * 96 + pc * 8);
                *(LAS u32x4*)(hl + RD_W2 + ch * RC_TS + pc * 16) = *(const u32x4*)(W2T + go); *(LAS u32x4*)(hl + RD_A2 + ch * RC_TS + pc * 16) = *(const u32x4*)(A2T + go); }
            if (htid < 64) { LAS float* cst = (LAS float*)(hl + RD_CST); const int c = head * 64 + htid;
                cst[htid] = w0p[dir * 2048 + c]; cst[64 + htid] = a0p[dir * 2048 + c]; cst[128 + htid] = kkp[c]; cst[192 + htid] = kap[c]; cst[256 + htid] = rkp[c]; }
            RD_PREFETCH(0);
            const unsigned sb = (unsigned)((((b * 2 + dir) * 32 + head) * 64 + hw * 16 + c16) * 64 + 4 * g);
#pragma unroll
            for (int jb = 0; jb < 4; ++jb) Sacc[jb] = lat ? *(const f32x4*)((const char*)srw + (sb + 16 * jb) * 4u) : (f32x4){0.f, 0.f, 0.f, 0.f};
            __builtin_amdgcn_s_waitcnt(0x0F70);
        }
        __syncthreads();
        RDD_BEGIN(1)
        if (active) {
            const int tok = 16 * (hw & 1) + m, mb0 = 2 * (hw >> 1);
            LAS unsigned char* ts = hl + (hw & 1) * RD_SET;
            f32x4 dW[2], dA[2];
#pragma unroll
            for (int mi = 0; mi < 2; ++mi) { dW[mi] = (f32x4){0.f, 0.f, 0.f, 0.f}; dA[mi] = (f32x4){0.f, 0.f, 0.f, 0.f}; }
#pragma unroll
            for (int ks = 0; ks < 3; ++ks) {
                const pg8::bf16x8 tw = pftw[ks], ta = pfta[ks];
#pragma unroll
                for (int mi = 0; mi < 2; ++mi) { const pg8::bf16x8 wf = *(const LAS pg8::bf16x8*)(hl + RD_W2 + (16 * (mb0 + mi) + m) * RC_TS + (32 * ks + 8 * q) * 2), af = *(const LAS pg8::bf16x8*)(hl + RD_A2 + (16 * (mb0 + mi) + m) * RC_TS + (32 * ks + 8 * q) * 2);
                    dW[mi] = __builtin_amdgcn_mfma_f32_16x16x32_bf16(wf, tw, dW[mi], 0, 0, 0); dA[mi] = __builtin_amdgcn_mfma_f32_16x16x32_bf16(af, ta, dA[mi], 0, 0, 0); } }
            float ss = 0.f, bon = 0.f;
#pragma unroll
            for (int mi = 0; mi < 2; ++mi) { const int mb = mb0 + mi, ch0 = 16 * mb + 4 * q;
                const u32x2 r2 = pfr[mi], k2 = pfk[mi], v2 = pfv[mi]; const LAS float* cst = (const LAS float*)(hl + RD_CST) + ch0;
                const f32x4 w0 = *(const LAS f32x4*)cst, a0 = *(const LAS f32x4*)(cst + 64), kkw = *(const LAS f32x4*)(cst + 128), kaw = *(const LAS f32x4*)(cst + 192), rkw = *(const LAS f32x4*)(cst + 256);
                const float rr[4] = {bflo(r2.x), bfhi(r2.x), bflo(r2.y), bfhi(r2.y)}, k0[4] = {bflo(k2.x), bfhi(k2.x), bflo(k2.y), bfhi(k2.y)};
                float at[4], rt[4], bt[4], kt[4], bh[4], kh[4]; f32x4 g15;
#pragma unroll
                for (int j = 0; j < 4; ++j) {
                    const float wdec = __builtin_amdgcn_exp2f(-0.8750387749f * __builtin_amdgcn_rcpf(1.f + __builtin_amdgcn_exp2f(-1.4426950409f * (w0[j] + dW[mi][j]))));
                    const float a = __builtin_amdgcn_rcpf(1.f + __builtin_amdgcn_exp2f(-1.4426950409f * (a0[j] + dA[mi][j])));
                    const float kk = k0[j] * kkw[j], kb = kk * a, kd = k0[j] * (1.f + (a - 1.f) * kaw[j]);
                    ss += kk * kk; bon += rr[j] * kd * rkw[j];
                    float gi = wdec; gi *= rw_shr1<1>(gi); gi *= rw_shr1<2>(gi); gi *= rw_shr1<4>(gi); gi *= rw_shr1<8>(gi);
                    const float gp = rw_shr1<1>(gi), gl = rw_row15(gi), ig = __builtin_amdgcn_rcpf(gi);
                    at[j] = -kk * gp; rt[j] = rr[j] * gi; bt[j] = kb * ig; kt[j] = kd * ig; bh[j] = bt[j] * gl; kh[j] = kt[j] * gl; g15[j] = gl; }
                *(LAS u32x2*)(ts + RS_AT + m * RC_TT + ch0 * 2) = (u32x2){cvtpk(at[0], at[1]), cvtpk(at[2], at[3])}; *(LAS u32x2*)(ts + RS_RT + m * RC_TT + ch0 * 2) = (u32x2){cvtpk(rt[0], rt[1]), cvtpk(rt[2], rt[3])};
                *(LAS u32x2*)(ts + RS_BT + m * RC_TT + ch0 * 2) = (u32x2){cvtpk(bt[0], bt[1]), cvtpk(bt[2], bt[3])}; *(LAS u32x2*)(ts + RS_KT + m * RC_TT + ch0 * 2) = (u32x2){cvtpk(kt[0], kt[1]), cvtpk(kt[2], kt[3])};
#pragma unroll
                for (int j = 0; j < 4; ++j) { *(LAS bf16_t*)(ts + RS_BH + (ch0 + j) * RC_HS + m * 2) = f2bf(bh[j]); *(LAS bf16_t*)(ts + RS_KH + (ch0 + j) * RC_HS + m * 2) = f2bf(kh[j]); }
                if (m == 15) *(LAS f32x4*)(ts + RS_GL + ch0 * 4) = g15;
                *(LAS u32x2*)(hl + RD_V + rw_sw(tok, ch0) * 2) = v2; }
            ss = red4(ss); bon = red4(bon);
            if (q == 0) { *(LAS float*)(hl + RD_SSP + (tok * 2 + (hw >> 1)) * 4) = ss; *(LAS float*)(hl + RD_BNP + (tok * 2 + (hw >> 1)) * 4) = bon; }
        }
        RDD_END(1)
        __syncthreads();
        if (active && blk + 1 < bpu) RD_PREFETCH(blk + 1);
        RDD_BEGIN(2)
        if (active) {
            const int xo = (hw & 1) ? RS_KT : RS_BT, yo = (hw & 2) ? RS_RT : RS_AT;
#pragma unroll
            for (int c2 = 0; c2 < 2; ++c2) { LAS unsigned char* ts = hl + c2 * RD_SET;
                f32x4 mm = (f32x4){0.f, 0.f, 0.f, 0.f};
#pragma unroll
                for (int ks = 0; ks < 2; ++ks) { const bf16x8 xf = *(const LAS bf16x8*)(ts + xo + c16 * RC_TT + (32 * ks + 8 * g) * 2), yf = *(const LAS bf16x8*)(ts + yo + c16 * RC_TT + (32 * ks + 8 * g) * 2);
                    mm = __builtin_amdgcn_mfma_f32_16x16x32_bf16(xf, yf, mm, 0, 0, 0); }
                const f32x2v st = *(const LAS f32x2v*)(hl + RD_SSP + (16 * c2 + c16) * 8);
                const float invt = __builtin_amdgcn_rcpf(fmaxf(__builtin_amdgcn_sqrtf(st.x + st.y), 1e-12f));
#pragma unroll
                for (int r = 0; r < 4; ++r) { const int s_ = 4 * g + r; const bool keep = (hw & 2) ? (s_ <= c16) : (s_ < c16); mm[r] = keep ? mm[r] : 0.f; }
                if (hw == 0) {
                    const int tb = c16 >> 2;
#pragma unroll
                    for (int r = 0; r < 4; ++r) { const f32x2v sr = *(const LAS f32x2v*)(hl + RD_SSP + (16 * c2 + 4 * g + r) * 8);
                        const float v = mm[r] * invt * __builtin_amdgcn_rcpf(fmaxf(__builtin_amdgcn_sqrtf(sr.x + sr.y), 1e-12f));
                        *(LAS float*)(ts + RS_MAB + (4 * g + r) * RC_MS + c16 * 4) = g < tb ? v : 0.f;
                        if (g == tb) *(LAS float*)(ts + RS_MD + (4 * g + r) * 16 + (c16 & 3) * 4) = v; } }
                else { if (hw == 1) mm = mm * invt;
                    u32x2 w; w.x = cvtpk(mm[0], mm[1]); w.y = cvtpk(mm[2], mm[3]); *(LAS u32x2*)(ts + (hw == 1 ? RS_MAK : hw == 2 ? RS_NBR : RS_NKR) + c16 * RC_NS + g * 8) = w; }
                if (hw == 3 && g == 0) { *(LAS float*)(hl + RD_INV + (16 * c2 + c16) * 4) = invt;
                    const f32x2v bn = *(const LAS f32x2v*)(hl + RD_BNP + (16 * c2 + c16) * 8); const int tau = blk * 32 + 16 * c2 + c16, t = dir ? L - 1 - tau : tau;
                    BON[((size_t)dir * MTOK + (size_t)(base + t)) * 32 + head] = bn.x + bn.y; } }
        }
        RDD_END(2)
        __syncthreads();
        RDD_BEGIN(3)
        if (active) {
#pragma unroll
            for (int cc = 0; cc < 2; ++cc) { const int cb = 16 * cc; LAS unsigned char* ts = hl + cc * RD_SET;
                bf16x8 sfr[2];
#pragma unroll
                for (int ks = 0; ks < 2; ++ks) { u32x4 s4; s4.x = cvtpk(Sacc[2 * ks][0], Sacc[2 * ks][1]); s4.y = cvtpk(Sacc[2 * ks][2], Sacc[2 * ks][3]);
                    s4.z = cvtpk(Sacc[2 * ks + 1][0], Sacc[2 * ks + 1][1]); s4.w = cvtpk(Sacc[2 * ks + 1][2], Sacc[2 * ks + 1][3]); sfr[ks] = __builtin_bit_cast(bf16x8, s4); }
                bf16x8 vfr;
                { const LAS bf16_t* vp = (const LAS bf16_t*)(hl + RD_V); const int vi_ = 16 * hw + c16, vt_ = cb + 4 * g;
                  const unsigned v0 = vp[rw_sw(vt_, vi_)], v1 = vp[rw_sw(vt_ + 1, vi_)], v2 = vp[rw_sw(vt_ + 2, vi_)], v3 = vp[rw_sw(vt_ + 3, vi_)]; vfr = mk_frag((u32x2){v0 | (v1 << 16), v2 | (v3 << 16)}, zz); }
                f32x4 mx[12], md[3];
#pragma unroll
                for (int s1 = 0; s1 < 12; ++s1) mx[s1] = *(const LAS f32x4*)(ts + RS_MAB + s1 * RC_MS + g * 16);
#pragma unroll
                for (int e = 0; e < 3; ++e) md[e] = *(const LAS f32x4*)(ts + RS_MD + (4 * g + e) * 16);
                const f32x4 inv4 = *(const LAS f32x4*)(hl + RD_INV + (cb + 4 * g) * 4);
                f32x4 xt = (f32x4){0.f, 0.f, 0.f, 0.f}, yt = (f32x4){0.f, 0.f, 0.f, 0.f};
#pragma unroll
                for (int ks = 0; ks < 2; ++ks) {
                    const LAS unsigned char* ap = ts + RS_AT + c16 * RC_TT + (32 * ks + 4 * g) * 2; const LAS unsigned char* rp = ts + RS_RT + c16 * RC_TT + (32 * ks + 4 * g) * 2;
                    xt = __builtin_amdgcn_mfma_f32_16x16x32_bf16(mk_frag(*(const LAS u32x2*)ap, *(const LAS u32x2*)(ap + 32)), sfr[ks], xt, 0, 0, 0);
                    yt = __builtin_amdgcn_mfma_f32_16x16x32_bf16(mk_frag(*(const LAS u32x2*)rp, *(const LAS u32x2*)(rp + 32)), sfr[ks], yt, 0, 0, 0); }
                xt = xt * inv4;
                xt = __builtin_amdgcn_mfma_f32_16x16x32_bf16(mk_frag(*(const LAS u32x2*)(ts + RS_MAK + c16 * RC_NS + g * 8), zz), vfr, xt, 0, 0, 0);
                yt = __builtin_amdgcn_mfma_f32_16x16x32_bf16(mk_frag(*(const LAS u32x2*)(ts + RS_NKR + c16 * RC_NS + g * 8), zz), vfr, yt, 0, 0, 0);
                float x[4] = {xt[0], xt[1], xt[2], xt[3]};
#pragma unroll
                for (int h = 0; h < 4; ++h) {
                    if (g == h) { x[1] += x[0] * md[0][1]; x[2] += x[0] * md[0][2]; x[3] += x[0] * md[0][3]; x[2] += x[1] * md[1][2]; x[3] += x[1] * md[1][3]; x[3] += x[2] * md[2][3]; }
                    if (h < 3) { float ub[4];
#pragma unroll
                        for (int e = 0; e < 4; ++e) { const unsigned xv = __float_as_uint(x[e]);
                            if (h == 2) { const auto r1 = __builtin_amdgcn_permlane16_swap(xv, xv, false, false); ub[e] = __uint_as_float(r1[0]); }
                            else { const auto r0 = __builtin_amdgcn_permlane32_swap(xv, xv, false, false); const auto r1 = __builtin_amdgcn_permlane16_swap(r0[0], r0[0], false, false); ub[e] = __uint_as_float(r1[h]); } }
#pragma unroll
                        for (int e2 = 0; e2 < 4; ++e2)
#pragma unroll
                            for (int e = 0; e < 4; ++e) x[e] += ub[e2] * mx[4 * h + e2][e]; } }
                const bf16x8 ufr = mk_frag((u32x2){cvtpk(x[0] * inv4[0], x[1] * inv4[1]), cvtpk(x[2] * inv4[2], x[3] * inv4[3])}, zz);
                yt = __builtin_amdgcn_mfma_f32_16x16x32_bf16(mk_frag(*(const LAS u32x2*)(ts + RS_NBR + c16 * RC_NS + g * 8), zz), ufr, yt, 0, 0, 0);
#pragma unroll
                for (int r = 0; r < 4; ++r) *(LAS bf16_t*)(hl + RD_YO + (cb + 4 * g + r) * 128 + (16 * hw + c16) * 2) = f2bf_rne(yt[r]);
#pragma unroll
                for (int jb = 0; jb < 4; ++jb) { const f32x4 gl4 = *(const LAS f32x4*)(ts + RS_GL + (16 * jb + 4 * g) * 4); Sacc[jb] = Sacc[jb] * gl4;
                    Sacc[jb] = __builtin_amdgcn_mfma_f32_16x16x32_bf16(mk_frag(*(const LAS u32x2*)(ts + RS_BH + (16 * jb + c16) * RC_HS + g * 8), zz), ufr, Sacc[jb], 0, 0, 0);
                    Sacc[jb] = __builtin_amdgcn_mfma_f32_16x16x32_bf16(mk_frag(*(const LAS u32x2*)(ts + RS_KH + (16 * jb + c16) * RC_HS + g * 8), zz), vfr, Sacc[jb], 0, 0, 0); }
            }
            if (blk == bpu - 1 && !lat) { const unsigned sb = (unsigned)((((b * 2 + dir) * 32 + head) * 64 + hw * 16 + c16) * 64 + 4 * g);
#pragma unroll
                for (int jb = 0; jb < 4; ++jb) *(f32x4*)((char*)p.out + ((unsigned)OUT_RWKV + sb + 16 * jb) * 4u) = Sacc[jb]; }
        }
        RDD_END(3)
        __syncthreads();
        if (active) {
            const int tok = htid >> 3, c8 = (htid & 7) * 8, tau = blk * 32 + tok, t = dir ? L - 1 - tau : tau; const size_t row = (size_t)(base + t);
            *(u32x4*)(YD + (size_t)dir * MTOK * DM + row * DM + head * 64 + c8) = *(const LAS u32x4*)(hl + RD_YO + tok * 128 + c8 * 2);
        }
    }
#undef RD_PREFETCH
}

__device__ __forceinline__ void rwkv_main_chunk(LAS unsigned char* rg, int cc, int hw, int c16, int g, f32x4 (&Sacc)[4]) {
                const int cb = 16 * cc; LAS unsigned char* ts = rg + cc * RD_SET; const u32x2 zz = (u32x2){0u, 0u};
                bf16x8 sfr[2];
#pragma unroll
                for (int ks = 0; ks < 2; ++ks) { u32x4 s4; s4.x = cvtpk(Sacc[2 * ks][0], Sacc[2 * ks][1]); s4.y = cvtpk(Sacc[2 * ks][2], Sacc[2 * ks][3]);
                    s4.z = cvtpk(Sacc[2 * ks + 1][0], Sacc[2 * ks + 1][1]); s4.w = cvtpk(Sacc[2 * ks + 1][2], Sacc[2 * ks + 1][3]); sfr[ks] = __builtin_bit_cast(bf16x8, s4); }
                bf16x8 vfr;
                { const LAS bf16_t* vp = (const LAS bf16_t*)(rg + RD_V); const int vi_ = 16 * hw + c16, vt_ = cb + 4 * g;
                  const unsigned v0 = vp[rw_sw(vt_, vi_)], v1 = vp[rw_sw(vt_ + 1, vi_)], v2 = vp[rw_sw(vt_ + 2, vi_)], v3 = vp[rw_sw(vt_ + 3, vi_)]; vfr = mk_frag((u32x2){v0 | (v1 << 16), v2 | (v3 << 16)}, zz); }
                f32x4 mx[12], md[3];
#pragma unroll
                for (int s1 = 0; s1 < 12; ++s1) mx[s1] = *(const LAS f32x4*)(ts + RS_MAB + s1 * RC_MS + g * 16);
#pragma unroll
                for (int e = 0; e < 3; ++e) md[e] = *(const LAS f32x4*)(ts + RS_MD + (4 * g + e) * 16);
                const f32x4 inv4 = *(const LAS f32x4*)(rg + RD_INV + (cb + 4 * g) * 4);
                f32x4 xt = (f32x4){0.f, 0.f, 0.f, 0.f}, yt = (f32x4){0.f, 0.f, 0.f, 0.f};
#pragma unroll
                for (int ks = 0; ks < 2; ++ks) {
                    const LAS unsigned char* ap = ts + RS_AT + c16 * RC_TT + (32 * ks + 4 * g) * 2; const LAS unsigned char* rp = ts + RS_RT + c16 * RC_TT + (32 * ks + 4 * g) * 2;
                    xt = __builtin_amdgcn_mfma_f32_16x16x32_bf16(mk_frag(*(const LAS u32x2*)ap, *(const LAS u32x2*)(ap + 32)), sfr[ks], xt, 0, 0, 0);
                    yt = __builtin_amdgcn_mfma_f32_16x16x32_bf16(mk_frag(*(const LAS u32x2*)rp, *(const LAS u32x2*)(rp + 32)), sfr[ks], yt, 0, 0, 0); }
                xt = xt * inv4;
                xt = __builtin_amdgcn_mfma_f32_16x16x32_bf16(mk_frag(*(const LAS u32x2*)(ts + RS_MAK + c16 * RC_NS + g * 8), zz), vfr, xt, 0, 0, 0);
                yt = __builtin_amdgcn_mfma_f32_16x16x32_bf16(mk_frag(*(const LAS u32x2*)(ts + RS_NKR + c16 * RC_NS + g * 8), zz), vfr, yt, 0, 0, 0);
                float x[4] = {xt[0], xt[1], xt[2], xt[3]};
#pragma unroll
                for (int h = 0; h < 4; ++h) {
                    if (g == h) { x[1] += x[0] * md[0][1]; x[2] += x[0] * md[0][2]; x[3] += x[0] * md[0][3]; x[2] += x[1] * md[1][2]; x[3] += x[1] * md[1][3]; x[3] += x[2] * md[2][3]; }
                    if (h < 3) { float ub[4];
#pragma unroll
                        for (int e = 0; e < 4; ++e) { const unsigned xv = __float_as_uint(x[e]);
                            if (h == 2) { const auto r1 = __builtin_amdgcn_permlane16_swap(xv, xv, false, false); ub[e] = __uint_as_float(r1[0]); }
                            else { const auto r0 = __builtin_amdgcn_permlane32_swap(xv, xv, false, false); const auto r1 = __builtin_amdgcn_permlane16_swap(r0[0], r0[0], false, false); ub[e] = __uint_as_float(r1[h]); } }
#pragma unroll
                        for (int e2 = 0; e2 < 4; ++e2)
#pragma unroll
                            for (int e = 0; e < 4; ++e) x[e] += ub[e2] * mx[4 * h + e2][e]; } }
                const bf16x8 ufr = mk_frag((u32x2){cvtpk(x[0] * inv4[0], x[1] * inv4[1]), cvtpk(x[2] * inv4[2], x[3] * inv4[3])}, zz);
                yt = __builtin_amdgcn_mfma_f32_16x16x32_bf16(mk_frag(*(const LAS u32x2*)(ts + RS_NBR + c16 * RC_NS + g * 8), zz), ufr, yt, 0, 0, 0);
#pragma unroll
                for (int r = 0; r < 4; ++r) *(LAS bf16_t*)(rg + RD_YO + (cb + 4 * g + r) * 128 + (16 * hw + c16) * 2) = f2bf_rne(yt[r]);
#pragma unroll
                for (int jb = 0; jb < 4; ++jb) { const f32x4 gl4 = *(const LAS f32x4*)(ts + RS_GL + (16 * jb + 4 * g) * 4); Sacc[jb] = Sacc[jb] * gl4;
                    Sacc[jb] = __builtin_amdgcn_mfma_f32_16x16x32_bf16(mk_frag(*(const LAS u32x2*)(ts + RS_BH + (16 * jb + c16) * RC_HS + g * 8), zz), ufr, Sacc[jb], 0, 0, 0);
                    Sacc[jb] = __builtin_amdgcn_mfma_f32_16x16x32_bf16(mk_frag(*(const LAS u32x2*)(ts + RS_KH + (16 * jb + c16) * RC_HS + g * 8), zz), vfr, Sacc[jb], 0, 0, 0); }
}

__device__ __forceinline__ void p9_rwkv_chunk3(const Params& p, LAS unsigned char* lds) {
    const int tid = tidx(), half = __builtin_amdgcn_readfirstlane(tid >> 8), htid = tid & 255, hw = __builtin_amdgcn_readfirstlane((tid >> 6) & 3), lane = tid & 63, c16 = lane & 15, g = lane >> 4, wg = blockIdx.x;
    LAS unsigned char* hl = lds + half * RD_HALF;
    const bf16_t* R = (const bf16_t*)(p.ws + WS_R); const bf16_t* K1 = (const bf16_t*)(p.ws + WS_K1); const bf16_t* V1 = (const bf16_t*)(p.ws + WS_V1); const bf16_t* LR = (const bf16_t*)(p.ws + WS_LR);
    const bf16_t* W2T = (const bf16_t*)(p.ws + WS_W2T); const bf16_t* A2T = (const bf16_t*)(p.ws + WS_A2T);
    float* BON = (float*)(p.ws + WS_BON); bf16_t* YD = (bf16_t*)(p.out + OUT_Y);
    const float* w0p = pin(p, I_W0); const float* a0p = pin(p, I_A0); const float* kkp = pin(p, I_KK); const float* kap = pin(p, I_KA); const float* rkp = pin(p, I_RK); const float* srw = pin(p, I_SRWKV);
    constexpr int NLAT = 128, NCTX = 32, PIPE0 = NCTX + 1;
    f32x4 Sacc[4];
    int base = 0, L = 0, b = 0, head = 0, dir = 0; bool lat = false;
    const int m = c16, q = g;
    pg8::bf16x8 pftw[3], pfta[3]; u32x2 pfr[2], pfk[2], pfv[2];
#define RD_PREFETCH(bk) do { const int tau_ = (bk) * 32 + 16 * (hw & 1) + m, t_ = dir ? L - 1 - tau_ : tau_; const unsigned row_ = (unsigned)(base + t_); \
        _Pragma("unroll") for (int ks = 0; ks < 3; ++ks) { pftw[ks] = *(const pg8::bf16x8*)((const char*)LR + row_ * 768u + (unsigned)(dir * 192 + (32 * ks + 8 * q) * 2)); \
            pfta[ks] = *(const pg8::bf16x8*)((const char*)LR + row_ * 768u + (unsigned)(384 + dir * 192 + (32 * ks + 8 * q) * 2)); } \
        _Pragma("unroll") for (int mi = 0; mi < 2; ++mi) { const unsigned ch_ = (unsigned)(head * 64 + 16 * (2 * (hw >> 1) + mi) + 4 * q); \
            pfr[mi] = *(const u32x2*)((const char*)R + (row_ * 2048u + ch_) * 2u); pfk[mi] = *(const u32x2*)((const char*)K1 + (row_ * 2048u + ch_) * 2u); pfv[mi] = *(const u32x2*)((const char*)V1 + (row_ * 2048u + ch_) * 2u); } } while (0)
    for (int step = 0; step <= NLAT; ++step) {
        const bool prod1 = half == 1 && step >= NCTX;
        const bool cons0 = half == 0 && step >= PIPE0;
        const bool normal = (half == 0 && step < PIPE0) || (half == 1 && step < NCTX);
        const int ablk = prod1 ? step + 1 : (half == 0 ? step : (step & 7));
        const bool doA = (normal && step < NLAT) || (prod1 && step + 1 < NLAT);
        LAS unsigned char* tg = prod1 ? lds + ((step + 1) & 1) * RD_HALF : hl;
        LAS unsigned char* rg = cons0 ? lds + (step & 1) * RD_HALF : hl;
        const bool unit_start = (half == 0 && step == 0) || (half == 1 && step < NCTX && (step & 7) == 0) || (half == 1 && step == NCTX);
        if (unit_start) {
            const int un = (half == 0 || step == NCTX) ? wg : wg + (step >> 3) * 256; int s;
            if (half == 0 || step == NCTX) { s = 16 + (un >> 6); } else { s = un >> 6; }
            head = (un >> 1) & 31; dir = un & 1;
            seq_info(s, base, L, b, lat);
            for (int i = htid; i < 768; i += 256) { const int ch = i / 12, pc = i % 12; const size_t go = ((size_t)(dir * 2048 + head * 64 + ch) * 96 + pc * 8);
                *(LAS u32x4*)(hl + RD_W2 + ch * RC_TS + pc * 16) = *(const u32x4*)(W2T + go); *(LAS u32x4*)(hl + RD_A2 + ch * RC_TS + pc * 16) = *(const u32x4*)(A2T + go); }
            if (htid < 64) { LAS float* cst = (LAS float*)(hl + RD_CST); const int c = head * 64 + htid;
                cst[htid] = w0p[dir * 2048 + c]; cst[64 + htid] = a0p[dir * 2048 + c]; cst[128 + htid] = kkp[c]; cst[192 + htid] = kap[c]; cst[256 + htid] = rkp[c]; }
            RD_PREFETCH(ablk);
            if (!prod1) {
                const unsigned sb = (unsigned)((((b * 2 + dir) * 32 + head) * 64 + hw * 16 + c16) * 64 + 4 * g);
#pragma unroll
                for (int jb = 0; jb < 4; ++jb) Sacc[jb] = lat ? *(const f32x4*)((const char*)srw + (sb + 16 * jb) * 4u) : (f32x4){0.f, 0.f, 0.f, 0.f}; }
            __builtin_amdgcn_s_waitcnt(0x0F70);
        }
        __syncthreads();
        if (cons0) {
            if (step > PIPE0) { const int tok = htid >> 3, c8 = (htid & 7) * 8, tau = (step - 1) * 32 + tok, t = dir ? L - 1 - tau : tau; const size_t row = (size_t)(base + t);
              *(u32x4*)(YD + (size_t)dir * MTOK * DM + row * DM + head * 64 + c8) = *(const LAS u32x4*)(lds + ((step - 1) & 1) * RD_HALF + RD_YO + tok * 128 + c8 * 2); }
            if (step < NLAT) rwkv_main_chunk(rg, 0, hw, c16, g, Sacc);
        }
        if (doA) {
            const int tok = 16 * (hw & 1) + m, mb0 = 2 * (hw >> 1);
            LAS unsigned char* ts = tg + (hw & 1) * RD_SET;
            f32x4 dW[2], dA[2];
#pragma unroll
            for (int mi = 0; mi < 2; ++mi) { dW[mi] = (f32x4){0.f, 0.f, 0.f, 0.f}; dA[mi] = (f32x4){0.f, 0.f, 0.f, 0.f}; }
#pragma unroll
            for (int ks = 0; ks < 3; ++ks) {
                const pg8::bf16x8 tw = pftw[ks], ta = pfta[ks];
#pragma unroll
                for (int mi = 0; mi < 2; ++mi) { const pg8::bf16x8 wf = *(const LAS pg8::bf16x8*)(hl + RD_W2 + (16 * (mb0 + mi) + m) * RC_TS + (32 * ks + 8 * q) * 2), af = *(const LAS pg8::bf16x8*)(hl + RD_A2 + (16 * (mb0 + mi) + m) * RC_TS + (32 * ks + 8 * q) * 2);
                    dW[mi] = __builtin_amdgcn_mfma_f32_16x16x32_bf16(wf, tw, dW[mi], 0, 0, 0); dA[mi] = __builtin_amdgcn_mfma_f32_16x16x32_bf16(af, ta, dA[mi], 0, 0, 0); } }
            float ss = 0.f, bon = 0.f;
#pragma unroll
            for (int mi = 0; mi < 2; ++mi) { const int mb = mb0 + mi, ch0 = 16 * mb + 4 * q;
                const u32x2 r2 = pfr[mi], k2 = pfk[mi], v2 = pfv[mi]; const LAS float* cst = (const LAS float*)(hl + RD_CST) + ch0;
                const f32x4 w0 = *(const LAS f32x4*)cst, a0 = *(const LAS f32x4*)(cst + 64), kkw = *(const LAS f32x4*)(cst + 128), kaw = *(const LAS f32x4*)(cst + 192), rkw = *(const LAS f32x4*)(cst + 256);
                const float rr[4] = {bflo(r2.x), bfhi(r2.x), bflo(r2.y), bfhi(r2.y)}, k0[4] = {bflo(k2.x), bfhi(k2.x), bflo(k2.y), bfhi(k2.y)};
                float at[4], rt[4], bt[4], kt[4], bh[4], kh[4]; f32x4 g15;
#pragma unroll
                for (int j = 0; j < 4; ++j) {
                    const float wdec = __builtin_amdgcn_exp2f(-0.8750387749f * __builtin_amdgcn_rcpf(1.f + __builtin_amdgcn_exp2f(-1.4426950409f * (w0[j] + dW[mi][j]))));
                    const float a = __builtin_amdgcn_rcpf(1.f + __builtin_amdgcn_exp2f(-1.4426950409f * (a0[j] + dA[mi][j])));
                    const float kk = k0[j] * kkw[j], kb = kk * a, kd = k0[j] * (1.f + (a - 1.f) * kaw[j]);
                    ss += kk * kk; bon += rr[j] * kd * rkw[j];
                    float gi = wdec; gi *= rw_shr1<1>(gi); gi *= rw_shr1<2>(gi); gi *= rw_shr1<4>(gi); gi *= rw_shr1<8>(gi);
                    const float gp = rw_shr1<1>(gi), gl = rw_row15(gi), ig = __builtin_amdgcn_rcpf(gi);
                    at[j] = -kk * gp; rt[j] = rr[j] * gi; bt[j] = kb * ig; kt[j] = kd * ig; bh[j] = bt[j] * gl; kh[j] = kt[j] * gl; g15[j] = gl; }
                *(LAS u32x2*)(ts + RS_AT + m * RC_TT + ch0 * 2) = (u32x2){cvtpk(at[0], at[1]), cvtpk(at[2], at[3])}; *(LAS u32x2*)(ts + RS_RT + m * RC_TT + ch0 * 2) = (u32x2){cvtpk(rt[0], rt[1]), cvtpk(rt[2], rt[3])};
                *(LAS u32x2*)(ts + RS_BT + m * RC_TT + ch0 * 2) = (u32x2){cvtpk(bt[0], bt[1]), cvtpk(bt[2], bt[3])}; *(LAS u32x2*)(ts + RS_KT + m * RC_TT + ch0 * 2) = (u32x2){cvtpk(kt[0], kt[1]), cvtpk(kt[2], kt[3])};
#pragma unroll
                for (int j = 0; j < 4; ++j) { *(LAS bf16_t*)(ts + RS_BH + (ch0 + j) * RC_HS + m * 2) = f2bf(bh[j]); *(LAS bf16_t*)(ts + RS_KH + (ch0 + j) * RC_HS + m * 2) = f2bf(kh[j]); }
                if (m == 15) *(LAS f32x4*)(ts + RS_GL + ch0 * 4) = g15;
                *(LAS u32x2*)(tg + RD_V + rw_sw(tok, ch0) * 2) = v2; }
            ss = red4(ss); bon = red4(bon);
            if (q == 0) { *(LAS float*)(tg + RD_SSP + (tok * 2 + (hw >> 1)) * 4) = ss; *(LAS float*)(tg + RD_BNP + (tok * 2 + (hw >> 1)) * 4) = bon; }
        }
        __syncthreads();
        if (doA && (half == 0 ? step + 1 < PIPE0 : ablk + 1 < (prod1 ? NLAT : 8))) RD_PREFETCH(ablk + 1);
        if (cons0 && step < NLAT) rwkv_main_chunk(rg, 1, hw, c16, g, Sacc);
        if (doA) {
            const int xo = (hw & 1) ? RS_KT : RS_BT, yo = (hw & 2) ? RS_RT : RS_AT;
#pragma unroll
            for (int c2 = 0; c2 < 2; ++c2) { LAS unsigned char* ts = tg + c2 * RD_SET;
                f32x4 mm = (f32x4){0.f, 0.f, 0.f, 0.f};
#pragma unroll
                for (int ks = 0; ks < 2; ++ks) { const bf16x8 xf = *(const LAS bf16x8*)(ts + xo + c16 * RC_TT + (32 * ks + 8 * g) * 2), yf = *(const LAS bf16x8*)(ts + yo + c16 * RC_TT + (32 * ks + 8 * g) * 2);
                    mm = __builtin_amdgcn_mfma_f32_16x16x32_bf16(xf, yf, mm, 0, 0, 0); }
                const f32x2v st = *(const LAS f32x2v*)(tg + RD_SSP + (16 * c2 + c16) * 8);
                const float invt = __builtin_amdgcn_rcpf(fmaxf(__builtin_amdgcn_sqrtf(st.x + st.y), 1e-12f));
#pragma unroll
                for (int r = 0; r < 4; ++r) { const int s_ = 4 * g + r; const bool keep = (hw & 2) ? (s_ <= c16) : (s_ < c16); mm[r] = keep ? mm[r] : 0.f; }
                if (hw == 0) {
                    const int tb = c16 >> 2;
#pragma unroll
                    for (int r = 0; r < 4; ++r) { const f32x2v sr = *(const LAS f32x2v*)(tg + RD_SSP + (16 * c2 + 4 * g + r) * 8);
                        const float v = mm[r] * invt * __builtin_amdgcn_rcpf(fmaxf(__builtin_amdgcn_sqrtf(sr.x + sr.y), 1e-12f));
                        *(LAS float*)(ts + RS_MAB + (4 * g + r) * RC_MS + c16 * 4) = g < tb ? v : 0.f;
                        if (g == tb) *(LAS float*)(ts + RS_MD + (4 * g + r) * 16 + (c16 & 3) * 4) = v; } }
                else { if (hw == 1) mm = mm * invt;
                    u32x2 w; w.x = cvtpk(mm[0], mm[1]); w.y = cvtpk(mm[2], mm[3]); *(LAS u32x2*)(ts + (hw == 1 ? RS_MAK : hw == 2 ? RS_NBR : RS_NKR) + c16 * RC_NS + g * 8) = w; }
                if (hw == 3 && g == 0) { *(LAS float*)(tg + RD_INV + (16 * c2 + c16) * 4) = invt;
                    const f32x2v bn = *(const LAS f32x2v*)(tg + RD_BNP + (16 * c2 + c16) * 8); const int tau = ablk * 32 + 16 * c2 + c16, t = dir ? L - 1 - tau : tau;
                    BON[((size_t)dir * MTOK + (size_t)(base + t)) * 32 + head] = bn.x + bn.y; } }
        }
        __syncthreads();
        if (normal && step < NLAT) {
            rwkv_main_chunk(rg, 0, hw, c16, g, Sacc); rwkv_main_chunk(rg, 1, hw, c16, g, Sacc);
            if (half == 1 && (step & 7) == 7) { const unsigned sb = (unsigned)((((b * 2 + dir) * 32 + head) * 64 + hw * 16 + c16) * 64 + 4 * g);
#pragma unroll
                for (int jb = 0; jb < 4; ++jb) *(f32x4*)((char*)p.out + ((unsigned)OUT_RWKV + sb + 16 * jb) * 4u) = Sacc[jb]; }
        }
        if (step < PIPE0) __syncthreads();
        if (normal && step < NLAT) {
            const int blk = half == 0 ? step : (step & 7);
            const int tok = htid >> 3, c8 = (htid & 7) * 8, tau = blk * 32 + tok, t = dir ? L - 1 - tau : tau; const size_t row = (size_t)(base + t);
            *(u32x4*)(YD + (size_t)dir * MTOK * DM + row * DM + head * 64 + c8) = *(const LAS u32x4*)(hl + RD_YO + tok * 128 + c8 * 2);
        }
    }
#undef RD_PREFETCH
}
__device__ __forceinline__ void p10_combine(const Params& p) {
    const int lane = tidx() & 63, gw = blockIdx.x * 8 + (tidx() >> 6), nw = gridDim.x * 8;
    const bf16_t* YF = (const bf16_t*)(p.out + OUT_Y); const bf16_t* YB = YF + (size_t)MTOK * DM; const bf16_t* V1 = (const bf16_t*)(p.ws + WS_V1); const bf16_t* G1 = (const bf16_t*)(p.ws + WS_G1);
    const float* BON = (const float*)(p.ws + WS_BON); bf16_t* O1 = (bf16_t*)(p.ws + WS_R);
    for (int row = gw; row < MTOK; row += nw) {
#pragma unroll 2
        for (int it = 0; it < 8; ++it) { const int ch = it * 256 + lane * 4, head = ch >> 6; const size_t e = (size_t)row * DM + ch;
            const u32x2 f2 = *(const u32x2*)(YF + e), b2 = *(const u32x2*)(YB + e), v2 = *(const u32x2*)(V1 + e), g2 = *(const u32x2*)(G1 + e);
            float y[4] = {bflo(f2.x) + bflo(b2.x), bfhi(f2.x) + bfhi(b2.x), bflo(f2.y) + bflo(b2.y), bfhi(f2.y) + bfhi(b2.y)};
            const float vv[4] = {bflo(v2.x), bfhi(v2.x), bflo(v2.y), bfhi(v2.y)}, gg[4] = {bflo(g2.x), bfhi(g2.x), bflo(g2.y), bfhi(g2.y)};
            float s = y[0] + y[1] + y[2] + y[3]; s += __shfl_xor(s, 1); s += __shfl_xor(s, 2); s += __shfl_xor(s, 4); s += __shfl_xor(s, 8);
            const float mean = s * (1.f / 64.f); float v = 0.f;
#pragma unroll
            for (int j = 0; j < 4; ++j) { y[j] -= mean; v += y[j] * y[j]; }
            v += __shfl_xor(v, 1); v += __shfl_xor(v, 2); v += __shfl_xor(v, 4); v += __shfl_xor(v, 8);
            const float rstd = rsqrtf(v * (1.f / 64.f) + 64e-5f);
            const float bon = BON[(size_t)row * 32 + head] + BON[((size_t)MTOK + row) * 32 + head];
            const f32x4 lw = *(const f32x4*)(pin(p, I_LNXW) + ch), lb = *(const f32x4*)(pin(p, I_LNXB) + ch);
            float o[4];
#pragma unroll
            for (int j = 0; j < 4; ++j) o[j] = (y[j] * rstd * lw[j] + lb[j] + bon * vv[j]) * silu(gg[j]);
            u32x2 w; w.x = cvtpk(o[0], o[1]); w.y = cvtpk(o[2], o[3]); *(u32x2*)(O1 + e) = w; }
    }
}
__device__ __forceinline__ void p12_final(const Params& p) {
    const int lane = tidx() & 63, gw = blockIdx.x * 8 + (tidx() >> 6), nw = gridDim.x * 8; const float* fw = pin(p, I_FNW);
    for (int row = gw; row < MTOK; row += nw) { float* xr = p.out + OUT_Y + (size_t)row * DM; f32x4 x[8]; float ss = 0.f;
#pragma unroll
        for (int it = 0; it < 8; ++it) { x[it] = *(const f32x4*)(xr + it * 256 + lane * 4);
#pragma unroll
            for (int j = 0; j < 4; ++j) ss += x[it][j] * x[it][j]; }
        ss = wave_sum(ss); const float rstd = rsqrtf(ss * (1.f / 2048.f) + 1e-6f);
#pragma unroll
        for (int it = 0; it < 8; ++it) { const f32x4 w = *(const f32x4*)(fw + it * 256 + lane * 4); *(f32x4*)(xr + it * 256 + lane * 4) = x[it] * rstd * w; }
    }
}

constexpr int NPHASE = 15;
__global__ void __launch_bounds__(512, 2) mk_fwd(Params p) {
    extern __shared__ __attribute__((aligned(16))) unsigned char shm[];
    LAS unsigned char* lds = (LAS unsigned char*)shm;
    const int lo = p.ph_lo, hi = p.ph_hi;
    volatile LAS unsigned* st = (volatile LAS unsigned*)(lds + LDS_BAR_OFF);
    if (tidx() == 0) { st[0] = 0u; st[1] = 0u; st[2] = 0u; st[3] = 0u; }
    __syncthreads();
    XcdBarrier bar; bar.bar = (unsigned*)(p.ws + WS_BAR); bar.x = 0; bar.st = st;
    if (hi - lo > 1) bar = xcd_barrier_post((unsigned*)(p.ws + WS_BAR), st);
#ifndef PHMASK
#define PHMASK 0x7fff
#endif
#define IN(k) (((PHMASK >> (k)) & 1) && lo <= (k) && (k) < hi)
#define SEAM(k) do { if (IN((k) + 1)) xcd_barrier(bar); } while (0)
    unsigned char* ws = p.ws;
#ifndef DUPMASK
#define DUPMASK 0
#endif
#ifndef SPLIT_TAIL
#define SPLIT_TAIL 1
#endif
#define RUN(k, ...) do { if (IN(k)) { __VA_ARGS__; if ((DUPMASK >> (k)) & 1) { xcd_barrier(bar); __VA_ARGS__; } SEAM(k); } } while (0)
    RUN(0, p0_prologue(p, lds));
    RUN(1, p1_h0(p));
    RUN(2, { pg8::Gemm g{(const bf16_t*)(p.out + OUT_GLA), (const bf16_t*)(ws + WS_WT_E_IN), MTOK, 11264, 2048}; pg8::StaticOrder S; S.init(MTOK, 11264, gridDim.x, blockIdx.x);
        EpiProj0 E{ws}; pg8::gemm_phase<EpiProj0, pg8::StaticOrder>(lds, g, S, E, nullptr); });
    RUN(3, p_s5_passA(p, lds));
    RUN(4, { p_s5_passC_ctx(p); xcd_barrier(bar); p_s5_passC_lat(p, lds); xcd_barrier(bar); p_s5_gelu(p); });
    RUN(5, { pg8::Gemm g{(const bf16_t*)(ws + WS_U), (const bf16_t*)(ws + WS_WT_GLU), MTOK, 1024, 1024}; pg8::StaticOrder S; S.init(MTOK, 1024, gridDim.x, blockIdx.x);
        EpiGlu E{(const bf16_t*)(ws + WS_U), (const bf16_t*)(ws + WS_SG), pin(p, I_GLUB), (bf16_t*)(p.out + OUT_Y)}; pg8::gemm_phase<EpiGlu, pg8::StaticOrder>(lds, g, S, E, nullptr);
        { pg8::Gemm g2{(const bf16_t*)(p.out + OUT_GLA), (const bf16_t*)(ws + WS_WT_E_IN) + (size_t)11264 * 2048, MTOK, 256, 2048}; pg8::StaticOrder S2; S2.init(MTOK, 256, gridDim.x, (int)((blockIdx.x + 128u) & 255u));
          EpiDlr E2{ws}; pg8::gemm_phase<EpiDlr, pg8::StaticOrder>(lds, g2, S2, E2, nullptr); } });
    RUN(6, p_gla_chunk(p, lds));
    RUN(7, p_gla_norm2(p));
    RUN(8, { pg8::Gemm g{(const bf16_t*)(p.out + OUT_Y), (const bf16_t*)(ws + WS_WT_E_OUT), MTOK, 2048, 4096}; pg8::StaticOrder S; S.init(MTOK, 2048, gridDim.x, blockIdx.x);
        if (SPLIT_TAIL) S.set_split(2, 4096, (pg8::f32x4*)(ws + WS_V), (unsigned*)(ws + WS_BAR) + XCD_BAR_WORDS);
        EpiRes E{pin(p, I_XP), pin(p, I_XS), P_POSTAB(p), P_MOD(p) + 4096, nullptr, 0, (float*)(ws + WS_X1)}; pg8::gemm_phase<EpiRes, pg8::StaticOrder>(lds, g, S, E, nullptr); });
    RUN(9, p7_xs(p, lds));
    RUN(10, { pg8::Gemm g{(const bf16_t*)(p.out + OUT_Y), (const bf16_t*)((unsigned char*)(p.out + OUT_Y) + OY_WT_O_IN_B), MTOK, 8704, 2048}; pg8::StaticOrder S; S.init(MTOK, 8704, gridDim.x, blockIdx.x);
        EpiProj1 E{ws}; pg8::gemm_phase<EpiProj1, pg8::StaticOrder>(lds, g, S, E, nullptr); });
#if defined(RWKV_OLD)
    RUN(11, p9_rwkv(p, lds));
#elif defined(RWKV_PIPE)
    RUN(11, p9_rwkv_pipe(p, lds));
#elif defined(RWKV_PIPE2)
    RUN(11, p9_rwkv_pipe2(p, lds));
#elif defined(RWKV_PIPE3)
    RUN(11, p9_rwkv_pipe3(p, lds));
#elif defined(RWKV_CHUNK2)
    RUN(11, p9_rwkv_chunk2(p, lds));
#elif defined(RWKV_CHUNK1)
    RUN(11, p9_rwkv_chunk(p, lds));
#else
    RUN(11, p9_rwkv_chunk3(p, lds));
#endif
    RUN(12, p10_combine(p));
    RUN(13, { pg8::Gemm g{(const bf16_t*)(ws + WS_R), (const bf16_t*)(ws + WS_WT_O_OUT), MTOK, 2048, 2048}; pg8::StaticOrder S; S.init(MTOK, 2048, gridDim.x, blockIdx.x);
        if (SPLIT_TAIL) S.set_split(2, 2048, (pg8::f32x4*)(ws + WS_K1), (unsigned*)(ws + WS_BAR) + XCD_BAR_WORDS + 128);
        EpiRes E{nullptr, nullptr, nullptr, P_MOD(p) + 5 * 6144 + 4096, (const float*)(ws + WS_X1), 1, p.out + OUT_Y}; pg8::gemm_phase<EpiRes, pg8::StaticOrder>(lds, g, S, E, nullptr); });
    if (IN(14)) { p12_final(p); }
#undef RUN
#undef IN
#undef SEAM
}

#ifndef MK_FUSED
#define MK_FUSED 1
#endif
extern "C" void kernel_launch(void* const* d_in, const int* in_sizes, int n_in, void* d_out, int out_size, void* d_ws, size_t ws_size, hipStream_t stream) {
    static int grid = 0;
    if (grid == 0) {
        if (n_in != N_IN || out_size != (int)OUT_TOTAL || ws_size < WS_END) { fprintf(stderr, "kernel_launch: unexpected shapes: n_in %d out %d ws %zu; nothing launched\n", n_in, out_size, ws_size); grid = -1; return; }
        int dev = 0, cus = 0, per_cu = 0;
        if (hipGetDevice(&dev) != hipSuccess || hipDeviceGetAttribute(&cus, hipDeviceAttributeMultiprocessorCount, dev) != hipSuccess) { grid = -1; return; }
        if (hipFuncSetAttribute((const void*)mk_fwd, hipFuncAttributeMaxDynamicSharedMemorySize, LDS_BYTES) != hipSuccess) { fprintf(stderr, "kernel_launch: hipFuncSetAttribute failed\n"); grid = -1; return; }
        if (hipOccupancyMaxActiveBlocksPerMultiprocessor(&per_cu, (const void*)mk_fwd, 512, LDS_BYTES) != hipSuccess || per_cu < 1) fprintf(stderr, "kernel_launch: occupancy query reports %d per CU\n", per_cu);
        (void)hipGetLastError();
        if (cus != 256) { fprintf(stderr, "kernel_launch: built for 256 CUs, device has %d; nothing launched\n", cus); grid = -1; return; }
        grid = 256;
    }
    if (grid < 0) return;
    Params p; memset(&p, 0, sizeof(p));
    for (int i = 0; i < N_IN; ++i) p.in[i] = (const float*)d_in[i];
    p.out = (float*)d_out; p.ws = (unsigned char*)d_ws;
#if MK_FUSED
    (void)hipMemsetAsync((unsigned char*)d_ws + WS_BAR, 0, 16384, stream);
    p.ph_lo = 0; p.ph_hi = NPHASE;
    hipLaunchKernelGGL(mk_fwd, dim3(grid), dim3(512), LDS_BYTES, stream, p);
#else
    for (int k = 0; k < NPHASE; ++k) { p.ph_lo = k; p.ph_hi = k + 1; hipLaunchKernelGGL(mk_fwd, dim3(grid), dim3(512), LDS_BYTES, stream, p); }
#endif
}
```

```cpp
#include <hip/hip_runtime.h>
#include <cstdio>
#include <cstdint>
#include <cstring>
__device__ __forceinline__ int tidx() { int t = threadIdx.x; asm volatile("" : "+v"(t)); return t; }
typedef __bf16 mk_bf16x2_t __attribute__((ext_vector_type(2)));
typedef float mk_f32x2_t __attribute__((ext_vector_type(2)));
__device__ __forceinline__ unsigned cvtpk(float lo, float hi) { const mk_f32x2_t v = {lo, hi}; return __builtin_bit_cast(unsigned, __builtin_convertvector(v, mk_bf16x2_t)); }
namespace pg8 {
#define PG8_LAS __attribute__((address_space(3)))
typedef unsigned short bf16_t;
typedef short bf16x8 __attribute__((ext_vector_type(8)));
typedef float f32x4 __attribute__((ext_vector_type(4)));
typedef unsigned u32x4 __attribute__((ext_vector_type(4)));
constexpr int BM = 256, BK = 64, HALF = 128, HTB = HALF * BK * 2  , STAGE_BYTES = 8 * HTB, NXCD = 8, WGM = 8;

__host__ __device__ __forceinline__ int lds_byte(int r, int c) { const int st = (r >> 4) * 2 + (c >> 5), rr = r & 15, cc = c & 31, ob = rr * 64 + cc * 2; return st * 1024 + (ob ^ (((ob >> 9) & 1) << 5)); }
__host__ __device__ __forceinline__ void stage_rc(int b, int& R, int& C) { const int st = b / 1024, sb = b % 1024, swz = sb ^ (((sb >> 9) & 1) << 5); R = (st >> 1) * 16 + swz / 64; C = (st & 1) * 32 + (swz % 64) / 2; }
__host__ __device__ __forceinline__ int perm32(int rho) { const int n = rho >> 4, i = rho & 15; return 8 * (i >> 2) + 4 * n + (i & 3); }

struct Unit { int pm, pn, k0, nt, role, pair; };
struct Gemm { const bf16_t* A; const bf16_t* Bt; int M, N, K; };

struct StaticOrder {
    int nM, nN, nwg, G, c, split_round, split_nt; f32x4* part; unsigned* flags;
    __host__ __device__ void init(int M, int N, int G_, int c_) { nM = M / BM; nN = N / BM; nwg = nM * nN; G = G_; c = c_; split_round = -1; split_nt = 0; part = nullptr; flags = nullptr; }
    __host__ __device__ void set_split(int round, int K, f32x4* part_, unsigned* flags_) { split_round = round; split_nt = K / BK / 2; part = part_; flags = flags_; }
    __host__ __device__ bool next(int i, Unit& u) const {
        const bool sp = i == split_round; if (split_round >= 0 && i > split_round) return false;
        const int hc = sp ? c % (G / 2) : c, kh = sp ? c / (G / 2) : 0;
        const long L = (long)i * G + hc; if (L >= nwg) return false;
        u.k0 = kh * split_nt; u.nt = sp ? split_nt : 0; u.role = sp ? 1 + kh : 0; u.pair = hc;
        int wgid = (int)L; { const int q = nwg / NXCD, r = nwg % NXCD, xcd = wgid % NXCD, off = wgid / NXCD; wgid = (xcd < r ? xcd * (q + 1) : r * (q + 1) + (xcd - r) * q) + off; }
        const int nig = WGM * nN, gid = wgid / nig, fm = gid * WGM, gsz = (nM - fm) < WGM ? (nM - fm) : WGM;
        u.pm = fm + ((wgid % nig) % gsz); u.pn = (wgid % nig) / gsz; return true;
    }
    __device__ __forceinline__ void dump(const f32x4 (&acc)[2][2][4][2], const Unit& u, int wid, int lane) const {
        float* dst = (float*)part + ((size_t)(u.pair * 8 + wid) * 128) * 64 + lane;
#pragma unroll
        for (int a = 0; a < 2; ++a)
#pragma unroll
            for (int b = 0; b < 2; ++b)
#pragma unroll
                for (int m = 0; m < 4; ++m)
#pragma unroll
                    for (int n = 0; n < 2; ++n)
#pragma unroll
                        for (int e = 0; e < 4; ++e) __hip_atomic_store(dst + ((((a * 2 + b) * 4 + m) * 2 + n) * 4 + e) * 64, acc[a][b][m][n][e], __ATOMIC_RELAXED, __HIP_MEMORY_SCOPE_AGENT);
        __builtin_amdgcn_fence(__ATOMIC_RELEASE, "workgroup");
        if (lane == 0) __hip_atomic_fetch_add(flags + u.pair, 1u, __ATOMIC_RELAXED, __HIP_MEMORY_SCOPE_AGENT);
    }
    __device__ __forceinline__ void fetch_add(f32x4 (&acc)[2][2][4][2], const Unit& u, int wid, int lane) const {
        while (__hip_atomic_load(flags + u.pair, __ATOMIC_RELAXED, __HIP_MEMORY_SCOPE_AGENT) < 8u) __builtin_amdgcn_s_sleep(2);
        __builtin_amdgcn_fence(__ATOMIC_ACQUIRE, "workgroup");
        const float* src = (const float*)part + ((size_t)(u.pair * 8 + wid) * 128) * 64 + lane;
#pragma unroll
        for (int a = 0; a < 2; ++a)
#pragma unroll
            for (int b = 0; b < 2; ++b)
#pragma unroll
                for (int m = 0; m < 4; ++m)
#pragma unroll
                    for (int n = 0; n < 2; ++n)
#pragma unroll
                        for (int e = 0; e < 4; ++e) acc[a][b][m][n][e] += __hip_atomic_load(src + ((((a * 2 + b) * 4 + m) * 2 + n) * 4 + e) * 64, __ATOMIC_RELAXED, __HIP_MEMORY_SCOPE_AGENT);
    }
    __device__ __forceinline__ void a_ready(const Unit&) const {}
    __device__ __forceinline__ void done(const Unit&) const {}
};
__device__ __forceinline__ unsigned cvt_pk_bf16(float lo, float hi) { unsigned r; asm volatile("v_cvt_pk_bf16_f32 %0, %1, %2" : "=v"(r) : "v"(lo), "v"(hi)); return r; }
template <class Epi, class Sched, bool STAMP = false>
__device__ __forceinline__ void gemm_phase(PG8_LAS unsigned char* lds, const Gemm g, const Sched& S, const Epi& E, unsigned long long* stamps) {
    const int tid = tidx(), wid = __builtin_amdgcn_readfirstlane(tid >> 6), lane = tid & 63, wr = wid >> 2, wc = wid & 3, fr = lane & 15, fq = lane >> 4;
    const int K = g.K, nt = K / BK;
    int ts_lo = 0, ts_hi = 0, nts = 0; const unsigned long long rt_entry = STAMP ? (unsigned long long)wall_clock64() : 0ull;
#define PG8_STAMP() do { if (STAMP && wid == 0 && nts < 64) { const unsigned long long _c = (unsigned long long)clock64(); \
        ts_lo = (lane == nts) ? (int)(unsigned)_c : ts_lo; ts_hi = (lane == nts) ? (int)(unsigned)(_c >> 32) : ts_hi; ++nts; } } while (0)
    PG8_STAMP();
    unsigned voffA[2], voffB[2];
#pragma unroll
    for (int i = 0; i < 2; ++i) { int R, C; stage_rc(tid * 16 + i * 8192, R, C); const int Rb = Epi::PERM ? ((R & ~31) + perm32(R & 31)) : R;
        voffA[i] = (unsigned)(R * K + C) * 2u; voffB[i] = (unsigned)(Rb * K + C) * 2u; }
    const size_t kstep = (size_t)(BK * 2);
    const size_t hstep = (size_t)HALF * K * 2;
    const size_t tstep = 2 * hstep;
    const unsigned ldsw = (unsigned)wid * 1024u;
    const int aoff = lds_byte(wr * 64 + fr, fq * 8), boff = lds_byte(wc * 32 + fr, fq * 8);
#define PG8_SA(b, h) (((b) * 2 + (h)) * HTB)
#define PG8_SB(b, h) ((4 + (b) * 2 + (h)) * HTB)
#define PG8_STAGE(bufoff, gbase, voff) do { _Pragma("unroll") for (int _i = 0; _i < 2; ++_i) \
        __builtin_amdgcn_global_load_lds((const unsigned*)((const char*)(gbase) + (voff)[_i]), (PG8_LAS unsigned*)(lds + (bufoff) + ldsw + _i * 8192), 16, 0, 0); } while (0)
#define PG8_LDA(dst, b, h) do { _Pragma("unroll") for (int m = 0; m < 4; ++m) _Pragma("unroll") for (int k = 0; k < 2; ++k) dst[m][k] = *(const PG8_LAS bf16x8*)(lds + PG8_SA(b, h) + aoff + m * 2048 + k * 1024); } while (0)
#define PG8_LDB(dst, b, h) do { _Pragma("unroll") for (int n = 0; n < 2; ++n) _Pragma("unroll") for (int k = 0; k < 2; ++k) dst[n][k] = *(const PG8_LAS bf16x8*)(lds + PG8_SB(b, h) + boff + n * 2048 + k * 1024); } while (0)
#define PG8_MMA(ai, bj, At, Bt) do { __builtin_amdgcn_s_setprio(1); _Pragma("unroll") for (int m = 0; m < 4; ++m) _Pragma("unroll") for (int n = 0; n < 2; ++n) _Pragma("unroll") for (int k = 0; k < 2; ++k) \
        acc[ai][bj][m][n] = __builtin_amdgcn_mfma_f32_16x16x32_bf16(Bt[n][k], At[m][k], acc[ai][bj][m][n], 0, 0, 0); __builtin_amdgcn_s_setprio(0); } while (0)
#define PG8_WAIT_V(n) asm volatile("s_waitcnt vmcnt(" #n ")" ::: "memory")
#define PG8_WAIT_L(n) asm volatile("s_waitcnt lgkmcnt(" #n ")" ::: "memory")
#define PG8_BAR __builtin_amdgcn_s_barrier()
#define PG8_SCHED __builtin_amdgcn_sched_barrier(0)
    Unit cur, nxt; int ui = 0;
    if (!S.next(0, cur)) return;
    f32x4 acc[2][2][4][2];
#pragma unroll
    for (int a = 0; a < 2; ++a)
#pragma unroll
        for (int b = 0; b < 2; ++b)
#pragma unroll
            for (int m = 0; m < 4; ++m)
#pragma unroll
                for (int n = 0; n < 2; ++n) acc[a][b][m][n] = (f32x4){0.f, 0.f, 0.f, 0.f};
    bf16x8 At[4][2], B0[2][2], B1[2][2];
    const char* cA = (const char*)g.A + (size_t)cur.pm * tstep + (size_t)cur.k0 * kstep; const char* cB = (const char*)g.Bt + (size_t)cur.pn * tstep + (size_t)cur.k0 * kstep;
    S.a_ready(cur);
    PG8_STAGE(PG8_SB(0, 0), cB, voffB); PG8_STAGE(PG8_SA(0, 0), cA, voffA); PG8_STAGE(PG8_SB(0, 1), cB + hstep, voffB); PG8_STAGE(PG8_SA(0, 1), cA + hstep, voffA);
    if (wr == 1) PG8_BAR;
    PG8_WAIT_V(4); PG8_BAR;
    PG8_STAGE(PG8_SB(1, 0), cB + kstep, voffB); PG8_STAGE(PG8_SA(1, 0), cA + kstep, voffA); PG8_STAGE(PG8_SB(1, 1), cB + hstep + kstep, voffB);
    PG8_WAIT_V(6); PG8_BAR;
    PG8_STAMP();
    for (;;) {
        const bool has_next = S.next(ui + 1, nxt);
        const char* nA = has_next ? (const char*)g.A + (size_t)nxt.pm * tstep + (size_t)nxt.k0 * kstep : cA; const char* nB = has_next ? (const char*)g.Bt + (size_t)nxt.pn * tstep + (size_t)nxt.k0 * kstep : cB;
        const int cnt = cur.nt ? cur.nt : nt;
        for (int t = 0; t < cnt; t += 2) {
            const bool last = (t == cnt - 2);
            const char* a1 = cA + (size_t)(t + 1) * kstep;
            const char* a2 = last ? nA : cA + (size_t)(t + 2) * kstep; const char* b2 = last ? nB : cB + (size_t)(t + 2) * kstep;
            const char* a3 = a2 + kstep; const char* b3 = b2 + kstep;
            if (last && has_next) S.a_ready(nxt);
            PG8_LDB(B0, 0, 0); PG8_SCHED; PG8_LDA(At, 0, 0); PG8_STAGE(PG8_SA(1, 1), a1 + hstep, voffA);
            PG8_WAIT_L(8); PG8_BAR; PG8_WAIT_L(0); PG8_MMA(0, 0, At, B0); PG8_BAR; PG8_SCHED;
            PG8_LDB(B1, 0, 1); PG8_STAGE(PG8_SB(0, 0), b2, voffB);
            PG8_BAR; PG8_WAIT_L(0); PG8_MMA(0, 1, At, B1); PG8_BAR;
            PG8_LDA(At, 0, 1); PG8_STAGE(PG8_SA(0, 0), a2, voffA);
            PG8_BAR; PG8_WAIT_L(0); PG8_MMA(1, 0, At, B0); PG8_BAR; PG8_SCHED;
            PG8_STAGE(PG8_SB(0, 1), b2 + hstep, voffB);
            PG8_WAIT_V(6); PG8_BAR; PG8_MMA(1, 1, At, B1); PG8_BAR;
            PG8_LDB(B0, 1, 0); PG8_SCHED; PG8_LDA(At, 1, 0); PG8_STAGE(PG8_SA(0, 1), a2 + hstep, voffA);
            PG8_WAIT_L(8); PG8_BAR; PG8_WAIT_L(0); PG8_MMA(0, 0, At, B0); PG8_BAR; PG8_SCHED;
            PG8_LDB(B1, 1, 1); PG8_STAGE(PG8_SB(1, 0), b3, voffB);
            PG8_BAR; PG8_WAIT_L(0); PG8_MMA(0, 1, At, B1); PG8_BAR;
            PG8_LDA(At, 1, 1); PG8_STAGE(PG8_SA(1, 0), a3, voffA);
            PG8_BAR; PG8_WAIT_L(0); PG8_MMA(1, 0, At, B0); PG8_BAR; PG8_SCHED;
            PG8_STAGE(PG8_SB(1, 1), b3 + hstep, voffB);
            PG8_WAIT_V(6); PG8_BAR; PG8_MMA(1, 1, At, B1); PG8_BAR;
        }
        PG8_STAMP();
        if constexpr (!Epi::AFTER_DRAIN) { if (cur.role == 2) S.dump(acc, cur, wid, lane); else { if (cur.role == 1) S.fetch_add(acc, cur, wid, lane); E(acc, cur, wr, wc, fr, fq); } S.done(cur); }
        PG8_STAMP();
        if (!has_next) break;
#pragma unroll
        for (int a = 0; a < 2; ++a)
#pragma unroll
            for (int b = 0; b < 2; ++b)
#pragma unroll
                for (int m = 0; m < 4; ++m)
#pragma unroll
                    for (int n = 0; n < 2; ++n) acc[a][b][m][n] = (f32x4){0.f, 0.f, 0.f, 0.f};
        cur = nxt; cA = nA; cB = nB; ++ui;
    }
    PG8_WAIT_V(0);
    if (wr == 0) PG8_BAR;
    PG8_BAR;
    if constexpr (Epi::AFTER_DRAIN) { E.fused(acc, cur, wr, wc, fr, fq, lds, wid, lane); S.done(cur); }
    PG8_STAMP();
    if (STAMP && wid == 0) { stamps[lane] = lane < nts ? (((unsigned long long)(unsigned)ts_hi << 32) | (unsigned)ts_lo) : 0ull;
        if (lane == 62) stamps[62] = rt_entry; if (lane == 63) stamps[63] = (unsigned long long)wall_clock64(); }
#undef PG8_STAMP
#undef PG8_SA
#undef PG8_SB
#undef PG8_STAGE
#undef PG8_LDA
#undef PG8_LDB
#undef PG8_MMA
#undef PG8_WAIT_V
#undef PG8_WAIT_L
#undef PG8_BAR
#undef PG8_SCHED
}
}

#define XB_TMO      128
#define XB_XCNT(j)  (256  + 64 * (j))
#define XB_XSUB(j)  (1280 + 64 * (j))
#define XB_XGEN(j)  (2304 + 64 * (j))
#define XB_TOP      3328
#define XB_TOPGEN   3392
#define XCD_BAR_WORDS 3456
#define XB_SPIN_CAP (1u << 18)
#define LAS __attribute__((address_space(3)))

__device__ __forceinline__ unsigned xb_ld(unsigned* p)              { return __hip_atomic_load(p, __ATOMIC_RELAXED, __HIP_MEMORY_SCOPE_AGENT); }
__device__ __forceinline__ unsigned xb_add(unsigned* p, unsigned v) { return __hip_atomic_fetch_add(p, v, __ATOMIC_RELAXED, __HIP_MEMORY_SCOPE_AGENT); }
__device__ __forceinline__ unsigned xb_xcc_id() { return (unsigned)__builtin_amdgcn_s_getreg((3 << 11) | 20) & 0xFu; }
#define XB_SPIN(cond, bar) do { unsigned _sp = 0; while (cond) { __builtin_amdgcn_s_sleep(1); \
    if ((++_sp & 255u) == 0u) { if (xb_ld(&(bar)[XB_TMO])) break; if (_sp > XB_SPIN_CAP) { atomicAdd(&(bar)[XB_TMO], 1u); break; } } } } while (0)

struct XcdBarrier {
    unsigned* bar; unsigned x;
    volatile LAS unsigned* st;
};

__device__ __forceinline__ XcdBarrier xcd_barrier_post(unsigned* bar, volatile LAS unsigned* st) {
    XcdBarrier b; b.bar = bar; b.x = xb_xcc_id(); b.st = st;
    if (threadIdx.x == 0) (void)xb_add(&bar[XB_XCNT(b.x)], 1u);
    return b;
}
__device__ __forceinline__ void xcd_barrier_complete(unsigned* bar, unsigned x, unsigned& nloc, unsigned& nx) {
    const unsigned G = gridDim.x * gridDim.y * gridDim.z;
    unsigned sum, cnt, mine, sp = 0u;
    for (;;) {
        sum = 0u; cnt = 0u; mine = 0u;
#pragma unroll
        for (unsigned j = 0; j < 16; ++j) { const unsigned c = xb_ld(&bar[XB_XCNT(j)]); sum += c; cnt += (c > 0u) ? 1u : 0u; mine = (j == x) ? c : mine; }
        if (sum == G) break;
        __builtin_amdgcn_s_sleep(1);
        if ((++sp & 255u) == 0u) { if (xb_ld(&bar[XB_TMO])) break; if (sp > XB_SPIN_CAP) { atomicAdd(&bar[XB_TMO], 1u); break; } }
    }
    nloc = mine > 0u ? mine : 1u; nx = cnt > 0u ? cnt : 1u;
}

__device__ __forceinline__ void xcd_barrier(const XcdBarrier& b) {
    asm volatile("s_waitcnt vmcnt(0)" ::: "memory");
    __syncthreads();
    if (threadIdx.x == 0) {
        unsigned* bar = b.bar;
        __builtin_amdgcn_s_waitcnt(0);
        unsigned nloc = b.st[0], nx = b.st[1];
        if (nloc == 0u) { xcd_barrier_complete(bar, b.x, nloc, nx); b.st[0] = nloc; b.st[1] = nx; }
        const unsigned old = xb_add(&bar[XB_XSUB(b.x)], 1u);
        const unsigned gen = old / nloc;
        if (old + 1u == (gen + 1u) * nloc) {
            __builtin_amdgcn_fence(__ATOMIC_RELEASE, "agent");
            asm volatile("s_waitcnt vmcnt(0)" ::: "memory");
            const unsigned og = xb_add(&bar[XB_TOP], 1u);
            const unsigned tg = og / nx;
            if (og + 1u == (tg + 1u) * nx) xb_add(&bar[XB_TOPGEN], 1u);
            else XB_SPIN(xb_ld(&bar[XB_TOPGEN]) == tg, bar);
            __builtin_amdgcn_fence(__ATOMIC_ACQUIRE, "agent");
            xb_add(&bar[XB_XGEN(b.x)], 1u);
            asm volatile("s_waitcnt vmcnt(0)" ::: "memory");
        } else {
            XB_SPIN(xb_ld(&bar[XB_XGEN(b.x)]) == gen, bar);
            __builtin_amdgcn_fence(__ATOMIC_ACQUIRE, "agent");
            asm volatile("s_waitcnt vmcnt(0)" ::: "memory");
        }
    }
    __syncthreads();
}

using pg8::bf16_t; using pg8::f32x4; using pg8::u32x4; using pg8::Unit; using pg8::cvt_pk_bf16;
typedef unsigned u32x2 __attribute__((ext_vector_type(2)));

constexpr int DM = 2048, MTOK = 20480, NCTXR = 4096;
constexpr int LDS_BYTES = 163840;
constexpr int LDS_BAR_OFF = 163824;

enum { I_XP = 0, I_XS, I_S5RE, I_S5IM, I_SGLA, I_SRWKV, I_C, I_CCTX, I_NORMW, I_ADAW, I_ADAB, I_FNW, I_EWIN, I_EWOUT, I_LRE, I_LIM, I_LSTEP, I_BRE, I_BIM, I_CRE, I_CIM,
       I_S5D, I_GLUW, I_GLUB, I_DECUP, I_DECB, I_GNW, I_OWIN, I_OWOUT, I_MU, I_W0, I_W2, I_A0, I_A2, I_KK, I_KA, I_RK, I_LNXW, I_LNXB, N_IN };

struct Params { const float* in[N_IN]; float* out; unsigned char* ws; int ph_lo, ph_hi; };
typedef const float* cfptr_t;
__device__ __forceinline__ const float* pin(const Params&, int i) { int z; asm volatile("s_mov_b32 %0, 0" : "=s"(z));
    const __attribute__((address_space(4))) cfptr_t* kp = (const __attribute__((address_space(4))) cfptr_t*)__builtin_amdgcn_kernarg_segment_ptr(); return kp[i + z]; }

constexpr size_t OUT_Y = 0, OUT_S5RE = 41943040, OUT_S5IM = 42074112, OUT_GLA = 42205184, OUT_RWKV = 67371008, OUT_TOTAL = 71565312;
constexpr size_t WS_U = 0, WS_SG = 41943040, WS_Q = 83886080, WS_K = 146800640, WS_V = 209715200, WS_GG = 335544320, WS_DLR = 461373440,
                 WS_WT_E_IN = 463994880, WS_WT_E_OUT = 511180800, WS_WT_GLU = 527958016;
constexpr size_t WS_X1 = 0, WS_R = 167772160, WS_K1 = 251658240, WS_V1 = 335544320, WS_G1 = 419430400, WS_LR = 503316480, WS_WT_O_OUT = 519045120, WS_BON = 527433728;
constexpr size_t WS_SMALL = 533725184, WS_MOD = WS_SMALL, WS_POSTAB = WS_MOD + 245760, WS_BAR = WS_POSTAB + 262144, WS_W2T = WS_BAR + 16384, WS_A2T = WS_W2T + 786432, WS_END = WS_A2T + 786432;
static_assert(WS_END <= 536870912ull, "workspace map");
static_assert(WS_BON + 5242880 <= WS_SMALL, "workspace map");
constexpr size_t OY_WT_O_IN_B = 83886080;

__device__ __forceinline__ float bf2f(bf16_t b) { return __uint_as_float(((unsigned)b) << 16); }
__device__ __forceinline__ float bflo(unsigned w) { return __uint_as_float(w << 16); }
__device__ __forceinline__ float bfhi(unsigned w) { return __uint_as_float(w & 0xffff0000u); }
__device__ __forceinline__ bf16_t f2bf(float f) { return (bf16_t)(cvtpk(f, 0.f) & 0xffffu); }
__device__ __forceinline__ float sigm(float x) { return __builtin_amdgcn_rcpf(1.f + __builtin_amdgcn_exp2f(-1.4426950409f * x)); }
__device__ __forceinline__ float silu(float x) { return x * __builtin_amdgcn_rcpf(1.f + __builtin_amdgcn_exp2f(-1.4426950409f * x)); }
__device__ __forceinline__ float ftanh(float x) { return 1.f - 2.f * __builtin_amdgcn_rcpf(1.f + __builtin_amdgcn_exp2f(2.8853900818f * x)); }
__device__ __forceinline__ float wave_sum(float v) {
#pragma unroll
    for (int o = 32; o >= 1; o >>= 1) v += __shfl_xor(v, o);
    return v;
}
__device__ __forceinline__ int row_ci(int row) { return row < NCTXR ? 0 : 1 + ((row - NCTXR) >> 12); }

#define P_MOD(p)    ((float*)((p).ws + WS_MOD))
#define P_POSTAB(p) ((float*)((p).ws + WS_POSTAB))

__device__ __forceinline__ f32x4 x0_load4(const Params& p, int row, int col) {
    if (row < NCTXR) return *(const f32x4*)(pin(p, I_XP) + (size_t)row * DM + col);
    const int rr = row - NCTXR, t = rr & 4095;
    const f32x4 a = *(const f32x4*)(pin(p, I_XS) + (size_t)rr * DM + col);
    const int pos = col < 1024 ? (t >> 6) : (t & 63);
    const f32x4 e = *(const f32x4*)(P_POSTAB(p) + pos * 1024 + (col & 1023));
    return a + e;
}

__device__ __forceinline__ void transpose_tiles(const float* src, int K, int N, bf16_t* dst, int Npad, LAS float* t, int rot) {
    const int tid = tidx(), tk = K / 64, tn = Npad / 64, nwg = gridDim.x;
    for (int tile = (blockIdx.x + rot) % nwg; tile < tk * tn; tile += nwg) {
        const int kt = tile % tk, nt = tile / tk, k0 = kt * 64, n0 = nt * 64;
#pragma unroll
        for (int ps = 0; ps < 8; ++ps) { const int kk = ps * 8 + (tid >> 6), n = n0 + (tid & 63); t[kk * 65 + (tid & 63)] = (n < N) ? src[(size_t)(k0 + kk) * N + n] : 0.f; }
        __syncthreads();
        { const int nn = tid >> 3, kk0 = (tid & 7) * 8; float v[8];
#pragma unroll
          for (int i = 0; i < 8; ++i) v[i] = t[(kk0 + i) * 65 + nn];
          u32x4 o; o.x = cvtpk(v[0], v[1]); o.y = cvtpk(v[2], v[3]); o.z = cvtpk(v[4], v[5]); o.w = cvtpk(v[6], v[7]);
          *(u32x4*)(dst + (size_t)(n0 + nn) * K + k0 + kk0) = o; }
        __syncthreads();
    }
}

__device__ __forceinline__ void p0_prologue(const Params& p, LAS unsigned char* lds) {
    const int tid = tidx(), wg = blockIdx.x, nwg = gridDim.x;
    {
        LAS float* sl = (LAS float*)lds;
        LAS float* red = (LAS float*)(lds + 40960);
        if (wg < 192 || nwg < 192) {
            for (int i = tid; i < 5 * 2048; i += 512) { const int ci = i >> 11, k = i & 2047; const float c = ci == 0 ? pin(p, I_CCTX)[k] : pin(p, I_C)[(ci - 1) * 2048 + k]; sl[i] = c / (1.f + expf(-c)); }
            __syncthreads();
            for (int blk = wg; blk < 192; blk += nwg) {
                const int l = blk / 96, nb = blk % 96, col = nb * 64 + (tid & 63), kg = tid >> 6;
                const float* W = pin(p, I_ADAW) + (size_t)l * 2048 * 6144 + col;
                float acc[5] = {0.f, 0.f, 0.f, 0.f, 0.f};
#pragma unroll 8
                for (int k = kg * 256; k < kg * 256 + 256; ++k) { const float w = W[(size_t)k * 6144];
#pragma unroll
                    for (int ci = 0; ci < 5; ++ci) acc[ci] += sl[ci * 2048 + k] * w; }
#pragma unroll
                for (int ci = 0; ci < 5; ++ci) red[(kg * 5 + ci) * 64 + (tid & 63)] = acc[ci];
                __syncthreads();
                if (tid < 320) { const int ci = tid >> 6, c = tid & 63; float s = 0.f;
#pragma unroll
                    for (int k2 = 0; k2 < 8; ++k2) s += red[(k2 * 5 + ci) * 64 + c];
                    P_MOD(p)[((size_t)l * 5 + ci) * 6144 + nb * 64 + c] = s + pin(p, I_ADAB)[l * 6144 + nb * 64 + c]; }
                __syncthreads();
            }
        }
    }
    __syncthreads();
    transpose_tiles(pin(p, I_EWIN), 2048, 11296, (bf16_t*)(p.ws + WS_WT_E_IN), 11520, (LAS float*)lds, 0);
    transpose_tiles(pin(p, I_EWOUT), 4096, 2048, (bf16_t*)(p.ws + WS_WT_E_OUT), 2048, (LAS float*)lds, 128);
    transpose_tiles(pin(p, I_GLUW), 1024, 1024, (bf16_t*)(p.ws + WS_WT_GLU), 1024, (LAS float*)lds, 64);
    const int gtid = wg * 512 + tid, gth = nwg * 512;
    for (int idx = gtid; idx < 64 * 512; idx += gth) { const int pos = idx >> 9, i = idx & 511;
        const float om = (float)(1.0 / pow(10000.0, (double)i / 512.0)); const float ang = (float)pos * om;
        P_POSTAB(p)[pos * 1024 + i] = (float)sin((double)ang); P_POSTAB(p)[pos * 1024 + 512 + i] = (float)cos((double)ang); }
    { float* AB = p.out + OUT_RWKV; float* BBRE = AB + 16384; float* BBIM = BBRE + 131072;
      for (int idx = gtid; idx < 2 * 64 * 64; idx += gth) {
        const double lr = pin(p, I_LRE)[idx], li = pin(p, I_LIM)[idx], dt = exp((double)pin(p, I_LSTEP)[idx >> 6]);
        const double mag = exp(lr * dt), abr = mag * cos(li * dt), abi = mag * sin(li * dt), den = lr * lr + li * li;
        const double fr = ((abr - 1.0) * lr + abi * li) / den, fi = (abi * lr - (abr - 1.0) * li) / den;
        AB[idx * 2] = (float)abr; AB[idx * 2 + 1] = (float)abi;
        for (int h = 0; h < 16; ++h) { const double br = pin(p, I_BRE)[idx * 16 + h], bi = pin(p, I_BIM)[idx * 16 + h];
            BBRE[idx * 16 + h] = (float)(fr * br - fi * bi); BBIM[idx * 16 + h] = (float)(fr * bi + fi * br); } } }
}

__device__ __forceinline__ void p1_h0(const Params& p) {
    const int lane = tidx() & 63, gw = blockIdx.x * 8 + (tidx() >> 6), nw = gridDim.x * 8;
    bf16_t* H0 = (bf16_t*)(p.out + OUT_GLA); const float* mod = P_MOD(p); const float* nwt = pin(p, I_NORMW);
    for (int row0 = gw; row0 < MTOK; row0 += 2 * nw) {
        f32x4 x[2][8]; float ss[2] = {0.f, 0.f};
#pragma unroll
        for (int rr = 0; rr < 2; ++rr)
#pragma unroll
            for (int it = 0; it < 4; ++it) { const int col = it * 512 + lane * 8; x[rr][2 * it] = x0_load4(p, row0 + rr * nw, col); x[rr][2 * it + 1] = x0_load4(p, row0 + rr * nw, col + 4); }
#pragma unroll
        for (int rr = 0; rr < 2; ++rr) {
#pragma unroll
            for (int it = 0; it < 8; ++it)
#pragma unroll
                for (int j = 0; j < 4; ++j) ss[rr] += x[rr][it][j] * x[rr][it][j];
            ss[rr] = wave_sum(ss[rr]); }
#pragma unroll
        for (int rr = 0; rr < 2; ++rr) { const int row = row0 + rr * nw; const float rstd = rsqrtf(ss[rr] * (1.f / 2048.f) + 1e-6f);
            const float* sh = mod + (size_t)row_ci(row) * 6144; const float* sc = sh + 2048;
#pragma unroll
            for (int it = 0; it < 4; ++it) { const int col = it * 512 + lane * 8; float h[8];
#pragma unroll
                for (int q = 0; q < 2; ++q) { const f32x4 w = *(const f32x4*)(nwt + col + 4 * q), s1 = *(const f32x4*)(sc + col + 4 * q), s0 = *(const f32x4*)(sh + col + 4 * q);
#pragma unroll
                    for (int j = 0; j < 4; ++j) h[4 * q + j] = x[rr][2 * it + q][j] * rstd * w[j] * (1.f + s1[j]) + s0[j]; }
                u32x4 o; o.x = cvtpk(h[0], h[1]); o.y = cvtpk(h[2], h[3]); o.z = cvtpk(h[4], h[5]); o.w = cvtpk(h[6], h[7]);
                *(u32x4*)(H0 + (size_t)row * DM + col) = o; } }
    }
}

struct EpiProj0 {
    static constexpr bool PERM = true, AFTER_DRAIN = false;
    unsigned char* ws;
    __device__ __forceinline__ void operator()(const f32x4 (&acc)[2][2][4][2], const Unit& u, int wr, int wc, int fr, int fq) const {
        const int row0 = u.pm * 256 + wr * 64 + fr; const int colt = u.pn * 256;
        if (u.pn == 44) {
            if (wc == 0) { bf16_t* D = (bf16_t*)(ws + WS_DLR);
#pragma unroll
                for (int ai = 0; ai < 2; ++ai)
#pragma unroll
                    for (int m = 0; m < 4; ++m) { const f32x4 v0 = acc[ai][0][m][0], v1 = acc[ai][0][m][1];
                        u32x4 w; w.x = cvtpk(v0[0], v0[1]); w.y = cvtpk(v0[2], v0[3]); w.z = cvtpk(v1[0], v1[1]); w.w = cvtpk(v1[2], v1[3]);
                        *(u32x4*)(D + (size_t)(row0 + ai * 128 + m * 16) * 32 + 8 * fq) = w; } }
            return; }
        bf16_t* base; int ldc, c0;
        if (colt < 1024) { base = (bf16_t*)(ws + WS_U); ldc = 1024; c0 = colt; }
        else if (colt < 2048) { base = (bf16_t*)(ws + WS_SG); ldc = 1024; c0 = colt - 1024; }
        else if (colt < 3584) { base = (bf16_t*)(ws + WS_Q); ldc = 1536; c0 = colt - 2048; }
        else if (colt < 5120) { base = (bf16_t*)(ws + WS_K); ldc = 1536; c0 = colt - 3584; }
        else if (colt < 8192) { base = (bf16_t*)(ws + WS_V); ldc = 3072; c0 = colt - 5120; }
        else { base = (bf16_t*)(ws + WS_GG); ldc = 3072; c0 = colt - 8192; }
        const int col0 = c0 + wc * 32 + 8 * fq;
#pragma unroll
        for (int ai = 0; ai < 2; ++ai)
#pragma unroll
            for (int m = 0; m < 4; ++m) { bf16_t* rowp = base + (size_t)(row0 + ai * 128 + m * 16) * ldc + col0;
#pragma unroll
                for (int bj = 0; bj < 2; ++bj) { const f32x4 v0 = acc[ai][bj][m][0], v1 = acc[ai][bj][m][1];
                    u32x4 w; w.x = cvtpk(v0[0], v0[1]); w.y = cvtpk(v0[2], v0[3]); w.z = cvtpk(v1[0], v1[1]); w.w = cvtpk(v1[2], v1[3]);
                    *(u32x4*)(rowp + bj * 128) = w; } }
    }
};
struct EpiDlr {
    static constexpr bool PERM = true, AFTER_DRAIN = false;
    unsigned char* ws;
    __device__ __forceinline__ void operator()(const f32x4 (&acc)[2][2][4][2], const Unit& u, int wr, int wc, int fr, int fq) const {
        const int row0 = u.pm * 256 + wr * 64 + fr;
        if (wc == 0) { bf16_t* D = (bf16_t*)(ws + WS_DLR);
#pragma unroll
            for (int ai = 0; ai < 2; ++ai)
#pragma unroll
                for (int m = 0; m < 4; ++m) { const f32x4 v0 = acc[ai][0][m][0], v1 = acc[ai][0][m][1];
                    u32x4 w; w.x = cvtpk(v0[0], v0[1]); w.y = cvtpk(v0[2], v0[3]); w.z = cvtpk(v1[0], v1[1]); w.w = cvtpk(v1[2], v1[3]);
                    *(u32x4*)(D + (size_t)(row0 + ai * 128 + m * 16) * 32 + 8 * fq) = w; } }
    }
};
struct EpiGlu {
    static constexpr bool PERM = true, AFTER_DRAIN = false;
    const bf16_t* GY; const bf16_t* SG; const float* glu_b; bf16_t* CAT;
    __device__ __forceinline__ void operator()(const f32x4 (&acc)[2][2][4][2], const Unit& u, int wr, int wc, int fr, int fq) const {
        const int row0 = u.pm * 256 + wr * 64 + fr, col0 = u.pn * 256 + wc * 32 + 8 * fq;
#pragma unroll
        for (int ai = 0; ai < 2; ++ai)
#pragma unroll
            for (int m = 0; m < 4; ++m) { const size_t row = (size_t)(row0 + ai * 128 + m * 16);
#pragma unroll
                for (int bj = 0; bj < 2; ++bj) { const int col = col0 + bj * 128;
                    const u32x4 g4 = *(const u32x4*)(GY + row * 1024 + col), s4 = *(const u32x4*)(SG + row * 1024 + col);
                    const f32x4 b0 = *(const f32x4*)(glu_b + col), b1 = *(const f32x4*)(glu_b + col + 4);
                    float o[8];
#pragma unroll
                    for (int j = 0; j < 4; ++j) { const float gy0 = (j & 1) ? bfhi(g4[j >> 1]) : bflo(g4[j >> 1]), sg0 = (j & 1) ? bfhi(s4[j >> 1]) : bflo(s4[j >> 1]);
                        const float gy1 = (j & 1) ? bfhi(g4[2 + (j >> 1)]) : bflo(g4[2 + (j >> 1)]), sg1 = (j & 1) ? bfhi(s4[2 + (j >> 1)]) : bflo(s4[2 + (j >> 1)]);
                        o[j] = gy0 * sigm(acc[ai][bj][m][0][j] + b0[j]) * silu(sg0); o[4 + j] = gy1 * sigm(acc[ai][bj][m][1][j] + b1[j]) * silu(sg1); }
                    u32x4 w; w.x = cvtpk(o[0], o[1]); w.y = cvtpk(o[2], o[3]); w.z = cvtpk(o[4], o[5]); w.w = cvtpk(o[6], o[7]);
                    *(u32x4*)(CAT + row * 4096 + col) = w; } }
    }
};
struct EpiRes {
    static constexpr bool PERM = false, AFTER_DRAIN = false;
    const float* xp; const float* xsm; const float* postab; const float* gatebase; const float* X1; int layer; float* xout;
    __device__ __forceinline__ void operator()(const f32x4 (&acc)[2][2][4][2], const Unit& u, int wr, int wc, int fr, int fq) const {
        const int row0 = u.pm * 256 + wr * 64 + fr, col0 = u.pn * 256 + wc * 32 + 4 * fq;
#pragma unroll
        for (int ai = 0; ai < 2; ++ai)
#pragma unroll
            for (int m = 0; m < 4; ++m) { const int row = row0 + ai * 128 + m * 16; const float* gate = gatebase + (size_t)row_ci(row) * 6144;
#pragma unroll
                for (int bj = 0; bj < 2; ++bj)
#pragma unroll
                    for (int n = 0; n < 2; ++n) { const int col = col0 + bj * 128 + n * 16;
                        f32x4 xi;
                        if (layer == 0) { if (row < NCTXR) xi = *(const f32x4*)(xp + (size_t)row * DM + col);
                            else { const int rr = row - NCTXR, t = rr & 4095, pos = col < 1024 ? (t >> 6) : (t & 63); xi = *(const f32x4*)(xsm + (size_t)rr * DM + col) + *(const f32x4*)(postab + pos * 1024 + (col & 1023)); } }
                        else xi = *(const f32x4*)(X1 + (size_t)row * DM + col);
                        const f32x4 g = *(const f32x4*)(gate + col);
                        *(f32x4*)(xout + (size_t)row * DM + col) = xi + g * acc[ai][bj][m][n]; } }
    }
};
struct EpiProj1 {
    static constexpr bool PERM = true, AFTER_DRAIN = false;
    unsigned char* ws;
    __device__ __forceinline__ void operator()(const f32x4 (&acc)[2][2][4][2], const Unit& u, int wr, int wc, int fr, int fq) const {
        const int row0 = u.pm * 256 + wr * 64 + fr;
        if (u.pn >= 32) { bf16_t* LR = (bf16_t*)(ws + WS_LR); const int cbase = (u.pn - 32) * 256 + wc * 32 + 8 * fq;
#pragma unroll
            for (int ai = 0; ai < 2; ++ai)
#pragma unroll
                for (int m = 0; m < 4; ++m) { const size_t row = (size_t)(row0 + ai * 128 + m * 16);
#pragma unroll
                    for (int bj = 0; bj < 2; ++bj) { const int col = cbase + bj * 128; if (col < 384) { f32x4 v0 = acc[ai][bj][m][0], v1 = acc[ai][bj][m][1];
                        if (col < 192) {
#pragma unroll
                            for (int j = 0; j < 4; ++j) { v0[j] = ftanh(v0[j]); v1[j] = ftanh(v1[j]); } }
                        u32x4 w; w.x = cvtpk(v0[0], v0[1]); w.y = cvtpk(v0[2], v0[3]); w.z = cvtpk(v1[0], v1[1]); w.w = cvtpk(v1[2], v1[3]);
                        *(u32x4*)(LR + row * 384 + col) = w; } } }
            return; }
        bf16_t* base = (bf16_t*)(ws + WS_R + (size_t)(u.pn >> 3) * 83886080ull); const int col0 = (u.pn & 7) * 256 + wc * 32 + 8 * fq;
#pragma unroll
        for (int ai = 0; ai < 2; ++ai)
#pragma unroll
            for (int m = 0; m < 4; ++m) { bf16_t* rowp = base + (size_t)(row0 + ai * 128 + m * 16) * DM + col0;
#pragma unroll
                for (int bj = 0; bj < 2; ++bj) { const f32x4 v0 = acc[ai][bj][m][0], v1 = acc[ai][bj][m][1];
                    u32x4 w; w.x = cvtpk(v0[0], v0[1]); w.y = cvtpk(v0[2], v0[3]); w.z = cvtpk(v1[0], v1[1]); w.w = cvtpk(v1[2], v1[3]);
                    *(u32x4*)(rowp + bj * 128) = w; } }
    }
};

__device__ __forceinline__ void seq_info(int s, int& base, int& L, int& b, bool& lat) { lat = s >= 16; b = lat ? s - 16 : s; base = lat ? NCTXR + b * 4096 : b * 256; L = lat ? 4096 : 256; }

constexpr int S5_LC = 256;
constexpr size_t S5_E_OFF = OUT_RWKV + 524288;
template <bool OUTPUT>
__device__ __forceinline__ void s5_chunk_item(const Params& p, int s, int g, int dir, int j) {
    const int lane = tidx() & 63; int base, L, b; bool lat; seq_info(s, base, L, b, lat);
    const float* AB = p.out + OUT_RWKV; const float* BBRE = AB + 16384; const float* BBIM = BBRE + 131072;
    const bf16_t* U = (const bf16_t*)(p.ws + WS_U); float* Y5 = p.out + OUT_Y + (size_t)dir * MTOK * 1024;
    const int sidx = (dir * 64 + g) * 64 + lane;
    const float ar = AB[sidx * 2], ai = AB[sidx * 2 + 1];
    float bbr[16], bbi[16], cr[16], cim[16];
    const float* cre = pin(p, I_CRE); const float* cimp = pin(p, I_CIM);
#pragma unroll
    for (int h = 0; h < 16; ++h) { bbr[h] = BBRE[sidx * 16 + h]; bbi[h] = BBIM[sidx * 16 + h]; if (OUTPUT) { cr[h] = cre[((dir * 64 + g) * 16 + h) * 64 + lane]; cim[h] = cimp[((dir * 64 + g) * 16 + h) * 64 + lane]; } }
    float hr = 0.f, hi = 0.f;
    float* E = p.out + S5_E_OFF + (size_t)(((b * 2 + dir) * 64 + g) * 16) * 128;
    if (OUTPUT && lat) {
        hr = pin(p, I_S5RE)[((b * 2 + dir) * 64 + g) * 64 + lane]; hi = pin(p, I_S5IM)[((b * 2 + dir) * 64 + g) * 64 + lane];
        float pr = ar, pi = ai;
#pragma unroll
        for (int k = 0; k < 8; ++k) { const float nr = pr * pr - pi * pi, ni = 2.f * pr * pi; pr = nr; pi = ni; }
        for (int i = 0; i < j; ++i) { const float er = E[i * 128 + lane * 2], ei = E[i * 128 + lane * 2 + 1]; const float nr = pr * hr - pi * hi + er, ni = pr * hi + pi * hr + ei; hr = nr; hi = ni; }
    }
    const int tau0 = j * S5_LC, t0 = dir ? L - 1 - tau0 : tau0, dtk = dir ? -1 : 1;
    const u32x4* up = (const u32x4*)(U + (size_t)(base + t0) * 1024 + g * 16);
    u32x4 ua = up[0], ub = up[1];
    for (int i = 0; i < S5_LC; ++i) {
        const int t = t0 + i * dtk; const size_t row = (size_t)(base + t);
        u32x4 na = ua, nb = ub;
        if (i + 1 < S5_LC) { const u32x4* np = (const u32x4*)(U + (size_t)(base + t + dtk) * 1024 + g * 16); na = np[0]; nb = np[1]; }
        float uu[16];
#pragma unroll
        for (int k = 0; k < 4; ++k) { uu[2 * k] = bflo(ua[k]); uu[2 * k + 1] = bfhi(ua[k]); uu[8 + 2 * k] = bflo(ub[k]); uu[8 + 2 * k + 1] = bfhi(ub[k]); }
        float bur = 0.f, bui = 0.f;
#pragma unroll
        for (int h = 0; h < 16; ++h) { bur += bbr[h] * uu[h]; bui += bbi[h] * uu[h]; }
        const float nr = ar * hr - ai * hi + bur, ni = ar * hi + ai * hr + bui; hr = nr; hi = ni;
        if (OUTPUT) {
            float z[16];
#pragma unroll
            for (int h = 0; h < 16; ++h) z[h] = hr * cr[h] - hi * cim[h];
            float z8[8], z4[4], z2[2], z1;
#pragma unroll
            for (int k = 0; k < 8; ++k) { const auto r = __builtin_amdgcn_permlane32_swap(__float_as_uint(z[k]), __float_as_uint(z[k + 8]), false, false); z8[k] = __uint_as_float(r[0]) + __uint_as_float(r[1]); }
#pragma unroll
            for (int k = 0; k < 4; ++k) { const auto r = __builtin_amdgcn_permlane16_swap(__float_as_uint(z8[k]), __float_as_uint(z8[k + 4]), false, false); z4[k] = __uint_as_float(r[0]) + __uint_as_float(r[1]); }
            { const bool up_ = lane & 8;
#pragma unroll
              for (int k = 0; k < 2; ++k) { const float keep = up_ ? z4[k + 2] : z4[k], send = up_ ? z4[k] : z4[k + 2];
                  z2[k] = keep + __int_as_float(__builtin_amdgcn_update_dpp(0, __float_as_int(send), 0x128, 0xf, 0xf, false)); } }
            { const bool up_ = lane & 4; const float keep = up_ ? z2[1] : z2[0], send = up_ ? z2[0] : z2[1];
              const float dn = __int_as_float(__builtin_amdgcn_update_dpp(0, __float_as_int(send), 0x104, 0xf, 0xf, false));
              const float upv = __int_as_float(__builtin_amdgcn_update_dpp(0, __float_as_int(send), 0x114, 0xf, 0xf, false));
              z1 = keep + (up_ ? upv : dn); }
            z1 += __int_as_float(__builtin_amdgcn_update_dpp(0, __float_as_int(z1), 0xB1, 0xf, 0xf, false));
            z1 += __int_as_float(__builtin_amdgcn_update_dpp(0, __float_as_int(z1), 0x4E, 0xf, 0xf, false));
            if ((lane & 3) == 0) { const int h = ((lane >> 5) & 1) * 8 + ((lane >> 4) & 1) * 4 + ((lane >> 3) & 1) * 2 + ((lane >> 2) & 1); Y5[row * 1024 + g * 16 + h] = z1; }
        }
        ua = na; ub = nb;
    }
    if (!OUTPUT) { E[j * 128 + lane * 2] = hr; E[j * 128 + lane * 2 + 1] = hi; }
    if (OUTPUT && !lat) { p.out[OUT_S5RE + ((b * 2 + dir) * 64 + g) * 64 + lane] = hr; p.out[OUT_S5IM + ((b * 2 + dir) * 64 + g) * 64 + lane] = hi; }
}
__device__ __forceinline__ void p_s5_gelu(const Params& p) {
    bf16_t* U = (bf16_t*)(p.ws + WS_U); const float* Y5F = p.out + OUT_Y; const float* Y5B = Y5F + (size_t)MTOK * 1024; const float* dsk = pin(p, I_S5D);
    const size_t n8 = (size_t)MTOK * 1024 / 8;
    for (size_t i = (size_t)blockIdx.x * 512 + tidx(); i < n8; i += (size_t)gridDim.x * 512) {
        const size_t e0 = i * 8; const int col = (int)(e0 & 1023);
        const u32x4 u4 = *(const u32x4*)(U + e0); float o[8];
#pragma unroll
        for (int q = 0; q < 2; ++q) { const f32x4 yf = *(const f32x4*)(Y5F + e0 + 4 * q), yb = *(const f32x4*)(Y5B + e0 + 4 * q), d4 = *(const f32x4*)(dsk + col + 4 * q);
#pragma unroll
            for (int j = 0; j < 4; ++j) { const unsigned w = u4[2 * q + (j >> 1)]; const float uu = (j & 1) ? bfhi(w) : bflo(w);
                const float y = d4[j] * uu + yf[j] + yb[j];
                o[4 * q + j] = y * __builtin_amdgcn_rcpf(1.f + __builtin_amdgcn_exp2f(-2.3022082f * (y + 0.044715f * y * y * y))); } }
        u32x4 w; w.x = cvtpk(o[0], o[1]); w.y = cvtpk(o[2], o[3]); w.z = cvtpk(o[4], o[5]); w.w = cvtpk(o[6], o[7]);
        *(u32x4*)(U + e0) = w;
    }
}

__device__ __forceinline__ float xs_rstd(const Params& p, int row, int lane) {
    if (row < 0 || row >= MTOK) return 0.f;
    const float* X1 = (const float*)(p.ws + WS_X1) + (size_t)row * DM; float ss = 0.f;
#pragma unroll
    for (int it = 0; it < 8; ++it) { const f32x4 x = *(const f32x4*)(X1 + it * 256 + lane * 4);
#pragma unroll
        for (int j = 0; j < 4; ++j) ss += x[j] * x[j]; }
    ss = wave_sum(ss); return rsqrtf(ss * (1.f / 2048.f) + 1e-6f);
}
__device__ __forceinline__ void xs_h16(const Params& p, int row, float rstd, int lane, int hf, float (&h)[16]) {
    if (row < 0 || row >= MTOK) {
#pragma unroll
        for (int j = 0; j < 16; ++j) h[j] = 0.f;
        return; }
    const float* X1 = (const float*)(p.ws + WS_X1) + (size_t)row * DM; const float* mod = P_MOD(p) + ((size_t)5 + row_ci(row)) * 6144; const float* nwt = pin(p, I_NORMW) + 2048;
#pragma unroll
    for (int i2 = 0; i2 < 2; ++i2)
#pragma unroll
        for (int q = 0; q < 2; ++q) { const int col = (hf * 2 + i2) * 512 + lane * 8 + 4 * q;
            const f32x4 x = *(const f32x4*)(X1 + col), w = *(const f32x4*)(nwt + col), s0 = *(const f32x4*)(mod + col), s1 = *(const f32x4*)(mod + 2048 + col);
#pragma unroll
            for (int j = 0; j < 4; ++j) h[i2 * 8 + q * 4 + j] = x[j] * rstd * w[j] * (1.f + s1[j]) + s0[j]; }
}
__device__ __forceinline__ void rwkv_tables(const Params& p);
__device__ __forceinline__ void p7_xs(const Params& p, LAS unsigned char* lds) {
    const int lane = tidx() & 63, gw = blockIdx.x * 8 + (tidx() >> 6), nw = gridDim.x * 8;
    bf16_t* XS = (bf16_t*)(p.out + OUT_Y); const float* mu = pin(p, I_MU);
    for (int item = gw; item < MTOK / 10; item += nw) {
        const int r0 = item * 10; LAS float* rs = (LAS float*)lds + (tidx() >> 6) * 16;
#pragma unroll 1
        for (int k = 0; k < 12; ++k) { const float v = xs_rstd(p, r0 - 1 + k, lane); if (lane == 0) rs[k] = v; }
#pragma unroll 1
        for (int hf = 0; hf < 2; ++hf) {
            float hp[16], hc[16], hn[16];
            xs_h16(p, r0 - 1, rs[0], lane, hf, hp); xs_h16(p, r0, rs[1], lane, hf, hc);
#pragma unroll 1
            for (int k = 0; k < 10; ++k) { const int r = r0 + k;
                const int L = r < NCTXR ? 256 : 4096, tin = r < NCTXR ? (r & 255) : ((r - NCTXR) & 4095);
                const bool first = tin == 0, last = tin == L - 1;
                xs_h16(p, r + 1, rs[k + 2], lane, hf, hn);
#pragma unroll
                for (int i2 = 0; i2 < 2; ++i2) { const int col = (hf * 2 + i2) * 512 + lane * 8; float o[8];
#pragma unroll
                    for (int q = 0; q < 2; ++q) { const f32x4 m0 = *(const f32x4*)(mu + col + 4 * q), m1 = *(const f32x4*)(mu + 2048 + col + 4 * q);
#pragma unroll
                        for (int j = 0; j < 4; ++j) { const int kk = i2 * 8 + q * 4 + j; const float c = hc[kk], pv = first ? 0.f : hp[kk], nv = last ? 0.f : hn[kk];
                            o[q * 4 + j] = c + m0[j] * (pv - c) + m1[j] * (nv - c); } }
                    u32x4 w; w.x = cvtpk(o[0], o[1]); w.y = cvtpk(o[2], o[3]); w.z = cvtpk(o[4], o[5]); w.w = cvtpk(o[6], o[7]);
                    *(u32x4*)(XS + (size_t)r * DM + col) = w; }
#pragma unroll
                for (int j = 0; j < 16; ++j) { hp[j] = hc[j]; hc[j] = hn[j]; }
            }
        }
    }
    __syncthreads();
    transpose_tiles(pin(p, I_OWIN), 2048, 8576, (bf16_t*)((unsigned char*)(p.out + OUT_Y) + OY_WT_O_IN_B), 8704, (LAS float*)lds, 0);
    transpose_tiles(pin(p, I_OWOUT), 2048, 2048, (bf16_t*)(p.ws + WS_WT_O_OUT), 2048, (LAS float*)lds, 128);
    rwkv_tables(p);
}

typedef pg8::bf16x8 bf16x8;
typedef float f32x16 __attribute__((ext_vector_type(16)));
typedef float f32x2v __attribute__((ext_vector_type(2)));
constexpr int GL_QD = 0, GL_KI = 33792, GL_KET = 67584, GL_VT = 104448, GL_ATT = 122880, GL_SEG = 132096, GL_EBL = 136192, GL_UPF = 137216, GL_BIAS = 153600, GL_END = 154624;
constexpr int GL_QS = 528, GL_KS = 144;
static_assert(GL_END <= LDS_BAR_OFF, "GLA LDS map");
constexpr int OB_SPLIT = 13653;
__device__ __forceinline__ bf16_t* ob_row(unsigned char* ws, int row) { return row < OB_SPLIT ? (bf16_t*)(ws + WS_U) + (size_t)row * 3072 : (bf16_t*)(ws + WS_WT_E_IN) + (size_t)(row - OB_SPLIT) * 3072; }

#ifndef GL_DELAY
#define GL_DELAY 0
#endif
#define GLD_BEGIN(S) unsigned long long gld_t0_##S = 0; if (GL_DELAY == S) gld_t0_##S = clock64();
#define GLD_END(S) if (GL_DELAY == S) { asm volatile("s_waitcnt lgkmcnt(0)" ::: "memory"); const unsigned long long t1_ = clock64(), d_ = t1_ - gld_t0_##S; while ((unsigned long long)clock64() - t1_ < d_) { } }
__device__ __forceinline__ void p_gla_chunk(const Params& p, LAS unsigned char* lds) {
    const int tid = tidx(), w = __builtin_amdgcn_readfirstlane(tid >> 6), l = tid & 63, n = l & 31, hh = l >> 5, g = l >> 4, c16 = l & 15, wg = blockIdx.x;
    const int mb = w & 1, np = w >> 1, d0 = 64 * np + 2 * n;
    const int arow = w & 3, acol = w >> 2;
    const bf16_t* Q = (const bf16_t*)(p.ws + WS_Q); const bf16_t* K = (const bf16_t*)(p.ws + WS_K); const bf16_t* V = (const bf16_t*)(p.ws + WS_V);
    const bf16_t* DLR = (const bf16_t*)(p.ws + WS_DLR); bf16_t* CAT = (bf16_t*)(p.out + OUT_Y);
    const float* decup = pin(p, I_DECUP); const float* decb = pin(p, I_DECB); const float* sgla = pin(p, I_SGLA);
    const int stride = wg < 192 ? 1000000 : 64;
    for (int u = wg; u < 960; u += stride) {
        int s_, h, dir, es; if (u < 192) { s_ = 16 + u / 48; const int r = u % 48; h = r >> 3; dir = (r >> 2) & 1; es = r & 3; } else { const int v = u - 192; s_ = v / 48; const int r = v % 48; h = r >> 3; dir = (r >> 2) & 1; es = r & 3; }
        int base, L, b; bool lat; seq_info(s_, base, L, b, lat);
        const int nst = L >> 6;
        { float ua[8], ub[8];
#pragma unroll
          for (int j = 0; j < 8; ++j) { const f32x2v pu = *(const f32x2v*)((const char*)decup + (unsigned)((dir * 16 + 8 * hh + j) * 1536 + h * 256 + d0) * 4u); ua[j] = pu.x; ub[j] = pu.y; }
          u32x4 a4, b4; a4.x = cvtpk(ua[0], ua[1]); a4.y = cvtpk(ua[2], ua[3]); a4.z = cvtpk(ua[4], ua[5]); a4.w = cvtpk(ua[6], ua[7]);
          b4.x = cvtpk(ub[0], ub[1]); b4.y = cvtpk(ub[2], ub[3]); b4.z = cvtpk(ub[4], ub[5]); b4.w = cvtpk(ub[6], ub[7]);
          *(LAS u32x4*)(lds + GL_UPF + tid * 32) = a4; *(LAS u32x4*)(lds + GL_UPF + tid * 32 + 16) = b4;
          if (mb == 0 && hh == 0) *(LAS f32x2v*)(lds + GL_BIAS + d0 * 4) = *(const f32x2v*)((const char*)decb + (unsigned)(dir * 1536 + h * 256 + d0) * 4u); }
        f32x4 Sacc[16];
        const unsigned sb = (unsigned)(((b * 2 + dir) * 6 + h) * 256 + 4 * g) * 512u + (unsigned)(es * 128 + 16 * w + c16);
#pragma unroll
        for (int db = 0; db < 16; ++db) Sacc[db] = (f32x4){0.f, 0.f, 0.f, 0.f};
        if (lat) {
#pragma unroll
            for (int db = 0; db < 16; ++db)
#pragma unroll
                for (int r = 0; r < 4; ++r) Sacc[db][r] = *(const float*)((const char*)sgla + (sb + (unsigned)((16 * db + r) * 512)) * 4u); }
        u32x4 pfq[4], pfk[4], pfv[2], pfd;
        const int cR = 32 * mb + 16 * ((n >> 2) & 1) + (n & 3) + 4 * (n >> 3);
#define GLA_ROW(st, c) (base + (dir ? L - 1 - ((st) * 64 + (c)) : (st) * 64 + (c)))
#define GLA_PREFETCH(st) do { \
        _Pragma("unroll") for (int i = 0; i < 4; ++i) { const int pi = tid + 512 * i, c = pi >> 5, pc = pi & 31; const unsigned off = (unsigned)GLA_ROW(st, c) * 3072u + (unsigned)(h * 512 + pc * 16); \
            pfq[i] = *(const u32x4*)((const char*)Q + off); pfk[i] = *(const u32x4*)((const char*)K + off); } \
        _Pragma("unroll") for (int i = 0; i < 2; ++i) { const int pi = tid + 512 * i, c = pi & 63, pc = pi >> 6; const unsigned off = (unsigned)GLA_ROW(st, c) * 6144u + (unsigned)(h * 1024 + es * 256 + pc * 16); \
            pfv[i] = *(const u32x4*)((const char*)V + off); } \
        { const unsigned off = (unsigned)GLA_ROW(st, cR) * 64u + (unsigned)(dir * 32 + 16 * hh); pfd = *(const u32x4*)((const char*)DLR + off); } } while (0)
        GLA_PREFETCH(0);
        __syncthreads();
        for (int st = 0; st < nst; ++st) {
            GLD_BEGIN(1)
#pragma unroll
            for (int i = 0; i < 4; ++i) { const int pi = tid + 512 * i, c = pi >> 5, pc = pi & 31; *(LAS u32x4*)(lds + GL_QD + c * GL_QS + pc * 16) = pfq[i]; *(LAS u32x4*)(lds + GL_KI + c * GL_QS + pc * 16) = pfk[i]; }
#pragma unroll
            for (int i = 0; i < 2; ++i) { const int pi = tid + 512 * i, c = pi & 63, pc = pi >> 6;
#pragma unroll
                for (int j = 0; j < 4; ++j) { const unsigned wv = pfv[i][j];
                    *(LAS bf16_t*)(lds + GL_VT + (pc * 8 + 2 * j) * GL_KS + c * 2) = (bf16_t)(wv & 0xffffu); *(LAS bf16_t*)(lds + GL_VT + (pc * 8 + 2 * j + 1) * GL_KS + c * 2) = (bf16_t)(wv >> 16); } }
            __builtin_amdgcn_sched_barrier(0);
#ifndef GL_REPS_0
#define GL_REPS_0 1
#define GL_REPS_2 1
#endif
            float bA[16], bB[16];
            for (int rep0 = 0; rep0 < GL_REPS_0; ++rep0) { const bf16x8 af = __builtin_bit_cast(bf16x8, pfd);
              const bf16x8 upA = *(const LAS bf16x8*)(lds + GL_UPF + tid * 32), upB = *(const LAS bf16x8*)(lds + GL_UPF + tid * 32 + 16);
              f32x16 zA, zB;
#pragma unroll
              for (int i = 0; i < 16; ++i) { zA[i] = 0.f; zB[i] = 0.f; }
              zA = __builtin_amdgcn_mfma_f32_32x32x16_bf16(af, upA, zA, 0, 0, 0); zB = __builtin_amdgcn_mfma_f32_32x32x16_bf16(af, upB, zB, 0, 0, 0);
              const f32x2v bi = *(const LAS f32x2v*)(lds + GL_BIAS + d0 * 4);
              float ra = 0.f, rb = 0.f;
#pragma unroll
              for (int i = 0; i < 16; ++i) {
                  const float za = zA[i] + bi.x, zb = zB[i] + bi.y;
                  const float la = fmaxf(fminf(za, 0.f) * 0.0625f - 0.04332169878f * __builtin_amdgcn_logf(1.f + __builtin_amdgcn_exp2f(-1.4426950409f * fabsf(za))), -1.f),
                              lb = fmaxf(fminf(zb, 0.f) * 0.0625f - 0.04332169878f * __builtin_amdgcn_logf(1.f + __builtin_amdgcn_exp2f(-1.4426950409f * fabsf(zb))), -1.f);
                  ra += la; rb += lb; bA[i] = ra; bB[i] = rb; }
              *(LAS f32x2v*)(lds + GL_SEG + ((2 * mb + hh) * 256 + d0) * 4) = (f32x2v){ra, rb}; }
            GLD_END(1)
            __syncthreads();
            GLD_BEGIN(2)
            if (st + 1 < nst) GLA_PREFETCH(st + 1);
            { float offA = 0.f, offB = 0.f, totA = 0.f, totB = 0.f; const int myseg = 2 * mb + hh;
#pragma unroll
              for (int sg = 0; sg < 4; ++sg) { const f32x2v t = *(LAS f32x2v*)(lds + GL_SEG + (sg * 256 + d0) * 4); if (sg < myseg) { offA += t.x; offB += t.y; } totA += t.x; totB += t.y; }
              const float eblA = __expf(totA), eblB = __expf(totB);
              if (myseg == 0) *(LAS f32x2v*)(lds + GL_EBL + d0 * 4) = (f32x2v){eblA, eblB};
              unsigned ke0[8], ke1[8];
#pragma unroll
              for (int i2 = 0; i2 < 8; ++i2) { float kea[2], keb[2];
#pragma unroll
                  for (int q = 0; q < 2; ++q) { const int i = 2 * i2 + q, c = 32 * mb + 16 * hh + i;
                      const float e1A = __expf(offA + bA[i]), e1B = __expf(offB + bB[i]); const float e2A = __builtin_amdgcn_rcpf(e1A), e2B = __builtin_amdgcn_rcpf(e1B);
                      LAS unsigned* qp = (LAS unsigned*)(lds + GL_QD + c * GL_QS + d0 * 2); LAS unsigned* kp = (LAS unsigned*)(lds + GL_KI + c * GL_QS + d0 * 2);
                      const unsigned qw = *qp, kw = *kp;
                      const float kiA = bflo(kw) * e2A, kiB = bfhi(kw) * e2B;
                      *qp = cvtpk(bflo(qw) * e1A * 0.0625f, bfhi(qw) * e1B * 0.0625f); *kp = cvtpk(kiA, kiB);
                      kea[q] = kiA * eblA; keb[q] = kiB * eblB; }
                  ke0[i2] = cvtpk(kea[0], kea[1]); ke1[i2] = cvtpk(keb[0], keb[1]); if (i2 & 1) __builtin_amdgcn_sched_barrier(0); }
              LAS u32x4* k0p = (LAS u32x4*)(lds + GL_KET + d0 * GL_KS + (32 * mb + 16 * hh) * 2); LAS u32x4* k1p = (LAS u32x4*)(lds + GL_KET + (d0 + 1) * GL_KS + (32 * mb + 16 * hh) * 2);
              k0p[0] = (u32x4){ke0[0], ke0[1], ke0[2], ke0[3]}; k0p[1] = (u32x4){ke0[4], ke0[5], ke0[6], ke0[7]};
              k1p[0] = (u32x4){ke1[0], ke1[1], ke1[2], ke1[3]}; k1p[1] = (u32x4){ke1[4], ke1[5], ke1[6], ke1[7]}; }
            GLD_END(2)
            __syncthreads();
            GLD_BEGIN(3)
            f32x4 oacc[4];
            for (int rep2 = 0; rep2 < GL_REPS_2; ++rep2) {
            { f32x4 att[2] = {(f32x4){0.f, 0.f, 0.f, 0.f}, (f32x4){0.f, 0.f, 0.f, 0.f}};
              bf16x8 aF[2], bF[2][2];
              aF[0] = *(const LAS bf16x8*)(lds + GL_QD + (16 * arow + c16) * GL_QS + (8 * g) * 2);
#pragma unroll
              for (int nb = 0; nb < 2; ++nb) bF[0][nb] = *(const LAS bf16x8*)(lds + GL_KI + (32 * acol + 16 * nb + c16) * GL_QS + (8 * g) * 2);
#pragma unroll
              for (int ks = 0; ks < 8; ++ks) {
                  if (ks + 1 < 8) { aF[(ks + 1) & 1] = *(const LAS bf16x8*)(lds + GL_QD + (16 * arow + c16) * GL_QS + (32 * (ks + 1) + 8 * g) * 2);
#pragma unroll
                      for (int nb = 0; nb < 2; ++nb) bF[(ks + 1) & 1][nb] = *(const LAS bf16x8*)(lds + GL_KI + (32 * acol + 16 * nb + c16) * GL_QS + (32 * (ks + 1) + 8 * g) * 2); }
                  __builtin_amdgcn_sched_barrier(0);
#pragma unroll
                  for (int nb = 0; nb < 2; ++nb) att[nb] = __builtin_amdgcn_mfma_f32_16x16x32_bf16(aF[ks & 1], bF[ks & 1][nb], att[nb], 0, 0, 0);
                  __builtin_amdgcn_sched_barrier(0); }
#pragma unroll
              for (int nb = 0; nb < 2; ++nb)
#pragma unroll
                  for (int r = 0; r < 4; ++r) { const int c = 16 * arow + 4 * g + r, sc = 32 * acol + 16 * nb + c16;
                      *(LAS bf16_t*)(lds + GL_ATT + c * GL_KS + sc * 2) = f2bf(sc <= c ? att[nb][r] : 0.f); } }
            oacc[0] = (f32x4){0.f, 0.f, 0.f, 0.f}; oacc[1] = oacc[0]; oacc[2] = oacc[0]; oacc[3] = oacc[0];
            { u32x2 qlo[2][4], qhi[2][4];
#pragma unroll
              for (int m4 = 0; m4 < 4; ++m4) { const LAS unsigned char* qrow = lds + GL_QD + (16 * m4 + c16) * GL_QS + (4 * g) * 2; qlo[0][m4] = *(const LAS u32x2*)qrow; qhi[0][m4] = *(const LAS u32x2*)(qrow + 32); }
#pragma unroll
              for (int ks = 0; ks < 8; ++ks) {
                  if (ks + 1 < 8) {
#pragma unroll
                      for (int m4 = 0; m4 < 4; ++m4) { const LAS unsigned char* qrow = lds + GL_QD + (16 * m4 + c16) * GL_QS + (32 * (ks + 1) + 4 * g) * 2; qlo[(ks + 1) & 1][m4] = *(const LAS u32x2*)qrow; qhi[(ks + 1) & 1][m4] = *(const LAS u32x2*)(qrow + 32); } }
                  __builtin_amdgcn_sched_barrier(0);
                  u32x4 s4; s4.x = cvtpk(Sacc[2 * ks][0], Sacc[2 * ks][1]); s4.y = cvtpk(Sacc[2 * ks][2], Sacc[2 * ks][3]); s4.z = cvtpk(Sacc[2 * ks + 1][0], Sacc[2 * ks + 1][1]); s4.w = cvtpk(Sacc[2 * ks + 1][2], Sacc[2 * ks + 1][3]);
                  const bf16x8 sf = __builtin_bit_cast(bf16x8, s4);
#pragma unroll
                  for (int m4 = 0; m4 < 4; ++m4) { const u32x2 lo = qlo[ks & 1][m4], hi = qhi[ks & 1][m4];
                      oacc[m4] = __builtin_amdgcn_mfma_f32_16x16x32_bf16(sf, __builtin_bit_cast(bf16x8, (u32x4){lo.x, lo.y, hi.x, hi.y}), oacc[m4], 0, 0, 0); }
                  __builtin_amdgcn_sched_barrier(0); } }
            }
            GLD_END(3)
            __syncthreads();
            GLD_BEGIN(4)
            { bf16x8 vf[2];
#pragma unroll
              for (int ks = 0; ks < 2; ++ks) vf[ks] = *(const LAS bf16x8*)(lds + GL_VT + (16 * w + c16) * GL_KS + (32 * ks + 8 * g) * 2);
#pragma unroll
              for (int ks = 0; ks < 2; ++ks)
#pragma unroll
                  for (int m4 = 0; m4 < 4; ++m4) { const bf16x8 af = *(const LAS bf16x8*)(lds + GL_ATT + (16 * m4 + c16) * GL_KS + (32 * ks + 8 * g) * 2);
                      oacc[m4] = __builtin_amdgcn_mfma_f32_16x16x32_bf16(vf[ks], af, oacc[m4], 0, 0, 0); }
#pragma unroll
              for (int db = 0; db < 16; ++db) { const f32x4 eb = *(const LAS f32x4*)(lds + GL_EBL + (16 * db + 4 * g) * 4); Sacc[db] = Sacc[db] * eb;
#pragma unroll
                  for (int ks = 0; ks < 2; ++ks) { const bf16x8 kf = *(const LAS bf16x8*)(lds + GL_KET + (16 * db + c16) * GL_KS + (32 * ks + 8 * g) * 2);
                      Sacc[db] = __builtin_amdgcn_mfma_f32_16x16x32_bf16(kf, vf[ks], Sacc[db], 0, 0, 0); } } }
#pragma unroll
            for (int m4 = 0; m4 < 4; ++m4) { const int row = GLA_ROW(st, 16 * m4 + c16); u32x2 o2; o2.x = cvtpk(oacc[m4][0], oacc[m4][1]); o2.y = cvtpk(oacc[m4][2], oacc[m4][3]);
                bf16_t* dst = dir ? ob_row(p.ws, row) + h * 512 + es * 128 + 16 * w + 4 * g : CAT + (size_t)row * 4096 + 1024 + h * 512 + es * 128 + 16 * w + 4 * g;
                *(u32x2*)dst = o2; }
            GLD_END(4)
            __syncthreads();
        }
        if (!lat) {
#pragma unroll
            for (int db = 0; db < 16; ++db)
#pragma unroll
                for (int r = 0; r < 4; ++r) *(float*)((char*)p.out + ((unsigned)OUT_GLA + sb + (unsigned)((16 * db + r) * 512)) * 4u) = Sacc[db][r]; }
#undef GLA_PREFETCH
#undef GLA_ROW
    }
}
__device__ __forceinline__ void p_gla_norm2(const Params& p) {
    const int lane = tidx() & 63, gw = blockIdx.x * 8 + (tidx() >> 6), nw = gridDim.x * 8;
    bf16_t* CAT = (bf16_t*)(p.out + OUT_Y); const bf16_t* GG = (const bf16_t*)(p.ws + WS_GG); const float* gnw = pin(p, I_GNW);
    for (int it = gw; it < MTOK * 6; it += nw) { const int row = it / 6, h = it % 6;
        bf16_t* op = CAT + (size_t)row * 4096 + 1024 + h * 512 + lane * 8; const u32x4 o4 = *(const u32x4*)op, b4 = *(const u32x4*)(ob_row(p.ws, row) + h * 512 + lane * 8), g4 = *(const u32x4*)(GG + (size_t)row * 3072 + h * 512 + lane * 8);
        float o[8], g[8];
#pragma unroll
        for (int j = 0; j < 4; ++j) { o[2 * j] = bflo(o4[j]) + bflo(b4[j]); o[2 * j + 1] = bfhi(o4[j]) + bfhi(b4[j]); g[2 * j] = bflo(g4[j]); g[2 * j + 1] = bfhi(g4[j]); }
        float ss = 0.f;
#pragma unroll
        for (int j = 0; j < 8; ++j) ss += o[j] * o[j];
        ss = wave_sum(ss); const float rstd = rsqrtf(ss * (1.f / 512.f) + 1e-6f);
        const f32x4 w0 = *(const f32x4*)(gnw + h * 512 + lane * 8), w1 = *(const f32x4*)(gnw + h * 512 + lane * 8 + 4);
        float r[8];
#pragma unroll
        for (int j = 0; j < 8; ++j) r[j] = o[j] * rstd * (j < 4 ? w0[j] : w1[j - 4]) * silu(g[j]);
        u32x4 wv; wv.x = cvtpk(r[0], r[1]); wv.y = cvtpk(r[2], r[3]); wv.z = cvtpk(r[4], r[5]); wv.w = cvtpk(r[6], r[7]);
        *(u32x4*)op = wv;
    }
}

typedef float f32x16s __attribute__((ext_vector_type(16)));

constexpr int S5_HT_STRIDE = 528, S5_HT_BYTES = 32 * S5_HT_STRIDE;
__device__ __forceinline__ u32x2 split_pk_(float a, float b) { u32x2 r; r.x = cvtpk(a, b); r.y = cvtpk(a - bflo(r.x), b - bfhi(r.x)); return r; }
#define split_pk(a, b, hi, lo) do { const u32x2 sp_ = split_pk_((a), (b)); (hi) = sp_.x; (lo) = sp_.y; } while (0)
template <bool OUTPUT>
__device__ __forceinline__ void s5_mfma_item(const Params& p, LAS unsigned char* ht, int g, int dir, int cidx0, int cidx1) {
    const int lane = tidx() & 63, n = lane & 31, hh = lane >> 5, c16 = lane & 15, g4 = lane >> 4;
    const float* AB = p.out + OUT_RWKV; const float* BBRE = AB + 16384; const float* BBIM = BBRE + 131072;
    const bf16_t* U = (const bf16_t*)(p.ws + WS_U); float* Y5 = p.out + OUT_Y + (size_t)dir * MTOK * 1024;
    int cbase[2], cL[2], cj[2], cb[2]; bool clat[2];
#pragma unroll
    for (int c = 0; c < 2; ++c) { const int ci = c ? cidx1 : cidx0; clat[c] = ci < 64; cb[c] = clat[c] ? (ci >> 4) : ci - 64; cj[c] = clat[c] ? (ci & 15) : 0; cbase[c] = clat[c] ? NCTXR + cb[c] * 4096 : cb[c] * 256; cL[c] = clat[c] ? 4096 : 256; }
    const int sidx0 = (dir * 64 + g) * 64 + n, sidx1 = sidx0 + 32;
    const float ar0 = AB[sidx0 * 2], ai0 = AB[sidx0 * 2 + 1], ar1 = AB[sidx1 * 2], ai1 = AB[sidx1 * 2 + 1];
    bf16x8 bbf[4], bbl[4];
#pragma unroll
    for (int nb = 0; nb < 4; ++nb) { const float* src = ((nb >> 1) ? BBIM : BBRE) + ((nb & 1) ? sidx1 : sidx0) * 16 + 8 * hh; const f32x4 v0 = *(const f32x4*)src, v1 = *(const f32x4*)(src + 4);
        u32x4 w, wl; split_pk(v0[0], v0[1], w.x, wl.x); split_pk(v0[2], v0[3], w.y, wl.y); split_pk(v1[0], v1[1], w.z, wl.z); split_pk(v1[2], v1[3], w.w, wl.w);
        bbf[nb] = __builtin_bit_cast(bf16x8, w); bbl[nb] = __builtin_bit_cast(bf16x8, wl); }
    bf16x8 cmf[4], cml[4];
    if (OUTPUT) { const float* cre = pin(p, I_CRE) + ((dir * 64 + g) * 16 + c16) * 64; const float* cim = pin(p, I_CIM) + ((dir * 64 + g) * 16 + c16) * 64;
#pragma unroll
        for (int ks = 0; ks < 4; ++ks) { const int s0 = 8 * ks + 2 * g4;
            u32x4 w, wl; split_pk(cre[s0], -cim[s0], w.x, wl.x); split_pk(cre[s0 + 32], -cim[s0 + 32], w.y, wl.y); split_pk(cre[s0 + 1], -cim[s0 + 1], w.z, wl.z); split_pk(cre[s0 + 33], -cim[s0 + 33], w.w, wl.w);
            cmf[ks] = __builtin_bit_cast(bf16x8, w); cml[ks] = __builtin_bit_cast(bf16x8, wl); } }
    float hr0 = 0.f, hi0 = 0.f, hr1 = 0.f, hi1 = 0.f;
    const bool mylat = hh ? clat[1] : clat[0]; const int myb = hh ? cb[1] : cb[0], myj = hh ? cj[1] : cj[0];
    float* E = p.out + S5_E_OFF + (size_t)(((myb * 2 + dir) * 64 + g) * 16) * 128;
    if (OUTPUT && mylat) {
        const float* s5r = pin(p, I_S5RE); const float* s5i = pin(p, I_S5IM); const int hidx = ((myb * 2 + dir) * 64 + g) * 64 + n;
        hr0 = s5r[hidx]; hi0 = s5i[hidx]; hr1 = s5r[hidx + 32]; hi1 = s5i[hidx + 32];
        float pr0 = ar0, pi0 = ai0, pr1 = ar1, pi1 = ai1;
#pragma unroll
        for (int k = 0; k < 8; ++k) { const float a = pr0 * pr0 - pi0 * pi0, b2 = 2.f * pr0 * pi0; pr0 = a; pi0 = b2; const float c = pr1 * pr1 - pi1 * pi1, d = 2.f * pr1 * pi1; pr1 = c; pi1 = d; }
        for (int i = 0; i < myj; ++i) { const f32x2v e0 = *(const f32x2v*)(E + i * 128 + n * 2), e1 = *(const f32x2v*)(E + i * 128 + (n + 32) * 2);
            const float a = pr0 * hr0 - pi0 * hi0 + e0.x, b2 = pr0 * hi0 + pi0 * hr0 + e0.y; hr0 = a; hi0 = b2;
            const float c = pr1 * hr1 - pi1 * hi1 + e1.x, d = pr1 * hi1 + pi1 * hr1 + e1.y; hr1 = c; hi1 = d; }
    }
    const int ca = (n >> 2) & 1, ia = (n & 3) + 4 * (n >> 3);
    const int abase = ca ? cbase[1] : cbase[0], aL = ca ? cL[1] : cL[0], aj = ca ? cj[1] : cj[0];
#define S5_AROW(st) (abase + (dir ? aL - 1 - (aj * 256 + (st) * 16 + ia) : aj * 256 + (st) * 16 + ia))
    u32x4 anext = *(const u32x4*)(U + (size_t)S5_AROW(0) * 1024 + g * 16 + 8 * hh);
    for (int st = 0; st < 16; ++st) {
        const bf16x8 af = __builtin_bit_cast(bf16x8, anext);
        if (st + 1 < 16) anext = *(const u32x4*)(U + (size_t)S5_AROW(st + 1) * 1024 + g * 16 + 8 * hh);
        f32x16s acc[4];
#pragma unroll
        for (int nb = 0; nb < 4; ++nb) {
#pragma unroll
            for (int i = 0; i < 16; ++i) acc[nb][i] = 0.f;
            acc[nb] = __builtin_amdgcn_mfma_f32_32x32x16_bf16(af, bbf[nb], acc[nb], 0, 0, 0); acc[nb] = __builtin_amdgcn_mfma_f32_32x32x16_bf16(af, bbl[nb], acc[nb], 0, 0, 0); }
#pragma unroll
        for (int i = 0; i < 16; ++i) {
            const float a = ar0 * hr0 - ai0 * hi0 + acc[0][i], b2 = ar0 * hi0 + ai0 * hr0 + acc[2][i]; hr0 = a; hi0 = b2;
            const float c = ar1 * hr1 - ai1 * hi1 + acc[1][i], d = ar1 * hi1 + ai1 * hr1 + acc[3][i]; hr1 = c; hi1 = d;
            if (OUTPUT) { u32x2 w, wl; split_pk(hr0, hi0, w.x, wl.x); split_pk(hr1, hi1, w.y, wl.y); *(LAS u32x2*)(ht + (16 * hh + i) * S5_HT_STRIDE + n * 8) = w; *(LAS u32x2*)(ht + (16 * hh + i) * S5_HT_STRIDE + 256 + n * 8) = wl; } }
        if (OUTPUT) {
            asm volatile("s_waitcnt lgkmcnt(0)" ::: "memory");
#pragma unroll
            for (int mbk = 0; mbk < 2; ++mbk) { f32x4 y = (f32x4){0.f, 0.f, 0.f, 0.f};
#pragma unroll
                for (int ks = 0; ks < 4; ++ks) { const bf16x8 hf = *(const LAS bf16x8*)(ht + (16 * mbk + c16) * S5_HT_STRIDE + (32 * ks + 8 * g4) * 2), hl = *(const LAS bf16x8*)(ht + (16 * mbk + c16) * S5_HT_STRIDE + 256 + (32 * ks + 8 * g4) * 2);
                    y = __builtin_amdgcn_mfma_f32_16x16x32_bf16(cmf[ks], hf, y, 0, 0, 0); y = __builtin_amdgcn_mfma_f32_16x16x32_bf16(cmf[ks], hl, y, 0, 0, 0); y = __builtin_amdgcn_mfma_f32_16x16x32_bf16(cml[ks], hf, y, 0, 0, 0); }
                const int tau = cj[mbk] * 256 + st * 16 + c16, t = dir ? cL[mbk] - 1 - tau : tau;
                *(f32x4*)(Y5 + (size_t)(cbase[mbk] + t) * 1024 + g * 16 + 4 * g4) = y; }
            asm volatile("" ::: "memory"); }
    }
#undef S5_AROW
    if (!OUTPUT) { *(f32x2v*)(E + myj * 128 + n * 2) = (f32x2v){hr0, hi0}; *(f32x2v*)(E + myj * 128 + (n + 32) * 2) = (f32x2v){hr1, hi1}; }
    if (OUTPUT && !mylat) { const int o = ((myb * 2 + dir) * 64 + g) * 64 + n; p.out[OUT_S5RE + o] = hr0; p.out[OUT_S5IM + o] = hi0; p.out[OUT_S5RE + o + 32] = hr1; p.out[OUT_S5IM + o + 32] = hi1; }
}
__device__ __forceinline__ void p_s5_passA(const Params& p, LAS unsigned char* lds) {
    const int wv = tidx() >> 6, gw = blockIdx.x * 8 + wv, nw = gridDim.x * 8;
    for (int it = gw; it < 30 * 128; it += nw) { const int pi = it >> 7, dir = (it >> 6) & 1, g = it & 63; const int i0 = 2 * pi, i1 = 2 * pi + 1;
        s5_mfma_item<false>(p, lds + wv * S5_HT_BYTES, g, dir, (i0 / 15) * 16 + i0 % 15, (i1 / 15) * 16 + i1 % 15); }
}
__device__ __forceinline__ void p_s5_passC_lat(const Params& p, LAS unsigned char* lds) {
    const int wv = tidx() >> 6, gw = blockIdx.x * 8 + wv, nw = gridDim.x * 8;
    for (int it = gw; it < 32 * 128; it += nw) { const int pi = it >> 7, dir = (it >> 6) & 1, g = it & 63;
        s5_mfma_item<true>(p, lds + wv * S5_HT_BYTES, g, dir, 2 * pi, 2 * pi + 1); }
}
__device__ __forceinline__ void p_s5_passC_ctx(const Params& p) {
    const int wv = tidx() >> 6, gw = blockIdx.x * 8 + wv, nw = gridDim.x * 8;
    for (int c = gw; c < 2048; c += nw) { const int dir = c & 1, g = (c >> 1) & 63, b = c >> 7; s5_chunk_item<true>(p, b, g, dir, 0); }
}

__device__ __forceinline__ float red4(float x) {
    { const auto r = __builtin_amdgcn_permlane16_swap(__float_as_uint(x), __float_as_uint(x), false, false); x = __uint_as_float(r[0]) + __uint_as_float(r[1]); }
    { const auto r = __builtin_amdgcn_permlane32_swap(__float_as_uint(x), __float_as_uint(x), false, false); x = __uint_as_float(r[0]) + __uint_as_float(r[1]); }
    return x;
}
#define RW_DPP(n) " row_newbcast:" #n " row_mask:0xf bank_mask:0xf\n\t"
#define RW_B1_SA(n, acc) "v_fmac_f32_dpp %" #acc ", %24, %" #n RW_DPP(n)
#define RW_B1_MUL(n) "v_mul_f32_dpp %" #n ", %25, %" #n RW_DPP(n)
#define RW_B1_KD(n) "v_fmac_f32_dpp %" #n ", %26, %28" RW_DPP(n)
#define RW_B1_YT(n, acc) "v_fmac_f32_dpp %" #acc ", %27, %" #n RW_DPP(n)
__device__ __forceinline__ void rw_block1(float (&S)[16], float A, float W, float KD, float R, float vi, float& sa, float& yt) {
    float s0 = 0.f, s1 = 0.f, s2 = 0.f, s3 = 0.f, y0 = 0.f, y1 = 0.f, y2 = 0.f, y3 = 0.f;
    asm("s_nop 1\n\t"
        RW_B1_SA(0, 16) RW_B1_SA(1, 17) RW_B1_SA(2, 18) RW_B1_SA(3, 19) RW_B1_SA(4, 16) RW_B1_SA(5, 17) RW_B1_SA(6, 18) RW_B1_SA(7, 19)
        RW_B1_SA(8, 16) RW_B1_SA(9, 17) RW_B1_SA(10, 18) RW_B1_SA(11, 19) RW_B1_SA(12, 16) RW_B1_SA(13, 17) RW_B1_SA(14, 18) RW_B1_SA(15, 19)
        RW_B1_MUL(0) RW_B1_MUL(1) RW_B1_MUL(2) RW_B1_MUL(3) RW_B1_MUL(4) RW_B1_MUL(5) RW_B1_MUL(6) RW_B1_MUL(7) RW_B1_MUL(8) RW_B1_MUL(9) RW_B1_MUL(10) RW_B1_MUL(11) RW_B1_MUL(12) RW_B1_MUL(13) RW_B1_MUL(14) RW_B1_MUL(15)
        RW_B1_KD(0) RW_B1_KD(1) RW_B1_KD(2) RW_B1_KD(3) RW_B1_KD(4) RW_B1_KD(5) RW_B1_KD(6) RW_B1_KD(7) RW_B1_KD(8) RW_B1_KD(9) RW_B1_KD(10) RW_B1_KD(11) RW_B1_KD(12) RW_B1_KD(13) RW_B1_KD(14) RW_B1_KD(15)
        RW_B1_YT(0, 20) RW_B1_YT(1, 21) RW_B1_YT(2, 22) RW_B1_YT(3, 23) RW_B1_YT(4, 20) RW_B1_YT(5, 21) RW_B1_YT(6, 22) RW_B1_YT(7, 23)
        RW_B1_YT(8, 20) RW_B1_YT(9, 21) RW_B1_YT(10, 22) RW_B1_YT(11, 23) RW_B1_YT(12, 20) RW_B1_YT(13, 21) RW_B1_YT(14, 22) RW_B1_YT(15, 23)
        : "+v"(S[0]), "+v"(S[1]), "+v"(S[2]), "+v"(S[3]), "+v"(S[4]), "+v"(S[5]), "+v"(S[6]), "+v"(S[7]), "+v"(S[8]), "+v"(S[9]), "+v"(S[10]), "+v"(S[11]), "+v"(S[12]), "+v"(S[13]), "+v"(S[14]), "+v"(S[15]),
          "+v"(s0), "+v"(s1), "+v"(s2), "+v"(s3), "+v"(y0), "+v"(y1), "+v"(y2), "+v"(y3)
        : "v"(A), "v"(W), "v"(KD), "v"(R), "v"(vi));
    sa = (s0 + s1) + (s2 + s3); yt = (y0 + y1) + (y2 + y3);
}
#define RW_B2(n) "v_fmac_f32_dpp %" #n ", %16, %17" RW_DPP(n)
__device__ __forceinline__ void rw_block2(float (&S)[16], float B, float sa) {
    asm("s_nop 1\n\t"
        RW_B2(0) RW_B2(1) RW_B2(2) RW_B2(3) RW_B2(4) RW_B2(5) RW_B2(6) RW_B2(7) RW_B2(8) RW_B2(9) RW_B2(10) RW_B2(11) RW_B2(12) RW_B2(13) RW_B2(14) RW_B2(15)
        : "+v"(S[0]), "+v"(S[1]), "+v"(S[2]), "+v"(S[3]), "+v"(S[4]), "+v"(S[5]), "+v"(S[6]), "+v"(S[7]), "+v"(S[8]), "+v"(S[9]), "+v"(S[10]), "+v"(S[11]), "+v"(S[12]), "+v"(S[13]), "+v"(S[14]), "+v"(S[15])
        : "v"(B), "v"(sa));
}

constexpr int RW_W2 = 0, RW_A2 = 13312, RW_W = 26624, RW_A = 34816, RW_B = 38912, RW_KD = 43008, RW_R = 47104, RW_V = 51200, RW_YO = 55296, RW_BR = 63488, RW_CST = 63616, RW_HALF_BYTES = 64896, RW_TS = 208;
static_assert(2 * RW_HALF_BYTES <= LDS_BAR_OFF, "RWKV LDS map");
__device__ __forceinline__ void rwkv_tables(const Params& p) {
    const float* w2 = pin(p, I_W2); const float* a2 = pin(p, I_A2); bf16_t* W2T = (bf16_t*)(p.ws + WS_W2T); bf16_t* A2T = (bf16_t*)(p.ws + WS_A2T);
    for (int i = blockIdx.x * 512 + tidx(); i < 2 * 2048 * 96; i += gridDim.x * 512) { const int k = i % 96, c = (i / 96) & 2047, d = i / (96 * 2048);
        W2T[i] = f2bf(w2[(size_t)(d * 96 + k) * 2048 + c]); A2T[i] = f2bf(a2[(size_t)(d * 96 + k) * 2048 + c]); }
}
__device__ __forceinline__ void p9_rwkv(const Params& p, LAS unsigned char* lds) {
    const int tid = tidx(), half = tid >> 8, htid = tid & 255, hw = __builtin_amdgcn_readfirstlane((tid >> 6) & 3), lane = tid & 63, m = lane & 15, q = lane >> 4, wg = blockIdx.x, nwg = gridDim.x;
    LAS unsigned char* hl = lds + half * RW_HALF_BYTES;
    LAS float* AW = (LAS float*)(hl + RW_W); LAS float* YO = (LAS float*)(hl + RW_YO);
    const bf16_t* R = (const bf16_t*)(p.ws + WS_R); const bf16_t* K1 = (const bf16_t*)(p.ws + WS_K1); const bf16_t* V1 = (const bf16_t*)(p.ws + WS_V1); const bf16_t* LR = (const bf16_t*)(p.ws + WS_LR);
    const bf16_t* W2T = (const bf16_t*)(p.ws + WS_W2T); const bf16_t* A2T = (const bf16_t*)(p.ws + WS_A2T);
    float* BON = (float*)(p.ws + WS_BON); bf16_t* YD = (bf16_t*)(p.out + OUT_Y);
    const float* w0p = pin(p, I_W0); const float* a0p = pin(p, I_A0); const float* kkp = pin(p, I_KK); const float* kap = pin(p, I_KA); const float* rkp = pin(p, I_RK); const float* srw = pin(p, I_SRWKV);
    const int nun = half == 0 ? (256 - wg + nwg - 1) / nwg : (1024 - wg + nwg - 1) / nwg;
    const int bpu = half == 0 ? 128 : 8;
    const int my_steps = nun * bpu;
    const int n0 = (256 - wg + nwg - 1) / nwg * 128, n1 = (1024 - wg + nwg - 1) / nwg * 8;
    const int nsteps = n0 > n1 ? n0 : n1;
    float S[16];
    int base = 0, L = 0, b = 0, head = 0, dir = 0; bool lat = false;
    pg8::bf16x8 pftw[3], pfta[3]; u32x2 pfr[4], pfk[4], pfv[4];
#define RW_PREFETCH(bk) do { const int tau_ = (bk) * 32 + 16 * hw + m, t_ = dir ? L - 1 - tau_ : tau_; const unsigned row_ = (unsigned)(base + t_); \
        _Pragma("unroll") for (int ks = 0; ks < 3; ++ks) { pftw[ks] = *(const pg8::bf16x8*)((const char*)LR + row_ * 768u + (unsigned)(dir * 192 + (32 * ks + 8 * q) * 2)); \
            pfta[ks] = *(const pg8::bf16x8*)((const char*)LR + row_ * 768u + (unsigned)(384 + dir * 192 + (32 * ks + 8 * q) * 2)); } \
        _Pragma("unroll") for (int mb = 0; mb < 4; ++mb) { const unsigned ch_ = (unsigned)(head * 64 + 16 * mb + 4 * q); \
            pfr[mb] = *(const u32x2*)((const char*)R + (row_ * 2048u + ch_) * 2u); pfk[mb] = *(const u32x2*)((const char*)K1 + (row_ * 2048u + ch_) * 2u); pfv[mb] = *(const u32x2*)((const char*)V1 + (row_ * 2048u + ch_) * 2u); } } while (0)
    for (int step = 0; step < nsteps; ++step) {
        const bool active = step < my_steps; const int blk = step % bpu;
        if (active && blk == 0) {
            const int un = wg + (step / bpu) * nwg; int s;
            if (half == 0) { s = 16 + (un >> 6); head = (un >> 1) & 31; dir = un & 1; } else { s = un >> 6; head = (un >> 1) & 31; dir = un & 1; }
            seq_info(s, base, L, b, lat);
            for (int i = htid; i < 768; i += 256) { const int ch = i / 12, pc = i % 12; const size_t go = ((size_t)(dir * 2048 + head * 64 + ch) * 96 + pc * 8);
                *(LAS u32x4*)(hl + RW_W2 + ch * RW_TS + pc * 16) = *(const u32x4*)(W2T + go); *(LAS u32x4*)(hl + RW_A2 + ch * RW_TS + pc * 16) = *(const u32x4*)(A2T + go); }
            if (htid < 64) { LAS float* cst = (LAS float*)(hl + RW_CST); const int c = head * 64 + htid;
                cst[htid] = w0p[dir * 2048 + c]; cst[64 + htid] = a0p[dir * 2048 + c]; cst[128 + htid] = kkp[c]; cst[192 + htid] = kap[c]; cst[256 + htid] = rkp[c]; }
            if (hw < 2) RW_PREFETCH(0);
            const unsigned sb = (unsigned)((((b * 2 + dir) * 32 + head) * 64 + hw * 16 + m) * 64 + q * 16);
#pragma unroll
            for (int n = 0; n < 16; ++n) S[n] = 0.f;
            if (lat) {
#pragma unroll
                for (int n = 0; n < 16; ++n) S[n] = *(const float*)((const char*)srw + (sb + n) * 4u); }
        }
        __syncthreads();
        if (active && hw < 2) {
            const int tok = 16 * hw + m, tau = blk * 32 + tok, t = dir ? L - 1 - tau : tau; const unsigned row = (unsigned)(base + t);
            f32x4 dW[4], dA[4];
#pragma unroll
            for (int mb = 0; mb < 4; ++mb) { dW[mb] = (f32x4){0.f, 0.f, 0.f, 0.f}; dA[mb] = (f32x4){0.f, 0.f, 0.f, 0.f}; }
#pragma unroll
            for (int ks = 0; ks < 3; ++ks) {
                const pg8::bf16x8 tw = pftw[ks], ta = pfta[ks];
#pragma unroll
                for (int mb = 0; mb < 4; ++mb) { const pg8::bf16x8 wf = *(const LAS pg8::bf16x8*)(hl + RW_W2 + (16 * mb + m) * RW_TS + (32 * ks + 8 * q) * 2), af = *(const LAS pg8::bf16x8*)(hl + RW_A2 + (16 * mb + m) * RW_TS + (32 * ks + 8 * q) * 2);
                    dW[mb] = __builtin_amdgcn_mfma_f32_16x16x32_bf16(wf, tw, dW[mb], 0, 0, 0); dA[mb] = __builtin_amdgcn_mfma_f32_16x16x32_bf16(af, ta, dA[mb], 0, 0, 0); } }
            float kk[16], kd[16], av[16], ss = 0.f, bon = 0.f;
#pragma unroll
            for (int mb = 0; mb < 4; ++mb) {
                const u32x2 r2 = pfr[mb], k2 = pfk[mb], v2 = pfv[mb]; const LAS float* cst = (const LAS float*)(hl + RW_CST) + 16 * mb + 4 * q;
                const f32x4 w0 = *(const LAS f32x4*)cst, a0 = *(const LAS f32x4*)(cst + 64), kkw = *(const LAS f32x4*)(cst + 128), kaw = *(const LAS f32x4*)(cst + 192), rkw = *(const LAS f32x4*)(cst + 256);
                const float rr[4] = {bflo(r2.x), bfhi(r2.x), bflo(r2.y), bfhi(r2.y)}, k0[4] = {bflo(k2.x), bfhi(k2.x), bflo(k2.y), bfhi(k2.y)};
                f32x4 oW;
#pragma unroll
                for (int j = 0; j < 4; ++j) { const int e = 4 * mb + j;
                    const float xw = -(w0[j] + dW[mb][j]);
                    const float sp = fmaxf(xw, 0.f) + __logf(1.f + __expf(-fabsf(xw)));
                    oW[j] = __expf(-__expf(-sp - 0.5f));
                    const float a = 1.f / (1.f + __expf(-(a0[j] + dA[mb][j])));
                    kk[e] = k0[j] * kkw[j]; ss += kk[e] * kk[e]; av[e] = a;
                    kd[e] = k0[j] * (1.f + (a - 1.f) * kaw[j]); bon += rr[j] * kd[e] * rkw[j]; }
                *(LAS f32x4*)(hl + RW_W + (tok * 64 + 16 * mb + 4 * q) * 4) = oW;
                *(LAS u32x2*)(hl + RW_R + (tok * 64 + 16 * mb + 4 * q) * 2) = r2; *(LAS u32x2*)(hl + RW_V + (tok * 64 + 16 * mb + 4 * q) * 2) = v2;
                u32x2 kdp; kdp.x = cvtpk(kd[4 * mb], kd[4 * mb + 1]); kdp.y = cvtpk(kd[4 * mb + 2], kd[4 * mb + 3]); *(LAS u32x2*)(hl + RW_KD + (tok * 64 + 16 * mb + 4 * q) * 2) = kdp; }
            ss = red4(ss); bon = red4(bon);
            const float inv = 1.f / fmaxf(sqrtf(ss), 1e-12f);
            if (q == 0) BON[((size_t)dir * MTOK + row) * 32 + head] = bon;
            float br = 0.f;
#pragma unroll
            for (int mb = 0; mb < 4; ++mb) { u32x2 ap, bp; float kn[4];
#pragma unroll
                for (int j = 0; j < 4; ++j) kn[j] = kk[4 * mb + j] * inv;
                { const u32x2 r2 = *(LAS u32x2*)(hl + RW_R + (tok * 64 + 16 * mb + 4 * q) * 2); const u32x2 bq = (u32x2){cvtpk(kn[0] * av[4 * mb], kn[1] * av[4 * mb + 1]), cvtpk(kn[2] * av[4 * mb + 2], kn[3] * av[4 * mb + 3])};
                  br += bflo(bq.x) * bflo(r2.x) + bfhi(bq.x) * bfhi(r2.x) + bflo(bq.y) * bflo(r2.y) + bfhi(bq.y) * bfhi(r2.y); }
                ap.x = cvtpk(-kn[0], -kn[1]); ap.y = cvtpk(-kn[2], -kn[3]);
                bp.x = cvtpk(kn[0] * av[4 * mb], kn[1] * av[4 * mb + 1]); bp.y = cvtpk(kn[2] * av[4 * mb + 2], kn[3] * av[4 * mb + 3]);
                *(LAS u32x2*)(hl + RW_A + (tok * 64 + 16 * mb + 4 * q) * 2) = ap; *(LAS u32x2*)(hl + RW_B + (tok * 64 + 16 * mb + 4 * q) * 2) = bp; }
            br = red4(br); if (q == 0) *(LAS float*)(hl + RW_BR + tok * 4) = br;
        }
        __syncthreads();
        if (active && hw < 2 && blk + 1 < bpu) RW_PREFETCH(blk + 1);
        if (active) {
            const LAS bf16_t* LA = (const LAS bf16_t*)(hl + RW_A); const LAS bf16_t* LB = (const LAS bf16_t*)(hl + RW_B); const LAS bf16_t* LK = (const LAS bf16_t*)(hl + RW_KD);
            const LAS bf16_t* LRr = (const LAS bf16_t*)(hl + RW_R); const LAS bf16_t* LV = (const LAS bf16_t*)(hl + RW_V);
            float W = AW[lane], brt = *(LAS float*)(hl + RW_BR); unsigned A = LA[lane], B = LB[lane], KD = LK[lane], RR = LRr[lane], vi = LV[hw * 16 + m];
            for (int tau = 0; tau < 32; ++tau) {
                const int tn = tau < 31 ? tau + 1 : 31;
                const float Wn = AW[tn * 64 + lane], brn = *(LAS float*)(hl + RW_BR + tn * 4); const unsigned An = LA[tn * 64 + lane], Bn = LB[tn * 64 + lane], KDn = LK[tn * 64 + lane], RRn = LRr[tn * 64 + lane], vin = LV[tn * 64 + hw * 16 + m];
                float sa, yt;
                rw_block1(S, __uint_as_float(A << 16), W, __uint_as_float(KD << 16), __uint_as_float(RR << 16), __uint_as_float(vi << 16), sa, yt);
                sa = red4(sa);
                rw_block2(S, __uint_as_float(B << 16), sa);
                const float yp = red4(yt) + sa * brt;
                if (q == 0) YO[tau * 64 + hw * 16 + m] = yp;
                W = Wn; A = An; B = Bn; KD = KDn; RR = RRn; vi = vin; brt = brn;
            }
            if (blk == bpu - 1 && !lat) { const unsigned sb = (unsigned)((((b * 2 + dir) * 32 + head) * 64 + hw * 16 + m) * 64 + q * 16);
#pragma unroll
                for (int n = 0; n < 16; ++n) *(float*)((char*)p.out + ((unsigned)OUT_RWKV + sb + n) * 4u) = S[n]; }
        }
        __syncthreads();
        if (active) {
            const int tok = htid >> 3, c8 = (htid & 7) * 8, tau = blk * 32 + tok, t = dir ? L - 1 - tau : tau; const size_t row = (size_t)(base + t);
            const f32x4 y0 = *(LAS f32x4*)(YO + tok * 64 + c8), y1 = *(LAS f32x4*)(YO + tok * 64 + c8 + 4);
            u32x4 wv; wv.x = cvtpk(y0[0], y0[1]); wv.y = cvtpk(y0[2], y0[3]); wv.z = cvtpk(y1[0], y1[1]); wv.w = cvtpk(y1[2], y1[3]);
            *(u32x4*)(YD + (size_t)dir * MTOK * DM + row * DM + head * 64 + c8) = wv;
        }
    }
}

constexpr int RC_GL = 0, RC_MAB = 256, RC_MAK = 1536, RC_NBR = 2176, RC_NKR = 2816, RC_XT = 3456, RC_MD = 3456, RC_SSP = 3712, RC_BNP = 3968, RC_YO = 7808, RC_BH = 9856, RC_KH = 12416, RC_AT = 14976, RC_RT = 17280, RC_BT = 19584, RC_KT = 21888,
              RC_CST = 24192, RC_W = 25472, RC_A = 33664, RC_B = 37760, RC_KD = 41856, RC_R = 45952, RC_V = 50048, RC_W2 = 54144, RC_A2 = 67456, RC_HALF = 80768;
constexpr int RC_TS = 208, RC_TT = 144, RC_HS = 40, RC_MS = 80, RC_NS = 40, RC_XS = 68;
static_assert(2 * RC_HALF <= LDS_BAR_OFF, "RWKV chunk LDS map");
__device__ __forceinline__ bf16_t f2bf_rne(float f) { unsigned u = __float_as_uint(f); u += 0x7FFFu + ((u >> 16) & 1u); return (bf16_t)(u >> 16); }
__device__ __forceinline__ bf16x8 mk_frag(u32x2 lo, u32x2 hi) { return __builtin_bit_cast(bf16x8, (u32x4){lo.x, lo.y, hi.x, hi.y}); }

__device__ __forceinline__ int rw_sw(int tok, int ch) { return tok * 64 + ((((ch >> 2) ^ (tok & 15)) << 2) | (ch & 3)); }
__device__ __forceinline__ void p9_rwkv_chunk(const Params& p, LAS unsigned char* lds) {
    const int tid = tidx(), half = tid >> 8, htid = tid & 255, hw = __builtin_amdgcn_readfirstlane((tid >> 6) & 3), lane = tid & 63, c16 = lane & 15, g = lane >> 4, wg = blockIdx.x, nwg = gridDim.x;
    LAS unsigned char* hl = lds + half * RC_HALF;
    const bf16_t* R = (const bf16_t*)(p.ws + WS_R); const bf16_t* K1 = (const bf16_t*)(p.ws + WS_K1); const bf16_t* V1 = (const bf16_t*)(p.ws + WS_V1); const bf16_t* LR = (const bf16_t*)(p.ws + WS_LR);
    const bf16_t* W2T = (const bf16_t*)(p.ws + WS_W2T); const bf16_t* A2T = (const bf16_t*)(p.ws + WS_A2T);
    float* BON = (float*)(p.ws + WS_BON); bf16_t* YD = (bf16_t*)(p.out + OUT_Y);
    const float* w0p = pin(p, I_W0); const float* a0p = pin(p, I_A0); const float* kkp = pin(p, I_KK); const float* kap = pin(p, I_KA); const float* rkp = pin(p, I_RK); const float* srw = pin(p, I_SRWKV);
    const int nun = half == 0 ? (256 - wg + nwg - 1) / nwg : (1024 - wg + nwg - 1) / nwg;
    const int bpu = half == 0 ? 128 : 8;
    const int my_steps = nun * bpu;
    const int n0 = (256 - wg + nwg - 1) / nwg * 128, n1 = (1024 - wg + nwg - 1) / nwg * 8;
    const int nsteps = n0 > n1 ? n0 : n1;
    f32x4 Sacc[4];
    int base = 0, L = 0, b = 0, head = 0, dir = 0; bool lat = false;
    const int m = c16, q = g;
    pg8::bf16x8 pftw[3], pfta[3]; u32x2 pfr[2], pfk[2], pfv[2];
#define RC_PREFETCH(bk) do { const int tau_ = (bk) * 32 + 16 * (hw & 1) + m, t_ = dir ? L - 1 - tau_ : tau_; const unsigned row_ = (unsigned)(base + t_); \
        _Pragma("unroll") for (int ks = 0; ks < 3; ++ks) { pftw[ks] = *(const pg8::bf16x8*)((const char*)LR + row_ * 768u + (unsigned)(dir * 192 + (32 * ks + 8 * q) * 2)); \
            pfta[ks] = *(const pg8::bf16x8*)((const char*)LR + row_ * 768u + (unsigned)(384 + dir * 192 + (32 * ks + 8 * q) * 2)); } \
        _Pragma("unroll") for (int mi = 0; mi < 2; ++mi) { const unsigned ch_ = (unsigned)(head * 64 + 16 * (2 * (hw >> 1) + mi) + 4 * q); \
            pfr[mi] = *(const u32x2*)((const char*)R + (row_ * 2048u + ch_) * 2u); pfk[mi] = *(const u32x2*)((const char*)K1 + (row_ * 2048u + ch_) * 2u); pfv[mi] = *(const u32x2*)((const char*)V1 + (row_ * 2048u + ch_) * 2u); } } while (0)
    for (int step = 0; step < nsteps; ++step) {
        const bool active = step < my_steps; const int blk = step % bpu;
        if (active && blk == 0) {
            const int un = wg + (step / bpu) * nwg; int s;
            if (half == 0) { s = 16 + (un >> 6); head = (un >> 1) & 31; dir = un & 1; } else { s = un >> 6; head = (un >> 1) & 31; dir = un & 1; }
            seq_info(s, base, L, b, lat);
            for (int i = htid; i < 768; i += 256) { const int ch = i / 12, pc = i % 12; const size_t go = ((size_t)(dir * 2048 + head * 64 + ch) * 96 + pc * 8);
                *(LAS u32x4*)(hl + RC_W2 + ch * RC_TS + pc * 16) = *(const u32x4*)(W2T + go); *(LAS u32x4*)(hl + RC_A2 + ch * RC_TS + pc * 16) = *(const u32x4*)(A2T + go); }
            if (htid < 64) { LAS float* cst = (LAS float*)(hl + RC_CST); const int c = head * 64 + htid;
                cst[htid] = w0p[dir * 2048 + c]; cst[64 + htid] = a0p[dir * 2048 + c]; cst[128 + htid] = kkp[c]; cst[192 + htid] = kap[c]; cst[256 + htid] = rkp[c]; }
            RC_PREFETCH(0);
            const unsigned sb = (unsigned)((((b * 2 + dir) * 32 + head) * 64 + hw * 16 + c16) * 64 + 4 * g);
#pragma unroll
            for (int jb = 0; jb < 4; ++jb) Sacc[jb] = lat ? *(const f32x4*)((const char*)srw + (sb + 16 * jb) * 4u) : (f32x4){0.f, 0.f, 0.f, 0.f};
            __builtin_amdgcn_s_waitcnt(0x0F70);
        }
        __syncthreads();
#ifndef RW_REPS_A
#define RW_REPS_A 1
#define RW_REPS_C 1
#define RW_REPS_M 1
#endif
#ifndef RW_REPS_1
#define RW_REPS_1 1
#endif
#ifndef RW_REPS_W
#define RW_REPS_W 1
#endif
#ifndef RW_DELAY
#define RW_DELAY 0
#endif
#define RWD_BEGIN(S) unsigned long long rwd_t0_##S = 0; if (RW_DELAY == S) rwd_t0_##S = clock64();
#define RWD_END(S) if (RW_DELAY == S) { asm volatile("s_waitcnt lgkmcnt(0)" ::: "memory"); const unsigned long long t1_ = clock64(), d_ = t1_ - rwd_t0_##S; while ((unsigned long long)clock64() - t1_ < d_) { } }
        RWD_BEGIN(1)
        if (active) for (int repa = 0; repa < RW_REPS_A; ++repa) {
            const int tok = 16 * (hw & 1) + m, mb0 = 2 * (hw >> 1);
            f32x4 dW[2], dA[2];
#pragma unroll
            for (int mi = 0; mi < 2; ++mi) { dW[mi] = (f32x4){0.f, 0.f, 0.f, 0.f}; dA[mi] = (f32x4){0.f, 0.f, 0.f, 0.f}; }
#pragma unroll
            for (int ks = 0; ks < 3; ++ks) {
                const pg8::bf16x8 tw = pftw[ks], ta = pfta[ks];
#pragma unroll
                for (int mi = 0; mi < 2; ++mi) { const pg8::bf16x8 wf = *(const LAS pg8::bf16x8*)(hl + RC_W2 + (16 * (mb0 + mi) + m) * RC_TS + (32 * ks + 8 * q) * 2), af = *(const LAS pg8::bf16x8*)(hl + RC_A2 + (16 * (mb0 + mi) + m) * RC_TS + (32 * ks + 8 * q) * 2);
                    dW[mi] = __builtin_amdgcn_mfma_f32_16x16x32_bf16(wf, tw, dW[mi], 0, 0, 0); dA[mi] = __builtin_amdgcn_mfma_f32_16x16x32_bf16(af, ta, dA[mi], 0, 0, 0); } }
            float ss = 0.f, bon = 0.f;
#pragma unroll
            for (int mi = 0; mi < 2; ++mi) { const int mb = mb0 + mi;
                const u32x2 r2 = pfr[mi], k2 = pfk[mi], v2 = pfv[mi]; const LAS float* cst = (const LAS float*)(hl + RC_CST) + 16 * mb + 4 * q;
                const f32x4 w0 = *(const LAS f32x4*)cst, a0 = *(const LAS f32x4*)(cst + 64), kkw = *(const LAS f32x4*)(cst + 128), kaw = *(const LAS f32x4*)(cst + 192), rkw = *(const LAS f32x4*)(cst + 256);
                const float rr[4] = {bflo(r2.x), bfhi(r2.x), bflo(r2.y), bfhi(r2.y)}, k0[4] = {bflo(k2.x), bfhi(k2.x), bflo(k2.y), bfhi(k2.y)};
                f32x4 oW; float kd[4], kk[4], kb[4];
#pragma unroll
                for (int j = 0; j < 4; ++j) {
                    const float xw = -(w0[j] + dW[mi][j]);
                    const float sp = fmaxf(xw, 0.f) + 0.6931471806f * __builtin_amdgcn_logf(1.f + __builtin_amdgcn_exp2f(-1.4426950409f * fabsf(xw)));
                    oW[j] = __builtin_amdgcn_exp2f(-1.4426950409f * __builtin_amdgcn_exp2f(-1.4426950409f * (sp + 0.5f)));
                    const float a = __builtin_amdgcn_rcpf(1.f + __builtin_amdgcn_exp2f(-1.4426950409f * (a0[j] + dA[mi][j])));
                    kk[j] = k0[j] * kkw[j]; ss += kk[j] * kk[j]; kb[j] = kk[j] * a;
                    kd[j] = k0[j] * (1.f + (a - 1.f) * kaw[j]); bon += rr[j] * kd[j] * rkw[j]; }
                const int eo = rw_sw(tok, 16 * mb + 4 * q);
                *(LAS f32x4*)(hl + RC_W + eo * 4) = oW;
                *(LAS u32x2*)(hl + RC_R + eo * 2) = r2; *(LAS u32x2*)(hl + RC_V + eo * 2) = v2;
                *(LAS u32x2*)(hl + RC_KD + eo * 2) = (u32x2){cvtpk(kd[0], kd[1]), cvtpk(kd[2], kd[3])};
                *(LAS u32x2*)(hl + RC_A + eo * 2) = (u32x2){cvtpk(-kk[0], -kk[1]), cvtpk(-kk[2], -kk[3])};
                *(LAS u32x2*)(hl + RC_B + eo * 2) = (u32x2){cvtpk(kb[0], kb[1]), cvtpk(kb[2], kb[3])}; }
            ss = red4(ss); bon = red4(bon);
            if (q == 0) { *(LAS float*)(hl + RC_SSP + (tok * 2 + (hw >> 1)) * 4) = ss; *(LAS float*)(hl + RC_BNP + (tok * 2 + (hw >> 1)) * 4) = bon; }
        }
        RWD_END(1)
        __syncthreads();
        if (active && blk + 1 < bpu) RC_PREFETCH(blk + 1);
#pragma unroll 1
        for (int cc = 0; cc < 2; ++cc) {
            const int cb = 16 * cc;
            RWD_BEGIN(2)
            if (active) for (int repc = 0; repc < RW_REPS_C; ++repc) { int ln = lane; asm volatile("" : "+v"(ln));
                float wv[16], ow[4], bt[4], kt[4]; unsigned ra[4], rb[4], rk[4], rr[4];
#pragma unroll
                for (int t1 = 0; t1 < 16; ++t1) wv[t1] = *(const LAS float*)(hl + RC_W + rw_sw(cb + t1, ln) * 4);
#pragma unroll
                for (int e = 0; e < 4; ++e) { const unsigned o = (unsigned)rw_sw(cb + 4 * hw + e, ln); ow[e] = *(const LAS float*)(hl + RC_W + o * 4u);
                    ra[e] = *(const LAS bf16_t*)(hl + RC_A + o * 2u); rb[e] = *(const LAS bf16_t*)(hl + RC_B + o * 2u); rk[e] = *(const LAS bf16_t*)(hl + RC_KD + o * 2u); rr[e] = *(const LAS bf16_t*)(hl + RC_R + o * 2u); }
                f32x2v ssp[4];
#pragma unroll
                for (int e = 0; e < 4; ++e) ssp[e] = *(const LAS f32x2v*)(hl + RC_SSP + (cb + 4 * hw + e) * 8);
                const f32x2v bnp = *(const LAS f32x2v*)(hl + RC_BNP + (cb + 4 * hw + (ln & 3)) * 8);
                __builtin_amdgcn_sched_barrier(0);
                float inv[4];
#pragma unroll
                for (int e = 0; e < 4; ++e) inv[e] = __builtin_amdgcn_rcpf(fmaxf(__builtin_amdgcn_sqrtf(ssp[e].x + ssp[e].y), 1e-12f));
                if (ln < 4) { const int tau = blk * 32 + cb + 4 * hw + ln, t = dir ? L - 1 - tau : tau; BON[((size_t)dir * MTOK + (size_t)(base + t)) * 32 + head] = bnp.x + bnp.y; }
                const float p40 = (wv[0] * wv[1]) * (wv[2] * wv[3]), p41 = (wv[4] * wv[5]) * (wv[6] * wv[7]), p42 = (wv[8] * wv[9]) * (wv[10] * wv[11]), p43 = (wv[12] * wv[13]) * (wv[14] * wv[15]);
                const float c01 = p40 * p41, c012 = c01 * p42, gl = c012 * p43;
                float grun = hw == 0 ? 1.f : hw == 1 ? p40 : hw == 2 ? c01 : c012;
#pragma unroll
                for (int e = 0; e < 4; ++e) { const int t1 = 4 * hw + e; const float gprev = grun; grun *= ow[e];
                    const float a = __uint_as_float(ra[e] << 16) * inv[e], bv = __uint_as_float(rb[e] << 16) * inv[e], kd = __uint_as_float(rk[e] << 16), rv = __uint_as_float(rr[e] << 16);
                    const float ig = __builtin_amdgcn_rcpf(grun); bt[e] = bv * ig; kt[e] = kd * ig;
                    *(LAS bf16_t*)(hl + RC_AT + t1 * RC_TT + ln * 2) = f2bf(gprev * a); *(LAS bf16_t*)(hl + RC_RT + t1 * RC_TT + ln * 2) = f2bf(grun * rv);
                    *(LAS bf16_t*)(hl + RC_BT + t1 * RC_TT + ln * 2) = f2bf(bt[e]); *(LAS bf16_t*)(hl + RC_KT + t1 * RC_TT + ln * 2) = f2bf(kt[e]); }
                u32x2 bh, kh; bh.x = cvtpk(bt[0] * gl, bt[1] * gl); bh.y = cvtpk(bt[2] * gl, bt[3] * gl); kh.x = cvtpk(kt[0] * gl, kt[1] * gl); kh.y = cvtpk(kt[2] * gl, kt[3] * gl);
                *(LAS u32x2*)(hl + RC_BH + ln * RC_HS + hw * 8) = bh; *(LAS u32x2*)(hl + RC_KH + ln * RC_HS + hw * 8) = kh;
                if (hw == 0) *(LAS float*)(hl + RC_GL + ln * 4) = gl;
            }
            RWD_END(2)
            __syncthreads();
            RWD_BEGIN(3)
            if (active) for (int rep1 = 0; rep1 < RW_REPS_1; ++rep1) {
                const int xo = (hw & 1) ? RC_KT : RC_BT, yo = (hw & 2) ? RC_RT : RC_AT;
                f32x4 mm = (f32x4){0.f, 0.f, 0.f, 0.f};
#pragma unroll
                for (int ks = 0; ks < 2; ++ks) { const bf16x8 xf = *(const LAS bf16x8*)(hl + xo + c16 * RC_TT + (32 * ks + 8 * g) * 2), yf = *(const LAS bf16x8*)(hl + yo + c16 * RC_TT + (32 * ks + 8 * g) * 2);
                    mm = __builtin_amdgcn_mfma_f32_16x16x32_bf16(xf, yf, mm, 0, 0, 0); }
#pragma unroll
                for (int r = 0; r < 4; ++r) { const int s_ = 4 * g + r; const bool keep = (hw & 2) ? (s_ <= c16) : (s_ < c16); mm[r] = keep ? mm[r] : 0.f; }
                if (hw == 0) {
                    const int tb = c16 >> 2;
#pragma unroll
                    for (int r = 0; r < 4; ++r) *(LAS float*)(hl + RC_MAB + (4 * g + r) * RC_MS + c16 * 4) = g < tb ? mm[r] : 0.f;
                    if (g == tb) {
#pragma unroll
                        for (int r = 0; r < 4; ++r) *(LAS float*)(hl + RC_MD + (4 * g + r) * 16 + (c16 & 3) * 4) = mm[r]; } }
                else { u32x2 w; w.x = cvtpk(mm[0], mm[1]); w.y = cvtpk(mm[2], mm[3]); *(LAS u32x2*)(hl + (hw == 1 ? RC_MAK : hw == 2 ? RC_NBR : RC_NKR) + c16 * RC_NS + g * 8) = w; }
            }
            RWD_END(3)
            __syncthreads();
            RWD_BEGIN(4)
            if (active) for (int repm = 0; repm < RW_REPS_M; ++repm) {
                const u32x2 zz = (u32x2){0u, 0u};
                bf16x8 sfr[2];
#pragma unroll
                for (int ks = 0; ks < 2; ++ks) { u32x4 s4; s4.x = cvtpk(Sacc[2 * ks][0], Sacc[2 * ks][1]); s4.y = cvtpk(Sacc[2 * ks][2], Sacc[2 * ks][3]);
                    s4.z = cvtpk(Sacc[2 * ks + 1][0], Sacc[2 * ks + 1][1]); s4.w = cvtpk(Sacc[2 * ks + 1][2], Sacc[2 * ks + 1][3]); sfr[ks] = __builtin_bit_cast(bf16x8, s4); }
                bf16x8 vfr;
                { const LAS bf16_t* vp = (const LAS bf16_t*)(hl + RC_V); const int vi_ = 16 * hw + c16, vt_ = cb + 4 * g;
                  const unsigned v0 = vp[rw_sw(vt_, vi_)], v1 = vp[rw_sw(vt_ + 1, vi_)], v2 = vp[rw_sw(vt_ + 2, vi_)], v3 = vp[rw_sw(vt_ + 3, vi_)]; vfr = mk_frag((u32x2){v0 | (v1 << 16), v2 | (v3 << 16)}, zz); }
                f32x4 mx[12], md[3];
#pragma unroll
                for (int s1 = 0; s1 < 12; ++s1) mx[s1] = *(const LAS f32x4*)(hl + RC_MAB + s1 * RC_MS + g * 16);
#pragma unroll
                for (int e = 0; e < 3; ++e) md[e] = *(const LAS f32x4*)(hl + RC_MD + (4 * g + e) * 16);
                f32x4 xt = (f32x4){0.f, 0.f, 0.f, 0.f}, yt = (f32x4){0.f, 0.f, 0.f, 0.f};
#pragma unroll
                for (int ks = 0; ks < 2; ++ks) {
                    const LAS unsigned char* ap = hl + RC_AT + c16 * RC_TT + (32 * ks + 4 * g) * 2; const LAS unsigned char* rp = hl + RC_RT + c16 * RC_TT + (32 * ks + 4 * g) * 2;
                    xt = __builtin_amdgcn_mfma_f32_16x16x32_bf16(mk_frag(*(const LAS u32x2*)ap, *(const LAS u32x2*)(ap + 32)), sfr[ks], xt, 0, 0, 0);
                    yt = __builtin_amdgcn_mfma_f32_16x16x32_bf16(mk_frag(*(const LAS u32x2*)rp, *(const LAS u32x2*)(rp + 32)), sfr[ks], yt, 0, 0, 0); }
                xt = __builtin_amdgcn_mfma_f32_16x16x32_bf16(mk_frag(*(const LAS u32x2*)(hl + RC_MAK + c16 * RC_NS + g * 8), zz), vfr, xt, 0, 0, 0);
                yt = __builtin_amdgcn_mfma_f32_16x16x32_bf16(mk_frag(*(const LAS u32x2*)(hl + RC_NKR + c16 * RC_NS + g * 8), zz), vfr, yt, 0, 0, 0);
                float x[4] = {xt[0], xt[1], xt[2], xt[3]};
#pragma unroll
                for (int h = 0; h < 4; ++h) {
                    if (g == h) { x[1] += x[0] * md[0][1]; x[2] += x[0] * md[0][2]; x[3] += x[0] * md[0][3]; x[2] += x[1] * md[1][2]; x[3] += x[1] * md[1][3]; x[3] += x[2] * md[2][3]; }
                    if (h < 3) { float ub[4];
#pragma unroll
                        for (int e = 0; e < 4; ++e) { const unsigned xv = __float_as_uint(x[e]);
                            if (h == 2) { const auto r1 = __builtin_amdgcn_permlane16_swap(xv, xv, false, false); ub[e] = __uint_as_float(r1[0]); }
                            else { const auto r0 = __builtin_amdgcn_permlane32_swap(xv, xv, false, false); const auto r1 = __builtin_amdgcn_permlane16_swap(r0[0], r0[0], false, false); ub[e] = __uint_as_float(r1[h]); } }
#pragma unroll
                        for (int e2 = 0; e2 < 4; ++e2)
#pragma unroll
                            for (int e = 0; e < 4; ++e) x[e] += ub[e2] * mx[4 * h + e2][e]; } }
                const bf16x8 ufr = mk_frag((u32x2){cvtpk(x[0], x[1]), cvtpk(x[2], x[3])}, zz);
                yt = __builtin_amdgcn_mfma_f32_16x16x32_bf16(mk_frag(*(const LAS u32x2*)(hl + RC_NBR + c16 * RC_NS + g * 8), zz), ufr, yt, 0, 0, 0);
#pragma unroll
                for (int r = 0; r < 4; ++r) *(LAS bf16_t*)(hl + RC_YO + (4 * g + r) * 128 + (16 * hw + c16) * 2) = f2bf_rne(yt[r]);
                if (repm + 1 == RW_REPS_M)
#pragma unroll
                for (int jb = 0; jb < 4; ++jb) { const f32x4 gl4 = *(const LAS f32x4*)(hl + RC_GL + (16 * jb + 4 * g) * 4); Sacc[jb] = Sacc[jb] * gl4;
                    Sacc[jb] = __builtin_amdgcn_mfma_f32_16x16x32_bf16(mk_frag(*(const LAS u32x2*)(hl + RC_BH + (16 * jb + c16) * RC_HS + g * 8), zz), ufr, Sacc[jb], 0, 0, 0);
                    Sacc[jb] = __builtin_amdgcn_mfma_f32_16x16x32_bf16(mk_frag(*(const LAS u32x2*)(hl + RC_KH + (16 * jb + c16) * RC_HS + g * 8), zz), vfr, Sacc[jb], 0, 0, 0); }
                if (cc == 1 && blk == bpu - 1 && !lat && repm + 1 == RW_REPS_M) { const unsigned sb = (unsigned)((((b * 2 + dir) * 32 + head) * 64 + hw * 16 + c16) * 64 + 4 * g);
#pragma unroll
                    for (int jb = 0; jb < 4; ++jb) *(f32x4*)((char*)p.out + ((unsigned)OUT_RWKV + sb + 16 * jb) * 4u) = Sacc[jb]; }
            }
            RWD_END(4)
            __syncthreads();
            RWD_BEGIN(5)
            if (active && htid < 128) for (int repw = 0; repw < RW_REPS_W; ++repw) {
                const int tok = htid >> 3, c8 = (htid & 7) * 8, tau = blk * 32 + cb + tok, t = dir ? L - 1 - tau : tau; const size_t row = (size_t)(base + t);
                *(u32x4*)(YD + (size_t)dir * MTOK * DM + row * DM + head * 64 + c8) = *(const LAS u32x4*)(hl + RC_YO + tok * 128 + c8 * 2);
            }
            RWD_END(5)
        }
    }
#undef RC_PREFETCH
}

constexpr int RP_W2 = 0, RP_A2 = 13312, RP_CST = 26624, RP_W = 27904, RP_A = 32000, RP_B = 34048, RP_KD = 36096, RP_R = 38144, RP_SSP = 40192, RP_BNP = 40448, RP_XT = 40704, RP_YO = 45056, RP_BUF = 47104;
constexpr int RB_V = 0, RB_AT = 2048, RB_RT = 4352, RB_BT = 6656, RB_KT = 8960, RB_BH = 11264, RB_KH = 13824, RB_GL = 16384, RB_MAB = 16640, RB_MAK = 17920, RB_NBR = 18560, RB_NKR = 19200, RB_SIZE = 19840;
static_assert(RP_BUF + 2 * RB_SIZE <= LDS_BAR_OFF, "RWKV pipe LDS map");

struct RwkvUnit { int base, L, b, head, dir; bool lat; };
__device__ __forceinline__ void rwkv_unit_of(int n, int wg, RwkvUnit& u, int& c, int& nch) {
    int un, s;
    if (n < 256) { un = wg; s = 16 + (un >> 6); c = n; nch = 256; } else { const int k = (n - 256) >> 4; un = wg + 256 * k; s = un >> 6; c = (n - 256) & 15; nch = 16; }
    u.head = (un >> 1) & 31; u.dir = un & 1; seq_info(s, u.base, u.L, u.b, u.lat);
}

__device__ __forceinline__ void p9_rwkv_pipe(const Params& p, LAS unsigned char* lds) {
    const int tid = tidx(), half = __builtin_amdgcn_readfirstlane(tid >> 8), htid = tid & 255, pw = __builtin_amdgcn_readfirstlane((tid >> 6) & 3), lane = tid & 63, c16 = lane & 15, g = lane >> 4, wg = blockIdx.x;
    const bool producer = half == 1;
    const bf16_t* R = (const bf16_t*)(p.ws + WS_R); const bf16_t* K1 = (const bf16_t*)(p.ws + WS_K1); const bf16_t* V1 = (const bf16_t*)(p.ws + WS_V1); const bf16_t* LR = (const bf16_t*)(p.ws + WS_LR);
    const bf16_t* W2T = (const bf16_t*)(p.ws + WS_W2T); const bf16_t* A2T = (const bf16_t*)(p.ws + WS_A2T);
    float* BON = (float*)(p.ws + WS_BON); bf16_t* YD = (bf16_t*)(p.out + OUT_Y);
    const float* w0p = pin(p, I_W0); const float* a0p = pin(p, I_A0); const float* kkp = pin(p, I_KK); const float* kap = pin(p, I_KA); const float* rkp = pin(p, I_RK); const float* srw = pin(p, I_SRWKV);
    constexpr int NCH = 256 + 4 * 16;
    f32x4 Sacc[4];
    pg8::bf16x8 pftw[3], pfta[3]; u32x2 pfr, pfk, pfv;
#define RP_PREFETCH(U, cc) do { const int tau_ = (cc) * 16 + c16, t_ = (U).dir ? (U).L - 1 - tau_ : tau_; const unsigned row_ = (unsigned)((U).base + t_); \
        _Pragma("unroll") for (int ks = 0; ks < 3; ++ks) { pftw[ks] = *(const pg8::bf16x8*)((const char*)LR + row_ * 768u + (unsigned)((U).dir * 192 + (32 * ks + 8 * g) * 2)); \
            pfta[ks] = *(const pg8::bf16x8*)((const char*)LR + row_ * 768u + (unsigned)(384 + (U).dir * 192 + (32 * ks + 8 * g) * 2)); } \
        { const unsigned ch_ = (unsigned)((U).head * 64 + 16 * pw + 4 * g); \
          pfr = *(const u32x2*)((const char*)R + (row_ * 2048u + ch_) * 2u); pfk = *(const u32x2*)((const char*)K1 + (row_ * 2048u + ch_) * 2u); pfv = *(const u32x2*)((const char*)V1 + (row_ * 2048u + ch_) * 2u); } } while (0)
    for (int n = -1; n < NCH; ++n) {
        RwkvUnit up; int cp = 0, nchp = 0; const bool has_p = n + 1 < NCH;
        if (has_p) rwkv_unit_of(n + 1, wg, up, cp, nchp);
        if (has_p && cp == 0) {
            if (producer) {
                for (int i = htid; i < 768; i += 256) { const int ch = i / 12, pc = i % 12; const size_t go = ((size_t)(up.dir * 2048 + up.head * 64 + ch) * 96 + pc * 8);
                    *(LAS u32x4*)(lds + RP_W2 + ch * RC_TS + pc * 16) = *(const u32x4*)(W2T + go); *(LAS u32x4*)(lds + RP_A2 + ch * RC_TS + pc * 16) = *(const u32x4*)(A2T + go); }
                if (htid < 64) { LAS float* cst = (LAS float*)(lds + RP_CST); const int c = up.head * 64 + htid;
                    cst[htid] = w0p[up.dir * 2048 + c]; cst[64 + htid] = a0p[up.dir * 2048 + c]; cst[128 + htid] = kkp[c]; cst[192 + htid] = kap[c]; cst[256 + htid] = rkp[c]; }
                RP_PREFETCH(up, 0);
            }
            __syncthreads();
        }
        RwkvUnit uc; int cc = 0, nchc = 0; const bool has_c = n >= 0;
        if (has_c) rwkv_unit_of(n, wg, uc, cc, nchc);
        LAS unsigned char* bufp = lds + RP_BUF + ((n + 1) & 1) * RB_SIZE; LAS unsigned char* bufc = lds + RP_BUF + (n & 1) * RB_SIZE;
        bf16x8 ufr, vfr; f32x4 yt = (f32x4){0.f, 0.f, 0.f, 0.f};
        if (producer) {
            if (has_p) {
                f32x4 dW = (f32x4){0.f, 0.f, 0.f, 0.f}, dA = (f32x4){0.f, 0.f, 0.f, 0.f};
#pragma unroll
                for (int ks = 0; ks < 3; ++ks) { const pg8::bf16x8 wf = *(const LAS pg8::bf16x8*)(lds + RP_W2 + (16 * pw + c16) * RC_TS + (32 * ks + 8 * g) * 2), af = *(const LAS pg8::bf16x8*)(lds + RP_A2 + (16 * pw + c16) * RC_TS + (32 * ks + 8 * g) * 2);
                    dW = __builtin_amdgcn_mfma_f32_16x16x32_bf16(wf, pftw[ks], dW, 0, 0, 0); dA = __builtin_amdgcn_mfma_f32_16x16x32_bf16(af, pfta[ks], dA, 0, 0, 0); }
                const u32x2 r2 = pfr, k2 = pfk, v2 = pfv; const LAS float* cst = (const LAS float*)(lds + RP_CST) + 16 * pw + 4 * g;
                const f32x4 w0 = *(const LAS f32x4*)cst, a0 = *(const LAS f32x4*)(cst + 64), kkw = *(const LAS f32x4*)(cst + 128), kaw = *(const LAS f32x4*)(cst + 192), rkw = *(const LAS f32x4*)(cst + 256);
                const float rr[4] = {bflo(r2.x), bfhi(r2.x), bflo(r2.y), bfhi(r2.y)}, k0[4] = {bflo(k2.x), bfhi(k2.x), bflo(k2.y), bfhi(k2.y)};
                f32x4 oW; float kd[4], kk[4], kb[4], ss = 0.f, bon = 0.f;
#pragma unroll
                for (int j = 0; j < 4; ++j) {
                    const float xw = -(w0[j] + dW[j]);
                    const float sp = fmaxf(xw, 0.f) + __logf(1.f + __expf(-fabsf(xw)));
                    oW[j] = __expf(-__expf(-sp - 0.5f));
                    const float a = 1.f / (1.f + __expf(-(a0[j] + dA[j])));
                    kk[j] = k0[j] * kkw[j]; ss += kk[j] * kk[j]; kb[j] = kk[j] * a;
                    kd[j] = k0[j] * (1.f + (a - 1.f) * kaw[j]); bon += rr[j] * kd[j] * rkw[j]; }
                const int eo = c16 * 64 + 16 * pw + 4 * g;
                *(LAS f32x4*)(lds + RP_W + eo * 4) = oW;
                *(LAS u32x2*)(lds + RP_R + eo * 2) = r2; *(LAS u32x2*)(bufp + RB_V + eo * 2) = v2;
                *(LAS u32x2*)(lds + RP_KD + eo * 2) = (u32x2){cvtpk(kd[0], kd[1]), cvtpk(kd[2], kd[3])};
                *(LAS u32x2*)(lds + RP_A + eo * 2) = (u32x2){cvtpk(-kk[0], -kk[1]), cvtpk(-kk[2], -kk[3])};
                *(LAS u32x2*)(lds + RP_B + eo * 2) = (u32x2){cvtpk(kb[0], kb[1]), cvtpk(kb[2], kb[3])};
                ss = red4(ss); bon = red4(bon);
                if (g == 0) { *(LAS float*)(lds + RP_SSP + (c16 * 4 + pw) * 4) = ss; *(LAS float*)(lds + RP_BNP + (c16 * 4 + pw) * 4) = bon; }
                if (cp + 1 < nchp) RP_PREFETCH(up, cp + 1);
            }
        } else if (has_c) {
            if (cc == 0) {
                const unsigned sb = (unsigned)((((uc.b * 2 + uc.dir) * 32 + uc.head) * 64 + pw * 16 + c16) * 64 + 4 * g);
#pragma unroll
                for (int jb = 0; jb < 4; ++jb) Sacc[jb] = (f32x4){0.f, 0.f, 0.f, 0.f};
                if (uc.lat) {
#pragma unroll
                    for (int jb = 0; jb < 4; ++jb) Sacc[jb] = *(const f32x4*)((const char*)srw + (sb + 16 * jb) * 4u); }
            }
            const u32x2 zz = (u32x2){0u, 0u};
            bf16x8 sfr[2];
#pragma unroll
            for (int ks = 0; ks < 2; ++ks) { u32x4 s4; s4.x = cvtpk(Sacc[2 * ks][0], Sacc[2 * ks][1]); s4.y = cvtpk(Sacc[2 * ks][2], Sacc[2 * ks][3]);
                s4.z = cvtpk(Sacc[2 * ks + 1][0], Sacc[2 * ks + 1][1]); s4.w = cvtpk(Sacc[2 * ks + 1][2], Sacc[2 * ks + 1][3]); sfr[ks] = __builtin_bit_cast(bf16x8, s4); }
            { const LAS bf16_t* vp = (const LAS bf16_t*)(bufc + RB_V) + (4 * g) * 64 + 16 * pw + c16;
              const unsigned v0 = vp[0], v1 = vp[64], v2 = vp[128], v3 = vp[192]; vfr = mk_frag((u32x2){v0 | (v1 << 16), v2 | (v3 << 16)}, zz); }
            f32x4 xt = (f32x4){0.f, 0.f, 0.f, 0.f};
#pragma unroll
            for (int ks = 0; ks < 2; ++ks) {
                const LAS unsigned char* ap = bufc + RB_AT + c16 * RC_TT + (32 * ks + 4 * g) * 2; const LAS unsigned char* rp = bufc + RB_RT + c16 * RC_TT + (32 * ks + 4 * g) * 2;
                xt = __builtin_amdgcn_mfma_f32_16x16x32_bf16(mk_frag(*(const LAS u32x2*)ap, *(const LAS u32x2*)(ap + 32)), sfr[ks], xt, 0, 0, 0);
                yt = __builtin_amdgcn_mfma_f32_16x16x32_bf16(mk_frag(*(const LAS u32x2*)rp, *(const LAS u32x2*)(rp + 32)), sfr[ks], yt, 0, 0, 0); }
            xt = __builtin_amdgcn_mfma_f32_16x16x32_bf16(mk_frag(*(const LAS u32x2*)(bufc + RB_MAK + c16 * RC_NS + g * 8), zz), vfr, xt, 0, 0, 0);
            yt = __builtin_amdgcn_mfma_f32_16x16x32_bf16(mk_frag(*(const LAS u32x2*)(bufc + RB_NKR + c16 * RC_NS + g * 8), zz), vfr, yt, 0, 0, 0);
            LAS float* xs = (LAS float*)(lds + RP_XT + pw * (16 * RC_XS));
#pragma unroll
            for (int r = 0; r < 4; ++r) xs[(4 * g + r) * (RC_XS / 4) + c16] = xt[r];
            asm volatile("s_waitcnt lgkmcnt(0)" ::: "memory");
            float u[16];
#pragma unroll
            for (int t1 = 0; t1 < 16; ++t1) u[t1] = xs[t1 * (RC_XS / 4) + c16];
#pragma unroll
            for (int t1 = 1; t1 < 16; ++t1) { float acc = u[t1];
#pragma unroll
                for (int s4 = 0; s4 < (t1 + 3) / 4; ++s4) { const f32x4 mr = *(const LAS f32x4*)(bufc + RB_MAB + t1 * RC_MS + s4 * 16);
#pragma unroll
                    for (int e = 0; e < 4; ++e) if (4 * s4 + e < t1) acc += u[4 * s4 + e] * mr[e]; }
                u[t1] = acc; }
            { float us[4];
#pragma unroll
              for (int e = 0; e < 4; ++e) us[e] = g == 0 ? u[e] : g == 1 ? u[4 + e] : g == 2 ? u[8 + e] : u[12 + e];
              ufr = mk_frag((u32x2){cvtpk(us[0], us[1]), cvtpk(us[2], us[3])}, zz); }
        }
        __syncthreads();
        if (producer) {
            if (has_p) {
                float grun = 1.f; float bt[4], kt[4];
#pragma unroll
                for (int t1 = 0; t1 < 16; ++t1) { const float gprev = grun; grun *= *(const LAS float*)(lds + RP_W + (t1 * 64 + lane) * 4);
                    if ((t1 >> 2) == pw) { const int e = t1 & 3; const unsigned o = (unsigned)(t1 * 64 + lane) * 2u;
                        const f32x4 sp4 = *(const LAS f32x4*)(lds + RP_SSP + t1 * 16); const float inv = 1.f / fmaxf(sqrtf((sp4[0] + sp4[1]) + (sp4[2] + sp4[3])), 1e-12f);
                        const float a = bf2f(*(const LAS bf16_t*)(lds + RP_A + o)) * inv, bv = bf2f(*(const LAS bf16_t*)(lds + RP_B + o)) * inv, kd = bf2f(*(const LAS bf16_t*)(lds + RP_KD + o)), rv = bf2f(*(const LAS bf16_t*)(lds + RP_R + o));
                        const float ig = __builtin_amdgcn_rcpf(grun); bt[e] = bv * ig; kt[e] = kd * ig;
                        *(LAS bf16_t*)(bufp + RB_AT + t1 * RC_TT + lane * 2) = f2bf(gprev * a); *(LAS bf16_t*)(bufp + RB_RT + t1 * RC_TT + lane * 2) = f2bf(grun * rv);
                        *(LAS bf16_t*)(bufp + RB_BT + t1 * RC_TT + lane * 2) = f2bf(bt[e]); *(LAS bf16_t*)(bufp + RB_KT + t1 * RC_TT + lane * 2) = f2bf(kt[e]); } }
                const float gl = grun;
                *(LAS u32x2*)(bufp + RB_BH + lane * RC_HS + pw * 8) = (u32x2){cvtpk(bt[0] * gl, bt[1] * gl), cvtpk(bt[2] * gl, bt[3] * gl)};
                *(LAS u32x2*)(bufp + RB_KH + lane * RC_HS + pw * 8) = (u32x2){cvtpk(kt[0] * gl, kt[1] * gl), cvtpk(kt[2] * gl, kt[3] * gl)};
                if (pw == 0) *(LAS float*)(bufp + RB_GL + lane * 4) = gl;
                if (htid < 16) { const int tau = cp * 16 + htid, t = up.dir ? up.L - 1 - tau : tau; const f32x4 b4 = *(const LAS f32x4*)(lds + RP_BNP + htid * 16);
                    BON[((size_t)up.dir * MTOK + (size_t)(up.base + t)) * 32 + up.head] = (b4[0] + b4[1]) + (b4[2] + b4[3]); }
            }
        } else if (has_c) {
            const u32x2 zz = (u32x2){0u, 0u};
            yt = __builtin_amdgcn_mfma_f32_16x16x32_bf16(mk_frag(*(const LAS u32x2*)(bufc + RB_NBR + c16 * RC_NS + g * 8), zz), ufr, yt, 0, 0, 0);
#pragma unroll
            for (int r = 0; r < 4; ++r) *(LAS bf16_t*)(lds + RP_YO + (4 * g + r) * 128 + (16 * pw + c16) * 2) = f2bf_rne(yt[r]);
#pragma unroll
            for (int jb = 0; jb < 4; ++jb) { const f32x4 gl4 = *(const LAS f32x4*)(bufc + RB_GL + (16 * jb + 4 * g) * 4); Sacc[jb] = Sacc[jb] * gl4;
                Sacc[jb] = __builtin_amdgcn_mfma_f32_16x16x32_bf16(mk_frag(*(const LAS u32x2*)(bufc + RB_BH + (16 * jb + c16) * RC_HS + g * 8), zz), ufr, Sacc[jb], 0, 0, 0);
                Sacc[jb] = __builtin_amdgcn_mfma_f32_16x16x32_bf16(mk_frag(*(const LAS u32x2*)(bufc + RB_KH + (16 * jb + c16) * RC_HS + g * 8), zz), vfr, Sacc[jb], 0, 0, 0); }
            if (cc == nchc - 1 && !uc.lat) { const unsigned sb = (unsigned)((((uc.b * 2 + uc.dir) * 32 + uc.head) * 64 + pw * 16 + c16) * 64 + 4 * g);
#pragma unroll
                for (int jb = 0; jb < 4; ++jb) *(f32x4*)((char*)p.out + ((unsigned)OUT_RWKV + sb + 16 * jb) * 4u) = Sacc[jb]; }
        }
        __syncthreads();
        if (producer) {
            if (has_p) {
                const int xo = (pw & 1) ? RB_KT : RB_BT, yo = (pw & 2) ? RB_RT : RB_AT;
                f32x4 mm = (f32x4){0.f, 0.f, 0.f, 0.f};
#pragma unroll
                for (int ks = 0; ks < 2; ++ks) { const bf16x8 xf = *(const LAS bf16x8*)(bufp + xo + c16 * RC_TT + (32 * ks + 8 * g) * 2), yf = *(const LAS bf16x8*)(bufp + yo + c16 * RC_TT + (32 * ks + 8 * g) * 2);
                    mm = __builtin_amdgcn_mfma_f32_16x16x32_bf16(xf, yf, mm, 0, 0, 0); }
#pragma unroll
                for (int r = 0; r < 4; ++r) { const int s_ = 4 * g + r; const bool keep = (pw & 2) ? (s_ <= c16) : (s_ < c16); mm[r] = keep ? mm[r] : 0.f; }
                if (pw == 0) *(LAS f32x4*)(bufp + RB_MAB + c16 * RC_MS + g * 16) = mm;
                else { u32x2 w; w.x = cvtpk(mm[0], mm[1]); w.y = cvtpk(mm[2], mm[3]); *(LAS u32x2*)(bufp + (pw == 1 ? RB_MAK : pw == 2 ? RB_NBR : RB_NKR) + c16 * RC_NS + g * 8) = w; }
            }
        } else if (has_c && htid < 128) {
            const int tok = htid >> 3, c8 = (htid & 7) * 8, tau = cc * 16 + tok, t = uc.dir ? uc.L - 1 - tau : tau; const size_t row = (size_t)(uc.base + t);
            *(u32x4*)(YD + (size_t)uc.dir * MTOK * DM + row * DM + uc.head * 64 + c8) = *(const LAS u32x4*)(lds + RP_YO + tok * 128 + c8 * 2);
        }
        __syncthreads();
    }
#undef RP_PREFETCH
}

constexpr int RB2_GL = 0, RB2_MAB = 256, RB2_MD = 1536, RB2_MAK = 1792, RB2_NBR = 2432, RB2_NKR = 3072, RB2_V = 3712, RB2_AT = 5760, RB2_RT = 8064, RB2_BT = 10368, RB2_KT = 12672, RB2_BH = 14976, RB2_KH = 17536, RB2_SIZE = 20096;
constexpr int RQ_SSP = 2 * RB2_SIZE, RQ_BNP = RQ_SSP + 256, RQ_YO = RQ_BNP + 256, RQ_CST = RQ_YO + 2048, RQ_W = RQ_CST + 1280, RQ_A = RQ_W + 4096, RQ_B = RQ_A + 2048, RQ_KD = RQ_B + 2048, RQ_R = RQ_KD + 2048,
              RQ_W2 = RQ_R + 2048, RQ_A2 = RQ_W2 + 13312, RQ_RING = RQ_A2 + 13312, RQ_SLOT = 12288, RQ_END = RQ_RING + 4 * RQ_SLOT;
static_assert(RQ_END <= LDS_BAR_OFF, "RWKV pipe LDS map");
struct RwkvPf { pg8::bf16x8 tw[3], ta[3]; u32x2 r, k, v; };

#ifndef RQ_DELAY
#define RQ_DELAY 0
#endif
#define RQD_BEGIN(S) unsigned long long rqd_t0_##S = 0; if (RQ_DELAY == S) rqd_t0_##S = clock64();
#define RQD_END(S) if (RQ_DELAY == S) { asm volatile("s_waitcnt lgkmcnt(0)" ::: "memory"); const unsigned long long t1_ = clock64(), d_ = t1_ - rqd_t0_##S; while ((unsigned long long)clock64() - t1_ < d_) { } }
__device__ __forceinline__ void rwkv_dma(const unsigned char* ws, LAS unsigned char* lds, int wg, int pw, int lane, int c) {
    constexpr int NCH = 256 + 4 * 16;
    const int cq = c < NCH ? c : NCH - 1; RwkvUnit U; int ci, nch; rwkv_unit_of(cq, wg, U, ci, nch);
    LAS unsigned char* slot = lds + RQ_RING + (c & 3) * RQ_SLOT;
#pragma unroll
    for (int j = 0; j < 3; ++j) { const int q = pw * 3 + j; const unsigned char* ga;
        if (q < 6) { const int i = (q % 3) * 64 + lane, tok = i / 12, piece = i % 12, tau_ = ci * 16 + tok, t_ = U.dir ? U.L - 1 - tau_ : tau_;
            ga = ws + WS_LR + (size_t)((unsigned)(U.base + t_) * 768u + (unsigned)((q >= 3 ? 384 : 0) + U.dir * 192 + piece * 16)); }
        else { const int ten = (q - 6) >> 1, i = ((q - 6) & 1) * 64 + lane, tok = i >> 3, piece = (i & 7) ^ (tok & 7), tau_ = ci * 16 + tok, t_ = U.dir ? U.L - 1 - tau_ : tau_;
            const size_t tb = ten == 0 ? WS_R : ten == 1 ? WS_K1 : WS_V1;
            ga = ws + tb + (size_t)(((unsigned)(U.base + t_) * 2048u + (unsigned)(U.head * 64)) * 2u + (unsigned)(piece * 16)); }
        __builtin_amdgcn_global_load_lds((const unsigned*)ga, (LAS unsigned*)(slot + q * 1024), 16, 0, 0); }
}
#define RQ_BAR() do { asm volatile("s_waitcnt lgkmcnt(0)" ::: "memory"); __builtin_amdgcn_s_barrier(); asm volatile("" ::: "memory"); } while (0)
__device__ __forceinline__ void p9_rwkv_pipe2(const Params& p, LAS unsigned char* lds) {
    const int tid = tidx(), half = __builtin_amdgcn_readfirstlane(tid >> 8), htid = tid & 255, pw = __builtin_amdgcn_readfirstlane((tid >> 6) & 3), lane = tid & 63, c16 = lane & 15, g = lane >> 4, wg = blockIdx.x;
    const bool producer = half == 1;
    const bf16_t* R = (const bf16_t*)(p.ws + WS_R); const bf16_t* K1 = (const bf16_t*)(p.ws + WS_K1); const bf16_t* V1 = (const bf16_t*)(p.ws + WS_V1); const bf16_t* LR = (const bf16_t*)(p.ws + WS_LR);
    const bf16_t* W2T = (const bf16_t*)(p.ws + WS_W2T); const bf16_t* A2T = (const bf16_t*)(p.ws + WS_A2T);
    float* BON = (float*)(p.ws + WS_BON); bf16_t* YD = (bf16_t*)(p.out + OUT_Y);
    const float* w0p = pin(p, I_W0); const float* a0p = pin(p, I_A0); const float* kkp = pin(p, I_KK); const float* kap = pin(p, I_KA); const float* rkp = pin(p, I_RK); const float* srw = pin(p, I_SRWKV);
    constexpr int NCH = 256 + 4 * 16;
    f32x4 Sacc[4];
#pragma unroll
    for (int jb = 0; jb < 4; ++jb) Sacc[jb] = (f32x4){0.f, 0.f, 0.f, 0.f};
    if (producer) { rwkv_dma(p.ws, lds, wg, pw, lane, 0); rwkv_dma(p.ws, lds, wg, pw, lane, 1); rwkv_dma(p.ws, lds, wg, pw, lane, 2); asm volatile("s_waitcnt vmcnt(0)" ::: "memory"); }
    for (int n = -1; n < NCH; ++n) {
        const bool has_p = n + 1 < NCH, has_c = n >= 0;
        RwkvUnit up, uc; int cp = 0, nchp = 0, cc = 0, nchc = 0;
        if (has_p) rwkv_unit_of(n + 1, wg, up, cp, nchp);
        if (has_c) rwkv_unit_of(n, wg, uc, cc, nchc);
        if (has_p && cp == 0) {
            if (producer) {
                for (int i = htid; i < 768; i += 256) { const int ch = i / 12, pc = i % 12; const size_t go = ((size_t)(up.dir * 2048 + up.head * 64 + ch) * 96 + pc * 8);
                    *(LAS u32x4*)(lds + RQ_W2 + ch * RC_TS + pc * 16) = *(const u32x4*)(W2T + go); *(LAS u32x4*)(lds + RQ_A2 + ch * RC_TS + pc * 16) = *(const u32x4*)(A2T + go); }
                if (htid < 64) { LAS float* cst = (LAS float*)(lds + RQ_CST); const int c = up.head * 64 + htid;
                    cst[htid] = w0p[up.dir * 2048 + c]; cst[64 + htid] = a0p[up.dir * 2048 + c]; cst[128 + htid] = kkp[c]; cst[192 + htid] = kap[c]; cst[256 + htid] = rkp[c]; }
            }
            RQ_BAR();
        }
        LAS unsigned char* bufp = lds + ((n + 1) & 1) * RB2_SIZE; LAS unsigned char* bufc = lds + (n & 1) * RB2_SIZE;
        const u32x2 zz = (u32x2){0u, 0u};
        bf16x8 ufr = __builtin_bit_cast(bf16x8, (u32x4){0u, 0u, 0u, 0u}), vfr = ufr; f32x4 yt = (f32x4){0.f, 0.f, 0.f, 0.f};
        if (producer) {
            if (has_p) {
                RQD_BEGIN(1)
                const LAS unsigned char* slot = lds + RQ_RING + ((n + 1) & 3) * RQ_SLOT;
                f32x4 dW = (f32x4){0.f, 0.f, 0.f, 0.f}, dA = (f32x4){0.f, 0.f, 0.f, 0.f};
#pragma unroll
                for (int ks = 0; ks < 3; ++ks) { const pg8::bf16x8 wf = *(const LAS pg8::bf16x8*)(lds + RQ_W2 + (16 * pw + c16) * RC_TS + (32 * ks + 8 * g) * 2), af = *(const LAS pg8::bf16x8*)(lds + RQ_A2 + (16 * pw + c16) * RC_TS + (32 * ks + 8 * g) * 2);
                    const pg8::bf16x8 tw = *(const LAS pg8::bf16x8*)(slot + c16 * 192 + (32 * ks + 8 * g) * 2), ta = *(const LAS pg8::bf16x8*)(slot + 3072 + c16 * 192 + (32 * ks + 8 * g) * 2);
                    dW = __builtin_amdgcn_mfma_f32_16x16x32_bf16(wf, tw, dW, 0, 0, 0); dA = __builtin_amdgcn_mfma_f32_16x16x32_bf16(af, ta, dA, 0, 0, 0); }
                const int rko = (c16 * 8 + ((2 * pw + (g >> 1)) ^ (c16 & 7))) * 16 + (g & 1) * 8;
                const u32x2 r2 = *(const LAS u32x2*)(slot + 6144 + rko), k2 = *(const LAS u32x2*)(slot + 8192 + rko), v2 = *(const LAS u32x2*)(slot + 10240 + rko); const LAS float* cst = (const LAS float*)(lds + RQ_CST) + 16 * pw + 4 * g;
                const f32x4 w0 = *(const LAS f32x4*)cst, a0 = *(const LAS f32x4*)(cst + 64), kkw = *(const LAS f32x4*)(cst + 128), kaw = *(const LAS f32x4*)(cst + 192), rkw = *(const LAS f32x4*)(cst + 256);
                const float rr[4] = {bflo(r2.x), bfhi(r2.x), bflo(r2.y), bfhi(r2.y)}, k0[4] = {bflo(k2.x), bfhi(k2.x), bflo(k2.y), bfhi(k2.y)};
                f32x4 oW; float kd[4], kk[4], kb[4], ss = 0.f, bon = 0.f;
#pragma unroll
                for (int j = 0; j < 4; ++j) {
                    const float xw = -(w0[j] + dW[j]);
                    const float sp = fmaxf(xw, 0.f) + 0.6931471806f * __builtin_amdgcn_logf(1.f + __builtin_amdgcn_exp2f(-1.4426950409f * fabsf(xw)));
                    oW[j] = __builtin_amdgcn_exp2f(-1.4426950409f * __builtin_amdgcn_exp2f(-1.4426950409f * (sp + 0.5f)));
                    const float a = __builtin_amdgcn_rcpf(1.f + __builtin_amdgcn_exp2f(-1.4426950409f * (a0[j] + dA[j])));
                    kk[j] = k0[j] * kkw[j]; ss += kk[j] * kk[j]; kb[j] = kk[j] * a;
                    kd[j] = k0[j] * (1.f + (a - 1.f) * kaw[j]); bon += rr[j] * kd[j] * rkw[j]; }
                const int eo = rw_sw(c16, 16 * pw + 4 * g);
                *(LAS f32x4*)(lds + RQ_W + eo * 4) = oW;
                *(LAS u32x2*)(lds + RQ_R + eo * 2) = r2; *(LAS u32x2*)(bufp + RB2_V + eo * 2) = v2;
                *(LAS u32x2*)(lds + RQ_KD + eo * 2) = (u32x2){cvtpk(kd[0], kd[1]), cvtpk(kd[2], kd[3])};
                *(LAS u32x2*)(lds + RQ_A + eo * 2) = (u32x2){cvtpk(-kk[0], -kk[1]), cvtpk(-kk[2], -kk[3])};
                *(LAS u32x2*)(lds + RQ_B + eo * 2) = (u32x2){cvtpk(kb[0], kb[1]), cvtpk(kb[2], kb[3])};
                ss = red4(ss); bon = red4(bon);
                if (g == 0) { *(LAS float*)(lds + RQ_SSP + (c16 * 4 + pw) * 4) = ss; *(LAS float*)(lds + RQ_BNP + (c16 * 4 + pw) * 4) = bon; }
                rwkv_dma(p.ws, lds, wg, pw, lane, n + 4);
                RQD_END(1)
            }
        } else if (has_c) {
            RQD_BEGIN(2)
            if (cc == 0) {
                const unsigned sb = (unsigned)((((uc.b * 2 + uc.dir) * 32 + uc.head) * 64 + pw * 16 + c16) * 64 + 4 * g);
#pragma unroll
                for (int jb = 0; jb < 4; ++jb) Sacc[jb] = (f32x4){0.f, 0.f, 0.f, 0.f};
                if (uc.lat) {
#pragma unroll
                    for (int jb = 0; jb < 4; ++jb) Sacc[jb] = *(const f32x4*)((const char*)srw + (sb + 16 * jb) * 4u); }
                __builtin_amdgcn_s_waitcnt(0x0F70);
            }
            bf16x8 sfr[2];
#pragma unroll
            for (int ks = 0; ks < 2; ++ks) { u32x4 s4; s4.x = cvtpk(Sacc[2 * ks][0], Sacc[2 * ks][1]); s4.y = cvtpk(Sacc[2 * ks][2], Sacc[2 * ks][3]);
                s4.z = cvtpk(Sacc[2 * ks + 1][0], Sacc[2 * ks + 1][1]); s4.w = cvtpk(Sacc[2 * ks + 1][2], Sacc[2 * ks + 1][3]); sfr[ks] = __builtin_bit_cast(bf16x8, s4); }
            { const LAS bf16_t* vp = (const LAS bf16_t*)(bufc + RB2_V); const int vi_ = 16 * pw + c16, vt_ = 4 * g;
              const unsigned v0 = vp[rw_sw(vt_, vi_)], v1 = vp[rw_sw(vt_ + 1, vi_)], v2 = vp[rw_sw(vt_ + 2, vi_)], v3 = vp[rw_sw(vt_ + 3, vi_)]; vfr = mk_frag((u32x2){v0 | (v1 << 16), v2 | (v3 << 16)}, zz); }
            f32x4 mx[12], md[3];
#pragma unroll
            for (int s1 = 0; s1 < 12; ++s1) mx[s1] = *(const LAS f32x4*)(bufc + RB2_MAB + s1 * RC_MS + g * 16);
#pragma unroll
            for (int e = 0; e < 3; ++e) md[e] = *(const LAS f32x4*)(bufc + RB2_MD + (4 * g + e) * 16);
            f32x4 xt = (f32x4){0.f, 0.f, 0.f, 0.f};
#pragma unroll
            for (int ks = 0; ks < 2; ++ks) {
                const LAS unsigned char* ap = bufc + RB2_AT + c16 * RC_TT + (32 * ks + 4 * g) * 2; const LAS unsigned char* rp = bufc + RB2_RT + c16 * RC_TT + (32 * ks + 4 * g) * 2;
                xt = __builtin_amdgcn_mfma_f32_16x16x32_bf16(mk_frag(*(const LAS u32x2*)ap, *(const LAS u32x2*)(ap + 32)), sfr[ks], xt, 0, 0, 0);
                yt = __builtin_amdgcn_mfma_f32_16x16x32_bf16(mk_frag(*(const LAS u32x2*)rp, *(const LAS u32x2*)(rp + 32)), sfr[ks], yt, 0, 0, 0); }
            xt = __builtin_amdgcn_mfma_f32_16x16x32_bf16(mk_frag(*(const LAS u32x2*)(bufc + RB2_MAK + c16 * RC_NS + g * 8), zz), vfr, xt, 0, 0, 0);
            yt = __builtin_amdgcn_mfma_f32_16x16x32_bf16(mk_frag(*(const LAS u32x2*)(bufc + RB2_NKR + c16 * RC_NS + g * 8), zz), vfr, yt, 0, 0, 0);
            float x[4] = {xt[0], xt[1], xt[2], xt[3]};
#pragma unroll
            for (int h = 0; h < 4; ++h) {
                if (g == h) { x[1] += x[0] * md[0][1]; x[2] += x[0] * md[0][2]; x[3] += x[0] * md[0][3]; x[2] += x[1] * md[1][2]; x[3] += x[1] * md[1][3]; x[3] += x[2] * md[2][3]; }
                if (h < 3) { float ub[4];
#pragma unroll
                    for (int e = 0; e < 4; ++e) { const unsigned xv = __float_as_uint(x[e]);
                        if (h == 2) { const auto r1 = __builtin_amdgcn_permlane16_swap(xv, xv, false, false); ub[e] = __uint_as_float(r1[0]); }
                        else { const auto r0 = __builtin_amdgcn_permlane32_swap(xv, xv, false, false); const auto r1 = __builtin_amdgcn_permlane16_swap(r0[0], r0[0], false, false); ub[e] = __uint_as_float(r1[h]); } }
#pragma unroll
                    for (int e2 = 0; e2 < 4; ++e2)
#pragma unroll
                        for (int e = 0; e < 4; ++e) x[e] += ub[e2] * mx[4 * h + e2][e]; } }
            ufr = mk_frag((u32x2){cvtpk(x[0], x[1]), cvtpk(x[2], x[3])}, zz);
            RQD_END(2)
        }
        RQ_BAR();
        if (producer) {
            if (has_p) {
                RQD_BEGIN(3)
                int ln = lane; asm volatile("" : "+v"(ln));
                float wv[16], ow[4], bt[4], kt[4]; unsigned ra[4], rb[4], rk[4], rr[4]; f32x4 ssp[4];
#pragma unroll
                for (int t1 = 0; t1 < 16; ++t1) wv[t1] = *(const LAS float*)(lds + RQ_W + rw_sw(t1, ln) * 4);
#pragma unroll
                for (int e = 0; e < 4; ++e) { const unsigned o = (unsigned)rw_sw(4 * pw + e, ln); ow[e] = *(const LAS float*)(lds + RQ_W + o * 4u);
                    ra[e] = *(const LAS bf16_t*)(lds + RQ_A + o * 2u); rb[e] = *(const LAS bf16_t*)(lds + RQ_B + o * 2u); rk[e] = *(const LAS bf16_t*)(lds + RQ_KD + o * 2u); rr[e] = *(const LAS bf16_t*)(lds + RQ_R + o * 2u);
                    ssp[e] = *(const LAS f32x4*)(lds + RQ_SSP + (4 * pw + e) * 16); }
                const f32x4 bnp = *(const LAS f32x4*)(lds + RQ_BNP + (4 * pw + (ln & 3)) * 16);
                __builtin_amdgcn_sched_barrier(0);
                if (ln < 4) { const int tau = cp * 16 + 4 * pw + ln, t = up.dir ? up.L - 1 - tau : tau; BON[((size_t)up.dir * MTOK + (size_t)(up.base + t)) * 32 + up.head] = (bnp[0] + bnp[1]) + (bnp[2] + bnp[3]); }
                const float p40 = (wv[0] * wv[1]) * (wv[2] * wv[3]), p41 = (wv[4] * wv[5]) * (wv[6] * wv[7]), p42 = (wv[8] * wv[9]) * (wv[10] * wv[11]), p43 = (wv[12] * wv[13]) * (wv[14] * wv[15]);
                const float c01 = p40 * p41, c012 = c01 * p42, gl = c012 * p43;
                float grun = pw == 0 ? 1.f : pw == 1 ? p40 : pw == 2 ? c01 : c012;
#pragma unroll
                for (int e = 0; e < 4; ++e) { const int t1 = 4 * pw + e; const float gprev = grun; grun *= ow[e];
                    const float inv = __builtin_amdgcn_rcpf(fmaxf(__builtin_amdgcn_sqrtf((ssp[e][0] + ssp[e][1]) + (ssp[e][2] + ssp[e][3])), 1e-12f));
                    const float a = __uint_as_float(ra[e] << 16) * inv, bv = __uint_as_float(rb[e] << 16) * inv, kd = __uint_as_float(rk[e] << 16), rv = __uint_as_float(rr[e] << 16);
                    const float ig = __builtin_amdgcn_rcpf(grun); bt[e] = bv * ig; kt[e] = kd * ig;
                    *(LAS bf16_t*)(bufp + RB2_AT + t1 * RC_TT + ln * 2) = f2bf(gprev * a); *(LAS bf16_t*)(bufp + RB2_RT + t1 * RC_TT + ln * 2) = f2bf(grun * rv);
                    *(LAS bf16_t*)(bufp + RB2_BT + t1 * RC_TT + ln * 2) = f2bf(bt[e]); *(LAS bf16_t*)(bufp + RB2_KT + t1 * RC_TT + ln * 2) = f2bf(kt[e]); }
                *(LAS u32x2*)(bufp + RB2_BH + ln * RC_HS + pw * 8) = (u32x2){cvtpk(bt[0] * gl, bt[1] * gl), cvtpk(bt[2] * gl, bt[3] * gl)};
                *(LAS u32x2*)(bufp + RB2_KH + ln * RC_HS + pw * 8) = (u32x2){cvtpk(kt[0] * gl, kt[1] * gl), cvtpk(kt[2] * gl, kt[3] * gl)};
                if (pw == 0) *(LAS float*)(bufp + RB2_GL + ln * 4) = gl;
                RQD_END(3)
            }
        } else if (has_c) {
            RQD_BEGIN(4)
            yt = __builtin_amdgcn_mfma_f32_16x16x32_bf16(mk_frag(*(const LAS u32x2*)(bufc + RB2_NBR + c16 * RC_NS + g * 8), zz), ufr, yt, 0, 0, 0);
#pragma unroll
            for (int r = 0; r < 4; ++r) *(LAS bf16_t*)(lds + RQ_YO + (4 * g + r) * 128 + (16 * pw + c16) * 2) = f2bf_rne(yt[r]);
#pragma unroll
            for (int jb = 0; jb < 4; ++jb) { const f32x4 gl4 = *(const LAS f32x4*)(bufc + RB2_GL + (16 * jb + 4 * g) * 4); Sacc[jb] = Sacc[jb] * gl4;
                Sacc[jb] = __builtin_amdgcn_mfma_f32_16x16x32_bf16(mk_frag(*(const LAS u32x2*)(bufc + RB2_BH + (16 * jb + c16) * RC_HS + g * 8), zz), ufr, Sacc[jb], 0, 0, 0);
                Sacc[jb] = __builtin_amdgcn_mfma_f32_16x16x32_bf16(mk_frag(*(const LAS u32x2*)(bufc + RB2_KH + (16 * jb + c16) * RC_HS + g * 8), zz), vfr, Sacc[jb], 0, 0, 0); }
            if (cc == nchc - 1 && !uc.lat) { const unsigned sb = (unsigned)((((uc.b * 2 + uc.dir) * 32 + uc.head) * 64 + pw * 16 + c16) * 64 + 4 * g);
#pragma unroll
                for (int jb = 0; jb < 4; ++jb) *(f32x4*)((char*)p.out + ((unsigned)OUT_RWKV + sb + 16 * jb) * 4u) = Sacc[jb]; }
            RQD_END(4)
        }
        RQ_BAR();
        if (producer) {
            if (has_p) {
                RQD_BEGIN(5)
                const int xo = (pw & 1) ? RB2_KT : RB2_BT, yo = (pw & 2) ? RB2_RT : RB2_AT;
                f32x4 mm = (f32x4){0.f, 0.f, 0.f, 0.f};
#pragma unroll
                for (int ks = 0; ks < 2; ++ks) { const bf16x8 xf = *(const LAS bf16x8*)(bufp + xo + c16 * RC_TT + (32 * ks + 8 * g) * 2), yf = *(const LAS bf16x8*)(bufp + yo + c16 * RC_TT + (32 * ks + 8 * g) * 2);
                    mm = __builtin_amdgcn_mfma_f32_16x16x32_bf16(xf, yf, mm, 0, 0, 0); }
#pragma unroll
                for (int r = 0; r < 4; ++r) { const int s_ = 4 * g + r; const bool keep = (pw & 2) ? (s_ <= c16) : (s_ < c16); mm[r] = keep ? mm[r] : 0.f; }
                if (pw == 0) {
                    const int tb = c16 >> 2;
#pragma unroll
                    for (int r = 0; r < 4; ++r) *(LAS float*)(bufp + RB2_MAB + (4 * g + r) * RC_MS + c16 * 4) = g < tb ? mm[r] : 0.f;
                    if (g == tb) {
#pragma unroll
                        for (int r = 0; r < 4; ++r) *(LAS float*)(bufp + RB2_MD + (4 * g + r) * 16 + (c16 & 3) * 4) = mm[r]; } }
                else { u32x2 w; w.x = cvtpk(mm[0], mm[1]); w.y = cvtpk(mm[2], mm[3]); *(LAS u32x2*)(bufp + (pw == 1 ? RB2_MAK : pw == 2 ? RB2_NBR : RB2_NKR) + c16 * RC_NS + g * 8) = w; }
                RQD_END(5)
            }
        } else if (has_c && htid < 128) {
            const int tok = htid >> 3, c8 = (htid & 7) * 8, tau = cc * 16 + tok, t = uc.dir ? uc.L - 1 - tau : tau; const size_t row = (size_t)(uc.base + t);
            *(u32x4*)(YD + (size_t)uc.dir * MTOK * DM + row * DM + uc.head * 64 + c8) = *(const LAS u32x4*)(lds + RQ_YO + tok * 128 + c8 * 2);
        }
        if (producer) asm volatile("s_waitcnt vmcnt(9)" ::: "memory");
        RQ_BAR();
    }
}

#ifndef RQ3_DELAY
#define RQ3_DELAY 0
#endif
#define RQ3D_BEGIN(S) unsigned long long rq3_t0_##S = 0; if (RQ3_DELAY == S) rq3_t0_##S = clock64();
#define RQ3D_END(S) if (RQ3_DELAY == S) { asm volatile("s_waitcnt lgkmcnt(0)" ::: "memory"); const unsigned long long t1_ = clock64(), d_ = t1_ - rq3_t0_##S; while ((unsigned long long)clock64() - t1_ < d_) { } }
__device__ __forceinline__ void p9_rwkv_pipe3(const Params& p, LAS unsigned char* lds) {
    const int tid = tidx(), half = __builtin_amdgcn_readfirstlane(tid >> 8), htid = tid & 255, pw = __builtin_amdgcn_readfirstlane((tid >> 6) & 3), lane = tid & 63, c16 = lane & 15, g = lane >> 4, wg = blockIdx.x;
    const bool producer = half == 1;
    const bf16_t* W2T = (const bf16_t*)(p.ws + WS_W2T); const bf16_t* A2T = (const bf16_t*)(p.ws + WS_A2T);
    float* BON = (float*)(p.ws + WS_BON); bf16_t* YD = (bf16_t*)(p.out + OUT_Y);
    const float* w0p = pin(p, I_W0); const float* a0p = pin(p, I_A0); const float* kkp = pin(p, I_KK); const float* kap = pin(p, I_KA); const float* rkp = pin(p, I_RK); const float* srw = pin(p, I_SRWKV);
    constexpr int NCH = 256 + 4 * 16;
    const u32x2 zz = (u32x2){0u, 0u};
    f32x4 Sacc[4];
#pragma unroll
    for (int jb = 0; jb < 4; ++jb) Sacc[jb] = (f32x4){0.f, 0.f, 0.f, 0.f};
    if (producer) { rwkv_dma(p.ws, lds, wg, pw, lane, 0); rwkv_dma(p.ws, lds, wg, pw, lane, 1); rwkv_dma(p.ws, lds, wg, pw, lane, 2); rwkv_dma(p.ws, lds, wg, pw, lane, 3);
        { RwkvUnit UT; int c0, n0; rwkv_unit_of(0, wg, UT, c0, n0);
                for (int i = htid; i < 768; i += 256) { const int ch = i / 12, pc = i % 12; const size_t go = ((size_t)(UT.dir * 2048 + UT.head * 64 + ch) * 96 + pc * 8);
                    *(LAS u32x4*)(lds + RQ_W2 + ch * RC_TS + pc * 16) = *(const u32x4*)(W2T + go); *(LAS u32x4*)(lds + RQ_A2 + ch * RC_TS + pc * 16) = *(const u32x4*)(A2T + go); }
                if (htid < 64) { LAS float* cst = (LAS float*)(lds + RQ_CST); const int c = UT.head * 64 + htid;
                    cst[htid] = w0p[UT.dir * 2048 + c]; cst[64 + htid] = a0p[UT.dir * 2048 + c]; cst[128 + htid] = kkp[c]; cst[192 + htid] = kap[c]; cst[256 + htid] = rkp[c]; } }
        asm volatile("s_waitcnt vmcnt(0)" ::: "memory"); }
    RQ_BAR();
    if (producer) { const int ca = 0;
                const LAS unsigned char* slot = lds + RQ_RING + (ca & 3) * RQ_SLOT; LAS unsigned char* bufa = lds + (ca & 1) * RB2_SIZE;
                f32x4 dW = (f32x4){0.f, 0.f, 0.f, 0.f}, dA = (f32x4){0.f, 0.f, 0.f, 0.f};
#pragma unroll
                for (int ks = 0; ks < 3; ++ks) { const pg8::bf16x8 wf = *(const LAS pg8::bf16x8*)(lds + RQ_W2 + (16 * pw + c16) * RC_TS + (32 * ks + 8 * g) * 2), af = *(const LAS pg8::bf16x8*)(lds + RQ_A2 + (16 * pw + c16) * RC_TS + (32 * ks + 8 * g) * 2);
                    const pg8::bf16x8 tw = *(const LAS pg8::bf16x8*)(slot + c16 * 192 + (32 * ks + 8 * g) * 2), ta = *(const LAS pg8::bf16x8*)(slot + 3072 + c16 * 192 + (32 * ks + 8 * g) * 2);
                    dW = __builtin_amdgcn_mfma_f32_16x16x32_bf16(wf, tw, dW, 0, 0, 0); dA = __builtin_amdgcn_mfma_f32_16x16x32_bf16(af, ta, dA, 0, 0, 0); }
                const int rko = (c16 * 8 + ((2 * pw + (g >> 1)) ^ (c16 & 7))) * 16 + (g & 1) * 8;
                const u32x2 r2 = *(const LAS u32x2*)(slot + 6144 + rko), k2 = *(const LAS u32x2*)(slot + 8192 + rko), v2 = *(const LAS u32x2*)(slot + 10240 + rko); const LAS float* cst = (const LAS float*)(lds + RQ_CST) + 16 * pw + 4 * g;
                const f32x4 w0 = *(const LAS f32x4*)cst, a0 = *(const LAS f32x4*)(cst + 64), kkw = *(const LAS f32x4*)(cst + 128), kaw = *(const LAS f32x4*)(cst + 192), rkw = *(const LAS f32x4*)(cst + 256);
                const float rr[4] = {bflo(r2.x), bfhi(r2.x), bflo(r2.y), bfhi(r2.y)}, k0[4] = {bflo(k2.x), bfhi(k2.x), bflo(k2.y), bfhi(k2.y)};
                f32x4 oW; float kd[4], kk[4], kb[4], ss = 0.f, bon = 0.f;
#pragma unroll
                for (int j = 0; j < 4; ++j) {
                    const float xw = -(w0[j] + dW[j]);
                    const float sp = fmaxf(xw, 0.f) + 0.6931471806f * __builtin_amdgcn_logf(1.f + __builtin_amdgcn_exp2f(-1.4426950409f * fabsf(xw)));
                    oW[j] = __builtin_amdgcn_exp2f(-1.4426950409f * __builtin_amdgcn_exp2f(-1.4426950409f * (sp + 0.5f)));
                    const float a = __builtin_amdgcn_rcpf(1.f + __builtin_amdgcn_exp2f(-1.4426950409f * (a0[j] + dA[j])));
                    kk[j] = k0[j] * kkw[j]; ss += kk[j] * kk[j]; kb[j] = kk[j] * a;
                    kd[j] = k0[j] * (1.f + (a - 1.f) * kaw[j]); bon += rr[j] * kd[j] * rkw[j]; }
                const int eo = rw_sw(c16, 16 * pw + 4 * g);
                *(LAS f32x4*)(lds + RQ_W + eo * 4) = oW;
                *(LAS u32x2*)(lds + RQ_R + eo * 2) = r2; *(LAS u32x2*)(bufa + RB2_V + eo * 2) = v2;
                *(LAS u32x2*)(lds + RQ_KD + eo * 2) = (u32x2){cvtpk(kd[0], kd[1]), cvtpk(kd[2], kd[3])};
                *(LAS u32x2*)(lds + RQ_A + eo * 2) = (u32x2){cvtpk(-kk[0], -kk[1]), cvtpk(-kk[2], -kk[3])};
                *(LAS u32x2*)(lds + RQ_B + eo * 2) = (u32x2){cvtpk(kb[0], kb[1]), cvtpk(kb[2], kb[3])};
                ss = red4(ss); bon = red4(bon);
                if (g == 0) { *(LAS float*)(lds + RQ_SSP + (c16 * 4 + pw) * 4) = ss; *(LAS float*)(lds + RQ_BNP + (c16 * 4 + pw) * 4) = bon; }
    }
    RQ_BAR();
    for (int n = -1; n <= NCH; ++n) {
        const bool has_p = n + 1 < NCH, has_a = n + 2 < NCH, has_c = n >= 0 && n < NCH, has_w = n >= 1;
        RwkvUnit up, uc, ua, uw; int cp = 0, nchp = 0, cc = 0, nchc = 0, cia = 1, ncha = 0, cw = 0, nchw = 0;
        if (has_p) rwkv_unit_of(n + 1, wg, up, cp, nchp);
        if (has_c) rwkv_unit_of(n, wg, uc, cc, nchc);
        if (has_a) rwkv_unit_of(n + 2, wg, ua, cia, ncha);
        if (has_w) rwkv_unit_of(n - 1, wg, uw, cw, nchw);
        LAS unsigned char* bufp = lds + ((n + 1) & 1) * RB2_SIZE; LAS unsigned char* bufc = lds + (n & 1) * RB2_SIZE;
        bf16x8 ufr = __builtin_bit_cast(bf16x8, (u32x4){0u, 0u, 0u, 0u}), vfr = ufr; f32x4 yt = (f32x4){0.f, 0.f, 0.f, 0.f};
        if (producer) {
            if (has_p) {
                RQ3D_BEGIN(1)
                                const int ln = lane;
                float wv[16], ow[4], bt[4], kt[4]; unsigned ra[4], rb[4], rk[4], rr[4]; f32x4 ssp[4];
#pragma unroll
                for (int t1 = 0; t1 < 16; ++t1) wv[t1] = *(const LAS float*)(lds + RQ_W + rw_sw(t1, ln) * 4);
#pragma unroll
                for (int e = 0; e < 4; ++e) { const unsigned o = (unsigned)rw_sw(4 * pw + e, ln); ow[e] = *(const LAS float*)(lds + RQ_W + o * 4u);
                    ra[e] = *(const LAS bf16_t*)(lds + RQ_A + o * 2u); rb[e] = *(const LAS bf16_t*)(lds + RQ_B + o * 2u); rk[e] = *(const LAS bf16_t*)(lds + RQ_KD + o * 2u); rr[e] = *(const LAS bf16_t*)(lds + RQ_R + o * 2u);
                    ssp[e] = *(const LAS f32x4*)(lds + RQ_SSP + (4 * pw + e) * 16); }
                const f32x4 bnp = *(const LAS f32x4*)(lds + RQ_BNP + (4 * pw + (ln & 3)) * 16);
                __builtin_amdgcn_sched_barrier(0);
                if (ln < 4) { const int tau = cp * 16 + 4 * pw + ln, t = up.dir ? up.L - 1 - tau : tau; BON[((size_t)up.dir * MTOK + (size_t)(up.base + t)) * 32 + up.head] = (bnp[0] + bnp[1]) + (bnp[2] + bnp[3]); }
                const float p40 = (wv[0] * wv[1]) * (wv[2] * wv[3]), p41 = (wv[4] * wv[5]) * (wv[6] * wv[7]), p42 = (wv[8] * wv[9]) * (wv[10] * wv[11]), p43 = (wv[12] * wv[13]) * (wv[14] * wv[15]);
                const float c01 = p40 * p41, c012 = c01 * p42, gl = c012 * p43;
                float grun = pw == 0 ? 1.f : pw == 1 ? p40 : pw == 2 ? c01 : c012;
#pragma unroll
                for (int e = 0; e < 4; ++e) { const int t1 = 4 * pw + e; const float gprev = grun; grun *= ow[e];
                    const float inv = __builtin_amdgcn_rcpf(fmaxf(__builtin_amdgcn_sqrtf((ssp[e][0] + ssp[e][1]) + (ssp[e][2] + ssp[e][3])), 1e-12f));
                    const float a = __uint_as_float(ra[e] << 16) * inv, bv = __uint_as_float(rb[e] << 16) * inv, kd = __uint_as_float(rk[e] << 16), rv = __uint_as_float(rr[e] << 16);
                    const float ig = __builtin_amdgcn_rcpf(grun); bt[e] = bv * ig; kt[e] = kd * ig;
                    *(LAS bf16_t*)(bufp + RB2_AT + t1 * RC_TT + ln * 2) = f2bf(gprev * a); *(LAS bf16_t*)(bufp + RB2_RT + t1 * RC_TT + ln * 2) = f2bf(grun * rv);
                    *(LAS bf16_t*)(bufp + RB2_BT + t1 * RC_TT + ln * 2) = f2bf(bt[e]); *(LAS bf16_t*)(bufp + RB2_KT + t1 * RC_TT + ln * 2) = f2bf(kt[e]); }
                *(LAS u32x2*)(bufp + RB2_BH + ln * RC_HS + pw * 8) = (u32x2){cvtpk(bt[0] * gl, bt[1] * gl), cvtpk(bt[2] * gl, bt[3] * gl)};
                *(LAS u32x2*)(bufp + RB2_KH + ln * RC_HS + pw * 8) = (u32x2){cvtpk(kt[0] * gl, kt[1] * gl), cvtpk(kt[2] * gl, kt[3] * gl)};
                if (pw == 0) *(LAS float*)(bufp + RB2_GL + ln * 4) = gl;
                RQ3D_END(1)
            }
        } else {
            RQ3D_BEGIN(2)
            if (has_w && htid < 128) {
                const int tok = htid >> 3, c8 = (htid & 7) * 8, tau = cw * 16 + tok, t = uw.dir ? uw.L - 1 - tau : tau; const size_t row = (size_t)(uw.base + t);
                *(u32x4*)(YD + (size_t)uw.dir * MTOK * DM + row * DM + uw.head * 64 + c8) = *(const LAS u32x4*)(lds + RQ_YO + tok * 128 + c8 * 2); }
            if (has_c) {
            if (cc == 0) {
                const unsigned sb = (unsigned)((((uc.b * 2 + uc.dir) * 32 + uc.head) * 64 + pw * 16 + c16) * 64 + 4 * g);
#pragma unroll
                for (int jb = 0; jb < 4; ++jb) Sacc[jb] = (f32x4){0.f, 0.f, 0.f, 0.f};
                if (uc.lat) {
#pragma unroll
                    for (int jb = 0; jb < 4; ++jb) Sacc[jb] = *(const f32x4*)((const char*)srw + (sb + 16 * jb) * 4u); }
                __builtin_amdgcn_s_waitcnt(0x0F70);
            }
            bf16x8 sfr[2];
#pragma unroll
            for (int ks = 0; ks < 2; ++ks) { u32x4 s4; s4.x = cvtpk(Sacc[2 * ks][0], Sacc[2 * ks][1]); s4.y = cvtpk(Sacc[2 * ks][2], Sacc[2 * ks][3]);
                s4.z = cvtpk(Sacc[2 * ks + 1][0], Sacc[2 * ks + 1][1]); s4.w = cvtpk(Sacc[2 * ks + 1][2], Sacc[2 * ks + 1][3]); sfr[ks] = __builtin_bit_cast(bf16x8, s4); }
            { const LAS bf16_t* vp = (const LAS bf16_t*)(bufc + RB2_V); const int vi_ = 16 * pw + c16, vt_ = 4 * g;
              const unsigned v0 = vp[rw_sw(vt_, vi_)], v1 = vp[rw_sw(vt_ + 1, vi_)], v2 = vp[rw_sw(vt_ + 2, vi_)], v3 = vp[rw_sw(vt_ + 3, vi_)]; vfr = mk_frag((u32x2){v0 | (v1 << 16), v2 | (v3 << 16)}, zz); }
            f32x4 mx[12], md[3];
#pragma unroll
            for (int s1 = 0; s1 < 12; ++s1) mx[s1] = *(const LAS f32x4*)(bufc + RB2_MAB + s1 * RC_MS + g * 16);
#pragma unroll
            for (int e = 0; e < 3; ++e) md[e] = *(const LAS f32x4*)(bufc + RB2_MD + (4 * g + e) * 16);
            f32x4 xt = (f32x4){0.f, 0.f, 0.f, 0.f};
#pragma unroll
            for (int ks = 0; ks < 2; ++ks) {
                const LAS unsigned char* ap = bufc + RB2_AT + c16 * RC_TT + (32 * ks + 4 * g) * 2; const LAS unsigned char* rp = bufc + RB2_RT + c16 * RC_TT + (32 * ks + 4 * g) * 2;
                xt = __builtin_amdgcn_mfma_f32_16x16x32_bf16(mk_frag(*(const LAS u32x2*)ap, *(const LAS u32x2*)(ap + 32)), sfr[ks], xt, 0, 0, 0);
                yt = __builtin_amdgcn_mfma_f32_16x16x32_bf16(mk_frag(*(const LAS u32x2*)rp, *(const LAS u32x2*)(rp + 32)), sfr[ks], yt, 0, 0, 0); }
            xt = __builtin_amdgcn_mfma_f32_16x16x32_bf16(mk_frag(*(const LAS u32x2*)(bufc + RB2_MAK + c16 * RC_NS + g * 8), zz), vfr, xt, 0, 0, 0);
            yt = __builtin_amdgcn_mfma_f32_16x16x32_bf16(mk_frag(*(const LAS u32x2*)(bufc + RB2_NKR + c16 * RC_NS + g * 8), zz), vfr, yt, 0, 0, 0);
            float x[4] = {xt[0], xt[1], xt[2], xt[3]};
#pragma unroll
            for (int h = 0; h < 4; ++h) {
                if (g == h) { x[1] += x[0] * md[0][1]; x[2] += x[0] * md[0][2]; x[3] += x[0] * md[0][3]; x[2] += x[1] * md[1][2]; x[3] += x[1] * md[1][3]; x[3] += x[2] * md[2][3]; }
                if (h < 3) { float ub[4];
#pragma unroll
                    for (int e = 0; e < 4; ++e) { const unsigned xv = __float_as_uint(x[e]);
                        if (h == 2) { const auto r1 = __builtin_amdgcn_permlane16_swap(xv, xv, false, false); ub[e] = __uint_as_float(r1[0]); }
                        else { const auto r0 = __builtin_amdgcn_permlane32_swap(xv, xv, false, false); const auto r1 = __builtin_amdgcn_permlane16_swap(r0[0], r0[0], false, false); ub[e] = __uint_as_float(r1[h]); } }
#pragma unroll
                    for (int e2 = 0; e2 < 4; ++e2)
#pragma unroll
                        for (int e = 0; e < 4; ++e) x[e] += ub[e2] * mx[4 * h + e2][e]; } }
            ufr = mk_frag((u32x2){cvtpk(x[0], x[1]), cvtpk(x[2], x[3])}, zz);
            }
            RQ3D_END(2)
        }
        RQ_BAR();
        if (has_a && cia == 0) {
            if (producer) { const RwkvUnit UT = ua;
                for (int i = htid; i < 768; i += 256) { const int ch = i / 12, pc = i % 12; const size_t go = ((size_t)(UT.dir * 2048 + UT.head * 64 + ch) * 96 + pc * 8);
                    *(LAS u32x4*)(lds + RQ_W2 + ch * RC_TS + pc * 16) = *(const u32x4*)(W2T + go); *(LAS u32x4*)(lds + RQ_A2 + ch * RC_TS + pc * 16) = *(const u32x4*)(A2T + go); }
                if (htid < 64) { LAS float* cst = (LAS float*)(lds + RQ_CST); const int c = UT.head * 64 + htid;
                    cst[htid] = w0p[UT.dir * 2048 + c]; cst[64 + htid] = a0p[UT.dir * 2048 + c]; cst[128 + htid] = kkp[c]; cst[192 + htid] = kap[c]; cst[256 + htid] = rkp[c]; } }
            RQ_BAR();
        }
        if (producer) {
            RQ3D_BEGIN(3)
            if (has_p) {
                const int xo = (pw & 1) ? RB2_KT : RB2_BT, yo = (pw & 2) ? RB2_RT : RB2_AT;
                f32x4 mm = (f32x4){0.f, 0.f, 0.f, 0.f};
#pragma unroll
                for (int ks = 0; ks < 2; ++ks) { const bf16x8 xf = *(const LAS bf16x8*)(bufp + xo + c16 * RC_TT + (32 * ks + 8 * g) * 2), yf = *(const LAS bf16x8*)(bufp + yo + c16 * RC_TT + (32 * ks + 8 * g) * 2);
                    mm = __builtin_amdgcn_mfma_f32_16x16x32_bf16(xf, yf, mm, 0, 0, 0); }
#pragma unroll
                for (int r = 0; r < 4; ++r) { const int s_ = 4 * g + r; const bool keep = (pw & 2) ? (s_ <= c16) : (s_ < c16); mm[r] = keep ? mm[r] : 0.f; }
                if (pw == 0) {
                    const int tb = c16 >> 2;
#pragma unroll
                    for (int r = 0; r < 4; ++r) *(LAS float*)(bufp + RB2_MAB + (4 * g + r) * RC_MS + c16 * 4) = g < tb ? mm[r] : 0.f;
                    if (g == tb) {
#pragma unroll
                        for (int r = 0; r < 4; ++r) *(LAS float*)(bufp + RB2_MD + (4 * g + r) * 16 + (c16 & 3) * 4) = mm[r]; } }
                else { u32x2 w; w.x = cvtpk(mm[0], mm[1]); w.y = cvtpk(mm[2], mm[3]); *(LAS u32x2*)(bufp + (pw == 1 ? RB2_MAK : pw == 2 ? RB2_NBR : RB2_NKR) + c16 * RC_NS + g * 8) = w; }
            }
            if (has_a) { const int ca = n + 2;
                const LAS unsigned char* slot = lds + RQ_RING + (ca & 3) * RQ_SLOT; LAS unsigned char* bufa = lds + (ca & 1) * RB2_SIZE;
                f32x4 dW = (f32x4){0.f, 0.f, 0.f, 0.f}, dA = (f32x4){0.f, 0.f, 0.f, 0.f};
#pragma unroll
                for (int ks = 0; ks < 3; ++ks) { const pg8::bf16x8 wf = *(const LAS pg8::bf16x8*)(lds + RQ_W2 + (16 * pw + c16) * RC_TS + (32 * ks + 8 * g) * 2), af = *(const LAS pg8::bf16x8*)(lds + RQ_A2 + (16 * pw + c16) * RC_TS + (32 * ks + 8 * g) * 2);
                    const pg8::bf16x8 tw = *(const LAS pg8::bf16x8*)(slot + c16 * 192 + (32 * ks + 8 * g) * 2), ta = *(const LAS pg8::bf16x8*)(slot + 3072 + c16 * 192 + (32 * ks + 8 * g) * 2);
                    dW = __builtin_amdgcn_mfma_f32_16x16x32_bf16(wf, tw, dW, 0, 0, 0); dA = __builtin_amdgcn_mfma_f32_16x16x32_bf16(af, ta, dA, 0, 0, 0); }
                const int rko = (c16 * 8 + ((2 * pw + (g >> 1)) ^ (c16 & 7))) * 16 + (g & 1) * 8;
                const u32x2 r2 = *(const LAS u32x2*)(slot + 6144 + rko), k2 = *(const LAS u32x2*)(slot + 8192 + rko), v2 = *(const LAS u32x2*)(slot + 10240 + rko); const LAS float* cst = (const LAS float*)(lds + RQ_CST) + 16 * pw + 4 * g;
                const f32x4 w0 = *(const LAS f32x4*)cst, a0 = *(const LAS f32x4*)(cst + 64), kkw = *(const LAS f32x4*)(cst + 128), kaw = *(const LAS f32x4*)(cst + 192), rkw = *(const LAS f32x4*)(cst + 256);
                const float rr[4] = {bflo(r2.x), bfhi(r2.x), bflo(r2.y), bfhi(r2.y)}, k0[4] = {bflo(k2.x), bfhi(k2.x), bflo(k2.y), bfhi(k2.y)};
                f32x4 oW; float kd[4], kk[4], kb[4], ss = 0.f, bon = 0.f;
#pragma unroll
                for (int j = 0; j < 4; ++j) {
                    const float xw = -(w0[j] + dW[j]);
                    const float sp = fmaxf(xw, 0.f) + 0.6931471806f * __builtin_amdgcn_logf(1.f + __builtin_amdgcn_exp2f(-1.4426950409f * fabsf(xw)));
                    oW[j] = __builtin_amdgcn_exp2f(-1.4426950409f * __builtin_amdgcn_exp2f(-1.4426950409f * (sp + 0.5f)));
                    const float a = __builtin_amdgcn_rcpf(1.f + __builtin_amdgcn_exp2f(-1.4426950409f * (a0[j] + dA[j])));
                    kk[j] = k0[j] * kkw[j]; ss += kk[j] * kk[j]; kb[j] = kk[j] * a;
                    kd[j] = k0[j] * (1.f + (a - 1.f) * kaw[j]); bon += rr[j] * kd[j] * rkw[j]; }
                const int eo = rw_sw(c16, 16 * pw + 4 * g);
                *(LAS f32x4*)(lds + RQ_W + eo * 4) = oW;
                *(LAS u32x2*)(lds + RQ_R + eo * 2) = r2; *(LAS u32x2*)(bufa + RB2_V + eo * 2) = v2;
                *(LAS u32x2*)(lds + RQ_KD + eo * 2) = (u32x2){cvtpk(kd[0], kd[1]), cvtpk(kd[2], kd[3])};
                *(LAS u32x2*)(lds + RQ_A + eo * 2) = (u32x2){cvtpk(-kk[0], -kk[1]), cvtpk(-kk[2], -kk[3])};
                *(LAS u32x2*)(lds + RQ_B + eo * 2) = (u32x2){cvtpk(kb[0], kb[1]), cvtpk(kb[2], kb[3])};
                ss = red4(ss); bon = red4(bon);
                if (g == 0) { *(LAS float*)(lds + RQ_SSP + (c16 * 4 + pw) * 4) = ss; *(LAS float*)(lds + RQ_BNP + (c16 * 4 + pw) * 4) = bon; }
            }
            rwkv_dma(p.ws, lds, wg, pw, lane, n + 5);
            RQ3D_END(3)
            asm volatile("s_waitcnt vmcnt(8)" ::: "memory");
        } else if (has_c) {
            RQ3D_BEGIN(4)
            yt = __builtin_amdgcn_mfma_f32_16x16x32_bf16(mk_frag(*(const LAS u32x2*)(bufc + RB2_NBR + c16 * RC_NS + g * 8), zz), ufr, yt, 0, 0, 0);
#pragma unroll
            for (int r = 0; r < 4; ++r) *(LAS bf16_t*)(lds + RQ_YO + (4 * g + r) * 128 + (16 * pw + c16) * 2) = f2bf_rne(yt[r]);
#pragma unroll
            for (int jb = 0; jb < 4; ++jb) { const f32x4 gl4 = *(const LAS f32x4*)(bufc + RB2_GL + (16 * jb + 4 * g) * 4); Sacc[jb] = Sacc[jb] * gl4;
                Sacc[jb] = __builtin_amdgcn_mfma_f32_16x16x32_bf16(mk_frag(*(const LAS u32x2*)(bufc + RB2_BH + (16 * jb + c16) * RC_HS + g * 8), zz), ufr, Sacc[jb], 0, 0, 0);
                Sacc[jb] = __builtin_amdgcn_mfma_f32_16x16x32_bf16(mk_frag(*(const LAS u32x2*)(bufc + RB2_KH + (16 * jb + c16) * RC_HS + g * 8), zz), vfr, Sacc[jb], 0, 0, 0); }
            if (cc == nchc - 1 && !uc.lat) { const unsigned sb = (unsigned)((((uc.b * 2 + uc.dir) * 32 + uc.head) * 64 + pw * 16 + c16) * 64 + 4 * g);
#pragma unroll
                for (int jb = 0; jb < 4; ++jb) *(f32x4*)((char*)p.out + ((unsigned)OUT_RWKV + sb + 16 * jb) * 4u) = Sacc[jb]; }
            RQ3D_END(4)
        }
        RQ_BAR();
    }
}

constexpr int RS_GL = 0, RS_MAB = 256, RS_MD = 1536, RS_MAK = 1792, RS_NBR = 2432, RS_NKR = 3072, RS_AT = 3712, RS_RT = 6016, RS_BT = 8320, RS_KT = 10624, RS_BH = 12928, RS_KH = 15488, RD_SET = 18048;
constexpr int RD_INV = 2 * RD_SET, RD_SSP = RD_INV + 256, RD_BNP = RD_SSP + 256, RD_YO = RD_BNP + 256, RD_V = RD_YO + 4096, RD_CST = RD_V + 4096, RD_W2 = RD_CST + 1280, RD_A2 = RD_W2 + 13312, RD_HALF = RD_A2 + 13312;
static_assert(2 * RD_HALF <= LDS_BAR_OFF, "RWKV chunk2 LDS map");
template <int N> __device__ __forceinline__ float rw_shr1(float x) { return __int_as_float(__builtin_amdgcn_update_dpp(0x3f800000, __float_as_int(x), 0x110 + N, 0xf, 0xf, false)); }
__device__ __forceinline__ float rw_row15(float x) { return __int_as_float(__builtin_amdgcn_update_dpp(0, __float_as_int(x), 0x15F, 0xf, 0xf, false)); }

#ifndef RD_DELAY
#define RD_DELAY 0
#endif
#define RDD_BEGIN(S) unsigned long long rdd_t0_##S = 0; if (RD_DELAY == S) rdd_t0_##S = clock64();
#define RDD_END(S) if (RD_DELAY == S) { asm volatile("s_waitcnt lgkmcnt(0)" ::: "memory"); const unsigned long long t1_ = clock64(), d_ = t1_ - rdd_t0_##S; while ((unsigned long long)clock64() - t1_ < d_) { } }
__device__ __forceinline__ void p9_rwkv_chunk2(const Params& p, LAS unsigned char* lds) {
    const int tid = tidx(), half = tid >> 8, htid = tid & 255, hw = __builtin_amdgcn_readfirstlane((tid >> 6) & 3), lane = tid & 63, c16 = lane & 15, g = lane >> 4, wg = blockIdx.x, nwg = gridDim.x;
    LAS unsigned char* hl = lds + half * RD_HALF;
    const bf16_t* R = (const bf16_t*)(p.ws + WS_R); const bf16_t* K1 = (const bf16_t*)(p.ws + WS_K1); const bf16_t* V1 = (const bf16_t*)(p.ws + WS_V1); const bf16_t* LR = (const bf16_t*)(p.ws + WS_LR);
    const bf16_t* W2T = (const bf16_t*)(p.ws + WS_W2T); const bf16_t* A2T = (const bf16_t*)(p.ws + WS_A2T);
    float* BON = (float*)(p.ws + WS_BON); bf16_t* YD = (bf16_t*)(p.out + OUT_Y);
    const float* w0p = pin(p, I_W0); const float* a0p = pin(p, I_A0); const float* kkp = pin(p, I_KK); const float* kap = pin(p, I_KA); const float* rkp = pin(p, I_RK); const float* srw = pin(p, I_SRWKV);
    const int nun = half == 0 ? (256 - wg + nwg - 1) / nwg : (1024 - wg + nwg - 1) / nwg;
    const int bpu = half == 0 ? 128 : 8;
    const int my_steps = nun * bpu;
    const int n0 = (256 - wg + nwg - 1) / nwg * 128, n1 = (1024 - wg + nwg - 1) / nwg * 8;
    const int nsteps = n0 > n1 ? n0 : n1;
    f32x4 Sacc[4];
    int base = 0, L = 0, b = 0, head = 0, dir = 0; bool lat = false;
    const int m = c16, q = g;
    const u32x2 zz = (u32x2){0u, 0u};
    pg8::bf16x8 pftw[3], pfta[3]; u32x2 pfr[2], pfk[2], pfv[2];
#define RD_PREFETCH(bk) do { const int tau_ = (bk) * 32 + 16 * (hw & 1) + m, t_ = dir ? L - 1 - tau_ : tau_; const unsigned row_ = (unsigned)(base + t_); \
        _Pragma("unroll") for (int ks = 0; ks < 3; ++ks) { pftw[ks] = *(const pg8::bf16x8*)((const char*)LR + row_ * 768u + (unsigned)(dir * 192 + (32 * ks + 8 * q) * 2)); \
            pfta[ks] = *(const pg8::bf16x8*)((const char*)LR + row_ * 768u + (unsigned)(384 + dir * 192 + (32 * ks + 8 * q) * 2)); } \
        _Pragma("unroll") for (int mi = 0; mi < 2; ++mi) { const unsigned ch_ = (unsigned)(head * 64 + 16 * (2 * (hw >> 1) + mi) + 4 * q); \
            pfr[mi] = *(const u32x2*)((const char*)R + (row_ * 2048u + ch_) * 2u); pfk[mi] = *(const u32x2*)((const char*)K1 + (row_ * 2048u + ch_) * 2u); pfv[mi] = *(const u32x2*)((const char*)V1 + (row_ * 2048u + ch_) * 2u); } } while (0)
    for (int step = 0; step < nsteps; ++step) {
        const bool active = step < my_steps; const int blk = step % bpu;
        if (active && blk == 0) {
            const int un = wg + (step / bpu) * nwg; int s;
            if (half == 0) { s = 16 + (un >> 6); head = (un >> 1) & 31; dir = un & 1; } else { s = un >> 6; head = (un >> 1) & 31; dir = un & 1; }
            seq_info(s, base, L, b, lat);
            for (int i = htid; i < 768; i += 256) { const int ch = i / 12, pc = i % 12; const size_t go = ((size_t)(dir * 2048 + head * 64 + ch) * 96 + pc * 8);
                *(LAS u32x4*)(hl + RD_W2 + ch * RC_TS + pc * 16) = *(const u32x4*)(W2T + go); *(LAS u32x4*)(hl + RD_A2 + ch * RC_TS + pc * 16) = *(const u32x4*)(A2T + go); }
            if (htid < 64) { LAS float* cst = (LAS float*)(hl + RD_CST); const int c = head * 64 + htid;
                cst[htid] = w0p[dir * 2048 + c]; cst[64 + htid] = a0p[dir * 2048 + c]; cst[128 + htid] = kkp[c]; cst[192 + htid] = kap[c]; cst[256 + htid] = rkp[c]; }
            RD_PREFETCH(0);
            const unsigned sb = (unsigned)((((b * 2 + dir) * 32 + head) * 64 + hw * 16 + c16) * 64 + 4 * g);
#pragma unroll
            for (int jb = 0; jb < 4; ++jb) Sacc[jb] = lat ? *(const f32x4*)((const char*)srw + (sb + 16 * jb) * 4u) : (f32x4){0.f, 0.f, 0.f, 0.f};
            __builtin_amdgcn_s_waitcnt(0x0F70);
        }
        __syncthreads();
        RDD_BEGIN(1)
        if (active) {
            const int tok = 16 * (hw & 1) + m, mb0 = 2 * (hw >> 1);
            LAS unsigned char* ts = hl + (hw & 1) * RD_SET;
            f32x4 dW[2], dA[2];
#pragma unroll
            for (int mi = 0; mi < 2; ++mi) { dW[mi] = (f32x4){0.f, 0.f, 0.f, 0.f}; dA[mi] = (f32x4){0.f, 0.f, 0.f, 0.f}; }
#pragma unroll
            for (int ks = 0; ks < 3; ++ks) {
                const pg8::bf16x8 tw = pftw[ks], ta = pfta[ks];
#pragma unroll
                for (int mi = 0; mi < 2; ++mi) { const pg8::bf16x8 wf = *(const LAS pg8::bf16x8*)(hl + RD_W2 + (16 * (mb0 + mi) + m) * RC_TS + (32 * ks + 8 * q) * 2), af = *(const LAS pg8::bf16x8*)(hl + RD_A2 + (16 * (mb0 + mi) + m) * RC_TS + (32 * ks + 8 * q) * 2);
                    dW[mi] = __builtin_amdgcn_mfma_f32_16x16x32_bf16(wf, tw, dW[mi], 0, 0, 0); dA[mi] = __builtin_amdgcn_mfma_f32_16x16x32_bf16(af, ta, dA[mi], 0, 0, 0); } }
            float ss = 0.f, bon = 0.f;
#pragma unroll
            for (int mi = 0; mi < 2; ++mi) { const int mb = mb0 + mi, ch0 = 16 * mb + 4 * q;
                const u32x2 r2 = pfr[mi], k2 = pfk[mi], v2 = pfv[mi]; const LAS float* cst = (const LAS float*)(hl + RD_CST) + ch0;
                const f32x4 w0 = *(const LAS f32x4*)cst, a0 = *(const LAS f32x4*)(cst + 64), kkw = *(const LAS f32x4*)(cst + 128), kaw = *(const LAS f32x4*)(cst + 192), rkw = *(const LAS f32x4*)(cst + 256);
                const float rr[4] = {bflo(r2.x), bfhi(r2.x), bflo(r2.y), bfhi(r2.y)}, k0[4] = {bflo(k2.x), bfhi(k2.x), bflo(k2.y), bfhi(k2.y)};
                float at[4], rt[4], bt[4], kt[4], bh[4], kh[4]; f32x4 g15;
#pragma unroll
                for (int j = 0; j < 4; ++j) {
                    const float wdec = __builtin_amdgcn_exp2f(-0.8750387749f * __builtin_amdgcn_rcpf(1.f + __builtin_amdgcn_exp2f(-1.4426950409f * (w0[j] + dW[mi][j]))));
                    const float a = __builtin_amdgcn_rcpf(1.f + __builtin_amdgcn_exp2f(-1.4426950409f * (a0[j] + dA[mi][j])));
                    const float kk = k0[j] * kkw[j], kb = kk * a, kd = k0[j] * (1.f + (a - 1.f) * kaw[j]);
                    ss += kk * kk; bon += rr[j] * kd * rkw[j];
                    float gi = wdec; gi *= rw_shr1<1>(gi); gi *= rw_shr1<2>(gi); gi *= rw_shr1<4>(gi); gi *= rw_shr1<8>(gi);
                    const float gp = rw_shr1<1>(gi), gl = rw_row15(gi), ig = __builtin_amdgcn_rcpf(gi);
                    at[j] = -kk * gp; rt[j] = rr[j] * gi; bt[j] = kb * ig; kt[j] = kd * ig; bh[j] = bt[j] * gl; kh[j] = kt[j] * gl; g15[j] = gl; }
                *(LAS u32x2*)(ts + RS_AT + m * RC_TT + ch0 * 2) = (u32x2){cvtpk(at[0], at[1]), cvtpk(at[2], at[3])}; *(LAS u32x2*)(ts + RS_RT + m * RC_TT + ch0 * 2) = (u32x2){cvtpk(rt[0], rt[1]), cvtpk(rt[2], rt[3])};
                *(LAS u32x2*)(ts + RS_BT + m * RC_TT + ch0 * 2) = (u32x2){cvtpk(bt[0], bt[1]), cvtpk(bt[2], bt[3])}; *(LAS u32x2*)(ts + RS_KT + m * RC_TT + ch0 * 2) = (u32x2){cvtpk(kt[0], kt[1]), cvtpk(kt[2], kt[3])};
#pragma unroll
                for (int j = 0; j < 4; ++j) { *(LAS bf16_t*)(ts + RS_BH + (ch0 + j) * RC_HS + m * 2) = f2bf(bh[j]); *(LAS bf16_t*)(ts + RS_KH + (ch0 + j) * RC_HS + m * 2) = f2bf(kh[j]); }
                if (m == 15) *(LAS f32x4*)(ts + RS_GL + ch0 * 4) = g15;
                *(LAS u32x2*)(hl + RD_V + rw_sw(tok, ch0) * 2) = v2; }
            ss = red4(ss); bon = red4(bon);
            if (q == 0) { *(LAS float*)(hl + RD_SSP + (tok * 2 + (hw >> 1)) * 4) = ss; *(LAS float*)(hl + RD_BNP + (tok * 2 + (hw >> 1)) * 4) = bon; }
        }
        RDD_END(1)
        __syncthreads();
        if (active && blk + 1 < bpu) RD_PREFETCH(blk + 1);
        RDD_BEGIN(2)
        if (active) {
            const int xo = (hw & 1) ? RS_KT : RS_BT, yo = (hw & 2) ? RS_RT : RS_AT;
#pragma unroll
            for (int c2 = 0; c2 < 2; ++c2) { LAS unsigned char* ts = hl + c2 * RD_SET;
                f32x4 mm = (f32x4){0.f, 0.f, 0.f, 0.f};
#pragma unroll
                for (int ks = 0; ks < 2; ++ks) { const bf16x8 xf = *(const LAS bf16x8*)(ts + xo + c16 * RC_TT + (32 * ks + 8 * g) * 2), yf = *(const LAS bf16x8*)(ts + yo + c16 * RC_TT + (32 * ks + 8 * g) * 2);
                    mm = __builtin_amdgcn_mfma_f32_16x16x32_bf16(xf, yf, mm, 0, 0, 0); }
                const f32x2v st = *(const LAS f32x2v*)(hl + RD_SSP + (16 * c2 + c16) * 8);
                const float invt = __builtin_amdgcn_rcpf(fmaxf(__builtin_amdgcn_sqrtf(st.x + st.y), 1e-12f));
#pragma unroll
                for (int r = 0; r < 4; ++r) { const int s_ = 4 * g + r; const bool keep = (hw & 2) ? (s_ <= c16) : (s_ < c16); mm[r] = keep ? mm[r] : 0.f; }
                if (hw == 0) {
                    const int tb = c16 >> 2;
#pragma unroll
                    for (int r = 0; r < 4; ++r) { const f32x2v sr = *(const LAS f32x2v*)(hl + RD_SSP + (16 * c2 + 4 * g + r) * 8);
                        const float v = mm[r] * invt * __builtin_amdgcn_rcpf(fmaxf(__builtin_amdgcn_sqrtf(sr.x + sr.y), 1e-12f));
                        *(LAS float*)(ts + RS_MAB + (4 * g + r) * RC_MS + c16 * 4) = g < tb ? v : 0.f;
                        if (g == tb) *(LAS float*)(ts + RS_MD + (4 * g + r) * 16 + (c16 & 3) * 4) = v; } }
                else { if (hw == 1) mm = mm * invt;
                    u32x2 w; w.x = cvtpk(mm[0], mm[1]); w.y = cvtpk(mm[2], mm[3]); *(LAS u32x2*)(ts + (hw == 1 ? RS_MAK : hw == 2 ? RS_NBR : RS_NKR) + c16 * RC_NS + g * 8) = w; }
                if (hw == 3 && g == 0) { *(LAS float*)(hl + RD_INV + (16 * c2 + c16) * 4) = invt;
                    const f32x2v bn = *(const LAS f32x2v*)(hl + RD_BNP + (16 * c2 + c16) * 8); const int tau = blk * 32 + 16 * c2 + c16, t = dir ? L - 1 - tau : tau;
                    BON[((size_t)dir * MTOK + (size_t)(base + t)) * 32 + head] = bn.x + bn.y; } }
        }
        RDD_END(2)
        __syncthreads();
        RDD_BEGIN(3)
        if (active) {
#pragma unroll
            for (int cc = 0; cc < 2; ++cc) { const int cb = 16 * cc; LAS unsigned char* ts = hl + cc * RD_SET;
                bf16x8 sfr[2];
#pragma unroll
                for (int ks = 0; ks < 2; ++ks) { u32x4 s4; s4.x = cvtpk(Sacc[2 * ks][0], Sacc[2 * ks][1]); s4.y = cvtpk(Sacc[2 * ks][2], Sacc[2 * ks][3]);
                    s4.z = cvtpk(Sacc[2 * ks + 1][0], Sacc[2 * ks + 1][1]); s4.w = cvtpk(Sacc[2 * ks + 1][2], Sacc[2 * ks + 1][3]); sfr[ks] = __builtin_bit_cast(bf16x8, s4); }
                bf16x8 vfr;
                { const LAS bf16_t* vp = (const LAS bf16_t*)(hl + RD_V); const int vi_ = 16 * hw + c16, vt_ = cb + 4 * g;
                  const unsigned v0 = vp[rw_sw(vt_, vi_)], v1 = vp[rw_sw(vt_ + 1, vi_)], v2 = vp[rw_sw(vt_ + 2, vi_)], v3 = vp[rw_sw(vt_ + 3, vi_)]; vfr = mk_frag((u32x2){v0 | (v1 << 16), v2 | (v3 << 16)}, zz); }
                f32x4 mx[12], md[3];
#pragma unroll
                for (int s1 = 0; s1 < 12; ++s1) mx[s1] = *(const LAS f32x4*)(ts + RS_MAB + s1 * RC_MS + g * 16);
#pragma unroll
                for (int e = 0; e < 3; ++e) md[e] = *(const LAS f32x4*)(ts + RS_MD + (4 * g + e) * 16);
                const f32x4 inv4 = *(const LAS f32x4*)(hl + RD_INV + (cb + 4 * g) * 4);
                f32x4 xt = (f32x4){0.f, 0.f, 0.f, 0.f}, yt = (f32x4){0.f, 0.f, 0.f, 0.f};
#pragma unroll
                for (int ks = 0; ks < 2; ++ks) {
                    const LAS unsigned char* ap = ts + RS_AT + c16 * RC_TT + (32 * ks + 4 * g) * 2; const LAS unsigned char* rp = ts + RS_RT + c16 * RC_TT + (32 * ks + 4 * g) * 2;
                    xt = __builtin_amdgcn_mfma_f32_16x16x32_bf16(mk_frag(*(const LAS u32x2*)ap, *(const LAS u32x2*)(ap + 32)), sfr[ks], xt, 0, 0, 0);
                    yt = __builtin_amdgcn_mfma_f32_16x16x32_bf16(mk_frag(*(const LAS u32x2*)rp, *(const LAS u32x2*)(rp + 32)), sfr[ks], yt, 0, 0, 0); }
                xt = xt * inv4;
                xt = __builtin_amdgcn_mfma_f32_16x16x32_bf16(mk_frag(*(const LAS u32x2*)(ts + RS_MAK + c16 * RC_NS + g * 8), zz), vfr, xt, 0, 0, 0);
                yt = __builtin_amdgcn_mfma_f32_16x16x32_bf16(mk_frag(*(const LAS u32x2*)(ts + RS_NKR + c16 * RC_NS + g * 8), zz), vfr, yt, 0, 0, 0);
                float x[4] = {xt[0], xt[1], xt[2], xt[3]};
#pragma unroll
                for (int h = 0; h < 4; ++h) {
                    if (g == h) { x[1] += x[0] * md[0][1]; x[2] += x[0] * md[0][2]; x[3] += x[0] * md[0][3]; x[2] += x[1] * md[1][2]; x[3] += x[1] * md[1][3]; x[3] += x[2] * md[2][3]; }
                    if (h < 3) { float ub[4];
#pragma unroll
                        for (int e = 0; e < 4; ++e) { const unsigned xv = __float_as_uint(x[e]);
                            if (h == 2) { const auto r1 = __builtin_amdgcn_permlane16_swap(xv, xv, false, false); ub[e] = __uint_as_float(r1[0]); }
                            else { const auto r0 = __builtin_amdgcn_permlane32_swap(xv, xv, false, false); const auto r1 = __builtin_amdgcn_permlane16_swap(r0[0], r0[0], false, false); ub[e] = __uint_as_float(r1[h]); } }
#pragma unroll
                        for (int e2 = 0; e2 < 4; ++e2)
#pragma unroll
                            for (int e = 0; e < 4; ++e) x[e] += ub[e2] * mx[4 * h + e2][e]; } }
                const bf16x8 ufr = mk_frag((u32x2){cvtpk(x[0] * inv4[0], x[1] * inv4[1]), cvtpk(x[2] * inv4[2], x[3] * inv4[3])}, zz);
                yt = __builtin_amdgcn_mfma_f32_16x16x32_bf16(mk_frag(*(const LAS u32x2*)(ts + RS_NBR + c16 * RC_NS + g * 8), zz), ufr, yt, 0, 0, 0);
#pragma unroll
                for (int r = 0; r < 4; ++r) *(LAS bf16_t*)(hl + RD_YO + (cb + 4 * g + r) * 128 + (16 * hw + c16) * 2) = f2bf_rne(yt[r]);
#pragma unroll
                for (int jb = 0; jb < 4; ++jb) { const f32x4 gl4 = *(const LAS f32x4*)(ts + RS_GL + (16 * jb + 4 * g) * 4); Sacc[jb] = Sacc[jb] * gl4;
                    Sacc[jb] = __builtin_amdgcn_mfma_f32_16x16x32_bf16(mk_frag(*(const LAS u32x2*)(ts + RS_BH + (16 * jb + c16) * RC_HS + g * 8), zz), ufr, Sacc[jb], 0, 0, 0);
                    Sacc[jb] = __builtin_amdgcn_mfma_f32_16x16x32_bf16(mk_frag(*(const LAS u32x2*)(ts + RS_KH + (16 * jb + c16) * RC_HS + g * 8), zz), vfr, Sacc[jb], 0, 0, 0); }
            }
            if (blk == bpu - 1 && !lat) { const unsigned sb = (unsigned)((((b * 2 + dir) * 32 + head) * 64 + hw * 16 + c16) * 64 + 4 * g);
#pragma unroll
                for (int jb = 0; jb < 4; ++jb) *(f32x4*)((char*)p.out + ((unsigned)OUT_RWKV + sb + 16 * jb) * 4u) = Sacc[jb]; }
        }
        RDD_END(3)
        __syncthreads();
        if (active) {
            const int tok = htid >> 3, c8 = (htid & 7) * 8, tau = blk * 32 + tok, t = dir ? L - 1 - tau : tau; const size_t row = (size_t)(base + t);
            *(u32x4*)(YD + (size_t)dir * MTOK * DM + row * DM + head * 64 + c8) = *(const LAS u32x4*)(hl + RD_YO + tok * 128 + c8 * 2);
        }
    }
#undef RD_PREFETCH
}

__device__ __forceinline__ void rwkv_main_chunk(LAS unsigned char* rg, int cc, int hw, int c16, int g, f32x4 (&Sacc)[4]) {
                const int cb = 16 * cc; LAS unsigned char* ts = rg + cc * RD_SET; const u32x2 zz = (u32x2){0u, 0u};
                bf16x8 sfr[2];
#pragma unroll
                for (int ks = 0; ks < 2; ++ks) { u32x4 s4; s4.x = cvtpk(Sacc[2 * ks][0], Sacc[2 * ks][1]); s4.y = cvtpk(Sacc[2 * ks][2], Sacc[2 * ks][3]);
                    s4.z = cvtpk(Sacc[2 * ks + 1][0], Sacc[2 * ks + 1][1]); s4.w = cvtpk(Sacc[2 * ks + 1][2], Sacc[2 * ks + 1][3]); sfr[ks] = __builtin_bit_cast(bf16x8, s4); }
                bf16x8 vfr;
                { const LAS bf16_t* vp = (const LAS bf16_t*)(rg + RD_V); const int vi_ = 16 * hw + c16, vt_ = cb + 4 * g;
                  const unsigned v0 = vp[rw_sw(vt_, vi_)], v1 = vp[rw_sw(vt_ + 1, vi_)], v2 = vp[rw_sw(vt_ + 2, vi_)], v3 = vp[rw_sw(vt_ + 3, vi_)]; vfr = mk_frag((u32x2){v0 | (v1 << 16), v2 | (v3 << 16)}, zz); }
                f32x4 mx[12], md[3];
#pragma unroll
                for (int s1 = 0; s1 < 12; ++s1) mx[s1] = *(const LAS f32x4*)(ts + RS_MAB + s1 * RC_MS + g * 16);
#pragma unroll
                for (int e = 0; e < 3; ++e) md[e] = *(const LAS f32x4*)(ts + RS_MD + (4 * g + e) * 16);
                const f32x4 inv4 = *(const LAS f32x4*)(rg + RD_INV + (cb + 4 * g) * 4);
                f32x4 xt = (f32x4){0.f, 0.f, 0.f, 0.f}, yt = (f32x4){0.f, 0.f, 0.f, 0.f};
#pragma unroll
                for (int ks = 0; ks < 2; ++ks) {
                    const LAS unsigned char* ap = ts + RS_AT + c16 * RC_TT + (32 * ks + 4 * g) * 2; const LAS unsigned char* rp = ts + RS_RT + c16 * RC_TT + (32 * ks + 4 * g) * 2;
                    xt = __builtin_amdgcn_mfma_f32_16x16x32_bf16(mk_frag(*(const LAS u32x2*)ap, *(const LAS u32x2*)(ap + 32)), sfr[ks], xt, 0, 0, 0);
                    yt = __builtin_amdgcn_mfma_f32_16x16x32_bf16(mk_frag(*(const LAS u32x2*)rp, *(const LAS u32x2*)(rp + 32)), sfr[ks], yt, 0, 0, 0); }
                xt = xt * inv4;
                xt = __builtin_amdgcn_mfma_f32_16x16x32_bf16(mk_frag(*(const LAS u32x2*)(ts + RS_MAK + c16 * RC_NS + g * 8), zz), vfr, xt, 0, 0, 0);
                yt = __builtin_amdgcn_mfma_f32_16x16x32_bf16(mk_frag(*(const LAS u32x2*)(ts + RS_NKR + c16 * RC_NS + g * 8), zz), vfr, yt, 0, 0, 0);
                float x[4] = {xt[0], xt[1], xt[2], xt[3]};
#pragma unroll
                for (int h = 0; h < 4; ++h) {
                    if (g == h) { x[1] += x[0] * md[0][1]; x[2] += x[0] * md[0][2]; x[3] += x[0] * md[0][3]; x[2] += x[1] * md[1][2]; x[3] += x[1] * md[1][3]; x[3] += x[2] * md[2][3]; }
                    if (h < 3) { float ub[4];
#pragma unroll
                        for (int e = 0; e < 4; ++e) ub[e] = __int_as_float(__builtin_amdgcn_ds_bpermute((h * 16 + c16) * 4, __float_as_int(x[e])));
#pragma unroll
                        for (int e2 = 0; e2 < 4; ++e2)
#pragma unroll
                            for (int e = 0; e < 4; ++e) x[e] += ub[e2] * mx[4 * h + e2][e]; } }
                const bf16x8 ufr = mk_frag((u32x2){cvtpk(x[0] * inv4[0], x[1] * inv4[1]), cvtpk(x[2] * inv4[2], x[3] * inv4[3])}, zz);
                yt = __builtin_amdgcn_mfma_f32_16x16x32_bf16(mk_frag(*(const LAS u32x2*)(ts + RS_NBR + c16 * RC_NS + g * 8), zz), ufr, yt, 0, 0, 0);
#pragma unroll
                for (int r = 0; r < 4; ++r) *(LAS bf16_t*)(rg + RD_YO + (cb + 4 * g + r) * 128 + (16 * hw + c16) * 2) = f2bf_rne(yt[r]);
#pragma unroll
                for (int jb = 0; jb < 4; ++jb) { const f32x4 gl4 = *(const LAS f32x4*)(ts + RS_GL + (16 * jb + 4 * g) * 4); Sacc[jb] = Sacc[jb] * gl4;
                    Sacc[jb] = __builtin_amdgcn_mfma_f32_16x16x32_bf16(mk_frag(*(const LAS u32x2*)(ts + RS_BH + (16 * jb + c16) * RC_HS + g * 8), zz), ufr, Sacc[jb], 0, 0, 0);
                    Sacc[jb] = __builtin_amdgcn_mfma_f32_16x16x32_bf16(mk_frag(*(const LAS u32x2*)(ts + RS_KH + (16 * jb + c16) * RC_HS + g * 8), zz), vfr, Sacc[jb], 0, 0, 0); }
}

__device__ __forceinline__ void p9_rwkv_chunk3(const Params& p, LAS unsigned char* lds) {
    const int tid = tidx(), half = __builtin_amdgcn_readfirstlane(tid >> 8), htid = tid & 255, hw = __builtin_amdgcn_readfirstlane((tid >> 6) & 3), lane = tid & 63, c16 = lane & 15, g = lane >> 4, wg = blockIdx.x;
    LAS unsigned char* hl = lds + half * RD_HALF;
    const bf16_t* R = (const bf16_t*)(p.ws + WS_R); const bf16_t* K1 = (const bf16_t*)(p.ws + WS_K1); const bf16_t* V1 = (const bf16_t*)(p.ws + WS_V1); const bf16_t* LR = (const bf16_t*)(p.ws + WS_LR);
    const bf16_t* W2T = (const bf16_t*)(p.ws + WS_W2T); const bf16_t* A2T = (const bf16_t*)(p.ws + WS_A2T);
    float* BON = (float*)(p.ws + WS_BON); bf16_t* YD = (bf16_t*)(p.out + OUT_Y);
    const float* w0p = pin(p, I_W0); const float* a0p = pin(p, I_A0); const float* kkp = pin(p, I_KK); const float* kap = pin(p, I_KA); const float* rkp = pin(p, I_RK); const float* srw = pin(p, I_SRWKV);
    constexpr int NLAT = 128, NCTX = 32, PIPE0 = NCTX + 1;
    f32x4 Sacc[4];
    int base = 0, L = 0, b = 0, head = 0, dir = 0; bool lat = false;
    const int m = c16, q = g;
    pg8::bf16x8 pftw[3], pfta[3]; u32x2 pfr[2], pfk[2], pfv[2];
#define RD_PREFETCH(bk) do { const int tau_ = (bk) * 32 + 16 * (hw & 1) + m, t_ = dir ? L - 1 - tau_ : tau_; const unsigned row_ = (unsigned)(base + t_); \
        _Pragma("unroll") for (int ks = 0; ks < 3; ++ks) { pftw[ks] = *(const pg8::bf16x8*)((const char*)LR + row_ * 768u + (unsigned)(dir * 192 + (32 * ks + 8 * q) * 2)); \
            pfta[ks] = *(const pg8::bf16x8*)((const char*)LR + row_ * 768u + (unsigned)(384 + dir * 192 + (32 * ks + 8 * q) * 2)); } \
        _Pragma("unroll") for (int mi = 0; mi < 2; ++mi) { const unsigned ch_ = (unsigned)(head * 64 + 16 * (2 * (hw >> 1) + mi) + 4 * q); \
            pfr[mi] = *(const u32x2*)((const char*)R + (row_ * 2048u + ch_) * 2u); pfk[mi] = *(const u32x2*)((const char*)K1 + (row_ * 2048u + ch_) * 2u); pfv[mi] = *(const u32x2*)((const char*)V1 + (row_ * 2048u + ch_) * 2u); } } while (0)
    for (int step = 0; step <= NLAT; ++step) {
        const bool prod1 = half == 1 && step >= NCTX;
        const bool cons0 = half == 0 && step >= PIPE0;
        const bool normal = (half == 0 && step < PIPE0) || (half == 1 && step < NCTX);
        const int ablk = prod1 ? step + 1 : (half == 0 ? step : (step & 7));
        const bool doA = (normal && step < NLAT) || (prod1 && step + 1 < NLAT);
        LAS unsigned char* tg = prod1 ? lds + ((step + 1) & 1) * RD_HALF : hl;
        LAS unsigned char* rg = cons0 ? lds + (step & 1) * RD_HALF : hl;
        const bool unit_start = (half == 0 && step == 0) || (half == 1 && step < NCTX && (step & 7) == 0) || (half == 1 && step == NCTX);
        if (unit_start) {
            const int un = (half == 0 || step == NCTX) ? wg : wg + (step >> 3) * 256; int s;
            if (half == 0 || step == NCTX) { s = 16 + (un >> 6); } else { s = un >> 6; }
            head = (un >> 1) & 31; dir = un & 1;
            seq_info(s, base, L, b, lat);
            for (int i = htid; i < 768; i += 256) { const int ch = i / 12, pc = i % 12; const size_t go = ((size_t)(dir * 2048 + head * 64 + ch) * 96 + pc * 8);
                *(LAS u32x4*)(hl + RD_W2 + ch * RC_TS + pc * 16) = *(const u32x4*)(W2T + go); *(LAS u32x4*)(hl + RD_A2 + ch * RC_TS + pc * 16) = *(const u32x4*)(A2T + go); }
            if (htid < 64) { LAS float* cst = (LAS float*)(hl + RD_CST); const int c = head * 64 + htid;
                cst[htid] = w0p[dir * 2048 + c]; cst[64 + htid] = a0p[dir * 2048 + c]; cst[128 + htid] = kkp[c]; cst[192 + htid] = kap[c]; cst[256 + htid] = rkp[c]; }
            RD_PREFETCH(ablk);
            if (!prod1) {
                const unsigned sb = (unsigned)((((b * 2 + dir) * 32 + head) * 64 + hw * 16 + c16) * 64 + 4 * g);
#pragma unroll
                for (int jb = 0; jb < 4; ++jb) Sacc[jb] = lat ? *(const f32x4*)((const char*)srw + (sb + 16 * jb) * 4u) : (f32x4){0.f, 0.f, 0.f, 0.f}; }
            __builtin_amdgcn_s_waitcnt(0x0F70);
        }
        __syncthreads();
        if (cons0) {
            if (step > PIPE0) { const int tok = htid >> 3, c8 = (htid & 7) * 8, tau = (step - 1) * 32 + tok, t = dir ? L - 1 - tau : tau; const size_t row = (size_t)(base + t);
              *(u32x4*)(YD + (size_t)dir * MTOK * DM + row * DM + head * 64 + c8) = *(const LAS u32x4*)(lds + ((step - 1) & 1) * RD_HALF + RD_YO + tok * 128 + c8 * 2); }
            if (step < NLAT) rwkv_main_chunk(rg, 0, hw, c16, g, Sacc);
        }
        if (doA) {
            const int tok = 16 * (hw & 1) + m, mb0 = 2 * (hw >> 1);
            LAS unsigned char* ts = tg + (hw & 1) * RD_SET;
            f32x4 dW[2], dA[2];
#pragma unroll
            for (int mi = 0; mi < 2; ++mi) { dW[mi] = (f32x4){0.f, 0.f, 0.f, 0.f}; dA[mi] = (f32x4){0.f, 0.f, 0.f, 0.f}; }
#pragma unroll
            for (int ks = 0; ks < 3; ++ks) {
                const pg8::bf16x8 tw = pftw[ks], ta = pfta[ks];
#pragma unroll
                for (int mi = 0; mi < 2; ++mi) { const pg8::bf16x8 wf = *(const LAS pg8::bf16x8*)(hl + RD_W2 + (16 * (mb0 + mi) + m) * RC_TS + (32 * ks + 8 * q) * 2), af = *(const LAS pg8::bf16x8*)(hl + RD_A2 + (16 * (mb0 + mi) + m) * RC_TS + (32 * ks + 8 * q) * 2);
                    dW[mi] = __builtin_amdgcn_mfma_f32_16x16x32_bf16(wf, tw, dW[mi], 0, 0, 0); dA[mi] = __builtin_amdgcn_mfma_f32_16x16x32_bf16(af, ta, dA[mi], 0, 0, 0); } }
            float ss = 0.f, bon = 0.f;
#pragma unroll
            for (int mi = 0; mi < 2; ++mi) { const int mb = mb0 + mi, ch0 = 16 * mb + 4 * q;
                const u32x2 r2 = pfr[mi], k2 = pfk[mi], v2 = pfv[mi]; const LAS float* cst = (const LAS float*)(hl + RD_CST) + ch0;
                const f32x4 w0 = *(const LAS f32x4*)cst, a0 = *(const LAS f32x4*)(cst + 64), kkw = *(const LAS f32x4*)(cst + 128), kaw = *(const LAS f32x4*)(cst + 192), rkw = *(const LAS f32x4*)(cst + 256);
                const float rr[4] = {bflo(r2.x), bfhi(r2.x), bflo(r2.y), bfhi(r2.y)}, k0[4] = {bflo(k2.x), bfhi(k2.x), bflo(k2.y), bfhi(k2.y)};
                float at[4], rt[4], bt[4], kt[4], bh[4], kh[4]; f32x4 g15;
#pragma unroll
                for (int j = 0; j < 4; ++j) {
                    const float wdec = __builtin_amdgcn_exp2f(-0.8750387749f * __builtin_amdgcn_rcpf(1.f + __builtin_amdgcn_exp2f(-1.4426950409f * (w0[j] + dW[mi][j]))));
                    const float a = __builtin_amdgcn_rcpf(1.f + __builtin_amdgcn_exp2f(-1.4426950409f * (a0[j] + dA[mi][j])));
                    const float kk = k0[j] * kkw[j], kb = kk * a, kd = k0[j] * (1.f + (a - 1.f) * kaw[j]);
                    ss += kk * kk; bon += rr[j] * kd * rkw[j];
                    float gi = wdec; gi *= rw_shr1<1>(gi); gi *= rw_shr1<2>(gi); gi *= rw_shr1<4>(gi); gi *= rw_shr1<8>(gi);
                    const float gp = rw_shr1<1>(gi), gl = rw_row15(gi), ig = __builtin_amdgcn_rcpf(gi);
                    at[j] = -kk * gp; rt[j] = rr[j] * gi; bt[j] = kb * ig; kt[j] = kd * ig; bh[j] = bt[j] * gl; kh[j] = kt[j] * gl; g15[j] = gl; }
                *(LAS u32x2*)(ts + RS_AT + m * RC_TT + ch0 * 2) = (u32x2){cvtpk(at[0], at[1]), cvtpk(at[2], at[3])}; *(LAS u32x2*)(ts + RS_RT + m * RC_TT + ch0 * 2) = (u32x2){cvtpk(rt[0], rt[1]), cvtpk(rt[2], rt[3])};
                *(LAS u32x2*)(ts + RS_BT + m * RC_TT + ch0 * 2) = (u32x2){cvtpk(bt[0], bt[1]), cvtpk(bt[2], bt[3])}; *(LAS u32x2*)(ts + RS_KT + m * RC_TT + ch0 * 2) = (u32x2){cvtpk(kt[0], kt[1]), cvtpk(kt[2], kt[3])};
#pragma unroll
                for (int j = 0; j < 4; ++j) { *(LAS bf16_t*)(ts + RS_BH + (ch0 + j) * RC_HS + m * 2) = f2bf(bh[j]); *(LAS bf16_t*)(ts + RS_KH + (ch0 + j) * RC_HS + m * 2) = f2bf(kh[j]); }
                if (m == 15) *(LAS f32x4*)(ts + RS_GL + ch0 * 4) = g15;
                *(LAS u32x2*)(tg + RD_V + rw_sw(tok, ch0) * 2) = v2; }
            ss = red4(ss); bon = red4(bon);
            if (q == 0) { *(LAS float*)(tg + RD_SSP + (tok * 2 + (hw >> 1)) * 4) = ss; *(LAS float*)(tg + RD_BNP + (tok * 2 + (hw >> 1)) * 4) = bon; }
        }
        __syncthreads();
        if (doA && (half == 0 ? step + 1 < PIPE0 : ablk + 1 < (prod1 ? NLAT : 8))) RD_PREFETCH(ablk + 1);
        if (cons0 && step < NLAT) rwkv_main_chunk(rg, 1, hw, c16, g, Sacc);
        if (doA) {
            const int xo = (hw & 1) ? RS_KT : RS_BT, yo = (hw & 2) ? RS_RT : RS_AT;
#pragma unroll
            for (int c2 = 0; c2 < 2; ++c2) { LAS unsigned char* ts = tg + c2 * RD_SET;
                f32x4 mm = (f32x4){0.f, 0.f, 0.f, 0.f};
#pragma unroll
                for (int ks = 0; ks < 2; ++ks) { const bf16x8 xf = *(const LAS bf16x8*)(ts + xo + c16 * RC_TT + (32 * ks + 8 * g) * 2), yf = *(const LAS bf16x8*)(ts + yo + c16 * RC_TT + (32 * ks + 8 * g) * 2);
                    mm = __builtin_amdgcn_mfma_f32_16x16x32_bf16(xf, yf, mm, 0, 0, 0); }
                const f32x2v st = *(const LAS f32x2v*)(tg + RD_SSP + (16 * c2 + c16) * 8);
                const float invt = __builtin_amdgcn_rcpf(fmaxf(__builtin_amdgcn_sqrtf(st.x + st.y), 1e-12f));
#pragma unroll
                for (int r = 0; r < 4; ++r) { const int s_ = 4 * g + r; const bool keep = (hw & 2) ? (s_ <= c16) : (s_ < c16); mm[r] = keep ? mm[r] : 0.f; }
                if (hw == 0) {
                    const int tb = c16 >> 2;
#pragma unroll
                    for (int r = 0; r < 4; ++r) { const f32x2v sr = *(const LAS f32x2v*)(tg + RD_SSP + (16 * c2 + 4 * g + r) * 8);
                        const float v = mm[r] * invt * __builtin_amdgcn_rcpf(fmaxf(__builtin_amdgcn_sqrtf(sr.x + sr.y), 1e-12f));
                        *(LAS float*)(ts + RS_MAB + (4 * g + r) * RC_MS + c16 * 4) = g < tb ? v : 0.f;
                        if (g == tb) *(LAS float*)(ts + RS_MD + (4 * g + r) * 16 + (c16 & 3) * 4) = v; } }
                else { if (hw == 1) mm = mm * invt;
                    u32x2 w; w.x = cvtpk(mm[0], mm[1]); w.y = cvtpk(mm[2], mm[3]); *(LAS u32x2*)(ts + (hw == 1 ? RS_MAK : hw == 2 ? RS_NBR : RS_NKR) + c16 * RC_NS + g * 8) = w; }
                if (hw == 3 && g == 0) { *(LAS float*)(tg + RD_INV + (16 * c2 + c16) * 4) = invt;
                    const f32x2v bn = *(const LAS f32x2v*)(tg + RD_BNP + (16 * c2 + c16) * 8); const int tau = ablk * 32 + 16 * c2 + c16, t = dir ? L - 1 - tau : tau;
                    BON[((size_t)dir * MTOK + (size_t)(base + t)) * 32 + head] = bn.x + bn.y; } }
        }
        __syncthreads();
        if (normal && step < NLAT) {
            rwkv_main_chunk(rg, 0, hw, c16, g, Sacc); rwkv_main_chunk(rg, 1, hw, c16, g, Sacc);
            if (half == 1 && (step & 7) == 7) { const unsigned sb = (unsigned)((((b * 2 + dir) * 32 + head) * 64 + hw * 16 + c16) * 64 + 4 * g);
#pragma unroll
                for (int jb = 0; jb < 4; ++jb) *(f32x4*)((char*)p.out + ((unsigned)OUT_RWKV + sb + 16 * jb) * 4u) = Sacc[jb]; }
        }
        if (step < PIPE0) __syncthreads();
        if (normal && step < NLAT) {
            const int blk = half == 0 ? step : (step & 7);
            const int tok = htid >> 3, c8 = (htid & 7) * 8, tau = blk * 32 + tok, t = dir ? L - 1 - tau : tau; const size_t row = (size_t)(base + t);
            *(u32x4*)(YD + (size_t)dir * MTOK * DM + row * DM + head * 64 + c8) = *(const LAS u32x4*)(hl + RD_YO + tok * 128 + c8 * 2);
        }
    }
#undef RD_PREFETCH
}
__device__ __forceinline__ void p10_combine(const Params& p) {
    const int lane = tidx() & 63, gw = blockIdx.x * 8 + (tidx() >> 6), nw = gridDim.x * 8;
    const bf16_t* YF = (const bf16_t*)(p.out + OUT_Y); const bf16_t* YB = YF + (size_t)MTOK * DM; const bf16_t* V1 = (const bf16_t*)(p.ws + WS_V1); const bf16_t* G1 = (const bf16_t*)(p.ws + WS_G1);
    const float* BON = (const float*)(p.ws + WS_BON); bf16_t* O1 = (bf16_t*)(p.ws + WS_R);
    for (int row = gw; row < MTOK; row += nw) {
#pragma unroll 2
        for (int it = 0; it < 8; ++it) { const int ch = it * 256 + lane * 4, head = ch >> 6; const size_t e = (size_t)row * DM + ch;
            const u32x2 f2 = *(const u32x2*)(YF + e), b2 = *(const u32x2*)(YB + e), v2 = *(const u32x2*)(V1 + e), g2 = *(const u32x2*)(G1 + e);
            float y[4] = {bflo(f2.x) + bflo(b2.x), bfhi(f2.x) + bfhi(b2.x), bflo(f2.y) + bflo(b2.y), bfhi(f2.y) + bfhi(b2.y)};
            const float vv[4] = {bflo(v2.x), bfhi(v2.x), bflo(v2.y), bfhi(v2.y)}, gg[4] = {bflo(g2.x), bfhi(g2.x), bflo(g2.y), bfhi(g2.y)};
            float s = y[0] + y[1] + y[2] + y[3]; s += __shfl_xor(s, 1); s += __shfl_xor(s, 2); s += __shfl_xor(s, 4); s += __shfl_xor(s, 8);
            const float mean = s * (1.f / 64.f); float v = 0.f;
#pragma unroll
            for (int j = 0; j < 4; ++j) { y[j] -= mean; v += y[j] * y[j]; }
            v += __shfl_xor(v, 1); v += __shfl_xor(v, 2); v += __shfl_xor(v, 4); v += __shfl_xor(v, 8);
            const float rstd = rsqrtf(v * (1.f / 64.f) + 64e-5f);
            const float bon = BON[(size_t)row * 32 + head] + BON[((size_t)MTOK + row) * 32 + head];
            const f32x4 lw = *(const f32x4*)(pin(p, I_LNXW) + ch), lb = *(const f32x4*)(pin(p, I_LNXB) + ch);
            float o[4];
#pragma unroll
            for (int j = 0; j < 4; ++j) o[j] = (y[j] * rstd * lw[j] + lb[j] + bon * vv[j]) * silu(gg[j]);
            u32x2 w; w.x = cvtpk(o[0], o[1]); w.y = cvtpk(o[2], o[3]); *(u32x2*)(O1 + e) = w; }
    }
}
__device__ __forceinline__ void p12_final(const Params& p) {
    const int lane = tidx() & 63, gw = blockIdx.x * 8 + (tidx() >> 6), nw = gridDim.x * 8; const float* fw = pin(p, I_FNW);
    for (int row = gw; row < MTOK; row += nw) { float* xr = p.out + OUT_Y + (size_t)row * DM; f32x4 x[8]; float ss = 0.f;
#pragma unroll
        for (int it = 0; it < 8; ++it) { x[it] = *(const f32x4*)(xr + it * 256 + lane * 4);
#pragma unroll
            for (int j = 0; j < 4; ++j) ss += x[it][j] * x[it][j]; }
        ss = wave_sum(ss); const float rstd = rsqrtf(ss * (1.f / 2048.f) + 1e-6f);
#pragma unroll
        for (int it = 0; it < 8; ++it) { const f32x4 w = *(const f32x4*)(fw + it * 256 + lane * 4); *(f32x4*)(xr + it * 256 + lane * 4) = x[it] * rstd * w; }
    }
}

constexpr int NPHASE = 15;
__global__ void __launch_bounds__(512, 2) mk_fwd(Params p) {
    extern __shared__ __attribute__((aligned(16))) unsigned char shm[];
    LAS unsigned char* lds = (LAS unsigned char*)shm;
    const int lo = p.ph_lo, hi = p.ph_hi;
    volatile LAS unsigned* st = (volatile LAS unsigned*)(lds + LDS_BAR_OFF);
    if (tidx() == 0) { st[0] = 0u; st[1] = 0u; st[2] = 0u; st[3] = 0u; }
    __syncthreads();
    XcdBarrier bar; bar.bar = (unsigned*)(p.ws + WS_BAR); bar.x = 0; bar.st = st;
    if (hi - lo > 1) bar = xcd_barrier_post((unsigned*)(p.ws + WS_BAR), st);
#ifndef PHMASK
#define PHMASK 0x7fff
#endif
#define IN(k) (((PHMASK >> (k)) & 1) && lo <= (k) && (k) < hi)
#define SEAM(k) do { if (IN((k) + 1)) xcd_barrier(bar); } while (0)
    unsigned char* ws = p.ws;
#ifndef DUPMASK
#define DUPMASK 0
#endif
#ifndef SPLIT_TAIL
#define SPLIT_TAIL 1
#endif
#define RUN(k, ...) do { if (IN(k)) { __VA_ARGS__; if ((DUPMASK >> (k)) & 1) { xcd_barrier(bar); __VA_ARGS__; } SEAM(k); } } while (0)
    RUN(0, p0_prologue(p, lds));
    RUN(1, p1_h0(p));
    RUN(2, { pg8::Gemm g{(const bf16_t*)(p.out + OUT_GLA), (const bf16_t*)(ws + WS_WT_E_IN), MTOK, 11264, 2048}; pg8::StaticOrder S; S.init(MTOK, 11264, gridDim.x, blockIdx.x);
        EpiProj0 E{ws}; pg8::gemm_phase<EpiProj0, pg8::StaticOrder>(lds, g, S, E, nullptr); });
    RUN(3, p_s5_passA(p, lds));
    RUN(4, { p_s5_passC_ctx(p); xcd_barrier(bar); p_s5_passC_lat(p, lds); xcd_barrier(bar); p_s5_gelu(p); });
    RUN(5, { pg8::Gemm g{(const bf16_t*)(ws + WS_U), (const bf16_t*)(ws + WS_WT_GLU), MTOK, 1024, 1024}; pg8::StaticOrder S; S.init(MTOK, 1024, gridDim.x, blockIdx.x);
        EpiGlu E{(const bf16_t*)(ws + WS_U), (const bf16_t*)(ws + WS_SG), pin(p, I_GLUB), (bf16_t*)(p.out + OUT_Y)}; pg8::gemm_phase<EpiGlu, pg8::StaticOrder>(lds, g, S, E, nullptr);
        { pg8::Gemm g2{(const bf16_t*)(p.out + OUT_GLA), (const bf16_t*)(ws + WS_WT_E_IN) + (size_t)11264 * 2048, MTOK, 256, 2048}; pg8::StaticOrder S2; S2.init(MTOK, 256, gridDim.x, (int)((blockIdx.x + 128u) & 255u));
          EpiDlr E2{ws}; pg8::gemm_phase<EpiDlr, pg8::StaticOrder>(lds, g2, S2, E2, nullptr); } });
    RUN(6, p_gla_chunk(p, lds));
    RUN(7, p_gla_norm2(p));
    RUN(8, { pg8::Gemm g{(const bf16_t*)(p.out + OUT_Y), (const bf16_t*)(ws + WS_WT_E_OUT), MTOK, 2048, 4096}; pg8::StaticOrder S; S.init(MTOK, 2048, gridDim.x, blockIdx.x);
        if (SPLIT_TAIL) S.set_split(2, 4096, (pg8::f32x4*)(ws + WS_V), (unsigned*)(ws + WS_BAR) + XCD_BAR_WORDS);
        EpiRes E{pin(p, I_XP), pin(p, I_XS), P_POSTAB(p), P_MOD(p) + 4096, nullptr, 0, (float*)(ws + WS_X1)}; pg8::gemm_phase<EpiRes, pg8::StaticOrder>(lds, g, S, E, nullptr); });
    RUN(9, p7_xs(p, lds));
    RUN(10, { pg8::Gemm g{(const bf16_t*)(p.out + OUT_Y), (const bf16_t*)((unsigned char*)(p.out + OUT_Y) + OY_WT_O_IN_B), MTOK, 8704, 2048}; pg8::StaticOrder S; S.init(MTOK, 8704, gridDim.x, blockIdx.x);
        EpiProj1 E{ws}; pg8::gemm_phase<EpiProj1, pg8::StaticOrder>(lds, g, S, E, nullptr); });
#if defined(RWKV_OLD)
    RUN(11, p9_rwkv(p, lds));
#elif defined(RWKV_PIPE)
    RUN(11, p9_rwkv_pipe(p, lds));
#elif defined(RWKV_PIPE2)
    RUN(11, p9_rwkv_pipe2(p, lds));
#elif defined(RWKV_PIPE3)
    RUN(11, p9_rwkv_pipe3(p, lds));
#elif defined(RWKV_CHUNK2)
    RUN(11, p9_rwkv_chunk2(p, lds));
#elif defined(RWKV_CHUNK1)
    RUN(11, p9_rwkv_chunk(p, lds));
#else
    RUN(11, p9_rwkv_chunk3(p, lds));
#endif
    RUN(12, p10_combine(p));
    RUN(13, { pg8::Gemm g{(const bf16_t*)(ws + WS_R), (const bf16_t*)(ws + WS_WT_O_OUT), MTOK, 2048, 2048}; pg8::StaticOrder S; S.init(MTOK, 2048, gridDim.x, blockIdx.x);
        if (SPLIT_TAIL) S.set_split(2, 2048, (pg8::f32x4*)(ws + WS_K1), (unsigned*)(ws + WS_BAR) + XCD_BAR_WORDS + 128);
        EpiRes E{nullptr, nullptr, nullptr, P_MOD(p) + 5 * 6144 + 4096, (const float*)(ws + WS_X1), 1, p.out + OUT_Y}; pg8::gemm_phase<EpiRes, pg8::StaticOrder>(lds, g, S, E, nullptr); });
    if (IN(14)) { p12_final(p); }
#undef RUN
#undef IN
#undef SEAM
}

#ifndef MK_FUSED
#define MK_FUSED 1
#endif
extern "C" void kernel_launch(void* const* d_in, const int* in_sizes, int n_in, void* d_out, int out_size, void* d_ws, size_t ws_size, hipStream_t stream) {
    static int grid = 0;
    if (grid == 0) {
        if (n_in != N_IN || out_size != (int)OUT_TOTAL || ws_size < WS_END) { fprintf(stderr, "kernel_launch: unexpected shapes: n_in %d out %d ws %zu; nothing launched\n", n_in, out_size, ws_size); grid = -1; return; }
        int dev = 0, cus = 0, per_cu = 0;
        if (hipGetDevice(&dev) != hipSuccess || hipDeviceGetAttribute(&cus, hipDeviceAttributeMultiprocessorCount, dev) != hipSuccess) { grid = -1; return; }
        if (hipFuncSetAttribute((const void*)mk_fwd, hipFuncAttributeMaxDynamicSharedMemorySize, LDS_BYTES) != hipSuccess) { fprintf(stderr, "kernel_launch: hipFuncSetAttribute failed\n"); grid = -1; return; }
        if (hipOccupancyMaxActiveBlocksPerMultiprocessor(&per_cu, (const void*)mk_fwd, 512, LDS_BYTES) != hipSuccess || per_cu < 1) fprintf(stderr, "kernel_launch: occupancy query reports %d per CU\n", per_cu);
        (void)hipGetLastError();
        if (cus != 256) { fprintf(stderr, "kernel_launch: built for 256 CUs, device has %d; nothing launched\n", cus); grid = -1; return; }
        grid = 256;
    }
    if (grid < 0) return;
    Params p; memset(&p, 0, sizeof(p));
    for (int i = 0; i < N_IN; ++i) p.in[i] = (const float*)d_in[i];
    p.out = (float*)d_out; p.ws = (unsigned char*)d_ws;
#if MK_FUSED
    (void)hipMemsetAsync((unsigned char*)d_ws + WS_BAR, 0, 16384, stream);
    p.ph_lo = 0; p.ph_hi = NPHASE;
    hipLaunchKernelGGL(mk_fwd, dim3(grid), dim3(512), LDS_BYTES, stream, p);
#else
    for (int k = 0; k < NPHASE; ++k) { p.ph_lo = k; p.ph_hi = k + 1; hipLaunchKernelGGL(mk_fwd, dim3(grid), dim3(512), LDS_BYTES, stream, p); }
#endif
}
```

```cpp
#include <hip/hip_runtime.h>
#include <cstdio>
#include <cstdint>
#include <cstring>
__device__ __forceinline__ int tidx() { int t = threadIdx.x; asm volatile("" : "+v"(t)); return t; }
typedef __bf16 mk_bf16x2_t __attribute__((ext_vector_type(2)));
typedef float mk_f32x2_t __attribute__((ext_vector_type(2)));
__device__ __forceinline__ unsigned cvtpk(float lo, float hi) { const mk_f32x2_t v = {lo, hi}; return __builtin_bit_cast(unsigned, __builtin_convertvector(v, mk_bf16x2_t)); }
namespace pg8 {
#define PG8_LAS __attribute__((address_space(3)))
typedef unsigned short bf16_t;
typedef short bf16x8 __attribute__((ext_vector_type(8)));
typedef float f32x4 __attribute__((ext_vector_type(4)));
typedef unsigned u32x4 __attribute__((ext_vector_type(4)));
constexpr int BM = 256, BK = 64, HALF = 128, HTB = HALF * BK * 2  , STAGE_BYTES = 8 * HTB, NXCD = 8, WGM = 8;

__host__ __device__ __forceinline__ int lds_byte(int r, int c) { const int st = (r >> 4) * 2 + (c >> 5), rr = r & 15, cc = c & 31, ob = rr * 64 + cc * 2; return st * 1024 + (ob ^ (((ob >> 9) & 1) << 5)); }
__host__ __device__ __forceinline__ void stage_rc(int b, int& R, int& C) { const int st = b / 1024, sb = b % 1024, swz = sb ^ (((sb >> 9) & 1) << 5); R = (st >> 1) * 16 + swz / 64; C = (st & 1) * 32 + (swz % 64) / 2; }
__host__ __device__ __forceinline__ int perm32(int rho) { const int n = rho >> 4, i = rho & 15; return 8 * (i >> 2) + 4 * n + (i & 3); }

struct Unit { int pm, pn, k0, nt, role, pair; };
struct Gemm { const bf16_t* A; const bf16_t* Bt; int M, N, K; };

struct StaticOrder {
    int nM, nN, nwg, G, c, split_round, split_nt; f32x4* part; unsigned* flags;
    __host__ __device__ void init(int M, int N, int G_, int c_) { nM = M / BM; nN = N / BM; nwg = nM * nN; G = G_; c = c_; split_round = -1; split_nt = 0; part = nullptr; flags = nullptr; }
    __host__ __device__ void set_split(int round, int K, f32x4* part_, unsigned* flags_) { split_round = round; split_nt = K / BK / 2; part = part_; flags = flags_; }
    __host__ __device__ bool next(int i, Unit& u) const {
        const bool sp = i == split_round; if (split_round >= 0 && i > split_round) return false;
        const int hc = sp ? c % (G / 2) : c, kh = sp ? c / (G / 2) : 0;
        const long L = (long)i * G + hc; if (L >= nwg) return false;
        u.k0 = kh * split_nt; u.nt = sp ? split_nt : 0; u.role = sp ? 1 + kh : 0; u.pair = hc;
        int wgid = (int)L; { const int q = nwg / NXCD, r = nwg % NXCD, xcd = wgid % NXCD, off = wgid / NXCD; wgid = (xcd < r ? xcd * (q + 1) : r * (q + 1) + (xcd - r) * q) + off; }
        const int nig = WGM * nN, gid = wgid / nig, fm = gid * WGM, gsz = (nM - fm) < WGM ? (nM - fm) : WGM;
        u.pm = fm + ((wgid % nig) % gsz); u.pn = (wgid % nig) / gsz; return true;
    }
    __device__ __forceinline__ void dump(const f32x4 (&acc)[2][2][4][2], const Unit& u, int wid, int lane) const {
        float* dst = (float*)part + ((size_t)(u.pair * 8 + wid) * 128) * 64 + lane;
#pragma unroll
        for (int a = 0; a < 2; ++a)
#pragma unroll
            for (int b = 0; b < 2; ++b)
#pragma unroll
                for (int m = 0; m < 4; ++m)
#pragma unroll
                    for (int n = 0; n < 2; ++n)
#pragma unroll
                        for (int e = 0; e < 4; ++e) __hip_atomic_store(dst + ((((a * 2 + b) * 4 + m) * 2 + n) * 4 + e) * 64, acc[a][b][m][n][e], __ATOMIC_RELAXED, __HIP_MEMORY_SCOPE_AGENT);
        __builtin_amdgcn_fence(__ATOMIC_RELEASE, "workgroup");
        if (lane == 0) __hip_atomic_fetch_add(flags + u.pair, 1u, __ATOMIC_RELAXED, __HIP_MEMORY_SCOPE_AGENT);
    }
    __device__ __forceinline__ void fetch_add(f32x4 (&acc)[2][2][4][2], const Unit& u, int wid, int lane) const {
        while (__hip_atomic_load(flags + u.pair, __ATOMIC_RELAXED, __HIP_MEMORY_SCOPE_AGENT) < 8u) __builtin_amdgcn_s_sleep(2);
        __builtin_amdgcn_fence(__ATOMIC_ACQUIRE, "workgroup");
        const float* src = (const float*)part + ((size_t)(u.pair * 8 + wid) * 128) * 64 + lane;
#pragma unroll
        for (int a = 0; a < 2; ++a)
#pragma unroll
            for (int b = 0; b < 2; ++b)
#pragma unroll
                for (int m = 0; m < 4; ++m)
#pragma unroll
                    for (int n = 0; n < 2; ++n)
#pragma unroll
                        for (int e = 0; e < 4; ++e) acc[a][b][m][n][e] += __hip_atomic_load(src + ((((a * 2 + b) * 4 + m) * 2 + n) * 4 + e) * 64, __ATOMIC_RELAXED, __HIP_MEMORY_SCOPE_AGENT);
    }
    __device__ __forceinline__ void a_ready(const Unit&) const {}
    __device__ __forceinline__ void done(const Unit&) const {}
};
__device__ __forceinline__ unsigned cvt_pk_bf16(float lo, float hi) { unsigned r; asm volatile("v_cvt_pk_bf16_f32 %0, %1, %2" : "=v"(r) : "v"(lo), "v"(hi)); return r; }
template <class Epi, class Sched, bool STAMP = false>
__device__ __forceinline__ void gemm_phase(PG8_LAS unsigned char* lds, const Gemm g, const Sched& S, const Epi& E, unsigned long long* stamps) {
    const int tid = tidx(), wid = __builtin_amdgcn_readfirstlane(tid >> 6), lane = tid & 63, wr = wid >> 2, wc = wid & 3, fr = lane & 15, fq = lane >> 4;
    const int K = g.K, nt = K / BK;
    int ts_lo = 0, ts_hi = 0, nts = 0; const unsigned long long rt_entry = STAMP ? (unsigned long long)wall_clock64() : 0ull;
#define PG8_STAMP() do { if (STAMP && wid == 0 && nts < 64) { const unsigned long long _c = (unsigned long long)clock64(); \
        ts_lo = (lane == nts) ? (int)(unsigned)_c : ts_lo; ts_hi = (lane == nts) ? (int)(unsigned)(_c >> 32) : ts_hi; ++nts; } } while (0)
    PG8_STAMP();
    unsigned voffA[2], voffB[2];
#pragma unroll
    for (int i = 0; i < 2; ++i) { int R, C; stage_rc(tid * 16 + i * 8192, R, C); const int Rb = Epi::PERM ? ((R & ~31) + perm32(R & 31)) : R;
        voffA[i] = (unsigned)(R * K + C) * 2u; voffB[i] = (unsigned)(Rb * K + C) * 2u; }
    const size_t kstep = (size_t)(BK * 2);
    const size_t hstep = (size_t)HALF * K * 2;
    const size_t tstep = 2 * hstep;
    const unsigned ldsw = (unsigned)wid * 1024u;
    const int aoff = lds_byte(wr * 64 + fr, fq * 8), boff = lds_byte(wc * 32 + fr, fq * 8);
#define PG8_SA(b, h) (((b) * 2 + (h)) * HTB)
#define PG8_SB(b, h) ((4 + (b) * 2 + (h)) * HTB)
#define PG8_STAGE(bufoff, gbase, voff) do { _Pragma("unroll") for (int _i = 0; _i < 2; ++_i) \
        __builtin_amdgcn_global_load_lds((const unsigned*)((const char*)(gbase) + (voff)[_i]), (PG8_LAS unsigned*)(lds + (bufoff) + ldsw + _i * 8192), 16, 0, 0); } while (0)
#define PG8_LDA(dst, b, h) do { _Pragma("unroll") for (int m = 0; m < 4; ++m) _Pragma("unroll") for (int k = 0; k < 2; ++k) dst[m][k] = *(const PG8_LAS bf16x8*)(lds + PG8_SA(b, h) + aoff + m * 2048 + k * 1024); } while (0)
#define PG8_LDB(dst, b, h) do { _Pragma("unroll") for (int n = 0; n < 2; ++n) _Pragma("unroll") for (int k = 0; k < 2; ++k) dst[n][k] = *(const PG8_LAS bf16x8*)(lds + PG8_SB(b, h) + boff + n * 2048 + k * 1024); } while (0)
#define PG8_MMA(ai, bj, At, Bt) do { __builtin_amdgcn_s_setprio(1); _Pragma("unroll") for (int m = 0; m < 4; ++m) _Pragma("unroll") for (int n = 0; n < 2; ++n) _Pragma("unroll") for (int k = 0; k < 2; ++k) \
        acc[ai][bj][m][n] = __builtin_amdgcn_mfma_f32_16x16x32_bf16(Bt[n][k], At[m][k], acc[ai][bj][m][n], 0, 0, 0); __builtin_amdgcn_s_setprio(0); } while (0)
#define PG8_WAIT_V(n) asm volatile("s_waitcnt vmcnt(" #n ")" ::: "memory")
#define PG8_WAIT_L(n) asm volatile("s_waitcnt lgkmcnt(" #n ")" ::: "memory")
#define PG8_BAR __builtin_amdgcn_s_barrier()
#define PG8_SCHED __builtin_amdgcn_sched_barrier(0)
    Unit cur, nxt; int ui = 0;
    if (!S.next(0, cur)) return;
    f32x4 acc[2][2][4][2];
#pragma unroll
    for (int a = 0; a < 2; ++a)
#pragma unroll
        for (int b = 0; b < 2; ++b)
#pragma unroll
            for (int m = 0; m < 4; ++m)
#pragma unroll
                for (int n = 0; n < 2; ++n) acc[a][b][m][n] = (f32x4){0.f, 0.f, 0.f, 0.f};
    bf16x8 At[4][2], B0[2][2], B1[2][2];
    const char* cA = (const char*)g.A + (size_t)cur.pm * tstep + (size_t)cur.k0 * kstep; const char* cB = (const char*)g.Bt + (size_t)cur.pn * tstep + (size_t)cur.k0 * kstep;
    S.a_ready(cur);
    PG8_STAGE(PG8_SB(0, 0), cB, voffB); PG8_STAGE(PG8_SA(0, 0), cA, voffA); PG8_STAGE(PG8_SB(0, 1), cB + hstep, voffB); PG8_STAGE(PG8_SA(0, 1), cA + hstep, voffA);
    if (wr == 1) PG8_BAR;
    PG8_WAIT_V(4); PG8_BAR;
    PG8_STAGE(PG8_SB(1, 0), cB + kstep, voffB); PG8_STAGE(PG8_SA(1, 0), cA + kstep, voffA); PG8_STAGE(PG8_SB(1, 1), cB + hstep + kstep, voffB);
    PG8_WAIT_V(6); PG8_BAR;
    PG8_STAMP();
    for (;;) {
        const bool has_next = S.next(ui + 1, nxt);
        const char* nA = has_next ? (const char*)g.A + (size_t)nxt.pm * tstep + (size_t)nxt.k0 * kstep : cA; const char* nB = has_next ? (const char*)g.Bt + (size_t)nxt.pn * tstep + (size_t)nxt.k0 * kstep : cB;
        const int cnt = cur.nt ? cur.nt : nt;
        for (int t = 0; t < cnt; t += 2) {
            const bool last = (t == cnt - 2);
            const char* a1 = cA + (size_t)(t + 1) * kstep;
            const char* a2 = last ? nA : cA + (size_t)(t + 2) * kstep; const char* b2 = last ? nB : cB + (size_t)(t + 2) * kstep;
            const char* a3 = a2 + kstep; const char* b3 = b2 + kstep;
            if (last && has_next) S.a_ready(nxt);
            PG8_LDB(B0, 0, 0); PG8_SCHED; PG8_LDA(At, 0, 0); PG8_STAGE(PG8_SA(1, 1), a1 + hstep, voffA);
            PG8_WAIT_L(8); PG8_BAR; PG8_WAIT_L(0); PG8_MMA(0, 0, At, B0); PG8_BAR; PG8_SCHED;
            PG8_LDB(B1, 0, 1); PG8_STAGE(PG8_SB(0, 0), b2, voffB);
            PG8_BAR; PG8_WAIT_L(0); PG8_MMA(0, 1, At, B1); PG8_BAR;
            PG8_LDA(At, 0, 1); PG8_STAGE(PG8_SA(0, 0), a2, voffA);
            PG8_BAR; PG8_WAIT_L(0); PG8_MMA(1, 0, At, B0); PG8_BAR; PG8_SCHED;
            PG8_STAGE(PG8_SB(0, 1), b2 + hstep, voffB);
            PG8_WAIT_V(6); PG8_BAR; PG8_MMA(1, 1, At, B1); PG8_BAR;
            PG8_LDB(B0, 1, 0); PG8_SCHED; PG8_LDA(At, 1, 0); PG8_STAGE(PG8_SA(0, 1), a2 + hstep, voffA);
            PG8_WAIT_L(8); PG8_BAR; PG8_WAIT_L(0); PG8_MMA(0, 0, At, B0); PG8_BAR; PG8_SCHED;
            PG8_LDB(B1, 1, 1); PG8_STAGE(PG8_SB(1, 0), b3, voffB);
            PG8_BAR; PG8_WAIT_L(0); PG8_MMA(0, 1, At, B1); PG8_BAR;
            PG8_LDA(At, 1, 1); PG8_STAGE(PG8_SA(1, 0), a3, voffA);
            PG8_BAR; PG8_WAIT_L(0); PG8_MMA(1, 0, At, B0); PG8_BAR; PG8_SCHED;
            PG8_STAGE(PG8_SB(1, 1), b3 + hstep, voffB);
            PG8_WAIT_V(6); PG8_BAR; PG8_MMA(1, 1, At, B1); PG8_BAR;
        }
        PG8_STAMP();
        if constexpr (!Epi::AFTER_DRAIN) { if (cur.role == 2) S.dump(acc, cur, wid, lane); else { if (cur.role == 1) S.fetch_add(acc, cur, wid, lane); E(acc, cur, wr, wc, fr, fq); } S.done(cur); }
        PG8_STAMP();
        if (!has_next) break;
#pragma unroll
        for (int a = 0; a < 2; ++a)
#pragma unroll
            for (int b = 0; b < 2; ++b)
#pragma unroll
                for (int m = 0; m < 4; ++m)
#pragma unroll
                    for (int n = 0; n < 2; ++n) acc[a][b][m][n] = (f32x4){0.f, 0.f, 0.f, 0.f};
        cur = nxt; cA = nA; cB = nB; ++ui;
    }
    PG8_WAIT_V(0);
    if (wr == 0) PG8_BAR;
    PG8_BAR;
    if constexpr (Epi::AFTER_DRAIN) { E.fused(acc, cur, wr, wc, fr, fq, lds, wid, lane); S.done(cur); }
    PG8_STAMP();
    if (STAMP && wid == 0) { stamps[lane] = lane < nts ? (((unsigned long long)(unsigned)ts_hi << 32) | (unsigned)ts_lo) : 0ull;
        if (lane == 62) stamps[62] = rt_entry; if (lane == 63) stamps[63] = (unsigned long long)wall_clock64(); }
#undef PG8_STAMP
#undef PG8_SA
#undef PG8_SB
#undef PG8_STAGE
#undef PG8_LDA
#undef PG8_LDB
#undef PG8_MMA
#undef PG8_WAIT_V
#undef PG8_WAIT_L
#undef PG8_BAR
#undef PG8_SCHED
}
}

#define XB_TMO      128
#define XB_XCNT(j)  (256  + 64 * (j))
#define XB_XSUB(j)  (1280 + 64 * (j))
#define XB_XGEN(j)  (2304 + 64 * (j))
#define XB_TOP      3328
#define XB_TOPGEN   3392
#define XCD_BAR_WORDS 3456
#define XB_SPIN_CAP (1u << 18)
#define LAS __attribute__((address_space(3)))

__device__ __forceinline__ unsigned xb_ld(unsigned* p)              { return __hip_atomic_load(p, __ATOMIC_RELAXED, __HIP_MEMORY_SCOPE_AGENT); }
__device__ __forceinline__ unsigned xb_add(unsigned* p, unsigned v) { return __hip_atomic_fetch_add(p, v, __ATOMIC_RELAXED, __HIP_MEMORY_SCOPE_AGENT); }
__device__ __forceinline__ unsigned xb_xcc_id() { return (unsigned)__builtin_amdgcn_s_getreg((3 << 11) | 20) & 0xFu; }
#define XB_SPIN(cond, bar) do { unsigned _sp = 0; while (cond) { __builtin_amdgcn_s_sleep(1); \
    if ((++_sp & 255u) == 0u) { if (xb_ld(&(bar)[XB_TMO])) break; if (_sp > XB_SPIN_CAP) { atomicAdd(&(bar)[XB_TMO], 1u); break; } } } } while (0)

struct XcdBarrier {
    unsigned* bar; unsigned x;
    volatile LAS unsigned* st;
};

__device__ __forceinline__ XcdBarrier xcd_barrier_post(unsigned* bar, volatile LAS unsigned* st) {
    XcdBarrier b; b.bar = bar; b.x = xb_xcc_id(); b.st = st;
    if (threadIdx.x == 0) (void)xb_add(&bar[XB_XCNT(b.x)], 1u);
    return b;
}
__device__ __forceinline__ void xcd_barrier_complete(unsigned* bar, unsigned x, unsigned& nloc, unsigned& nx) {
    const unsigned G = gridDim.x * gridDim.y * gridDim.z;
    unsigned sum, cnt, mine, sp = 0u;
    for (;;) {
        sum = 0u; cnt = 0u; mine = 0u;
#pragma unroll
        for (unsigned j = 0; j < 16; ++j) { const unsigned c = xb_ld(&bar[XB_XCNT(j)]); sum += c; cnt += (c > 0u) ? 1u : 0u; mine = (j == x) ? c : mine; }
        if (sum == G) break;
        __builtin_amdgcn_s_sleep(1);
        if ((++sp & 255u) == 0u) { if (xb_ld(&bar[XB_TMO])) break; if (sp > XB_SPIN_CAP) { atomicAdd(&bar[XB_TMO], 1u); break; } }
    }
    nloc = mine > 0u ? mine : 1u; nx = cnt > 0u ? cnt : 1u;
}

__device__ __forceinline__ void xcd_barrier(const XcdBarrier& b) {
    asm volatile("s_waitcnt vmcnt(0)" ::: "memory");
    __syncthreads();
    if (threadIdx.x == 0) {
        unsigned* bar = b.bar;
        __builtin_amdgcn_s_waitcnt(0);
        unsigned nloc = b.st[0], nx = b.st[1];
        if (nloc == 0u) { xcd_barrier_complete(bar, b.x, nloc, nx); b.st[0] = nloc; b.st[1] = nx; }
        const unsigned old = xb_add(&bar[XB_XSUB(b.x)], 1u);
        const unsigned gen = old / nloc;
        if (old + 1u == (gen + 1u) * nloc) {
            __builtin_amdgcn_fence(__ATOMIC_RELEASE, "agent");
            asm volatile("s_waitcnt vmcnt(0)" ::: "memory");
            const unsigned og = xb_add(&bar[XB_TOP], 1u);
            const unsigned tg = og / nx;
            if (og + 1u == (tg + 1u) * nx) xb_add(&bar[XB_TOPGEN], 1u);
            else XB_SPIN(xb_ld(&bar[XB_TOPGEN]) == tg, bar);
            __builtin_amdgcn_fence(__ATOMIC_ACQUIRE, "agent");
            xb_add(&bar[XB_XGEN(b.x)], 1u);
            asm volatile("s_waitcnt vmcnt(0)" ::: "memory");
        } else {
            XB_SPIN(xb_ld(&bar[XB_XGEN(b.x)]) == gen, bar);
            __builtin_amdgcn_fence(__ATOMIC_ACQUIRE, "agent");
            asm volatile("s_waitcnt vmcnt(0)" ::: "memory");
        }
    }
    __syncthreads();
}

using pg8::bf16_t; using pg8::f32x4; using pg8::u32x4; using pg8::Unit; using pg8::cvt_pk_bf16;
typedef unsigned u32x2 __attribute__((ext_vector_type(2)));

constexpr int DM = 2048, MTOK = 20480, NCTXR = 4096;
constexpr int LDS_BYTES = 163840;
constexpr int LDS_BAR_OFF = 163824;

enum { I_XP = 0, I_XS, I_S5RE, I_S5IM, I_SGLA, I_SRWKV, I_C, I_CCTX, I_NORMW, I_ADAW, I_ADAB, I_FNW, I_EWIN, I_EWOUT, I_LRE, I_LIM, I_LSTEP, I_BRE, I_BIM, I_CRE, I_CIM,
       I_S5D, I_GLUW, I_GLUB, I_DECUP, I_DECB, I_GNW, I_OWIN, I_OWOUT, I_MU, I_W0, I_W2, I_A0, I_A2, I_KK, I_KA, I_RK, I_LNXW, I_LNXB, N_IN };

struct Params { const float* in[N_IN]; float* out; unsigned char* ws; int ph_lo, ph_hi; };
typedef const float* cfptr_t;
__device__ __forceinline__ const float* pin(const Params&, int i) { int z; asm volatile("s_mov_b32 %0, 0" : "=s"(z));
    const __attribute__((address_space(4))) cfptr_t* kp = (const __attribute__((address_space(4))) cfptr_t*)__builtin_amdgcn_kernarg_segment_ptr(); return kp[i + z]; }

constexpr size_t OUT_Y = 0, OUT_S5RE = 41943040, OUT_S5IM = 42074112, OUT_GLA = 42205184, OUT_RWKV = 67371008, OUT_TOTAL = 71565312;
constexpr size_t WS_U = 0, WS_SG = 41943040, WS_Q = 83886080, WS_K = 146800640, WS_V = 209715200, WS_GG = 335544320, WS_DLR = 461373440,
                 WS_WT_E_IN = 463994880, WS_WT_E_OUT = 511180800, WS_WT_GLU = 527958016;
constexpr size_t WS_X1 = 0, WS_R = 167772160, WS_K1 = 251658240, WS_V1 = 335544320, WS_G1 = 419430400, WS_LR = 503316480, WS_WT_O_OUT = 519045120, WS_BON = 527433728;
constexpr size_t WS_SMALL = 533725184, WS_MOD = WS_SMALL, WS_POSTAB = WS_MOD + 245760, WS_BAR = WS_POSTAB + 262144, WS_W2T = WS_BAR + 16384, WS_A2T = WS_W2T + 786432, WS_END = WS_A2T + 786432;
static_assert(WS_END <= 536870912ull, "workspace map");
static_assert(WS_BON + 5242880 <= WS_SMALL, "workspace map");
constexpr size_t OY_WT_O_IN_B = 83886080;

__device__ __forceinline__ float bf2f(bf16_t b) { return __uint_as_float(((unsigned)b) << 16); }
__device__ __forceinline__ float bflo(unsigned w) { return __uint_as_float(w << 16); }
__device__ __forceinline__ float bfhi(unsigned w) { return __uint_as_float(w & 0xffff0000u); }
__device__ __forceinline__ bf16_t f2bf(float f) { return (bf16_t)(cvtpk(f, 0.f) & 0xffffu); }
__device__ __forceinline__ float sigm(float x) { return __builtin_amdgcn_rcpf(1.f + __builtin_amdgcn_exp2f(-1.4426950409f * x)); }
__device__ __forceinline__ float silu(float x) { return x * __builtin_amdgcn_rcpf(1.f + __builtin_amdgcn_exp2f(-1.4426950409f * x)); }
__device__ __forceinline__ float ftanh(float x) { return 1.f - 2.f * __builtin_amdgcn_rcpf(1.f + __builtin_amdgcn_exp2f(2.8853900818f * x)); }
__device__ __forceinline__ float wave_sum(float v) {
#pragma unroll
    for (int o = 32; o >= 1; o >>= 1) v += __shfl_xor(v, o);
    return v;
}
__device__ __forceinline__ int row_ci(int row) { return row < NCTXR ? 0 : 1 + ((row - NCTXR) >> 12); }

#define P_MOD(p)    ((float*)((p).ws + WS_MOD))
#define P_POSTAB(p) ((float*)((p).ws + WS_POSTAB))

__device__ __forceinline__ f32x4 x0_load4(const Params& p, int row, int col) {
    if (row < NCTXR) return *(const f32x4*)(pin(p, I_XP) + (size_t)row * DM + col);
    const int rr = row - NCTXR, t = rr & 4095;
    const f32x4 a = *(const f32x4*)(pin(p, I_XS) + (size_t)rr * DM + col);
    const int pos = col < 1024 ? (t >> 6) : (t & 63);
    const f32x4 e = *(const f32x4*)(P_POSTAB(p) + pos * 1024 + (col & 1023));
    return a + e;
}

__device__ __forceinline__ void transpose_tiles(const float* src, int K, int N, bf16_t* dst, int Npad, LAS float* t, int rot) {
    const int tid = tidx(), tk = K / 64, tn = Npad / 64, nwg = gridDim.x, ntile = tk * tn;
    float cur[8], nx[8];
    int tile = (blockIdx.x + rot) % nwg;
    if (tile < ntile) { const int kt = tile % tk, nt = tile / tk, k0 = kt * 64, n0 = nt * 64;
#pragma unroll
        for (int ps = 0; ps < 8; ++ps) { const int kk = ps * 8 + (tid >> 6), n = n0 + (tid & 63); cur[ps] = (n < N) ? src[(size_t)(k0 + kk) * N + n] : 0.f; } }
    for (; tile < ntile; tile += nwg) {
        const int kt = tile % tk, nt = tile / tk, k0 = kt * 64, n0 = nt * 64;
#pragma unroll
        for (int ps = 0; ps < 8; ++ps) { const int kk = ps * 8 + (tid >> 6); t[kk * 65 + (tid & 63)] = cur[ps]; }
        { const int tl2 = tile + nwg;
          if (tl2 < ntile) { const int kt2 = tl2 % tk, nt2 = tl2 / tk, k02 = kt2 * 64, n02 = nt2 * 64;
#pragma unroll
              for (int ps = 0; ps < 8; ++ps) { const int kk = ps * 8 + (tid >> 6), n = n02 + (tid & 63); nx[ps] = (n < N) ? src[(size_t)(k02 + kk) * N + n] : 0.f; } } }
        __syncthreads();
        { const int nn = tid >> 3, kk0 = (tid & 7) * 8; float v[8];
#pragma unroll
          for (int i = 0; i < 8; ++i) v[i] = t[(kk0 + i) * 65 + nn];
          u32x4 o; o.x = cvtpk(v[0], v[1]); o.y = cvtpk(v[2], v[3]); o.z = cvtpk(v[4], v[5]); o.w = cvtpk(v[6], v[7]);
          *(u32x4*)(dst + (size_t)(n0 + nn) * K + k0 + kk0) = o; }
        __syncthreads();
#pragma unroll
        for (int ps = 0; ps < 8; ++ps) cur[ps] = nx[ps];
    }
}

__device__ __forceinline__ void p0_prologue(const Params& p, LAS unsigned char* lds) {
    const int tid = tidx(), wg = blockIdx.x, nwg = gridDim.x;
    {
        LAS float* sl = (LAS float*)lds;
        LAS float* red = (LAS float*)(lds + 40960);
        if (wg < 192 || nwg < 192) {
            for (int i = tid; i < 5 * 2048; i += 512) { const int ci = i >> 11, k = i & 2047; const float c = ci == 0 ? pin(p, I_CCTX)[k] : pin(p, I_C)[(ci - 1) * 2048 + k]; sl[i] = c / (1.f + expf(-c)); }
            __syncthreads();
            for (int blk = wg; blk < 192; blk += nwg) {
                const int l = blk / 96, nb = blk % 96, col = nb * 64 + (tid & 63), kg = tid >> 6;
                const float* W = pin(p, I_ADAW) + (size_t)l * 2048 * 6144 + col;
                float acc[5] = {0.f, 0.f, 0.f, 0.f, 0.f};
#pragma unroll 1
                for (int k0 = kg * 256; k0 < kg * 256 + 256; k0 += 32) {
                    float w[32];
#pragma unroll
                    for (int j = 0; j < 32; ++j) w[j] = W[(size_t)(k0 + j) * 6144];
                    __builtin_amdgcn_sched_barrier(0);
#pragma unroll
                    for (int j = 0; j < 32; ++j)
#pragma unroll
                        for (int ci = 0; ci < 5; ++ci) acc[ci] += sl[ci * 2048 + k0 + j] * w[j]; }
#pragma unroll
                for (int ci = 0; ci < 5; ++ci) red[(kg * 5 + ci) * 64 + (tid & 63)] = acc[ci];
                __syncthreads();
                if (tid < 320) { const int ci = tid >> 6, c = tid & 63; float s = 0.f;
#pragma unroll
                    for (int k2 = 0; k2 < 8; ++k2) s += red[(k2 * 5 + ci) * 64 + c];
                    P_MOD(p)[((size_t)l * 5 + ci) * 6144 + nb * 64 + c] = s + pin(p, I_ADAB)[l * 6144 + nb * 64 + c]; }
                __syncthreads();
            }
        }
    }
    __syncthreads();
    transpose_tiles(pin(p, I_EWIN), 2048, 11296, (bf16_t*)(p.ws + WS_WT_E_IN), 11520, (LAS float*)lds, 0);
    transpose_tiles(pin(p, I_EWOUT), 4096, 2048, (bf16_t*)(p.ws + WS_WT_E_OUT), 2048, (LAS float*)lds, 128);
    transpose_tiles(pin(p, I_GLUW), 1024, 1024, (bf16_t*)(p.ws + WS_WT_GLU), 1024, (LAS float*)lds, 64);
    const int gtid = wg * 512 + tid, gth = nwg * 512;
    for (int idx = gtid; idx < 64 * 512; idx += gth) { const int pos = idx >> 9, i = idx & 511;
        const float om = (float)(1.0 / pow(10000.0, (double)i / 512.0)); const float ang = (float)pos * om;
        P_POSTAB(p)[pos * 1024 + i] = (float)sin((double)ang); P_POSTAB(p)[pos * 1024 + 512 + i] = (float)cos((double)ang); }
    { float* AB = p.out + OUT_RWKV; float* BBRE = AB + 16384; float* BBIM = BBRE + 131072;
      for (int idx = gtid; idx < 2 * 64 * 64; idx += gth) {
        const double lr = pin(p, I_LRE)[idx], li = pin(p, I_LIM)[idx], dt = exp((double)pin(p, I_LSTEP)[idx >> 6]);
        const double mag = exp(lr * dt), abr = mag * cos(li * dt), abi = mag * sin(li * dt), den = lr * lr + li * li;
        const double fr = ((abr - 1.0) * lr + abi * li) / den, fi = (abi * lr - (abr - 1.0) * li) / den;
        AB[idx * 2] = (float)abr; AB[idx * 2 + 1] = (float)abi;
        for (int h = 0; h < 16; ++h) { const double br = pin(p, I_BRE)[idx * 16 + h], bi = pin(p, I_BIM)[idx * 16 + h];
            BBRE[idx * 16 + h] = (float)(fr * br - fi * bi); BBIM[idx * 16 + h] = (float)(fr * bi + fi * br); } } }
}

__device__ __forceinline__ void p1_h0(const Params& p) {
    const int lane = tidx() & 63, gw = blockIdx.x * 8 + (tidx() >> 6), nw = gridDim.x * 8;
    bf16_t* H0 = (bf16_t*)(p.out + OUT_GLA); const float* mod = P_MOD(p); const float* nwt = pin(p, I_NORMW);
    for (int row0 = gw; row0 < MTOK; row0 += 2 * nw) {
        f32x4 x[2][8]; float ss[2] = {0.f, 0.f};
#pragma unroll
        for (int rr = 0; rr < 2; ++rr)
#pragma unroll
            for (int it = 0; it < 4; ++it) { const int col = it * 512 + lane * 8; x[rr][2 * it] = x0_load4(p, row0 + rr * nw, col); x[rr][2 * it + 1] = x0_load4(p, row0 + rr * nw, col + 4); }
#pragma unroll
        for (int rr = 0; rr < 2; ++rr) {
#pragma unroll
            for (int it = 0; it < 8; ++it)
#pragma unroll
                for (int j = 0; j < 4; ++j) ss[rr] += x[rr][it][j] * x[rr][it][j];
            ss[rr] = wave_sum(ss[rr]); }
#pragma unroll
        for (int rr = 0; rr < 2; ++rr) { const int row = row0 + rr * nw; const float rstd = rsqrtf(ss[rr] * (1.f / 2048.f) + 1e-6f);
            const float* sh = mod + (size_t)row_ci(row) * 6144; const float* sc = sh + 2048;
#pragma unroll
            for (int it = 0; it < 4; ++it) { const int col = it * 512 + lane * 8; float h[8];
#pragma unroll
                for (int q = 0; q < 2; ++q) { const f32x4 w = *(const f32x4*)(nwt + col + 4 * q), s1 = *(const f32x4*)(sc + col + 4 * q), s0 = *(const f32x4*)(sh + col + 4 * q);
#pragma unroll
                    for (int j = 0; j < 4; ++j) h[4 * q + j] = x[rr][2 * it + q][j] * rstd * w[j] * (1.f + s1[j]) + s0[j]; }
                u32x4 o; o.x = cvtpk(h[0], h[1]); o.y = cvtpk(h[2], h[3]); o.z = cvtpk(h[4], h[5]); o.w = cvtpk(h[6], h[7]);
                *(u32x4*)(H0 + (size_t)row * DM + col) = o; } }
    }
}

struct EpiProj0 {
    static constexpr bool PERM = true, AFTER_DRAIN = false;
    unsigned char* ws;
    __device__ __forceinline__ void operator()(const f32x4 (&acc)[2][2][4][2], const Unit& u, int wr, int wc, int fr, int fq) const {
        const int row0 = u.pm * 256 + wr * 64 + fr; const int colt = u.pn * 256;
        if (u.pn == 44) {
            if (wc == 0) { bf16_t* D = (bf16_t*)(ws + WS_DLR);
#pragma unroll
                for (int ai = 0; ai < 2; ++ai)
#pragma unroll
                    for (int m = 0; m < 4; ++m) { const f32x4 v0 = acc[ai][0][m][0], v1 = acc[ai][0][m][1];
                        u32x4 w; w.x = cvtpk(v0[0], v0[1]); w.y = cvtpk(v0[2], v0[3]); w.z = cvtpk(v1[0], v1[1]); w.w = cvtpk(v1[2], v1[3]);
                        *(u32x4*)(D + (size_t)(row0 + ai * 128 + m * 16) * 32 + 8 * fq) = w; } }
            return; }
        bf16_t* base; int ldc, c0;
        if (colt < 1024) { base = (bf16_t*)(ws + WS_U); ldc = 1024; c0 = colt; }
        else if (colt < 2048) { base = (bf16_t*)(ws + WS_SG); ldc = 1024; c0 = colt - 1024; }
        else if (colt < 3584) { base = (bf16_t*)(ws + WS_Q); ldc = 1536; c0 = colt - 2048; }
        else if (colt < 5120) { base = (bf16_t*)(ws + WS_K); ldc = 1536; c0 = colt - 3584; }
        else if (colt < 8192) { base = (bf16_t*)(ws + WS_V); ldc = 3072; c0 = colt - 5120; }
        else { base = (bf16_t*)(ws + WS_GG); ldc = 3072; c0 = colt - 8192; }
        const int col0 = c0 + wc * 32 + 8 * fq;
#pragma unroll
        for (int ai = 0; ai < 2; ++ai)
#pragma unroll
            for (int m = 0; m < 4; ++m) { bf16_t* rowp = base + (size_t)(row0 + ai * 128 + m * 16) * ldc + col0;
#pragma unroll
                for (int bj = 0; bj < 2; ++bj) { const f32x4 v0 = acc[ai][bj][m][0], v1 = acc[ai][bj][m][1];
                    u32x4 w; w.x = cvtpk(v0[0], v0[1]); w.y = cvtpk(v0[2], v0[3]); w.z = cvtpk(v1[0], v1[1]); w.w = cvtpk(v1[2], v1[3]);
                    *(u32x4*)(rowp + bj * 128) = w; } }
    }
};
struct EpiDlr {
    static constexpr bool PERM = true, AFTER_DRAIN = false;
    unsigned char* ws;
    __device__ __forceinline__ void operator()(const f32x4 (&acc)[2][2][4][2], const Unit& u, int wr, int wc, int fr, int fq) const {
        const int row0 = u.pm * 256 + wr * 64 + fr;
        if (wc == 0) { bf16_t* D = (bf16_t*)(ws + WS_DLR);
#pragma unroll
            for (int ai = 0; ai < 2; ++ai)
#pragma unroll
                for (int m = 0; m < 4; ++m) { const f32x4 v0 = acc[ai][0][m][0], v1 = acc[ai][0][m][1];
                    u32x4 w; w.x = cvtpk(v0[0], v0[1]); w.y = cvtpk(v0[2], v0[3]); w.z = cvtpk(v1[0], v1[1]); w.w = cvtpk(v1[2], v1[3]);
                    *(u32x4*)(D + (size_t)(row0 + ai * 128 + m * 16) * 32 + 8 * fq) = w; } }
    }
};
struct EpiGlu {
    static constexpr bool PERM = true, AFTER_DRAIN = false;
    const bf16_t* GY; const bf16_t* SG; const float* glu_b; bf16_t* CAT;
    __device__ __forceinline__ void operator()(const f32x4 (&acc)[2][2][4][2], const Unit& u, int wr, int wc, int fr, int fq) const {
        const int row0 = u.pm * 256 + wr * 64 + fr, col0 = u.pn * 256 + wc * 32 + 8 * fq;
#pragma unroll
        for (int ai = 0; ai < 2; ++ai)
#pragma unroll
            for (int m = 0; m < 4; ++m) { const size_t row = (size_t)(row0 + ai * 128 + m * 16);
#pragma unroll
                for (int bj = 0; bj < 2; ++bj) { const int col = col0 + bj * 128;
                    const u32x4 g4 = *(const u32x4*)(GY + row * 1024 + col), s4 = *(const u32x4*)(SG + row * 1024 + col);
                    const f32x4 b0 = *(const f32x4*)(glu_b + col), b1 = *(const f32x4*)(glu_b + col + 4);
                    float o[8];
#pragma unroll
                    for (int j = 0; j < 4; ++j) { const float gy0 = (j & 1) ? bfhi(g4[j >> 1]) : bflo(g4[j >> 1]), sg0 = (j & 1) ? bfhi(s4[j >> 1]) : bflo(s4[j >> 1]);
                        const float gy1 = (j & 1) ? bfhi(g4[2 + (j >> 1)]) : bflo(g4[2 + (j >> 1)]), sg1 = (j & 1) ? bfhi(s4[2 + (j >> 1)]) : bflo(s4[2 + (j >> 1)]);
                        o[j] = gy0 * sigm(acc[ai][bj][m][0][j] + b0[j]) * silu(sg0); o[4 + j] = gy1 * sigm(acc[ai][bj][m][1][j] + b1[j]) * silu(sg1); }
                    u32x4 w; w.x = cvtpk(o[0], o[1]); w.y = cvtpk(o[2], o[3]); w.z = cvtpk(o[4], o[5]); w.w = cvtpk(o[6], o[7]);
                    *(u32x4*)(CAT + row * 4096 + col) = w; } }
    }
};
struct EpiRes {
    static constexpr bool PERM = false, AFTER_DRAIN = false;
    const float* xp; const float* xsm; const float* postab; const float* gatebase; const float* X1; int layer; float* xout;
    __device__ __forceinline__ void operator()(const f32x4 (&acc)[2][2][4][2], const Unit& u, int wr, int wc, int fr, int fq) const {
        const int row0 = u.pm * 256 + wr * 64 + fr, col0 = u.pn * 256 + wc * 32 + 4 * fq;
#pragma unroll
        for (int ai = 0; ai < 2; ++ai)
#pragma unroll
            for (int m = 0; m < 4; ++m) { const int row = row0 + ai * 128 + m * 16; const float* gate = gatebase + (size_t)row_ci(row) * 6144;
#pragma unroll
                for (int bj = 0; bj < 2; ++bj)
#pragma unroll
                    for (int n = 0; n < 2; ++n) { const int col = col0 + bj * 128 + n * 16;
                        f32x4 xi;
                        if (layer == 0) { if (row < NCTXR) xi = *(const f32x4*)(xp + (size_t)row * DM + col);
                            else { const int rr = row - NCTXR, t = rr & 4095, pos = col < 1024 ? (t >> 6) : (t & 63); xi = *(const f32x4*)(xsm + (size_t)rr * DM + col) + *(const f32x4*)(postab + pos * 1024 + (col & 1023)); } }
                        else xi = *(const f32x4*)(X1 + (size_t)row * DM + col);
                        const f32x4 g = *(const f32x4*)(gate + col);
                        *(f32x4*)(xout + (size_t)row * DM + col) = xi + g * acc[ai][bj][m][n]; } }
    }
};
struct EpiProj1 {
    static constexpr bool PERM = true, AFTER_DRAIN = false;
    unsigned char* ws;
    __device__ __forceinline__ void operator()(const f32x4 (&acc)[2][2][4][2], const Unit& u, int wr, int wc, int fr, int fq) const {
        const int row0 = u.pm * 256 + wr * 64 + fr;
        if (u.pn >= 32) { bf16_t* LR = (bf16_t*)(ws + WS_LR); const int cbase = (u.pn - 32) * 256 + wc * 32 + 8 * fq;
#pragma unroll
            for (int ai = 0; ai < 2; ++ai)
#pragma unroll
                for (int m = 0; m < 4; ++m) { const size_t row = (size_t)(row0 + ai * 128 + m * 16);
#pragma unroll
                    for (int bj = 0; bj < 2; ++bj) { const int col = cbase + bj * 128; if (col < 384) { f32x4 v0 = acc[ai][bj][m][0], v1 = acc[ai][bj][m][1];
                        if (col < 192) {
#pragma unroll
                            for (int j = 0; j < 4; ++j) { v0[j] = ftanh(v0[j]); v1[j] = ftanh(v1[j]); } }
                        u32x4 w; w.x = cvtpk(v0[0], v0[1]); w.y = cvtpk(v0[2], v0[3]); w.z = cvtpk(v1[0], v1[1]); w.w = cvtpk(v1[2], v1[3]);
                        *(u32x4*)(LR + row * 384 + col) = w; } } }
            return; }
        bf16_t* base = (bf16_t*)(ws + WS_R + (size_t)(u.pn >> 3) * 83886080ull); const int col0 = (u.pn & 7) * 256 + wc * 32 + 8 * fq;
#pragma unroll
        for (int ai = 0; ai < 2; ++ai)
#pragma unroll
            for (int m = 0; m < 4; ++m) { bf16_t* rowp = base + (size_t)(row0 + ai * 128 + m * 16) * DM + col0;
#pragma unroll
                for (int bj = 0; bj < 2; ++bj) { const f32x4 v0 = acc[ai][bj][m][0], v1 = acc[ai][bj][m][1];
                    u32x4 w; w.x = cvtpk(v0[0], v0[1]); w.y = cvtpk(v0[2], v0[3]); w.z = cvtpk(v1[0], v1[1]); w.w = cvtpk(v1[2], v1[3]);
                    *(u32x4*)(rowp + bj * 128) = w; } }
    }
};

__device__ __forceinline__ void seq_info(int s, int& base, int& L, int& b, bool& lat) { lat = s >= 16; b = lat ? s - 16 : s; base = lat ? NCTXR + b * 4096 : b * 256; L = lat ? 4096 : 256; }

constexpr int S5_LC = 256;
constexpr size_t S5_E_OFF = OUT_RWKV + 524288;
template <bool OUTPUT>
__device__ __forceinline__ void s5_chunk_item(const Params& p, int s, int g, int dir, int j) {
    const int lane = tidx() & 63; int base, L, b; bool lat; seq_info(s, base, L, b, lat);
    const float* AB = p.out + OUT_RWKV; const float* BBRE = AB + 16384; const float* BBIM = BBRE + 131072;
    const bf16_t* U = (const bf16_t*)(p.ws + WS_U); float* Y5 = p.out + OUT_Y + (size_t)dir * MTOK * 1024;
    const int sidx = (dir * 64 + g) * 64 + lane;
    const float ar = AB[sidx * 2], ai = AB[sidx * 2 + 1];
    float bbr[16], bbi[16], cr[16], cim[16];
    const float* cre = pin(p, I_CRE); const float* cimp = pin(p, I_CIM);
#pragma unroll
    for (int h = 0; h < 16; ++h) { bbr[h] = BBRE[sidx * 16 + h]; bbi[h] = BBIM[sidx * 16 + h]; if (OUTPUT) { cr[h] = cre[((dir * 64 + g) * 16 + h) * 64 + lane]; cim[h] = cimp[((dir * 64 + g) * 16 + h) * 64 + lane]; } }
    float hr = 0.f, hi = 0.f;
    float* E = p.out + S5_E_OFF + (size_t)(((b * 2 + dir) * 64 + g) * 16) * 128;
    if (OUTPUT && lat) {
        hr = pin(p, I_S5RE)[((b * 2 + dir) * 64 + g) * 64 + lane]; hi = pin(p, I_S5IM)[((b * 2 + dir) * 64 + g) * 64 + lane];
        float pr = ar, pi = ai;
#pragma unroll
        for (int k = 0; k < 8; ++k) { const float nr = pr * pr - pi * pi, ni = 2.f * pr * pi; pr = nr; pi = ni; }
        for (int i = 0; i < j; ++i) { const float er = E[i * 128 + lane * 2], ei = E[i * 128 + lane * 2 + 1]; const float nr = pr * hr - pi * hi + er, ni = pr * hi + pi * hr + ei; hr = nr; hi = ni; }
    }
    const int tau0 = j * S5_LC, t0 = dir ? L - 1 - tau0 : tau0, dtk = dir ? -1 : 1;
    const u32x4* up = (const u32x4*)(U + (size_t)(base + t0) * 1024 + g * 16);
    u32x4 ua = up[0], ub = up[1];
    for (int i = 0; i < S5_LC; ++i) {
        const int t = t0 + i * dtk; const size_t row = (size_t)(base + t);
        u32x4 na = ua, nb = ub;
        if (i + 1 < S5_LC) { const u32x4* np = (const u32x4*)(U + (size_t)(base + t + dtk) * 1024 + g * 16); na = np[0]; nb = np[1]; }
        float uu[16];
#pragma unroll
        for (int k = 0; k < 4; ++k) { uu[2 * k] = bflo(ua[k]); uu[2 * k + 1] = bfhi(ua[k]); uu[8 + 2 * k] = bflo(ub[k]); uu[8 + 2 * k + 1] = bfhi(ub[k]); }
        float bur = 0.f, bui = 0.f;
#pragma unroll
        for (int h = 0; h < 16; ++h) { bur += bbr[h] * uu[h]; bui += bbi[h] * uu[h]; }
        const float nr = ar * hr - ai * hi + bur, ni = ar * hi + ai * hr + bui; hr = nr; hi = ni;
        if (OUTPUT) {
            float z[16];
#pragma unroll
            for (int h = 0; h < 16; ++h) z[h] = hr * cr[h] - hi * cim[h];
            float z8[8], z4[4], z2[2], z1;
#pragma unroll
            for (int k = 0; k < 8; ++k) { const auto r = __builtin_amdgcn_permlane32_swap(__float_as_uint(z[k]), __float_as_uint(z[k + 8]), false, false); z8[k] = __uint_as_float(r[0]) + __uint_as_float(r[1]); }
#pragma unroll
            for (int k = 0; k < 4; ++k) { const auto r = __builtin_amdgcn_permlane16_swap(__float_as_uint(z8[k]), __float_as_uint(z8[k + 4]), false, false); z4[k] = __uint_as_float(r[0]) + __uint_as_float(r[1]); }
            { const bool up_ = lane & 8;
#pragma unroll
              for (int k = 0; k < 2; ++k) { const float keep = up_ ? z4[k + 2] : z4[k], send = up_ ? z4[k] : z4[k + 2];
                  z2[k] = keep + __int_as_float(__builtin_amdgcn_update_dpp(0, __float_as_int(send), 0x128, 0xf, 0xf, false)); } }
            { const bool up_ = lane & 4; const float keep = up_ ? z2[1] : z2[0], send = up_ ? z2[0] : z2[1];
              const float dn = __int_as_float(__builtin_amdgcn_update_dpp(0, __float_as_int(send), 0x104, 0xf, 0xf, false));
              const float upv = __int_as_float(__builtin_amdgcn_update_dpp(0, __float_as_int(send), 0x114, 0xf, 0xf, false));
              z1 = keep + (up_ ? upv : dn); }
            z1 += __int_as_float(__builtin_amdgcn_update_dpp(0, __float_as_int(z1), 0xB1, 0xf, 0xf, false));
            z1 += __int_as_float(__builtin_amdgcn_update_dpp(0, __float_as_int(z1), 0x4E, 0xf, 0xf, false));
            if ((lane & 3) == 0) { const int h = ((lane >> 5) & 1) * 8 + ((lane >> 4) & 1) * 4 + ((lane >> 3) & 1) * 2 + ((lane >> 2) & 1); Y5[row * 1024 + g * 16 + h] = z1; }
        }
        ua = na; ub = nb;
    }
    if (!OUTPUT) { E[j * 128 + lane * 2] = hr; E[j * 128 + lane * 2 + 1] = hi; }
    if (OUTPUT && !lat) { p.out[OUT_S5RE + ((b * 2 + dir) * 64 + g) * 64 + lane] = hr; p.out[OUT_S5IM + ((b * 2 + dir) * 64 + g) * 64 + lane] = hi; }
}
__device__ __forceinline__ void p_s5_gelu(const Params& p) {
    bf16_t* U = (bf16_t*)(p.ws + WS_U); const float* Y5F = p.out + OUT_Y; const float* Y5B = Y5F + (size_t)MTOK * 1024; const float* dsk = pin(p, I_S5D);
    const size_t n8 = (size_t)MTOK * 1024 / 8;
    for (size_t i = (size_t)blockIdx.x * 512 + tidx(); i < n8; i += (size_t)gridDim.x * 512) {
        const size_t e0 = i * 8; const int col = (int)(e0 & 1023);
        const u32x4 u4 = *(const u32x4*)(U + e0); float o[8];
#pragma unroll
        for (int q = 0; q < 2; ++q) { const f32x4 yf = *(const f32x4*)(Y5F + e0 + 4 * q), yb = *(const f32x4*)(Y5B + e0 + 4 * q), d4 = *(const f32x4*)(dsk + col + 4 * q);
#pragma unroll
            for (int j = 0; j < 4; ++j) { const unsigned w = u4[2 * q + (j >> 1)]; const float uu = (j & 1) ? bfhi(w) : bflo(w);
                const float y = d4[j] * uu + yf[j] + yb[j];
                o[4 * q + j] = y * __builtin_amdgcn_rcpf(1.f + __builtin_amdgcn_exp2f(-2.3022082f * (y + 0.044715f * y * y * y))); } }
        u32x4 w; w.x = cvtpk(o[0], o[1]); w.y = cvtpk(o[2], o[3]); w.z = cvtpk(o[4], o[5]); w.w = cvtpk(o[6], o[7]);
        *(u32x4*)(U + e0) = w;
    }
}

__device__ __forceinline__ float xs_rstd(const Params& p, int row, int lane) {
    if (row < 0 || row >= MTOK) return 0.f;
    const float* X1 = (const float*)(p.ws + WS_X1) + (size_t)row * DM; float ss = 0.f;
#pragma unroll
    for (int it = 0; it < 8; ++it) { const f32x4 x = *(const f32x4*)(X1 + it * 256 + lane * 4);
#pragma unroll
        for (int j = 0; j < 4; ++j) ss += x[j] * x[j]; }
    ss = wave_sum(ss); return rsqrtf(ss * (1.f / 2048.f) + 1e-6f);
}
__device__ __forceinline__ void xs_h16(const Params& p, int row, float rstd, int lane, int hf, float (&h)[16]) {
    if (row < 0 || row >= MTOK) {
#pragma unroll
        for (int j = 0; j < 16; ++j) h[j] = 0.f;
        return; }
    const float* X1 = (const float*)(p.ws + WS_X1) + (size_t)row * DM; const float* mod = P_MOD(p) + ((size_t)5 + row_ci(row)) * 6144; const float* nwt = pin(p, I_NORMW) + 2048;
#pragma unroll
    for (int i2 = 0; i2 < 2; ++i2)
#pragma unroll
        for (int q = 0; q < 2; ++q) { const int col = (hf * 2 + i2) * 512 + lane * 8 + 4 * q;
            const f32x4 x = *(const f32x4*)(X1 + col), w = *(const f32x4*)(nwt + col), s0 = *(const f32x4*)(mod + col), s1 = *(const f32x4*)(mod + 2048 + col);
#pragma unroll
            for (int j = 0; j < 4; ++j) h[i2 * 8 + q * 4 + j] = x[j] * rstd * w[j] * (1.f + s1[j]) + s0[j]; }
}
__device__ __forceinline__ void rwkv_tables(const Params& p);
__device__ __forceinline__ void p7_xs(const Params& p, LAS unsigned char* lds) {
    const int lane = tidx() & 63, gw = blockIdx.x * 8 + (tidx() >> 6), nw = gridDim.x * 8;
    bf16_t* XS = (bf16_t*)(p.out + OUT_Y); const float* mu = pin(p, I_MU);
    for (int item = gw; item < MTOK / 10; item += nw) {
        const int r0 = item * 10; LAS float* rs = (LAS float*)lds + (tidx() >> 6) * 16;
#pragma unroll 1
        for (int k = 0; k < 12; ++k) { const float v = xs_rstd(p, r0 - 1 + k, lane); if (lane == 0) rs[k] = v; }
#pragma unroll 1
        for (int hf = 0; hf < 2; ++hf) {
            float hp[16], hc[16], hn[16];
            xs_h16(p, r0 - 1, rs[0], lane, hf, hp); xs_h16(p, r0, rs[1], lane, hf, hc);
#pragma unroll 1
            for (int k = 0; k < 10; ++k) { const int r = r0 + k;
                const int L = r < NCTXR ? 256 : 4096, tin = r < NCTXR ? (r & 255) : ((r - NCTXR) & 4095);
                const bool first = tin == 0, last = tin == L - 1;
                xs_h16(p, r + 1, rs[k + 2], lane, hf, hn);
#pragma unroll
                for (int i2 = 0; i2 < 2; ++i2) { const int col = (hf * 2 + i2) * 512 + lane * 8; float o[8];
#pragma unroll
                    for (int q = 0; q < 2; ++q) { const f32x4 m0 = *(const f32x4*)(mu + col + 4 * q), m1 = *(const f32x4*)(mu + 2048 + col + 4 * q);
#pragma unroll
                        for (int j = 0; j < 4; ++j) { const int kk = i2 * 8 + q * 4 + j; const float c = hc[kk], pv = first ? 0.f : hp[kk], nv = last ? 0.f : hn[kk];
                            o[q * 4 + j] = c + m0[j] * (pv - c) + m1[j] * (nv - c); } }
                    u32x4 w; w.x = cvtpk(o[0], o[1]); w.y = cvtpk(o[2], o[3]); w.z = cvtpk(o[4], o[5]); w.w = cvtpk(o[6], o[7]);
                    *(u32x4*)(XS + (size_t)r * DM + col) = w; }
#pragma unroll
                for (int j = 0; j < 16; ++j) { hp[j] = hc[j]; hc[j] = hn[j]; }
            }
        }
    }
    __syncthreads();
    transpose_tiles(pin(p, I_OWIN), 2048, 8576, (bf16_t*)((unsigned char*)(p.out + OUT_Y) + OY_WT_O_IN_B), 8704, (LAS float*)lds, 0);
    transpose_tiles(pin(p, I_OWOUT), 2048, 2048, (bf16_t*)(p.ws + WS_WT_O_OUT), 2048, (LAS float*)lds, 128);
    rwkv_tables(p);
}

typedef pg8::bf16x8 bf16x8;
typedef float f32x16 __attribute__((ext_vector_type(16)));
typedef float f32x2v __attribute__((ext_vector_type(2)));
constexpr int GL_QD = 0, GL_KI = 33792, GL_KET = 67584, GL_VT = 104448, GL_ATT = 122880, GL_SEG = 132096, GL_EBL = 136192, GL_UPF = 137216, GL_BIAS = 153600, GL_END = 154624;
constexpr int GL_QS = 528, GL_KS = 144;
static_assert(GL_END <= LDS_BAR_OFF, "GLA LDS map");
constexpr int OB_SPLIT = 13653;
__device__ __forceinline__ bf16_t* ob_row(unsigned char* ws, int row) { return row < OB_SPLIT ? (bf16_t*)(ws + WS_U) + (size_t)row * 3072 : (bf16_t*)(ws + WS_WT_E_IN) + (size_t)(row - OB_SPLIT) * 3072; }

#ifndef GL_DELAY
#define GL_DELAY 0
#endif
#define GLD_BEGIN(S) unsigned long long gld_t0_##S = 0; if (GL_DELAY == S) gld_t0_##S = clock64();
#define GLD_END(S) if (GL_DELAY == S) { asm volatile("s_waitcnt lgkmcnt(0)" ::: "memory"); const unsigned long long t1_ = clock64(), d_ = t1_ - gld_t0_##S; while ((unsigned long long)clock64() - t1_ < d_) { } }
__device__ __forceinline__ void p_gla_chunk(const Params& p, LAS unsigned char* lds) {
    const int tid = tidx(), w = __builtin_amdgcn_readfirstlane(tid >> 6), l = tid & 63, n = l & 31, hh = l >> 5, g = l >> 4, c16 = l & 15, wg = blockIdx.x;
    const int mb = w & 1, np = w >> 1, d0 = 64 * np + 2 * n;
    const int arow = w & 3, acol = w >> 2;
    const bf16_t* Q = (const bf16_t*)(p.ws + WS_Q); const bf16_t* K = (const bf16_t*)(p.ws + WS_K); const bf16_t* V = (const bf16_t*)(p.ws + WS_V);
    const bf16_t* DLR = (const bf16_t*)(p.ws + WS_DLR); bf16_t* CAT = (bf16_t*)(p.out + OUT_Y);
    const float* decup = pin(p, I_DECUP); const float* decb = pin(p, I_DECB); const float* sgla = pin(p, I_SGLA);
    const int stride = wg < 192 ? 1000000 : 64;
    for (int u = wg; u < 960; u += stride) {
        int s_, h, dir, es; if (u < 192) { s_ = 16 + u / 48; const int r = u % 48; h = r >> 3; dir = (r >> 2) & 1; es = r & 3; } else { const int v = u - 192; s_ = v / 48; const int r = v % 48; h = r >> 3; dir = (r >> 2) & 1; es = r & 3; }
        int base, L, b; bool lat; seq_info(s_, base, L, b, lat);
        const int nst = L >> 6;
        { float ua[8], ub[8];
#pragma unroll
          for (int j = 0; j < 8; ++j) { const f32x2v pu = *(const f32x2v*)((const char*)decup + (unsigned)((dir * 16 + 8 * hh + j) * 1536 + h * 256 + d0) * 4u); ua[j] = pu.x; ub[j] = pu.y; }
          u32x4 a4, b4; a4.x = cvtpk(ua[0], ua[1]); a4.y = cvtpk(ua[2], ua[3]); a4.z = cvtpk(ua[4], ua[5]); a4.w = cvtpk(ua[6], ua[7]);
          b4.x = cvtpk(ub[0], ub[1]); b4.y = cvtpk(ub[2], ub[3]); b4.z = cvtpk(ub[4], ub[5]); b4.w = cvtpk(ub[6], ub[7]);
          *(LAS u32x4*)(lds + GL_UPF + tid * 32) = a4; *(LAS u32x4*)(lds + GL_UPF + tid * 32 + 16) = b4;
          if (mb == 0 && hh == 0) *(LAS f32x2v*)(lds + GL_BIAS + d0 * 4) = *(const f32x2v*)((const char*)decb + (unsigned)(dir * 1536 + h * 256 + d0) * 4u); }
        f32x4 Sacc[16];
        const unsigned sb = (unsigned)(((b * 2 + dir) * 6 + h) * 256 + 4 * g) * 512u + (unsigned)(es * 128 + 16 * w + c16);
#pragma unroll
        for (int db = 0; db < 16; ++db) Sacc[db] = (f32x4){0.f, 0.f, 0.f, 0.f};
        if (lat) {
#pragma unroll
            for (int db = 0; db < 16; ++db)
#pragma unroll
                for (int r = 0; r < 4; ++r) Sacc[db][r] = *(const float*)((const char*)sgla + (sb + (unsigned)((16 * db + r) * 512)) * 4u); }
        u32x4 pfq[4], pfk[4], pfv[2], pfd;
        const int cR = 32 * mb + 16 * ((n >> 2) & 1) + (n & 3) + 4 * (n >> 3);
#define GLA_ROW(st, c) (base + (dir ? L - 1 - ((st) * 64 + (c)) : (st) * 64 + (c)))
#define GLA_PREFETCH(st) do { \
        _Pragma("unroll") for (int i = 0; i < 4; ++i) { const int pi = tid + 512 * i, c = pi >> 5, pc = pi & 31; const unsigned off = (unsigned)GLA_ROW(st, c) * 3072u + (unsigned)(h * 512 + pc * 16); \
            pfq[i] = *(const u32x4*)((const char*)Q + off); pfk[i] = *(const u32x4*)((const char*)K + off); } \
        _Pragma("unroll") for (int i = 0; i < 2; ++i) { const int pi = tid + 512 * i, c = pi & 63, pc = pi >> 6; const unsigned off = (unsigned)GLA_ROW(st, c) * 6144u + (unsigned)(h * 1024 + es * 256 + pc * 16); \
            pfv[i] = *(const u32x4*)((const char*)V + off); } \
        { const unsigned off = (unsigned)GLA_ROW(st, cR) * 64u + (unsigned)(dir * 32 + 16 * hh); pfd = *(const u32x4*)((const char*)DLR + off); } } while (0)
        GLA_PREFETCH(0);
        __syncthreads();
        for (int st = 0; st < nst; ++st) {
            GLD_BEGIN(1)
#pragma unroll
            for (int i = 0; i < 4; ++i) { const int pi = tid + 512 * i, c = pi >> 5, pc = pi & 31; *(LAS u32x4*)(lds + GL_QD + c * GL_QS + pc * 16) = pfq[i]; *(LAS u32x4*)(lds + GL_KI + c * GL_QS + pc * 16) = pfk[i]; }
#pragma unroll
            for (int i = 0; i < 2; ++i) { const int pi = tid + 512 * i, c = pi & 63, pc = pi >> 6;
#pragma unroll
                for (int j = 0; j < 4; ++j) { const unsigned wv = pfv[i][j];
                    *(LAS bf16_t*)(lds + GL_VT + (pc * 8 + 2 * j) * GL_KS + c * 2) = (bf16_t)(wv & 0xffffu); *(LAS bf16_t*)(lds + GL_VT + (pc * 8 + 2 * j + 1) * GL_KS + c * 2) = (bf16_t)(wv >> 16); } }
            __builtin_amdgcn_sched_barrier(0);
#ifndef GL_REPS_0
#define GL_REPS_0 1
#define GL_REPS_2 1
#endif
            float bA[16], bB[16];
            for (int rep0 = 0; rep0 < GL_REPS_0; ++rep0) { const bf16x8 af = __builtin_bit_cast(bf16x8, pfd);
              const bf16x8 upA = *(const LAS bf16x8*)(lds + GL_UPF + tid * 32), upB = *(const LAS bf16x8*)(lds + GL_UPF + tid * 32 + 16);
              f32x16 zA, zB;
#pragma unroll
              for (int i = 0; i < 16; ++i) { zA[i] = 0.f; zB[i] = 0.f; }
              zA = __builtin_amdgcn_mfma_f32_32x32x16_bf16(af, upA, zA, 0, 0, 0); zB = __builtin_amdgcn_mfma_f32_32x32x16_bf16(af, upB, zB, 0, 0, 0);
              const f32x2v bi = *(const LAS f32x2v*)(lds + GL_BIAS + d0 * 4);
              float ra = 0.f, rb = 0.f;
#pragma unroll
              for (int i = 0; i < 16; ++i) {
                  const float za = zA[i] + bi.x, zb = zB[i] + bi.y;
                  const float la = fmaxf(fminf(za, 0.f) * 0.0625f - 0.04332169878f * __builtin_amdgcn_logf(1.f + __builtin_amdgcn_exp2f(-1.4426950409f * fabsf(za))), -1.f),
                              lb = fmaxf(fminf(zb, 0.f) * 0.0625f - 0.04332169878f * __builtin_amdgcn_logf(1.f + __builtin_amdgcn_exp2f(-1.4426950409f * fabsf(zb))), -1.f);
                  ra += la; rb += lb; bA[i] = ra; bB[i] = rb; }
              *(LAS f32x2v*)(lds + GL_SEG + ((2 * mb + hh) * 256 + d0) * 4) = (f32x2v){ra, rb}; }
            GLD_END(1)
            __syncthreads();
            GLD_BEGIN(2)
            if (st + 1 < nst) GLA_PREFETCH(st + 1);
            { float offA = 0.f, offB = 0.f, totA = 0.f, totB = 0.f; const int myseg = 2 * mb + hh;
#pragma unroll
              for (int sg = 0; sg < 4; ++sg) { const f32x2v t = *(LAS f32x2v*)(lds + GL_SEG + (sg * 256 + d0) * 4); if (sg < myseg) { offA += t.x; offB += t.y; } totA += t.x; totB += t.y; }
              const float eblA = __expf(totA), eblB = __expf(totB);
              if (myseg == 0) *(LAS f32x2v*)(lds + GL_EBL + d0 * 4) = (f32x2v){eblA, eblB};
              unsigned ke0[8], ke1[8];
#pragma unroll
              for (int i2 = 0; i2 < 8; ++i2) { float kea[2], keb[2];
#pragma unroll
                  for (int q = 0; q < 2; ++q) { const int i = 2 * i2 + q, c = 32 * mb + 16 * hh + i;
                      const float e1A = __expf(offA + bA[i]), e1B = __expf(offB + bB[i]); const float e2A = __builtin_amdgcn_rcpf(e1A), e2B = __builtin_amdgcn_rcpf(e1B);
                      LAS unsigned* qp = (LAS unsigned*)(lds + GL_QD + c * GL_QS + d0 * 2); LAS unsigned* kp = (LAS unsigned*)(lds + GL_KI + c * GL_QS + d0 * 2);
                      const unsigned qw = *qp, kw = *kp;
                      const float kiA = bflo(kw) * e2A, kiB = bfhi(kw) * e2B;
                      *qp = cvtpk(bflo(qw) * e1A * 0.0625f, bfhi(qw) * e1B * 0.0625f); *kp = cvtpk(kiA, kiB);
                      kea[q] = kiA * eblA; keb[q] = kiB * eblB; }
                  ke0[i2] = cvtpk(kea[0], kea[1]); ke1[i2] = cvtpk(keb[0], keb[1]); if (i2 & 1) __builtin_amdgcn_sched_barrier(0); }
              LAS u32x4* k0p = (LAS u32x4*)(lds + GL_KET + d0 * GL_KS + (32 * mb + 16 * hh) * 2); LAS u32x4* k1p = (LAS u32x4*)(lds + GL_KET + (d0 + 1) * GL_KS + (32 * mb + 16 * hh) * 2);
              k0p[0] = (u32x4){ke0[0], ke0[1], ke0[2], ke0[3]}; k0p[1] = (u32x4){ke0[4], ke0[5], ke0[6], ke0[7]};
              k1p[0] = (u32x4){ke1[0], ke1[1], ke1[2], ke1[3]}; k1p[1] = (u32x4){ke1[4], ke1[5], ke1[6], ke1[7]}; }
            GLD_END(2)
            __syncthreads();
            GLD_BEGIN(3)
            f32x4 oacc[4];
            for (int rep2 = 0; rep2 < GL_REPS_2; ++rep2) {
            { f32x4 att[2] = {(f32x4){0.f, 0.f, 0.f, 0.f}, (f32x4){0.f, 0.f, 0.f, 0.f}};
              bf16x8 aF[2], bF[2][2];
              aF[0] = *(const LAS bf16x8*)(lds + GL_QD + (16 * arow + c16) * GL_QS + (8 * g) * 2);
#pragma unroll
              for (int nb = 0; nb < 2; ++nb) bF[0][nb] = *(const LAS bf16x8*)(lds + GL_KI + (32 * acol + 16 * nb + c16) * GL_QS + (8 * g) * 2);
#pragma unroll
              for (int ks = 0; ks < 8; ++ks) {
                  if (ks + 1 < 8) { aF[(ks + 1) & 1] = *(const LAS bf16x8*)(lds + GL_QD + (16 * arow + c16) * GL_QS + (32 * (ks + 1) + 8 * g) * 2);
#pragma unroll
                      for (int nb = 0; nb < 2; ++nb) bF[(ks + 1) & 1][nb] = *(const LAS bf16x8*)(lds + GL_KI + (32 * acol + 16 * nb + c16) * GL_QS + (32 * (ks + 1) + 8 * g) * 2); }
                  __builtin_amdgcn_sched_barrier(0);
#pragma unroll
                  for (int nb = 0; nb < 2; ++nb) att[nb] = __builtin_amdgcn_mfma_f32_16x16x32_bf16(aF[ks & 1], bF[ks & 1][nb], att[nb], 0, 0, 0);
                  __builtin_amdgcn_sched_barrier(0); }
#pragma unroll
              for (int nb = 0; nb < 2; ++nb)
#pragma unroll
                  for (int r = 0; r < 4; ++r) { const int c = 16 * arow + 4 * g + r, sc = 32 * acol + 16 * nb + c16;
                      *(LAS bf16_t*)(lds + GL_ATT + c * GL_KS + sc * 2) = f2bf(sc <= c ? att[nb][r] : 0.f); } }
            oacc[0] = (f32x4){0.f, 0.f, 0.f, 0.f}; oacc[1] = oacc[0]; oacc[2] = oacc[0]; oacc[3] = oacc[0];
            { u32x2 qlo[2][4], qhi[2][4];
#pragma unroll
              for (int m4 = 0; m4 < 4; ++m4) { const LAS unsigned char* qrow = lds + GL_QD + (16 * m4 + c16) * GL_QS + (4 * g) * 2; qlo[0][m4] = *(const LAS u32x2*)qrow; qhi[0][m4] = *(const LAS u32x2*)(qrow + 32); }
#pragma unroll
              for (int ks = 0; ks < 8; ++ks) {
                  if (ks + 1 < 8) {
#pragma unroll
                      for (int m4 = 0; m4 < 4; ++m4) { const LAS unsigned char* qrow = lds + GL_QD + (16 * m4 + c16) * GL_QS + (32 * (ks + 1) + 4 * g) * 2; qlo[(ks + 1) & 1][m4] = *(const LAS u32x2*)qrow; qhi[(ks + 1) & 1][m4] = *(const LAS u32x2*)(qrow + 32); } }
                  __builtin_amdgcn_sched_barrier(0);
                  u32x4 s4; s4.x = cvtpk(Sacc[2 * ks][0], Sacc[2 * ks][1]); s4.y = cvtpk(Sacc[2 * ks][2], Sacc[2 * ks][3]); s4.z = cvtpk(Sacc[2 * ks + 1][0], Sacc[2 * ks + 1][1]); s4.w = cvtpk(Sacc[2 * ks + 1][2], Sacc[2 * ks + 1][3]);
                  const bf16x8 sf = __builtin_bit_cast(bf16x8, s4);
#pragma unroll
                  for (int m4 = 0; m4 < 4; ++m4) { const u32x2 lo = qlo[ks & 1][m4], hi = qhi[ks & 1][m4];
                      oacc[m4] = __builtin_amdgcn_mfma_f32_16x16x32_bf16(sf, __builtin_bit_cast(bf16x8, (u32x4){lo.x, lo.y, hi.x, hi.y}), oacc[m4], 0, 0, 0); }
                  __builtin_amdgcn_sched_barrier(0); } }
            }
            GLD_END(3)
            __syncthreads();
            GLD_BEGIN(4)
            { bf16x8 vf[2];
#pragma unroll
              for (int ks = 0; ks < 2; ++ks) vf[ks] = *(const LAS bf16x8*)(lds + GL_VT + (16 * w + c16) * GL_KS + (32 * ks + 8 * g) * 2);
#pragma unroll
              for (int ks = 0; ks < 2; ++ks)
#pragma unroll
                  for (int m4 = 0; m4 < 4; ++m4) { const bf16x8 af = *(const LAS bf16x8*)(lds + GL_ATT + (16 * m4 + c16) * GL_KS + (32 * ks + 8 * g) * 2);
                      oacc[m4] = __builtin_amdgcn_mfma_f32_16x16x32_bf16(vf[ks], af, oacc[m4], 0, 0, 0); }
#pragma unroll
              for (int db = 0; db < 16; ++db) { const f32x4 eb = *(const LAS f32x4*)(lds + GL_EBL + (16 * db + 4 * g) * 4); Sacc[db] = Sacc[db] * eb;
#pragma unroll
                  for (int ks = 0; ks < 2; ++ks) { const bf16x8 kf = *(const LAS bf16x8*)(lds + GL_KET + (16 * db + c16) * GL_KS + (32 * ks + 8 * g) * 2);
                      Sacc[db] = __builtin_amdgcn_mfma_f32_16x16x32_bf16(kf, vf[ks], Sacc[db], 0, 0, 0); } } }
#pragma unroll
            for (int m4 = 0; m4 < 4; ++m4) { const int row = GLA_ROW(st, 16 * m4 + c16); u32x2 o2; o2.x = cvtpk(oacc[m4][0], oacc[m4][1]); o2.y = cvtpk(oacc[m4][2], oacc[m4][3]);
                bf16_t* dst = dir ? ob_row(p.ws, row) + h * 512 + es * 128 + 16 * w + 4 * g : CAT + (size_t)row * 4096 + 1024 + h * 512 + es * 128 + 16 * w + 4 * g;
                *(u32x2*)dst = o2; }
            GLD_END(4)
            __syncthreads();
        }
        if (!lat) {
#pragma unroll
            for (int db = 0; db < 16; ++db)
#pragma unroll
                for (int r = 0; r < 4; ++r) *(float*)((char*)p.out + ((unsigned)OUT_GLA + sb + (unsigned)((16 * db + r) * 512)) * 4u) = Sacc[db][r]; }
#undef GLA_PREFETCH
#undef GLA_ROW
    }
}
__device__ __forceinline__ void p_gla_norm2(const Params& p) {
    const int lane = tidx() & 63, gw = blockIdx.x * 8 + (tidx() >> 6), nw = gridDim.x * 8;
    bf16_t* CAT = (bf16_t*)(p.out + OUT_Y); const bf16_t* GG = (const bf16_t*)(p.ws + WS_GG); const float* gnw = pin(p, I_GNW);
    for (int it0 = gw; it0 < MTOK * 6; it0 += 4 * nw) {
        u32x4 o4[4], b4[4], g4[4]; bf16_t* op[4]; int hh[4]; bool ok[4];
#pragma unroll
        for (int k = 0; k < 4; ++k) { const int it = it0 + k * nw; ok[k] = it < MTOK * 6; const int itc = ok[k] ? it : it0, row = itc / 6, h = itc % 6; hh[k] = h;
            op[k] = CAT + (size_t)row * 4096 + 1024 + h * 512 + lane * 8; o4[k] = *(const u32x4*)op[k]; b4[k] = *(const u32x4*)(ob_row(p.ws, row) + h * 512 + lane * 8); g4[k] = *(const u32x4*)(GG + (size_t)row * 3072 + h * 512 + lane * 8); }
#pragma unroll
        for (int k = 0; k < 4; ++k) { const int h = hh[k];
            float o[8], g[8];
#pragma unroll
            for (int j = 0; j < 4; ++j) { o[2 * j] = bflo(o4[k][j]) + bflo(b4[k][j]); o[2 * j + 1] = bfhi(o4[k][j]) + bfhi(b4[k][j]); g[2 * j] = bflo(g4[k][j]); g[2 * j + 1] = bfhi(g4[k][j]); }
            float ss = 0.f;
#pragma unroll
            for (int j = 0; j < 8; ++j) ss += o[j] * o[j];
            ss = wave_sum(ss); const float rstd = rsqrtf(ss * (1.f / 512.f) + 1e-6f);
            const f32x4 w0 = *(const f32x4*)(gnw + h * 512 + lane * 8), w1 = *(const f32x4*)(gnw + h * 512 + lane * 8 + 4);
            float r[8];
#pragma unroll
            for (int j = 0; j < 8; ++j) r[j] = o[j] * rstd * (j < 4 ? w0[j] : w1[j - 4]) * silu(g[j]);
            u32x4 wv; wv.x = cvtpk(r[0], r[1]); wv.y = cvtpk(r[2], r[3]); wv.z = cvtpk(r[4], r[5]); wv.w = cvtpk(r[6], r[7]);
            if (ok[k]) *(u32x4*)op[k] = wv; }
    }
}

typedef float f32x16s __attribute__((ext_vector_type(16)));

constexpr int S5_HT_STRIDE = 528, S5_HT_BYTES = 32 * S5_HT_STRIDE;
__device__ __forceinline__ u32x2 split_pk_(float a, float b) { u32x2 r; r.x = cvtpk(a, b); r.y = cvtpk(a - bflo(r.x), b - bfhi(r.x)); return r; }
#define split_pk(a, b, hi, lo) do { const u32x2 sp_ = split_pk_((a), (b)); (hi) = sp_.x; (lo) = sp_.y; } while (0)
template <bool OUTPUT>
__device__ __forceinline__ void s5_mfma_item(const Params& p, LAS unsigned char* ht, int g, int dir, int cidx0, int cidx1) {
    const int lane = tidx() & 63, n = lane & 31, hh = lane >> 5, c16 = lane & 15, g4 = lane >> 4;
    const float* AB = p.out + OUT_RWKV; const float* BBRE = AB + 16384; const float* BBIM = BBRE + 131072;
    const bf16_t* U = (const bf16_t*)(p.ws + WS_U); float* Y5 = p.out + OUT_Y + (size_t)dir * MTOK * 1024;
    int cbase[2], cL[2], cj[2], cb[2]; bool clat[2];
#pragma unroll
    for (int c = 0; c < 2; ++c) { const int ci = c ? cidx1 : cidx0; clat[c] = ci < 64; cb[c] = clat[c] ? (ci >> 4) : ci - 64; cj[c] = clat[c] ? (ci & 15) : 0; cbase[c] = clat[c] ? NCTXR + cb[c] * 4096 : cb[c] * 256; cL[c] = clat[c] ? 4096 : 256; }
    const int sidx0 = (dir * 64 + g) * 64 + n, sidx1 = sidx0 + 32;
    const float ar0 = AB[sidx0 * 2], ai0 = AB[sidx0 * 2 + 1], ar1 = AB[sidx1 * 2], ai1 = AB[sidx1 * 2 + 1];
    bf16x8 bbf[4], bbl[4];
#pragma unroll
    for (int nb = 0; nb < 4; ++nb) { const float* src = ((nb >> 1) ? BBIM : BBRE) + ((nb & 1) ? sidx1 : sidx0) * 16 + 8 * hh; const f32x4 v0 = *(const f32x4*)src, v1 = *(const f32x4*)(src + 4);
        u32x4 w, wl; split_pk(v0[0], v0[1], w.x, wl.x); split_pk(v0[2], v0[3], w.y, wl.y); split_pk(v1[0], v1[1], w.z, wl.z); split_pk(v1[2], v1[3], w.w, wl.w);
        bbf[nb] = __builtin_bit_cast(bf16x8, w); bbl[nb] = __builtin_bit_cast(bf16x8, wl); }
    bf16x8 cmf[4], cml[4];
    if (OUTPUT) { const float* cre = pin(p, I_CRE) + ((dir * 64 + g) * 16 + c16) * 64; const float* cim = pin(p, I_CIM) + ((dir * 64 + g) * 16 + c16) * 64;
#pragma unroll
        for (int ks = 0; ks < 4; ++ks) { const int s0 = 8 * ks + 2 * g4;
            u32x4 w, wl; split_pk(cre[s0], -cim[s0], w.x, wl.x); split_pk(cre[s0 + 32], -cim[s0 + 32], w.y, wl.y); split_pk(cre[s0 + 1], -cim[s0 + 1], w.z, wl.z); split_pk(cre[s0 + 33], -cim[s0 + 33], w.w, wl.w);
            cmf[ks] = __builtin_bit_cast(bf16x8, w); cml[ks] = __builtin_bit_cast(bf16x8, wl); } }
    float hr0 = 0.f, hi0 = 0.f, hr1 = 0.f, hi1 = 0.f;
    const bool mylat = hh ? clat[1] : clat[0]; const int myb = hh ? cb[1] : cb[0], myj = hh ? cj[1] : cj[0];
    float* E = p.out + S5_E_OFF + (size_t)(((myb * 2 + dir) * 64 + g) * 16) * 128;
    if (OUTPUT && mylat) {
        const float* s5r = pin(p, I_S5RE); const float* s5i = pin(p, I_S5IM); const int hidx = ((myb * 2 + dir) * 64 + g) * 64 + n;
        hr0 = s5r[hidx]; hi0 = s5i[hidx]; hr1 = s5r[hidx + 32]; hi1 = s5i[hidx + 32];
        float pr0 = ar0, pi0 = ai0, pr1 = ar1, pi1 = ai1;
#pragma unroll
        for (int k = 0; k < 8; ++k) { const float a = pr0 * pr0 - pi0 * pi0, b2 = 2.f * pr0 * pi0; pr0 = a; pi0 = b2; const float c = pr1 * pr1 - pi1 * pi1, d = 2.f * pr1 * pi1; pr1 = c; pi1 = d; }
        for (int i = 0; i < myj; ++i) { const f32x2v e0 = *(const f32x2v*)(E + i * 128 + n * 2), e1 = *(const f32x2v*)(E + i * 128 + (n + 32) * 2);
            const float a = pr0 * hr0 - pi0 * hi0 + e0.x, b2 = pr0 * hi0 + pi0 * hr0 + e0.y; hr0 = a; hi0 = b2;
            const float c = pr1 * hr1 - pi1 * hi1 + e1.x, d = pr1 * hi1 + pi1 * hr1 + e1.y; hr1 = c; hi1 = d; }
    }
    const int ca = (n >> 2) & 1, ia = (n & 3) + 4 * (n >> 3);
    const int abase = ca ? cbase[1] : cbase[0], aL = ca ? cL[1] : cL[0], aj = ca ? cj[1] : cj[0];
#define S5_AROW(st) (abase + (dir ? aL - 1 - (aj * 256 + (st) * 16 + ia) : aj * 256 + (st) * 16 + ia))
    u32x4 anext = *(const u32x4*)(U + (size_t)S5_AROW(0) * 1024 + g * 16 + 8 * hh);
    for (int st = 0; st < 16; ++st) {
        const bf16x8 af = __builtin_bit_cast(bf16x8, anext);
        if (st + 1 < 16) anext = *(const u32x4*)(U + (size_t)S5_AROW(st + 1) * 1024 + g * 16 + 8 * hh);
        f32x16s acc[4];
#pragma unroll
        for (int nb = 0; nb < 4; ++nb) {
#pragma unroll
            for (int i = 0; i < 16; ++i) acc[nb][i] = 0.f;
            acc[nb] = __builtin_amdgcn_mfma_f32_32x32x16_bf16(af, bbf[nb], acc[nb], 0, 0, 0); acc[nb] = __builtin_amdgcn_mfma_f32_32x32x16_bf16(af, bbl[nb], acc[nb], 0, 0, 0); }
#pragma unroll
        for (int i = 0; i < 16; ++i) {
            const float a = ar0 * hr0 - ai0 * hi0 + acc[0][i], b2 = ar0 * hi0 + ai0 * hr0 + acc[2][i]; hr0 = a; hi0 = b2;
            const float c = ar1 * hr1 - ai1 * hi1 + acc[1][i], d = ar1 * hi1 + ai1 * hr1 + acc[3][i]; hr1 = c; hi1 = d;
            if (OUTPUT) { u32x2 w, wl; split_pk(hr0, hi0, w.x, wl.x); split_pk(hr1, hi1, w.y, wl.y); *(LAS u32x2*)(ht + (16 * hh + i) * S5_HT_STRIDE + n * 8) = w; *(LAS u32x2*)(ht + (16 * hh + i) * S5_HT_STRIDE + 256 + n * 8) = wl; } }
        if (OUTPUT) {
            asm volatile("s_waitcnt lgkmcnt(0)" ::: "memory");
#pragma unroll
            for (int mbk = 0; mbk < 2; ++mbk) { f32x4 y = (f32x4){0.f, 0.f, 0.f, 0.f};
#pragma unroll
                for (int ks = 0; ks < 4; ++ks) { const bf16x8 hf = *(const LAS bf16x8*)(ht + (16 * mbk + c16) * S5_HT_STRIDE + (32 * ks + 8 * g4) * 2), hl = *(const LAS bf16x8*)(ht + (16 * mbk + c16) * S5_HT_STRIDE + 256 + (32 * ks + 8 * g4) * 2);
                    y = __builtin_amdgcn_mfma_f32_16x16x32_bf16(cmf[ks], hf, y, 0, 0, 0); y = __builtin_amdgcn_mfma_f32_16x16x32_bf16(cmf[ks], hl, y, 0, 0, 0); y = __builtin_amdgcn_mfma_f32_16x16x32_bf16(cml[ks], hf, y, 0, 0, 0); }
                const int tau = cj[mbk] * 256 + st * 16 + c16, t = dir ? cL[mbk] - 1 - tau : tau;
                *(f32x4*)(Y5 + (size_t)(cbase[mbk] + t) * 1024 + g * 16 + 4 * g4) = y; }
            asm volatile("" ::: "memory"); }
    }
#undef S5_AROW
    if (!OUTPUT) { *(f32x2v*)(E + myj * 128 + n * 2) = (f32x2v){hr0, hi0}; *(f32x2v*)(E + myj * 128 + (n + 32) * 2) = (f32x2v){hr1, hi1}; }
    if (OUTPUT && !mylat) { const int o = ((myb * 2 + dir) * 64 + g) * 64 + n; p.out[OUT_S5RE + o] = hr0; p.out[OUT_S5IM + o] = hi0; p.out[OUT_S5RE + o + 32] = hr1; p.out[OUT_S5IM + o + 32] = hi1; }
}
__device__ __forceinline__ void p_s5_passA(const Params& p, LAS unsigned char* lds) {
    const int wv = tidx() >> 6, gw = blockIdx.x * 8 + wv, nw = gridDim.x * 8;
    for (int it = gw; it < 30 * 128; it += nw) { const int pi = it >> 7, dir = (it >> 6) & 1, g = it & 63; const int i0 = 2 * pi, i1 = 2 * pi + 1;
        s5_mfma_item<false>(p, lds + wv * S5_HT_BYTES, g, dir, (i0 / 15) * 16 + i0 % 15, (i1 / 15) * 16 + i1 % 15); }
}
__device__ __forceinline__ void p_s5_passC_lat(const Params& p, LAS unsigned char* lds) {
    const int wv = tidx() >> 6, gw = blockIdx.x * 8 + wv, nw = gridDim.x * 8;
    for (int it = gw; it < 32 * 128; it += nw) { const int pi = it >> 7, dir = (it >> 6) & 1, g = it & 63;
        s5_mfma_item<true>(p, lds + wv * S5_HT_BYTES, g, dir, 2 * pi, 2 * pi + 1); }
}
__device__ __forceinline__ void p_s5_passC_ctx(const Params& p) {
    const int wv = tidx() >> 6, gw = blockIdx.x * 8 + wv, nw = gridDim.x * 8;
    for (int c = gw; c < 2048; c += nw) { const int dir = c & 1, g = (c >> 1) & 63, b = c >> 7; s5_chunk_item<true>(p, b, g, dir, 0); }
}

__device__ __forceinline__ float red4(float x) {
    { const auto r = __builtin_amdgcn_permlane16_swap(__float_as_uint(x), __float_as_uint(x), false, false); x = __uint_as_float(r[0]) + __uint_as_float(r[1]); }
    { const auto r = __builtin_amdgcn_permlane32_swap(__float_as_uint(x), __float_as_uint(x), false, false); x = __uint_as_float(r[0]) + __uint_as_float(r[1]); }
    return x;
}
#define RW_DPP(n) " row_newbcast:" #n " row_mask:0xf bank_mask:0xf\n\t"
#define RW_B1_SA(n, acc) "v_fmac_f32_dpp %" #acc ", %24, %" #n RW_DPP(n)
#define RW_B1_MUL(n) "v_mul_f32_dpp %" #n ", %25, %" #n RW_DPP(n)
#define RW_B1_KD(n) "v_fmac_f32_dpp %" #n ", %26, %28" RW_DPP(n)
#define RW_B1_YT(n, acc) "v_fmac_f32_dpp %" #acc ", %27, %" #n RW_DPP(n)
__device__ __forceinline__ void rw_block1(float (&S)[16], float A, float W, float KD, float R, float vi, float& sa, float& yt) {
    float s0 = 0.f, s1 = 0.f, s2 = 0.f, s3 = 0.f, y0 = 0.f, y1 = 0.f, y2 = 0.f, y3 = 0.f;
    asm("s_nop 1\n\t"
        RW_B1_SA(0, 16) RW_B1_SA(1, 17) RW_B1_SA(2, 18) RW_B1_SA(3, 19) RW_B1_SA(4, 16) RW_B1_SA(5, 17) RW_B1_SA(6, 18) RW_B1_SA(7, 19)
        RW_B1_SA(8, 16) RW_B1_SA(9, 17) RW_B1_SA(10, 18) RW_B1_SA(11, 19) RW_B1_SA(12, 16) RW_B1_SA(13, 17) RW_B1_SA(14, 18) RW_B1_SA(15, 19)
        RW_B1_MUL(0) RW_B1_MUL(1) RW_B1_MUL(2) RW_B1_MUL(3) RW_B1_MUL(4) RW_B1_MUL(5) RW_B1_MUL(6) RW_B1_MUL(7) RW_B1_MUL(8) RW_B1_MUL(9) RW_B1_MUL(10) RW_B1_MUL(11) RW_B1_MUL(12) RW_B1_MUL(13) RW_B1_MUL(14) RW_B1_MUL(15)
        RW_B1_KD(0) RW_B1_KD(1) RW_B1_KD(2) RW_B1_KD(3) RW_B1_KD(4) RW_B1_KD(5) RW_B1_KD(6) RW_B1_KD(7) RW_B1_KD(8) RW_B1_KD(9) RW_B1_KD(10) RW_B1_KD(11) RW_B1_KD(12) RW_B1_KD(13) RW_B1_KD(14) RW_B1_KD(15)
        RW_B1_YT(0, 20) RW_B1_YT(1, 21) RW_B1_YT(2, 22) RW_B1_YT(3, 23) RW_B1_YT(4, 20) RW_B1_YT(5, 21) RW_B1_YT(6, 22) RW_B1_YT(7, 23)
        RW_B1_YT(8, 20) RW_B1_YT(9, 21) RW_B1_YT(10, 22) RW_B1_YT(11, 23) RW_B1_YT(12, 20) RW_B1_YT(13, 21) RW_B1_YT(14, 22) RW_B1_YT(15, 23)
        : "+v"(S[0]), "+v"(S[1]), "+v"(S[2]), "+v"(S[3]), "+v"(S[4]), "+v"(S[5]), "+v"(S[6]), "+v"(S[7]), "+v"(S[8]), "+v"(S[9]), "+v"(S[10]), "+v"(S[11]), "+v"(S[12]), "+v"(S[13]), "+v"(S[14]), "+v"(S[15]),
          "+v"(s0), "+v"(s1), "+v"(s2), "+v"(s3), "+v"(y0), "+v"(y1), "+v"(y2), "+v"(y3)
        : "v"(A), "v"(W), "v"(KD), "v"(R), "v"(vi));
    sa = (s0 + s1) + (s2 + s3); yt = (y0 + y1) + (y2 + y3);
}
#define RW_B2(n) "v_fmac_f32_dpp %" #n ", %16, %17" RW_DPP(n)
__device__ __forceinline__ void rw_block2(float (&S)[16], float B, float sa) {
    asm("s_nop 1\n\t"
        RW_B2(0) RW_B2(1) RW_B2(2) RW_B2(3) RW_B2(4) RW_B2(5) RW_B2(6) RW_B2(7) RW_B2(8) RW_B2(9) RW_B2(10) RW_B2(11) RW_B2(12) RW_B2(13) RW_B2(14) RW_B2(15)
        : "+v"(S[0]), "+v"(S[1]), "+v"(S[2]), "+v"(S[3]), "+v"(S[4]), "+v"(S[5]), "+v"(S[6]), "+v"(S[7]), "+v"(S[8]), "+v"(S[9]), "+v"(S[10]), "+v"(S[11]), "+v"(S[12]), "+v"(S[13]), "+v"(S[14]), "+v"(S[15])
        : "v"(B), "v"(sa));
}

constexpr int RW_W2 = 0, RW_A2 = 13312, RW_W = 26624, RW_A = 34816, RW_B = 38912, RW_KD = 43008, RW_R = 47104, RW_V = 51200, RW_YO = 55296, RW_BR = 63488, RW_CST = 63616, RW_HALF_BYTES = 64896, RW_TS = 208;
static_assert(2 * RW_HALF_BYTES <= LDS_BAR_OFF, "RWKV LDS map");
__device__ __forceinline__ void rwkv_tables(const Params& p) {
    const float* w2 = pin(p, I_W2); const float* a2 = pin(p, I_A2); bf16_t* W2T = (bf16_t*)(p.ws + WS_W2T); bf16_t* A2T = (bf16_t*)(p.ws + WS_A2T);
    for (int i = blockIdx.x * 512 + tidx(); i < 2 * 2048 * 96; i += gridDim.x * 512) { const int k = i % 96, c = (i / 96) & 2047, d = i / (96 * 2048);
        W2T[i] = f2bf(w2[(size_t)(d * 96 + k) * 2048 + c]); A2T[i] = f2bf(a2[(size_t)(d * 96 + k) * 2048 + c]); }
}
__device__ __forceinline__ void p9_rwkv(const Params& p, LAS unsigned char* lds) {
    const int tid = tidx(), half = tid >> 8, htid = tid & 255, hw = __builtin_amdgcn_readfirstlane((tid >> 6) & 3), lane = tid & 63, m = lane & 15, q = lane >> 4, wg = blockIdx.x, nwg = gridDim.x;
    LAS unsigned char* hl = lds + half * RW_HALF_BYTES;
    LAS float* AW = (LAS float*)(hl + RW_W); LAS float* YO = (LAS float*)(hl + RW_YO);
    const bf16_t* R = (const bf16_t*)(p.ws + WS_R); const bf16_t* K1 = (const bf16_t*)(p.ws + WS_K1); const bf16_t* V1 = (const bf16_t*)(p.ws + WS_V1); const bf16_t* LR = (const bf16_t*)(p.ws + WS_LR);
    const bf16_t* W2T = (const bf16_t*)(p.ws + WS_W2T); const bf16_t* A2T = (const bf16_t*)(p.ws + WS_A2T);
    float* BON = (float*)(p.ws + WS_BON); bf16_t* YD = (bf16_t*)(p.out + OUT_Y);
    const float* w0p = pin(p, I_W0); const float* a0p = pin(p, I_A0); const float* kkp = pin(p, I_KK); const float* kap = pin(p, I_KA); const float* rkp = pin(p, I_RK); const float* srw = pin(p, I_SRWKV);
    const int nun = half == 0 ? (256 - wg + nwg - 1) / nwg : (1024 - wg + nwg - 1) / nwg;
    const int bpu = half == 0 ? 128 : 8;
    const int my_steps = nun * bpu;
    const int n0 = (256 - wg + nwg - 1) / nwg * 128, n1 = (1024 - wg + nwg - 1) / nwg * 8;
    const int nsteps = n0 > n1 ? n0 : n1;
    float S[16];
    int base = 0, L = 0, b = 0, head = 0, dir = 0; bool lat = false;
    pg8::bf16x8 pftw[3], pfta[3]; u32x2 pfr[4], pfk[4], pfv[4];
#define RW_PREFETCH(bk) do { const int tau_ = (bk) * 32 + 16 * hw + m, t_ = dir ? L - 1 - tau_ : tau_; const unsigned row_ = (unsigned)(base + t_); \
        _Pragma("unroll") for (int ks = 0; ks < 3; ++ks) { pftw[ks] = *(const pg8::bf16x8*)((const char*)LR + row_ * 768u + (unsigned)(dir * 192 + (32 * ks + 8 * q) * 2)); \
            pfta[ks] = *(const pg8::bf16x8*)((const char*)LR + row_ * 768u + (unsigned)(384 + dir * 192 + (32 * ks + 8 * q) * 2)); } \
        _Pragma("unroll") for (int mb = 0; mb < 4; ++mb) { const unsigned ch_ = (unsigned)(head * 64 + 16 * mb + 4 * q); \
            pfr[mb] = *(const u32x2*)((const char*)R + (row_ * 2048u + ch_) * 2u); pfk[mb] = *(const u32x2*)((const char*)K1 + (row_ * 2048u + ch_) * 2u); pfv[mb] = *(const u32x2*)((const char*)V1 + (row_ * 2048u + ch_) * 2u); } } while (0)
    for (int step = 0; step < nsteps; ++step) {
        const bool active = step < my_steps; const int blk = step % bpu;
        if (active && blk == 0) {
            const int un = wg + (step / bpu) * nwg; int s;
            if (half == 0) { s = 16 + (un >> 6); head = (un >> 1) & 31; dir = un & 1; } else { s = un >> 6; head = (un >> 1) & 31; dir = un & 1; }
            seq_info(s, base, L, b, lat);
            for (int i = htid; i < 768; i += 256) { const int ch = i / 12, pc = i % 12; const size_t go = ((size_t)(dir * 2048 + head * 64 + ch) * 96 + pc * 8);
                *(LAS u32x4*)(hl + RW_W2 + ch * RW_TS + pc * 16) = *(const u32x4*)(W2T + go); *(LAS u32x4*)(hl + RW_A2 + ch * RW_TS + pc * 16) = *(const u32x4*)(A2T + go); }
            if (htid < 64) { LAS float* cst = (LAS float*)(hl + RW_CST); const int c = head * 64 + htid;
                cst[htid] = w0p[dir * 2048 + c]; cst[64 + htid] = a0p[dir * 2048 + c]; cst[128 + htid] = kkp[c]; cst[192 + htid] = kap[c]; cst[256 + htid] = rkp[c]; }
            if (hw < 2) RW_PREFETCH(0);
            const unsigned sb = (unsigned)((((b * 2 + dir) * 32 + head) * 64 + hw * 16 + m) * 64 + q * 16);
#pragma unroll
            for (int n = 0; n < 16; ++n) S[n] = 0.f;
            if (lat) {
#pragma unroll
                for (int n = 0; n < 16; ++n) S[n] = *(const float*)((const char*)srw + (sb + n) * 4u); }
        }
        __syncthreads();
        if (active && hw < 2) {
            const int tok = 16 * hw + m, tau = blk * 32 + tok, t = dir ? L - 1 - tau : tau; const unsigned row = (unsigned)(base + t);
            f32x4 dW[4], dA[4];
#pragma unroll
            for (int mb = 0; mb < 4; ++mb) { dW[mb] = (f32x4){0.f, 0.f, 0.f, 0.f}; dA[mb] = (f32x4){0.f, 0.f, 0.f, 0.f}; }
#pragma unroll
            for (int ks = 0; ks < 3; ++ks) {
                const pg8::bf16x8 tw = pftw[ks], ta = pfta[ks];
#pragma unroll
                for (int mb = 0; mb < 4; ++mb) { const pg8::bf16x8 wf = *(const LAS pg8::bf16x8*)(hl + RW_W2 + (16 * mb + m) * RW_TS + (32 * ks + 8 * q) * 2), af = *(const LAS pg8::bf16x8*)(hl + RW_A2 + (16 * mb + m) * RW_TS + (32 * ks + 8 * q) * 2);
                    dW[mb] = __builtin_amdgcn_mfma_f32_16x16x32_bf16(wf, tw, dW[mb], 0, 0, 0); dA[mb] = __builtin_amdgcn_mfma_f32_16x16x32_bf16(af, ta, dA[mb], 0, 0, 0); } }
            float kk[16], kd[16], av[16], ss = 0.f, bon = 0.f;
#pragma unroll
            for (int mb = 0; mb < 4; ++mb) {
                const u32x2 r2 = pfr[mb], k2 = pfk[mb], v2 = pfv[mb]; const LAS float* cst = (const LAS float*)(hl + RW_CST) + 16 * mb + 4 * q;
                const f32x4 w0 = *(const LAS f32x4*)cst, a0 = *(const LAS f32x4*)(cst + 64), kkw = *(const LAS f32x4*)(cst + 128), kaw = *(const LAS f32x4*)(cst + 192), rkw = *(const LAS f32x4*)(cst + 256);
                const float rr[4] = {bflo(r2.x), bfhi(r2.x), bflo(r2.y), bfhi(r2.y)}, k0[4] = {bflo(k2.x), bfhi(k2.x), bflo(k2.y), bfhi(k2.y)};
                f32x4 oW;
#pragma unroll
                for (int j = 0; j < 4; ++j) { const int e = 4 * mb + j;
                    const float xw = -(w0[j] + dW[mb][j]);
                    const float sp = fmaxf(xw, 0.f) + __logf(1.f + __expf(-fabsf(xw)));
                    oW[j] = __expf(-__expf(-sp - 0.5f));
                    const float a = 1.f / (1.f + __expf(-(a0[j] + dA[mb][j])));
                    kk[e] = k0[j] * kkw[j]; ss += kk[e] * kk[e]; av[e] = a;
                    kd[e] = k0[j] * (1.f + (a - 1.f) * kaw[j]); bon += rr[j] * kd[e] * rkw[j]; }
                *(LAS f32x4*)(hl + RW_W + (tok * 64 + 16 * mb + 4 * q) * 4) = oW;
                *(LAS u32x2*)(hl + RW_R + (tok * 64 + 16 * mb + 4 * q) * 2) = r2; *(LAS u32x2*)(hl + RW_V + (tok * 64 + 16 * mb + 4 * q) * 2) = v2;
                u32x2 kdp; kdp.x = cvtpk(kd[4 * mb], kd[4 * mb + 1]); kdp.y = cvtpk(kd[4 * mb + 2], kd[4 * mb + 3]); *(LAS u32x2*)(hl + RW_KD + (tok * 64 + 16 * mb + 4 * q) * 2) = kdp; }
            ss = red4(ss); bon = red4(bon);
            const float inv = 1.f / fmaxf(sqrtf(ss), 1e-12f);
            if (q == 0) BON[((size_t)dir * MTOK + row) * 32 + head] = bon;
            float br = 0.f;
#pragma unroll
            for (int mb = 0; mb < 4; ++mb) { u32x2 ap, bp; float kn[4];
#pragma unroll
                for (int j = 0; j < 4; ++j) kn[j] = kk[4 * mb + j] * inv;
                { const u32x2 r2 = *(LAS u32x2*)(hl + RW_R + (tok * 64 + 16 * mb + 4 * q) * 2); const u32x2 bq = (u32x2){cvtpk(kn[0] * av[4 * mb], kn[1] * av[4 * mb + 1]), cvtpk(kn[2] * av[4 * mb + 2], kn[3] * av[4 * mb + 3])};
                  br += bflo(bq.x) * bflo(r2.x) + bfhi(bq.x) * bfhi(r2.x) + bflo(bq.y) * bflo(r2.y) + bfhi(bq.y) * bfhi(r2.y); }
                ap.x = cvtpk(-kn[0], -kn[1]); ap.y = cvtpk(-kn[2], -kn[3]);
                bp.x = cvtpk(kn[0] * av[4 * mb], kn[1] * av[4 * mb + 1]); bp.y = cvtpk(kn[2] * av[4 * mb + 2], kn[3] * av[4 * mb + 3]);
                *(LAS u32x2*)(hl + RW_A + (tok * 64 + 16 * mb + 4 * q) * 2) = ap; *(LAS u32x2*)(hl + RW_B + (tok * 64 + 16 * mb + 4 * q) * 2) = bp; }
            br = red4(br); if (q == 0) *(LAS float*)(hl + RW_BR + tok * 4) = br;
        }
        __syncthreads();
        if (active && hw < 2 && blk + 1 < bpu) RW_PREFETCH(blk + 1);
        if (active) {
            const LAS bf16_t* LA = (const LAS bf16_t*)(hl + RW_A); const LAS bf16_t* LB = (const LAS bf16_t*)(hl + RW_B); const LAS bf16_t* LK = (const LAS bf16_t*)(hl + RW_KD);
            const LAS bf16_t* LRr = (const LAS bf16_t*)(hl + RW_R); const LAS bf16_t* LV = (const LAS bf16_t*)(hl + RW_V);
            float W = AW[lane], brt = *(LAS float*)(hl + RW_BR); unsigned A = LA[lane], B = LB[lane], KD = LK[lane], RR = LRr[lane], vi = LV[hw * 16 + m];
            for (int tau = 0; tau < 32; ++tau) {
                const int tn = tau < 31 ? tau + 1 : 31;
                const float Wn = AW[tn * 64 + lane], brn = *(LAS float*)(hl + RW_BR + tn * 4); const unsigned An = LA[tn * 64 + lane], Bn = LB[tn * 64 + lane], KDn = LK[tn * 64 + lane], RRn = LRr[tn * 64 + lane], vin = LV[tn * 64 + hw * 16 + m];
                float sa, yt;
                rw_block1(S, __uint_as_float(A << 16), W, __uint_as_float(KD << 16), __uint_as_float(RR << 16), __uint_as_float(vi << 16), sa, yt);
                sa = red4(sa);
                rw_block2(S, __uint_as_float(B << 16), sa);
                const float yp = red4(yt) + sa * brt;
                if (q == 0) YO[tau * 64 + hw * 16 + m] = yp;
                W = Wn; A = An; B = Bn; KD = KDn; RR = RRn; vi = vin; brt = brn;
            }
            if (blk == bpu - 1 && !lat) { const unsigned sb = (unsigned)((((b * 2 + dir) * 32 + head) * 64 + hw * 16 + m) * 64 + q * 16);
#pragma unroll
                for (int n = 0; n < 16; ++n) *(float*)((char*)p.out + ((unsigned)OUT_RWKV + sb + n) * 4u) = S[n]; }
        }
        __syncthreads();
        if (active) {
            const int tok = htid >> 3, c8 = (htid & 7) * 8, tau = blk * 32 + tok, t = dir ? L - 1 - tau : tau; const size_t row = (size_t)(base + t);
            const f32x4 y0 = *(LAS f32x4*)(YO + tok * 64 + c8), y1 = *(LAS f32x4*)(YO + tok * 64 + c8 + 4);
            u32x4 wv; wv.x = cvtpk(y0[0], y0[1]); wv.y = cvtpk(y0[2], y0[3]); wv.z = cvtpk(y1[0], y1[1]); wv.w = cvtpk(y1[2], y1[3]);
            *(u32x4*)(YD + (size_t)dir * MTOK * DM + row * DM + head * 64 + c8) = wv;
        }
    }
}

constexpr int RC_GL = 0, RC_MAB = 256, RC_MAK = 1536, RC_NBR = 2176, RC_NKR = 2816, RC_XT = 3456, RC_MD = 3456, RC_SSP = 3712, RC_BNP = 3968, RC_YO = 7808, RC_BH = 9856, RC_KH = 12416, RC_AT = 14976, RC_RT = 17280, RC_BT = 19584, RC_KT = 21888,
              RC_CST = 24192, RC_W = 25472, RC_A = 33664, RC_B = 37760, RC_KD = 41856, RC_R = 45952, RC_V = 50048, RC_W2 = 54144, RC_A2 = 67456, RC_HALF = 80768;
constexpr int RC_TS = 208, RC_TT = 144, RC_HS = 40, RC_MS = 80, RC_NS = 40, RC_XS = 68;
static_assert(2 * RC_HALF <= LDS_BAR_OFF, "RWKV chunk LDS map");
__device__ __forceinline__ bf16_t f2bf_rne(float f) { unsigned u = __float_as_uint(f); u += 0x7FFFu + ((u >> 16) & 1u); return (bf16_t)(u >> 16); }
__device__ __forceinline__ bf16x8 mk_frag(u32x2 lo, u32x2 hi) { return __builtin_bit_cast(bf16x8, (u32x4){lo.x, lo.y, hi.x, hi.y}); }

__device__ __forceinline__ int rw_sw(int tok, int ch) { return tok * 64 + ((((ch >> 2) ^ (tok & 15)) << 2) | (ch & 3)); }
__device__ __forceinline__ void p9_rwkv_chunk(const Params& p, LAS unsigned char* lds) {
    const int tid = tidx(), half = tid >> 8, htid = tid & 255, hw = __builtin_amdgcn_readfirstlane((tid >> 6) & 3), lane = tid & 63, c16 = lane & 15, g = lane >> 4, wg = blockIdx.x, nwg = gridDim.x;
    LAS unsigned char* hl = lds + half * RC_HALF;
    const bf16_t* R = (const bf16_t*)(p.ws + WS_R); const bf16_t* K1 = (const bf16_t*)(p.ws + WS_K1); const bf16_t* V1 = (const bf16_t*)(p.ws + WS_V1); const bf16_t* LR = (const bf16_t*)(p.ws + WS_LR);
    const bf16_t* W2T = (const bf16_t*)(p.ws + WS_W2T); const bf16_t* A2T = (const bf16_t*)(p.ws + WS_A2T);
    float* BON = (float*)(p.ws + WS_BON); bf16_t* YD = (bf16_t*)(p.out + OUT_Y);
    const float* w0p = pin(p, I_W0); const float* a0p = pin(p, I_A0); const float* kkp = pin(p, I_KK); const float* kap = pin(p, I_KA); const float* rkp = pin(p, I_RK); const float* srw = pin(p, I_SRWKV);
    const int nun = half == 0 ? (256 - wg + nwg - 1) / nwg : (1024 - wg + nwg - 1) / nwg;
    const int bpu = half == 0 ? 128 : 8;
    const int my_steps = nun * bpu;
    const int n0 = (256 - wg + nwg - 1) / nwg * 128, n1 = (1024 - wg + nwg - 1) / nwg * 8;
    const int nsteps = n0 > n1 ? n0 : n1;
    f32x4 Sacc[4];
    int base = 0, L = 0, b = 0, head = 0, dir = 0; bool lat = false;
    const int m = c16, q = g;
    pg8::bf16x8 pftw[3], pfta[3]; u32x2 pfr[2], pfk[2], pfv[2];
#define RC_PREFETCH(bk) do { const int tau_ = (bk) * 32 + 16 * (hw & 1) + m, t_ = dir ? L - 1 - tau_ : tau_; const unsigned row_ = (unsigned)(base + t_); \
        _Pragma("unroll") for (int ks = 0; ks < 3; ++ks) { pftw[ks] = *(const pg8::bf16x8*)((const char*)LR + row_ * 768u + (unsigned)(dir * 192 + (32 * ks + 8 * q) * 2)); \
            pfta[ks] = *(const pg8::bf16x8*)((const char*)LR + row_ * 768u + (unsigned)(384 + dir * 192 + (32 * ks + 8 * q) * 2)); } \
        _Pragma("unroll") for (int mi = 0; mi < 2; ++mi) { const unsigned ch_ = (unsigned)(head * 64 + 16 * (2 * (hw >> 1) + mi) + 4 * q); \
            pfr[mi] = *(const u32x2*)((const char*)R + (row_ * 2048u + ch_) * 2u); pfk[mi] = *(const u32x2*)((const char*)K1 + (row_ * 2048u + ch_) * 2u); pfv[mi] = *(const u32x2*)((const char*)V1 + (row_ * 2048u + ch_) * 2u); } } while (0)
    for (int step = 0; step < nsteps; ++step) {
        const bool active = step < my_steps; const int blk = step % bpu;
        if (active && blk == 0) {
            const int un = wg + (step / bpu) * nwg; int s;
            if (half == 0) { s = 16 + (un >> 6); head = (un >> 1) & 31; dir = un & 1; } else { s = un >> 6; head = (un >> 1) & 31; dir = un & 1; }
            seq_info(s, base, L, b, lat);
            for (int i = htid; i < 768; i += 256) { const int ch = i / 12, pc = i % 12; const size_t go = ((size_t)(dir * 2048 + head * 64 + ch) * 96 + pc * 8);
                *(LAS u32x4*)(hl + RC_W2 + ch * RC_TS + pc * 16) = *(const u32x4*)(W2T + go); *(LAS u32x4*)(hl + RC_A2 + ch * RC_TS + pc * 16) = *(const u32x4*)(A2T + go); }
            if (htid < 64) { LAS float* cst = (LAS float*)(hl + RC_CST); const int c = head * 64 + htid;
                cst[htid] = w0p[dir * 2048 + c]; cst[64 + htid] = a0p[dir * 2048 + c]; cst[128 + htid] = kkp[c]; cst[192 + htid] = kap[c]; cst[256 + htid] = rkp[c]; }
            RC_PREFETCH(0);
            const unsigned sb = (unsigned)((((b * 2 + dir) * 32 + head) * 64 + hw * 16 + c16) * 64 + 4 * g);
#pragma unroll
            for (int jb = 0; jb < 4; ++jb) Sacc[jb] = lat ? *(const f32x4*)((const char*)srw + (sb + 16 * jb) * 4u) : (f32x4){0.f, 0.f, 0.f, 0.f};
            __builtin_amdgcn_s_waitcnt(0x0F70);
        }
        __syncthreads();
#ifndef RW_REPS_A
#define RW_REPS_A 1
#define RW_REPS_C 1
#define RW_REPS_M 1
#endif
#ifndef RW_REPS_1
#define RW_REPS_1 1
#endif
#ifndef RW_REPS_W
#define RW_REPS_W 1
#endif
#ifndef RW_DELAY
#define RW_DELAY 0
#endif
#define RWD_BEGIN(S) unsigned long long rwd_t0_##S = 0; if (RW_DELAY == S) rwd_t0_##S = clock64();
#define RWD_END(S) if (RW_DELAY == S) { asm volatile("s_waitcnt lgkmcnt(0)" ::: "memory"); const unsigned long long t1_ = clock64(), d_ = t1_ - rwd_t0_##S; while ((unsigned long long)clock64() - t1_ < d_) { } }
        RWD_BEGIN(1)
        if (active) for (int repa = 0; repa < RW_REPS_A; ++repa) {
            const int tok = 16 * (hw & 1) + m, mb0 = 2 * (hw >> 1);
            f32x4 dW[2], dA[2];
#pragma unroll
            for (int mi = 0; mi < 2; ++mi) { dW[mi] = (f32x4){0.f, 0.f, 0.f, 0.f}; dA[mi] = (f32x4){0.f, 0.f, 0.f, 0.f}; }
#pragma unroll
            for (int ks = 0; ks < 3; ++ks) {
                const pg8::bf16x8 tw = pftw[ks], ta = pfta[ks];
#pragma unroll
                for (int mi = 0; mi < 2; ++mi) { const pg8::bf16x8 wf = *(const LAS pg8::bf16x8*)(hl + RC_W2 + (16 * (mb0 + mi) + m) * RC_TS + (32 * ks + 8 * q) * 2), af = *(const LAS pg8::bf16x8*)(hl + RC_A2 + (16 * (mb0 + mi) + m) * RC_TS + (32 * ks + 8 * q) * 2);
                    dW[mi] = __builtin_amdgcn_mfma_f32_16x16x32_bf16(wf, tw, dW[mi], 0, 0, 0); dA[mi] = __builtin_amdgcn_mfma_f32_16x16x32_bf16(af, ta, dA[mi], 0, 0, 0); } }
            float ss = 0.f, bon = 0.f;
#pragma unroll
            for (int mi = 0; mi < 2; ++mi) { const int mb = mb0 + mi;
                const u32x2 r2 = pfr[mi], k2 = pfk[mi], v2 = pfv[mi]; const LAS float* cst = (const LAS float*)(hl + RC_CST) + 16 * mb + 4 * q;
                const f32x4 w0 = *(const LAS f32x4*)cst, a0 = *(const LAS f32x4*)(cst + 64), kkw = *(const LAS f32x4*)(cst + 128), kaw = *(const LAS f32x4*)(cst + 192), rkw = *(const LAS f32x4*)(cst + 256);
                const float rr[4] = {bflo(r2.x), bfhi(r2.x), bflo(r2.y), bfhi(r2.y)}, k0[4] = {bflo(k2.x), bfhi(k2.x), bflo(k2.y), bfhi(k2.y)};
                f32x4 oW; float kd[4], kk[4], kb[4];
#pragma unroll
                for (int j = 0; j < 4; ++j) {
                    const float xw = -(w0[j] + dW[mi][j]);
                    const float sp = fmaxf(xw, 0.f) + 0.6931471806f * __builtin_amdgcn_logf(1.f + __builtin_amdgcn_exp2f(-1.4426950409f * fabsf(xw)));
                    oW[j] = __builtin_amdgcn_exp2f(-1.4426950409f * __builtin_amdgcn_exp2f(-1.4426950409f * (sp + 0.5f)));
                    const float a = __builtin_amdgcn_rcpf(1.f + __builtin_amdgcn_exp2f(-1.4426950409f * (a0[j] + dA[mi][j])));
                    kk[j] = k0[j] * kkw[j]; ss += kk[j] * kk[j]; kb[j] = kk[j] * a;
                    kd[j] = k0[j] * (1.f + (a - 1.f) * kaw[j]); bon += rr[j] * kd[j] * rkw[j]; }
                const int eo = rw_sw(tok, 16 * mb + 4 * q);
                *(LAS f32x4*)(hl + RC_W + eo * 4) = oW;
                *(LAS u32x2*)(hl + RC_R + eo * 2) = r2; *(LAS u32x2*)(hl + RC_V + eo * 2) = v2;
                *(LAS u32x2*)(hl + RC_KD + eo * 2) = (u32x2){cvtpk(kd[0], kd[1]), cvtpk(kd[2], kd[3])};
                *(LAS u32x2*)(hl + RC_A + eo * 2) = (u32x2){cvtpk(-kk[0], -kk[1]), cvtpk(-kk[2], -kk[3])};
                *(LAS u32x2*)(hl + RC_B + eo * 2) = (u32x2){cvtpk(kb[0], kb[1]), cvtpk(kb[2], kb[3])}; }
            ss = red4(ss); bon = red4(bon);
            if (q == 0) { *(LAS float*)(hl + RC_SSP + (tok * 2 + (hw >> 1)) * 4) = ss; *(LAS float*)(hl + RC_BNP + (tok * 2 + (hw >> 1)) * 4) = bon; }
        }
        RWD_END(1)
        __syncthreads();
        if (active && blk + 1 < bpu) RC_PREFETCH(blk + 1);
#pragma unroll 1
        for (int cc = 0; cc < 2; ++cc) {
            const int cb = 16 * cc;
            RWD_BEGIN(2)
            if (active) for (int repc = 0; repc < RW_REPS_C; ++repc) { int ln = lane; asm volatile("" : "+v"(ln));
                float wv[16], ow[4], bt[4], kt[4]; unsigned ra[4], rb[4], rk[4], rr[4];
#pragma unroll
                for (int t1 = 0; t1 < 16; ++t1) wv[t1] = *(const LAS float*)(hl + RC_W + rw_sw(cb + t1, ln) * 4);
#pragma unroll
                for (int e = 0; e < 4; ++e) { const unsigned o = (unsigned)rw_sw(cb + 4 * hw + e, ln); ow[e] = *(const LAS float*)(hl + RC_W + o * 4u);
                    ra[e] = *(const LAS bf16_t*)(hl + RC_A + o * 2u); rb[e] = *(const LAS bf16_t*)(hl + RC_B + o * 2u); rk[e] = *(const LAS bf16_t*)(hl + RC_KD + o * 2u); rr[e] = *(const LAS bf16_t*)(hl + RC_R + o * 2u); }
                f32x2v ssp[4];
#pragma unroll
                for (int e = 0; e < 4; ++e) ssp[e] = *(const LAS f32x2v*)(hl + RC_SSP + (cb + 4 * hw + e) * 8);
                const f32x2v bnp = *(const LAS f32x2v*)(hl + RC_BNP + (cb + 4 * hw + (ln & 3)) * 8);
                __builtin_amdgcn_sched_barrier(0);
                float inv[4];
#pragma unroll
                for (int e = 0; e < 4; ++e) inv[e] = __builtin_amdgcn_rcpf(fmaxf(__builtin_amdgcn_sqrtf(ssp[e].x + ssp[e].y), 1e-12f));
                if (ln < 4) { const int tau = blk * 32 + cb + 4 * hw + ln, t = dir ? L - 1 - tau : tau; BON[((size_t)dir * MTOK + (size_t)(base + t)) * 32 + head] = bnp.x + bnp.y; }
                const float p40 = (wv[0] * wv[1]) * (wv[2] * wv[3]), p41 = (wv[4] * wv[5]) * (wv[6] * wv[7]), p42 = (wv[8] * wv[9]) * (wv[10] * wv[11]), p43 = (wv[12] * wv[13]) * (wv[14] * wv[15]);
                const float c01 = p40 * p41, c012 = c01 * p42, gl = c012 * p43;
                float grun = hw == 0 ? 1.f : hw == 1 ? p40 : hw == 2 ? c01 : c012;
#pragma unroll
                for (int e = 0; e < 4; ++e) { const int t1 = 4 * hw + e; const float gprev = grun; grun *= ow[e];
                    const float a = __uint_as_float(ra[e] << 16) * inv[e], bv = __uint_as_float(rb[e] << 16) * inv[e], kd = __uint_as_float(rk[e] << 16), rv = __uint_as_float(rr[e] << 16);
                    const float ig = __builtin_amdgcn_rcpf(grun); bt[e] = bv * ig; kt[e] = kd * ig;
                    *(LAS bf16_t*)(hl + RC_AT + t1 * RC_TT + ln * 2) = f2bf(gprev * a); *(LAS bf16_t*)(hl + RC_RT + t1 * RC_TT + ln * 2) = f2bf(grun * rv);
                    *(LAS bf16_t*)(hl + RC_BT + t1 * RC_TT + ln * 2) = f2bf(bt[e]); *(LAS bf16_t*)(hl + RC_KT + t1 * RC_TT + ln * 2) = f2bf(kt[e]); }
                u32x2 bh, kh; bh.x = cvtpk(bt[0] * gl, bt[1] * gl); bh.y = cvtpk(bt[2] * gl, bt[3] * gl); kh.x = cvtpk(kt[0] * gl, kt[1] * gl); kh.y = cvtpk(kt[2] * gl, kt[3] * gl);
                *(LAS u32x2*)(hl + RC_BH + ln * RC_HS + hw * 8) = bh; *(LAS u32x2*)(hl + RC_KH + ln * RC_HS + hw * 8) = kh;
                if (hw == 0) *(LAS float*)(hl + RC_GL + ln * 4) = gl;
            }
            RWD_END(2)
            __syncthreads();
            RWD_BEGIN(3)
            if (active) for (int rep1 = 0; rep1 < RW_REPS_1; ++rep1) {
                const int xo = (hw & 1) ? RC_KT : RC_BT, yo = (hw & 2) ? RC_RT : RC_AT;
                f32x4 mm = (f32x4){0.f, 0.f, 0.f, 0.f};
#pragma unroll
                for (int ks = 0; ks < 2; ++ks) { const bf16x8 xf = *(const LAS bf16x8*)(hl + xo + c16 * RC_TT + (32 * ks + 8 * g) * 2), yf = *(const LAS bf16x8*)(hl + yo + c16 * RC_TT + (32 * ks + 8 * g) * 2);
                    mm = __builtin_amdgcn_mfma_f32_16x16x32_bf16(xf, yf, mm, 0, 0, 0); }
#pragma unroll
                for (int r = 0; r < 4; ++r) { const int s_ = 4 * g + r; const bool keep = (hw & 2) ? (s_ <= c16) : (s_ < c16); mm[r] = keep ? mm[r] : 0.f; }
                if (hw == 0) {
                    const int tb = c16 >> 2;
#pragma unroll
                    for (int r = 0; r < 4; ++r) *(LAS float*)(hl + RC_MAB + (4 * g + r) * RC_MS + c16 * 4) = g < tb ? mm[r] : 0.f;
                    if (g == tb) {
#pragma unroll
                        for (int r = 0; r < 4; ++r) *(LAS float*)(hl + RC_MD + (4 * g + r) * 16 + (c16 & 3) * 4) = mm[r]; } }
                else { u32x2 w; w.x = cvtpk(mm[0], mm[1]); w.y = cvtpk(mm[2], mm[3]); *(LAS u32x2*)(hl + (hw == 1 ? RC_MAK : hw == 2 ? RC_NBR : RC_NKR) + c16 * RC_NS + g * 8) = w; }
            }
            RWD_END(3)
            __syncthreads();
            RWD_BEGIN(4)
            if (active) for (int repm = 0; repm < RW_REPS_M; ++repm) {
                const u32x2 zz = (u32x2){0u, 0u};
                bf16x8 sfr[2];
#pragma unroll
                for (int ks = 0; ks < 2; ++ks) { u32x4 s4; s4.x = cvtpk(Sacc[2 * ks][0], Sacc[2 * ks][1]); s4.y = cvtpk(Sacc[2 * ks][2], Sacc[2 * ks][3]);
                    s4.z = cvtpk(Sacc[2 * ks + 1][0], Sacc[2 * ks + 1][1]); s4.w = cvtpk(Sacc[2 * ks + 1][2], Sacc[2 * ks + 1][3]); sfr[ks] = __builtin_bit_cast(bf16x8, s4); }
                bf16x8 vfr;
                { const LAS bf16_t* vp = (const LAS bf16_t*)(hl + RC_V); const int vi_ = 16 * hw + c16, vt_ = cb + 4 * g;
                  const unsigned v0 = vp[rw_sw(vt_, vi_)], v1 = vp[rw_sw(vt_ + 1, vi_)], v2 = vp[rw_sw(vt_ + 2, vi_)], v3 = vp[rw_sw(vt_ + 3, vi_)]; vfr = mk_frag((u32x2){v0 | (v1 << 16), v2 | (v3 << 16)}, zz); }
                f32x4 mx[12], md[3];
#pragma unroll
                for (int s1 = 0; s1 < 12; ++s1) mx[s1] = *(const LAS f32x4*)(hl + RC_MAB + s1 * RC_MS + g * 16);
#pragma unroll
                for (int e = 0; e < 3; ++e) md[e] = *(const LAS f32x4*)(hl + RC_MD + (4 * g + e) * 16);
                f32x4 xt = (f32x4){0.f, 0.f, 0.f, 0.f}, yt = (f32x4){0.f, 0.f, 0.f, 0.f};
#pragma unroll
                for (int ks = 0; ks < 2; ++ks) {
                    const LAS unsigned char* ap = hl + RC_AT + c16 * RC_TT + (32 * ks + 4 * g) * 2; const LAS unsigned char* rp = hl + RC_RT + c16 * RC_TT + (32 * ks + 4 * g) * 2;
                    xt = __builtin_amdgcn_mfma_f32_16x16x32_bf16(mk_frag(*(const LAS u32x2*)ap, *(const LAS u32x2*)(ap + 32)), sfr[ks], xt, 0, 0, 0);
                    yt = __builtin_amdgcn_mfma_f32_16x16x32_bf16(mk_frag(*(const LAS u32x2*)rp, *(const LAS u32x2*)(rp + 32)), sfr[ks], yt, 0, 0, 0); }
                xt = __builtin_amdgcn_mfma_f32_16x16x32_bf16(mk_frag(*(const LAS u32x2*)(hl + RC_MAK + c16 * RC_NS + g * 8), zz), vfr, xt, 0, 0, 0);
                yt = __builtin_amdgcn_mfma_f32_16x16x32_bf16(mk_frag(*(const LAS u32x2*)(hl + RC_NKR + c16 * RC_NS + g * 8), zz), vfr, yt, 0, 0, 0);
                float x[4] = {xt[0], xt[1], xt[2], xt[3]};
#pragma unroll
                for (int h = 0; h < 4; ++h) {
                    if (g == h) { x[1] += x[0] * md[0][1]; x[2] += x[0] * md[0][2]; x[3] += x[0] * md[0][3]; x[2] += x[1] * md[1][2]; x[3] += x[1] * md[1][3]; x[3] += x[2] * md[2][3]; }
                    if (h < 3) { float ub[4];
#pragma unroll
                        for (int e = 0; e < 4; ++e) { const unsigned xv = __float_as_uint(x[e]);
                            if (h == 2) { const auto r1 = __builtin_amdgcn_permlane16_swap(xv, xv, false, false); ub[e] = __uint_as_float(r1[0]); }
                            else { const auto r0 = __builtin_amdgcn_permlane32_swap(xv, xv, false, false); const auto r1 = __builtin_amdgcn_permlane16_swap(r0[0], r0[0], false, false); ub[e] = __uint_as_float(r1[h]); } }
#pragma unroll
                        for (int e2 = 0; e2 < 4; ++e2)
#pragma unroll
                            for (int e = 0; e < 4; ++e) x[e] += ub[e2] * mx[4 * h + e2][e]; } }
                const bf16x8 ufr = mk_frag((u32x2){cvtpk(x[0], x[1]), cvtpk(x[2], x[3])}, zz);
                yt = __builtin_amdgcn_mfma_f32_16x16x32_bf16(mk_frag(*(const LAS u32x2*)(hl + RC_NBR + c16 * RC_NS + g * 8), zz), ufr, yt, 0, 0, 0);
#pragma unroll
                for (int r = 0; r < 4; ++r) *(LAS bf16_t*)(hl + RC_YO + (4 * g + r) * 128 + (16 * hw + c16) * 2) = f2bf_rne(yt[r]);
                if (repm + 1 == RW_REPS_M)
#pragma unroll
                for (int jb = 0; jb < 4; ++jb) { const f32x4 gl4 = *(const LAS f32x4*)(hl + RC_GL + (16 * jb + 4 * g) * 4); Sacc[jb] = Sacc[jb] * gl4;
                    Sacc[jb] = __builtin_amdgcn_mfma_f32_16x16x32_bf16(mk_frag(*(const LAS u32x2*)(hl + RC_BH + (16 * jb + c16) * RC_HS + g * 8), zz), ufr, Sacc[jb], 0, 0, 0);
                    Sacc[jb] = __builtin_amdgcn_mfma_f32_16x16x32_bf16(mk_frag(*(const LAS u32x2*)(hl + RC_KH + (16 * jb + c16) * RC_HS + g * 8), zz), vfr, Sacc[jb], 0, 0, 0); }
                if (cc == 1 && blk == bpu - 1 && !lat && repm + 1 == RW_REPS_M) { const unsigned sb = (unsigned)((((b * 2 + dir) * 32 + head) * 64 + hw * 16 + c16) * 64 + 4 * g);
#pragma unroll
                    for (int jb = 0; jb < 4; ++jb) *(f32x4*)((char*)p.out + ((unsigned)OUT_RWKV + sb + 16 * jb) * 4u) = Sacc[jb]; }
            }
            RWD_END(4)
            __syncthreads();
            RWD_BEGIN(5)
            if (active && htid < 128) for (int repw = 0; repw < RW_REPS_W; ++repw) {
                const int tok = htid >> 3, c8 = (htid & 7) * 8, tau = blk * 32 + cb + tok, t = dir ? L - 1 - tau : tau; const size_t row = (size_t)(base + t);
                *(u32x4*)(YD + (size_t)dir * MTOK * DM + row * DM + head * 64 + c8) = *(const LAS u32x4*)(hl + RC_YO + tok * 128 + c8 * 2);
            }
            RWD_END(5)
        }
    }
#undef RC_PREFETCH
}

constexpr int RP_W2 = 0, RP_A2 = 13312, RP_CST = 26624, RP_W = 27904, RP_A = 32000, RP_B = 34048, RP_KD = 36096, RP_R = 38144, RP_SSP = 40192, RP_BNP = 40448, RP_XT = 40704, RP_YO = 45056, RP_BUF = 47104;
constexpr int RB_V = 0, RB_AT = 2048, RB_RT = 4352, RB_BT = 6656, RB_KT = 8960, RB_BH = 11264, RB_KH = 13824, RB_GL = 16384, RB_MAB = 16640, RB_MAK = 17920, RB_NBR = 18560, RB_NKR = 19200, RB_SIZE = 19840;
static_assert(RP_BUF + 2 * RB_SIZE <= LDS_BAR_OFF, "RWKV pipe LDS map");

struct RwkvUnit { int base, L, b, head, dir; bool lat; };
__device__ __forceinline__ void rwkv_unit_of(int n, int wg, RwkvUnit& u, int& c, int& nch) {
    int un, s;
    if (n < 256) { un = wg; s = 16 + (un >> 6); c = n; nch = 256; } else { const int k = (n - 256) >> 4; un = wg + 256 * k; s = un >> 6; c = (n - 256) & 15; nch = 16; }
    u.head = (un >> 1) & 31; u.dir = un & 1; seq_info(s, u.base, u.L, u.b, u.lat);
}

__device__ __forceinline__ void p9_rwkv_pipe(const Params& p, LAS unsigned char* lds) {
    const int tid = tidx(), half = __builtin_amdgcn_readfirstlane(tid >> 8), htid = tid & 255, pw = __builtin_amdgcn_readfirstlane((tid >> 6) & 3), lane = tid & 63, c16 = lane & 15, g = lane >> 4, wg = blockIdx.x;
    const bool producer = half == 1;
    const bf16_t* R = (const bf16_t*)(p.ws + WS_R); const bf16_t* K1 = (const bf16_t*)(p.ws + WS_K1); const bf16_t* V1 = (const bf16_t*)(p.ws + WS_V1); const bf16_t* LR = (const bf16_t*)(p.ws + WS_LR);
    const bf16_t* W2T = (const bf16_t*)(p.ws + WS_W2T); const bf16_t* A2T = (const bf16_t*)(p.ws + WS_A2T);
    float* BON = (float*)(p.ws + WS_BON); bf16_t* YD = (bf16_t*)(p.out + OUT_Y);
    const float* w0p = pin(p, I_W0); const float* a0p = pin(p, I_A0); const float* kkp = pin(p, I_KK); const float* kap = pin(p, I_KA); const float* rkp = pin(p, I_RK); const float* srw = pin(p, I_SRWKV);
    constexpr int NCH = 256 + 4 * 16;
    f32x4 Sacc[4];
    pg8::bf16x8 pftw[3], pfta[3]; u32x2 pfr, pfk, pfv;
#define RP_PREFETCH(U, cc) do { const int tau_ = (cc) * 16 + c16, t_ = (U).dir ? (U).L - 1 - tau_ : tau_; const unsigned row_ = (unsigned)((U).base + t_); \
        _Pragma("unroll") for (int ks = 0; ks < 3; ++ks) { pftw[ks] = *(const pg8::bf16x8*)((const char*)LR + row_ * 768u + (unsigned)((U).dir * 192 + (32 * ks + 8 * g) * 2)); \
            pfta[ks] = *(const pg8::bf16x8*)((const char*)LR + row_ * 768u + (unsigned)(384 + (U).dir * 192 + (32 * ks + 8 * g) * 2)); } \
        { const unsigned ch_ = (unsigned)((U).head * 64 + 16 * pw + 4 * g); \
          pfr = *(const u32x2*)((const char*)R + (row_ * 2048u + ch_) * 2u); pfk = *(const u32x2*)((const char*)K1 + (row_ * 2048u + ch_) * 2u); pfv = *(const u32x2*)((const char*)V1 + (row_ * 2048u + ch_) * 2u); } } while (0)
    for (int n = -1; n < NCH; ++n) {
        RwkvUnit up; int cp = 0, nchp = 0; const bool has_p = n + 1 < NCH;
        if (has_p) rwkv_unit_of(n + 1, wg, up, cp, nchp);
        if (has_p && cp == 0) {
            if (producer) {
                for (int i = htid; i < 768; i += 256) { const int ch = i / 12, pc = i % 12; const size_t go = ((size_t)(up.dir * 2048 + up.head * 64 + ch) * 96 + pc * 8);
                    *(LAS u32x4*)(lds + RP_W2 + ch * RC_TS + pc * 16) = *(const u32x4*)(W2T + go); *(LAS u32x4*)(lds + RP_A2 + ch * RC_TS + pc * 16) = *(const u32x4*)(A2T + go); }
                if (htid < 64) { LAS float* cst = (LAS float*)(lds + RP_CST); const int c = up.head * 64 + htid;
                    cst[htid] = w0p[up.dir * 2048 + c]; cst[64 + htid] = a0p[up.dir * 2048 + c]; cst[128 + htid] = kkp[c]; cst[192 + htid] = kap[c]; cst[256 + htid] = rkp[c]; }
                RP_PREFETCH(up, 0);
            }
            __syncthreads();
        }
        RwkvUnit uc; int cc = 0, nchc = 0; const bool has_c = n >= 0;
        if (has_c) rwkv_unit_of(n, wg, uc, cc, nchc);
        LAS unsigned char* bufp = lds + RP_BUF + ((n + 1) & 1) * RB_SIZE; LAS unsigned char* bufc = lds + RP_BUF + (n & 1) * RB_SIZE;
        bf16x8 ufr, vfr; f32x4 yt = (f32x4){0.f, 0.f, 0.f, 0.f};
        if (producer) {
            if (has_p) {
                f32x4 dW = (f32x4){0.f, 0.f, 0.f, 0.f}, dA = (f32x4){0.f, 0.f, 0.f, 0.f};
#pragma unroll
                for (int ks = 0; ks < 3; ++ks) { const pg8::bf16x8 wf = *(const LAS pg8::bf16x8*)(lds + RP_W2 + (16 * pw + c16) * RC_TS + (32 * ks + 8 * g) * 2), af = *(const LAS pg8::bf16x8*)(lds + RP_A2 + (16 * pw + c16) * RC_TS + (32 * ks + 8 * g) * 2);
                    dW = __builtin_amdgcn_mfma_f32_16x16x32_bf16(wf, pftw[ks], dW, 0, 0, 0); dA = __builtin_amdgcn_mfma_f32_16x16x32_bf16(af, pfta[ks], dA, 0, 0, 0); }
                const u32x2 r2 = pfr, k2 = pfk, v2 = pfv; const LAS float* cst = (const LAS float*)(lds + RP_CST) + 16 * pw + 4 * g;
                const f32x4 w0 = *(const LAS f32x4*)cst, a0 = *(const LAS f32x4*)(cst + 64), kkw = *(const LAS f32x4*)(cst + 128), kaw = *(const LAS f32x4*)(cst + 192), rkw = *(const LAS f32x4*)(cst + 256);
                const float rr[4] = {bflo(r2.x), bfhi(r2.x), bflo(r2.y), bfhi(r2.y)}, k0[4] = {bflo(k2.x), bfhi(k2.x), bflo(k2.y), bfhi(k2.y)};
                f32x4 oW; float kd[4], kk[4], kb[4], ss = 0.f, bon = 0.f;
#pragma unroll
                for (int j = 0; j < 4; ++j) {
                    const float xw = -(w0[j] + dW[j]);
                    const float sp = fmaxf(xw, 0.f) + __logf(1.f + __expf(-fabsf(xw)));
                    oW[j] = __expf(-__expf(-sp - 0.5f));
                    const float a = 1.f / (1.f + __expf(-(a0[j] + dA[j])));
                    kk[j] = k0[j] * kkw[j]; ss += kk[j] * kk[j]; kb[j] = kk[j] * a;
                    kd[j] = k0[j] * (1.f + (a - 1.f) * kaw[j]); bon += rr[j] * kd[j] * rkw[j]; }
                const int eo = c16 * 64 + 16 * pw + 4 * g;
                *(LAS f32x4*)(lds + RP_W + eo * 4) = oW;
                *(LAS u32x2*)(lds + RP_R + eo * 2) = r2; *(LAS u32x2*)(bufp + RB_V + eo * 2) = v2;
                *(LAS u32x2*)(lds + RP_KD + eo * 2) = (u32x2){cvtpk(kd[0], kd[1]), cvtpk(kd[2], kd[3])};
                *(LAS u32x2*)(lds + RP_A + eo * 2) = (u32x2){cvtpk(-kk[0], -kk[1]), cvtpk(-kk[2], -kk[3])};
                *(LAS u32x2*)(lds + RP_B + eo * 2) = (u32x2){cvtpk(kb[0], kb[1]), cvtpk(kb[2], kb[3])};
                ss = red4(ss); bon = red4(bon);
                if (g == 0) { *(LAS float*)(lds + RP_SSP + (c16 * 4 + pw) * 4) = ss; *(LAS float*)(lds + RP_BNP + (c16 * 4 + pw) * 4) = bon; }
                if (cp + 1 < nchp) RP_PREFETCH(up, cp + 1);
            }
        } else if (has_c) {
            if (cc == 0) {
                const unsigned sb = (unsigned)((((uc.b * 2 + uc.dir) * 32 + uc.head) * 64 + pw * 16 + c16) * 64 + 4 * g);
#pragma unroll
                for (int jb = 0; jb < 4; ++jb) Sacc[jb] = (f32x4){0.f, 0.f, 0.f, 0.f};
                if (uc.lat) {
#pragma unroll
                    for (int jb = 0; jb < 4; ++jb) Sacc[jb] = *(const f32x4*)((const char*)srw + (sb + 16 * jb) * 4u); }
            }
            const u32x2 zz = (u32x2){0u, 0u};
            bf16x8 sfr[2];
#pragma unroll
            for (int ks = 0; ks < 2; ++ks) { u32x4 s4; s4.x = cvtpk(Sacc[2 * ks][0], Sacc[2 * ks][1]); s4.y = cvtpk(Sacc[2 * ks][2], Sacc[2 * ks][3]);
                s4.z = cvtpk(Sacc[2 * ks + 1][0], Sacc[2 * ks + 1][1]); s4.w = cvtpk(Sacc[2 * ks + 1][2], Sacc[2 * ks + 1][3]); sfr[ks] = __builtin_bit_cast(bf16x8, s4); }
            { const LAS bf16_t* vp = (const LAS bf16_t*)(bufc + RB_V) + (4 * g) * 64 + 16 * pw + c16;
              const unsigned v0 = vp[0], v1 = vp[64], v2 = vp[128], v3 = vp[192]; vfr = mk_frag((u32x2){v0 | (v1 << 16), v2 | (v3 << 16)}, zz); }
            f32x4 xt = (f32x4){0.f, 0.f, 0.f, 0.f};
#pragma unroll
            for (int ks = 0; ks < 2; ++ks) {
                const LAS unsigned char* ap = bufc + RB_AT + c16 * RC_TT + (32 * ks + 4 * g) * 2; const LAS unsigned char* rp = bufc + RB_RT + c16 * RC_TT + (32 * ks + 4 * g) * 2;
                xt = __builtin_amdgcn_mfma_f32_16x16x32_bf16(mk_frag(*(const LAS u32x2*)ap, *(const LAS u32x2*)(ap + 32)), sfr[ks], xt, 0, 0, 0);
                yt = __builtin_amdgcn_mfma_f32_16x16x32_bf16(mk_frag(*(const LAS u32x2*)rp, *(const LAS u32x2*)(rp + 32)), sfr[ks], yt, 0, 0, 0); }
            xt = __builtin_amdgcn_mfma_f32_16x16x32_bf16(mk_frag(*(const LAS u32x2*)(bufc + RB_MAK + c16 * RC_NS + g * 8), zz), vfr, xt, 0, 0, 0);
            yt = __builtin_amdgcn_mfma_f32_16x16x32_bf16(mk_frag(*(const LAS u32x2*)(bufc + RB_NKR + c16 * RC_NS + g * 8), zz), vfr, yt, 0, 0, 0);
            LAS float* xs = (LAS float*)(lds + RP_XT + pw * (16 * RC_XS));
#pragma unroll
            for (int r = 0; r < 4; ++r) xs[(4 * g + r) * (RC_XS / 4) + c16] = xt[r];
            asm volatile("s_waitcnt lgkmcnt(0)" ::: "memory");
            float u[16];
#pragma unroll
            for (int t1 = 0; t1 < 16; ++t1) u[t1] = xs[t1 * (RC_XS / 4) + c16];
#pragma unroll
            for (int t1 = 1; t1 < 16; ++t1) { float acc = u[t1];
#pragma unroll
                for (int s4 = 0; s4 < (t1 + 3) / 4; ++s4) { const f32x4 mr = *(const LAS f32x4*)(bufc + RB_MAB + t1 * RC_MS + s4 * 16);
#pragma unroll
                    for (int e = 0; e < 4; ++e) if (4 * s4 + e < t1) acc += u[4 * s4 + e] * mr[e]; }
                u[t1] = acc; }
            { float us[4];
#pragma unroll
              for (int e = 0; e < 4; ++e) us[e] = g == 0 ? u[e] : g == 1 ? u[4 + e] : g == 2 ? u[8 + e] : u[12 + e];
              ufr = mk_frag((u32x2){cvtpk(us[0], us[1]), cvtpk(us[2], us[3])}, zz); }
        }
        __syncthreads();
        if (producer) {
            if (has_p) {
                float grun = 1.f; float bt[4], kt[4];
#pragma unroll
                for (int t1 = 0; t1 < 16; ++t1) { const float gprev = grun; grun *= *(const LAS float*)(lds + RP_W + (t1 * 64 + lane) * 4);
                    if ((t1 >> 2) == pw) { const int e = t1 & 3; const unsigned o = (unsigned)(t1 * 64 + lane) * 2u;
                        const f32x4 sp4 = *(const LAS f32x4*)(lds + RP_SSP + t1 * 16); const float inv = 1.f / fmaxf(sqrtf((sp4[0] + sp4[1]) + (sp4[2] + sp4[3])), 1e-12f);
                        const float a = bf2f(*(const LAS bf16_t*)(lds + RP_A + o)) * inv, bv = bf2f(*(const LAS bf16_t*)(lds + RP_B + o)) * inv, kd = bf2f(*(const LAS bf16_t*)(lds + RP_KD + o)), rv = bf2f(*(const LAS bf16_t*)(lds + RP_R + o));
                        const float ig = __builtin_amdgcn_rcpf(grun); bt[e] = bv * ig; kt[e] = kd * ig;
                        *(LAS bf16_t*)(bufp + RB_AT + t1 * RC_TT + lane * 2) = f2bf(gprev * a); *(LAS bf16_t*)(bufp + RB_RT + t1 * RC_TT + lane * 2) = f2bf(grun * rv);
                        *(LAS bf16_t*)(bufp + RB_BT + t1 * RC_TT + lane * 2) = f2bf(bt[e]); *(LAS bf16_t*)(bufp + RB_KT + t1 * RC_TT + lane * 2) = f2bf(kt[e]); } }
                const float gl = grun;
                *(LAS u32x2*)(bufp + RB_BH + lane * RC_HS + pw * 8) = (u32x2){cvtpk(bt[0] * gl, bt[1] * gl), cvtpk(bt[2] * gl, bt[3] * gl)};
                *(LAS u32x2*)(bufp + RB_KH + lane * RC_HS + pw * 8) = (u32x2){cvtpk(kt[0] * gl, kt[1] * gl), cvtpk(kt[2] * gl, kt[3] * gl)};
                if (pw == 0) *(LAS float*)(bufp + RB_GL + lane * 4) = gl;
                if (htid < 16) { const int tau = cp * 16 + htid, t = up.dir ? up.L - 1 - tau : tau; const f32x4 b4 = *(const LAS f32x4*)(lds + RP_BNP + htid * 16);
                    BON[((size_t)up.dir * MTOK + (size_t)(up.base + t)) * 32 + up.head] = (b4[0] + b4[1]) + (b4[2] + b4[3]); }
            }
        } else if (has_c) {
            const u32x2 zz = (u32x2){0u, 0u};
            yt = __builtin_amdgcn_mfma_f32_16x16x32_bf16(mk_frag(*(const LAS u32x2*)(bufc + RB_NBR + c16 * RC_NS + g * 8), zz), ufr, yt, 0, 0, 0);
#pragma unroll
            for (int r = 0; r < 4; ++r) *(LAS bf16_t*)(lds + RP_YO + (4 * g + r) * 128 + (16 * pw + c16) * 2) = f2bf_rne(yt[r]);
#pragma unroll
            for (int jb = 0; jb < 4; ++jb) { const f32x4 gl4 = *(const LAS f32x4*)(bufc + RB_GL + (16 * jb + 4 * g) * 4); Sacc[jb] = Sacc[jb] * gl4;
                Sacc[jb] = __builtin_amdgcn_mfma_f32_16x16x32_bf16(mk_frag(*(const LAS u32x2*)(bufc + RB_BH + (16 * jb + c16) * RC_HS + g * 8), zz), ufr, Sacc[jb], 0, 0, 0);
                Sacc[jb] = __builtin_amdgcn_mfma_f32_16x16x32_bf16(mk_frag(*(const LAS u32x2*)(bufc + RB_KH + (16 * jb + c16) * RC_HS + g * 8), zz), vfr, Sacc[jb], 0, 0, 0); }
            if (cc == nchc - 1 && !uc.lat) { const unsigned sb = (unsigned)((((uc.b * 2 + uc.dir) * 32 + uc.head) * 64 + pw * 16 + c16) * 64 + 4 * g);
#pragma unroll
                for (int jb = 0; jb < 4; ++jb) *(f32x4*)((char*)p.out + ((unsigned)OUT_RWKV + sb + 16 * jb) * 4u) = Sacc[jb]; }
        }
        __syncthreads();
        if (producer) {
            if (has_p) {
                const int xo = (pw & 1) ? RB_KT : RB_BT, yo = (pw & 2) ? RB_RT : RB_AT;
                f32x4 mm = (f32x4){0.f, 0.f, 0.f, 0.f};
#pragma unroll
                for (int ks = 0; ks < 2; ++ks) { const bf16x8 xf = *(const LAS bf16x8*)(bufp + xo + c16 * RC_TT + (32 * ks + 8 * g) * 2), yf = *(const LAS bf16x8*)(bufp + yo + c16 * RC_TT + (32 * ks + 8 * g) * 2);
                    mm = __builtin_amdgcn_mfma_f32_16x16x32_bf16(xf, yf, mm, 0, 0, 0); }
#pragma unroll
                for (int r = 0; r < 4; ++r) { const int s_ = 4 * g + r; const bool keep = (pw & 2) ? (s_ <= c16) : (s_ < c16); mm[r] = keep ? mm[r] : 0.f; }
                if (pw == 0) *(LAS f32x4*)(bufp + RB_MAB + c16 * RC_MS + g * 16) = mm;
                else { u32x2 w; w.x = cvtpk(mm[0], mm[1]); w.y = cvtpk(mm[2], mm[3]); *(LAS u32x2*)(bufp + (pw == 1 ? RB_MAK : pw == 2 ? RB_NBR : RB_NKR) + c16 * RC_NS + g * 8) = w; }
            }
        } else if (has_c && htid < 128) {
            const int tok = htid >> 3, c8 = (htid & 7) * 8, tau = cc * 16 + tok, t = uc.dir ? uc.L - 1 - tau : tau; const size_t row = (size_t)(uc.base + t);
            *(u32x4*)(YD + (size_t)uc.dir * MTOK * DM + row * DM + uc.head * 64 + c8) = *(const LAS u32x4*)(lds + RP_YO + tok * 128 + c8 * 2);
        }
        __syncthreads();
    }
#undef RP_PREFETCH
}

constexpr int RB2_GL = 0, RB2_MAB = 256, RB2_MD = 1536, RB2_MAK = 1792, RB2_NBR = 2432, RB2_NKR = 3072, RB2_V = 3712, RB2_AT = 5760, RB2_RT = 8064, RB2_BT = 10368, RB2_KT = 12672, RB2_BH = 14976, RB2_KH = 17536, RB2_SIZE = 20096;
constexpr int RQ_SSP = 2 * RB2_SIZE, RQ_BNP = RQ_SSP + 256, RQ_YO = RQ_BNP + 256, RQ_CST = RQ_YO + 2048, RQ_W = RQ_CST + 1280, RQ_A = RQ_W + 4096, RQ_B = RQ_A + 2048, RQ_KD = RQ_B + 2048, RQ_R = RQ_KD + 2048,
              RQ_W2 = RQ_R + 2048, RQ_A2 = RQ_W2 + 13312, RQ_RING = RQ_A2 + 13312, RQ_SLOT = 12288, RQ_END = RQ_RING + 4 * RQ_SLOT;
static_assert(RQ_END <= LDS_BAR_OFF, "RWKV pipe LDS map");
struct RwkvPf { pg8::bf16x8 tw[3], ta[3]; u32x2 r, k, v; };

#ifndef RQ_DELAY
#define RQ_DELAY 0
#endif
#define RQD_BEGIN(S) unsigned long long rqd_t0_##S = 0; if (RQ_DELAY == S) rqd_t0_##S = clock64();
#define RQD_END(S) if (RQ_DELAY == S) { asm volatile("s_waitcnt lgkmcnt(0)" ::: "memory"); const unsigned long long t1_ = clock64(), d_ = t1_ - rqd_t0_##S; while ((unsigned long long)clock64() - t1_ < d_) { } }
__device__ __forceinline__ void rwkv_dma(const unsigned char* ws, LAS unsigned char* lds, int wg, int pw, int lane, int c) {
    constexpr int NCH = 256 + 4 * 16;
    const int cq = c < NCH ? c : NCH - 1; RwkvUnit U; int ci, nch; rwkv_unit_of(cq, wg, U, ci, nch);
    LAS unsigned char* slot = lds + RQ_RING + (c & 3) * RQ_SLOT;
#pragma unroll
    for (int j = 0; j < 3; ++j) { const int q = pw * 3 + j; const unsigned char* ga;
        if (q < 6) { const int i = (q % 3) * 64 + lane, tok = i / 12, piece = i % 12, tau_ = ci * 16 + tok, t_ = U.dir ? U.L - 1 - tau_ : tau_;
            ga = ws + WS_LR + (size_t)((unsigned)(U.base + t_) * 768u + (unsigned)((q >= 3 ? 384 : 0) + U.dir * 192 + piece * 16)); }
        else { const int ten = (q - 6) >> 1, i = ((q - 6) & 1) * 64 + lane, tok = i >> 3, piece = (i & 7) ^ (tok & 7), tau_ = ci * 16 + tok, t_ = U.dir ? U.L - 1 - tau_ : tau_;
            const size_t tb = ten == 0 ? WS_R : ten == 1 ? WS_K1 : WS_V1;
            ga = ws + tb + (size_t)(((unsigned)(U.base + t_) * 2048u + (unsigned)(U.head * 64)) * 2u + (unsigned)(piece * 16)); }
        __builtin_amdgcn_global_load_lds((const unsigned*)ga, (LAS unsigned*)(slot + q * 1024), 16, 0, 0); }
}
#define RQ_BAR() do { asm volatile("s_waitcnt lgkmcnt(0)" ::: "memory"); __builtin_amdgcn_s_barrier(); asm volatile("" ::: "memory"); } while (0)
__device__ __forceinline__ void p9_rwkv_pipe2(const Params& p, LAS unsigned char* lds) {
    const int tid = tidx(), half = __builtin_amdgcn_readfirstlane(tid >> 8), htid = tid & 255, pw = __builtin_amdgcn_readfirstlane((tid >> 6) & 3), lane = tid & 63, c16 = lane & 15, g = lane >> 4, wg = blockIdx.x;
    const bool producer = half == 1;
    const bf16_t* R = (const bf16_t*)(p.ws + WS_R); const bf16_t* K1 = (const bf16_t*)(p.ws + WS_K1); const bf16_t* V1 = (const bf16_t*)(p.ws + WS_V1); const bf16_t* LR = (const bf16_t*)(p.ws + WS_LR);
    const bf16_t* W2T = (const bf16_t*)(p.ws + WS_W2T); const bf16_t* A2T = (const bf16_t*)(p.ws + WS_A2T);
    float* BON = (float*)(p.ws + WS_BON); bf16_t* YD = (bf16_t*)(p.out + OUT_Y);
    const float* w0p = pin(p, I_W0); const float* a0p = pin(p, I_A0); const float* kkp = pin(p, I_KK); const float* kap = pin(p, I_KA); const float* rkp = pin(p, I_RK); const float* srw = pin(p, I_SRWKV);
    constexpr int NCH = 256 + 4 * 16;
    f32x4 Sacc[4];
#pragma unroll
    for (int jb = 0; jb < 4; ++jb) Sacc[jb] = (f32x4){0.f, 0.f, 0.f, 0.f};
    if (producer) { rwkv_dma(p.ws, lds, wg, pw, lane, 0); rwkv_dma(p.ws, lds, wg, pw, lane, 1); rwkv_dma(p.ws, lds, wg, pw, lane, 2); asm volatile("s_waitcnt vmcnt(0)" ::: "memory"); }
    for (int n = -1; n < NCH; ++n) {
        const bool has_p = n + 1 < NCH, has_c = n >= 0;
        RwkvUnit up, uc; int cp = 0, nchp = 0, cc = 0, nchc = 0;
        if (has_p) rwkv_unit_of(n + 1, wg, up, cp, nchp);
        if (has_c) rwkv_unit_of(n, wg, uc, cc, nchc);
        if (has_p && cp == 0) {
            if (producer) {
                for (int i = htid; i < 768; i += 256) { const int ch = i / 12, pc = i % 12; const size_t go = ((size_t)(up.dir * 2048 + up.head * 64 + ch) * 96 + pc * 8);
                    *(LAS u32x4*)(lds + RQ_W2 + ch * RC_TS + pc * 16) = *(const u32x4*)(W2T + go); *(LAS u32x4*)(lds + RQ_A2 + ch * RC_TS + pc * 16) = *(const u32x4*)(A2T + go); }
                if (htid < 64) { LAS float* cst = (LAS float*)(lds + RQ_CST); const int c = up.head * 64 + htid;
                    cst[htid] = w0p[up.dir * 2048 + c]; cst[64 + htid] = a0p[up.dir * 2048 + c]; cst[128 + htid] = kkp[c]; cst[192 + htid] = kap[c]; cst[256 + htid] = rkp[c]; }
            }
            RQ_BAR();
        }
        LAS unsigned char* bufp = lds + ((n + 1) & 1) * RB2_SIZE; LAS unsigned char* bufc = lds + (n & 1) * RB2_SIZE;
        const u32x2 zz = (u32x2){0u, 0u};
        bf16x8 ufr = __builtin_bit_cast(bf16x8, (u32x4){0u, 0u, 0u, 0u}), vfr = ufr; f32x4 yt = (f32x4){0.f, 0.f, 0.f, 0.f};
        if (producer) {
            if (has_p) {
                RQD_BEGIN(1)
                const LAS unsigned char* slot = lds + RQ_RING + ((n + 1) & 3) * RQ_SLOT;
                f32x4 dW = (f32x4){0.f, 0.f, 0.f, 0.f}, dA = (f32x4){0.f, 0.f, 0.f, 0.f};
#pragma unroll
                for (int ks = 0; ks < 3; ++ks) { const pg8::bf16x8 wf = *(const LAS pg8::bf16x8*)(lds + RQ_W2 + (16 * pw + c16) * RC_TS + (32 * ks + 8 * g) * 2), af = *(const LAS pg8::bf16x8*)(lds + RQ_A2 + (16 * pw + c16) * RC_TS + (32 * ks + 8 * g) * 2);
                    const pg8::bf16x8 tw = *(const LAS pg8::bf16x8*)(slot + c16 * 192 + (32 * ks + 8 * g) * 2), ta = *(const LAS pg8::bf16x8*)(slot + 3072 + c16 * 192 + (32 * ks + 8 * g) * 2);
                    dW = __builtin_amdgcn_mfma_f32_16x16x32_bf16(wf, tw, dW, 0, 0, 0); dA = __builtin_amdgcn_mfma_f32_16x16x32_bf16(af, ta, dA, 0, 0, 0); }
                const int rko = (c16 * 8 + ((2 * pw + (g >> 1)) ^ (c16 & 7))) * 16 + (g & 1) * 8;
                const u32x2 r2 = *(const LAS u32x2*)(slot + 6144 + rko), k2 = *(const LAS u32x2*)(slot + 8192 + rko), v2 = *(const LAS u32x2*)(slot + 10240 + rko); const LAS float* cst = (const LAS float*)(lds + RQ_CST) + 16 * pw + 4 * g;
                const f32x4 w0 = *(const LAS f32x4*)cst, a0 = *(const LAS f32x4*)(cst + 64), kkw = *(const LAS f32x4*)(cst + 128), kaw = *(const LAS f32x4*)(cst + 192), rkw = *(const LAS f32x4*)(cst + 256);
                const float rr[4] = {bflo(r2.x), bfhi(r2.x), bflo(r2.y), bfhi(r2.y)}, k0[4] = {bflo(k2.x), bfhi(k2.x), bflo(k2.y), bfhi(k2.y)};
                f32x4 oW; float kd[4], kk[4], kb[4], ss = 0.f, bon = 0.f;
#pragma unroll
                for (int j = 0; j < 4; ++j) {
                    const float xw = -(w0[j] + dW[j]);
                    const float sp = fmaxf(xw, 0.f) + 0.6931471806f * __builtin_amdgcn_logf(1.f + __builtin_amdgcn_exp2f(-1.4426950409f * fabsf(xw)));
                    oW[j] = __builtin_amdgcn_exp2f(-1.4426950409f * __builtin_amdgcn_exp2f(-1.4426950409f * (sp + 0.5f)));
                    const float a = __builtin_amdgcn_rcpf(1.f + __builtin_amdgcn_exp2f(-1.4426950409f * (a0[j] + dA[j])));
                    kk[j] = k0[j] * kkw[j]; ss += kk[j] * kk[j]; kb[j] = kk[j] * a;
                    kd[j] = k0[j] * (1.f + (a - 1.f) * kaw[j]); bon += rr[j] * kd[j] * rkw[j]; }
                const int eo = rw_sw(c16, 16 * pw + 4 * g);
                *(LAS f32x4*)(lds + RQ_W + eo * 4) = oW;
                *(LAS u32x2*)(lds + RQ_R + eo * 2) = r2; *(LAS u32x2*)(bufp + RB2_V + eo * 2) = v2;
                *(LAS u32x2*)(lds + RQ_KD + eo * 2) = (u32x2){cvtpk(kd[0], kd[1]), cvtpk(kd[2], kd[3])};
                *(LAS u32x2*)(lds + RQ_A + eo * 2) = (u32x2){cvtpk(-kk[0], -kk[1]), cvtpk(-kk[2], -kk[3])};
                *(LAS u32x2*)(lds + RQ_B + eo * 2) = (u32x2){cvtpk(kb[0], kb[1]), cvtpk(kb[2], kb[3])};
                ss = red4(ss); bon = red4(bon);
                if (g == 0) { *(LAS float*)(lds + RQ_SSP + (c16 * 4 + pw) * 4) = ss; *(LAS float*)(lds + RQ_BNP + (c16 * 4 + pw) * 4) = bon; }
                rwkv_dma(p.ws, lds, wg, pw, lane, n + 4);
                RQD_END(1)
            }
        } else if (has_c) {
            RQD_BEGIN(2)
            if (cc == 0) {
                const unsigned sb = (unsigned)((((uc.b * 2 + uc.dir) * 32 + uc.head) * 64 + pw * 16 + c16) * 64 + 4 * g);
#pragma unroll
                for (int jb = 0; jb < 4; ++jb) Sacc[jb] = (f32x4){0.f, 0.f, 0.f, 0.f};
                if (uc.lat) {
#pragma unroll
                    for (int jb = 0; jb < 4; ++jb) Sacc[jb] = *(const f32x4*)((const char*)srw + (sb + 16 * jb) * 4u); }
                __builtin_amdgcn_s_waitcnt(0x0F70);
            }
            bf16x8 sfr[2];
#pragma unroll
            for (int ks = 0; ks < 2; ++ks) { u32x4 s4; s4.x = cvtpk(Sacc[2 * ks][0], Sacc[2 * ks][1]); s4.y = cvtpk(Sacc[2 * ks][2], Sacc[2 * ks][3]);
                s4.z = cvtpk(Sacc[2 * ks + 1][0], Sacc[2 * ks + 1][1]); s4.w = cvtpk(Sacc[2 * ks + 1][2], Sacc[2 * ks + 1][3]); sfr[ks] = __builtin_bit_cast(bf16x8, s4); }
            { const LAS bf16_t* vp = (const LAS bf16_t*)(bufc + RB2_V); const int vi_ = 16 * pw + c16, vt_ = 4 * g;
              const unsigned v0 = vp[rw_sw(vt_, vi_)], v1 = vp[rw_sw(vt_ + 1, vi_)], v2 = vp[rw_sw(vt_ + 2, vi_)], v3 = vp[rw_sw(vt_ + 3, vi_)]; vfr = mk_frag((u32x2){v0 | (v1 << 16), v2 | (v3 << 16)}, zz); }
            f32x4 mx[12], md[3];
#pragma unroll
            for (int s1 = 0; s1 < 12; ++s1) mx[s1] = *(const LAS f32x4*)(bufc + RB2_MAB + s1 * RC_MS + g * 16);
#pragma unroll
            for (int e = 0; e < 3; ++e) md[e] = *(const LAS f32x4*)(bufc + RB2_MD + (4 * g + e) * 16);
            f32x4 xt = (f32x4){0.f, 0.f, 0.f, 0.f};
#pragma unroll
            for (int ks = 0; ks < 2; ++ks) {
                const LAS unsigned char* ap = bufc + RB2_AT + c16 * RC_TT + (32 * ks + 4 * g) * 2; const LAS unsigned char* rp = bufc + RB2_RT + c16 * RC_TT + (32 * ks + 4 * g) * 2;
                xt = __builtin_amdgcn_mfma_f32_16x16x32_bf16(mk_frag(*(const LAS u32x2*)ap, *(const LAS u32x2*)(ap + 32)), sfr[ks], xt, 0, 0, 0);
                yt = __builtin_amdgcn_mfma_f32_16x16x32_bf16(mk_frag(*(const LAS u32x2*)rp, *(const LAS u32x2*)(rp + 32)), sfr[ks], yt, 0, 0, 0); }
            xt = __builtin_amdgcn_mfma_f32_16x16x32_bf16(mk_frag(*(const LAS u32x2*)(bufc + RB2_MAK + c16 * RC_NS + g * 8), zz), vfr, xt, 0, 0, 0);
            yt = __builtin_amdgcn_mfma_f32_16x16x32_bf16(mk_frag(*(const LAS u32x2*)(bufc + RB2_NKR + c16 * RC_NS + g * 8), zz), vfr, yt, 0, 0, 0);
            float x[4] = {xt[0], xt[1], xt[2], xt[3]};
#pragma unroll
            for (int h = 0; h < 4; ++h) {
                if (g == h) { x[1] += x[0] * md[0][1]; x[2] += x[0] * md[0][2]; x[3] += x[0] * md[0][3]; x[2] += x[1] * md[1][2]; x[3] += x[1] * md[1][3]; x[3] += x[2] * md[2][3]; }
                if (h < 3) { float ub[4];
#pragma unroll
                    for (int e = 0; e < 4; ++e) { const unsigned xv = __float_as_uint(x[e]);
                        if (h == 2) { const auto r1 = __builtin_amdgcn_permlane16_swap(xv, xv, false, false); ub[e] = __uint_as_float(r1[0]); }
                        else { const auto r0 = __builtin_amdgcn_permlane32_swap(xv, xv, false, false); const auto r1 = __builtin_amdgcn_permlane16_swap(r0[0], r0[0], false, false); ub[e] = __uint_as_float(r1[h]); } }
#pragma unroll
                    for (int e2 = 0; e2 < 4; ++e2)
#pragma unroll
                        for (int e = 0; e < 4; ++e) x[e] += ub[e2] * mx[4 * h + e2][e]; } }
            ufr = mk_frag((u32x2){cvtpk(x[0], x[1]), cvtpk(x[2], x[3])}, zz);
            RQD_END(2)
        }
        RQ_BAR();
        if (producer) {
            if (has_p) {
                RQD_BEGIN(3)
                int ln = lane; asm volatile("" : "+v"(ln));
                float wv[16], ow[4], bt[4], kt[4]; unsigned ra[4], rb[4], rk[4], rr[4]; f32x4 ssp[4];
#pragma unroll
                for (int t1 = 0; t1 < 16; ++t1) wv[t1] = *(const LAS float*)(lds + RQ_W + rw_sw(t1, ln) * 4);
#pragma unroll
                for (int e = 0; e < 4; ++e) { const unsigned o = (unsigned)rw_sw(4 * pw + e, ln); ow[e] = *(const LAS float*)(lds + RQ_W + o * 4u);
                    ra[e] = *(const LAS bf16_t*)(lds + RQ_A + o * 2u); rb[e] = *(const LAS bf16_t*)(lds + RQ_B + o * 2u); rk[e] = *(const LAS bf16_t*)(lds + RQ_KD + o * 2u); rr[e] = *(const LAS bf16_t*)(lds + RQ_R + o * 2u);
                    ssp[e] = *(const LAS f32x4*)(lds + RQ_SSP + (4 * pw + e) * 16); }
                const f32x4 bnp = *(const LAS f32x4*)(lds + RQ_BNP + (4 * pw + (ln & 3)) * 16);
                __builtin_amdgcn_sched_barrier(0);
                if (ln < 4) { const int tau = cp * 16 + 4 * pw + ln, t = up.dir ? up.L - 1 - tau : tau; BON[((size_t)up.dir * MTOK + (size_t)(up.base + t)) * 32 + up.head] = (bnp[0] + bnp[1]) + (bnp[2] + bnp[3]); }
                const float p40 = (wv[0] * wv[1]) * (wv[2] * wv[3]), p41 = (wv[4] * wv[5]) * (wv[6] * wv[7]), p42 = (wv[8] * wv[9]) * (wv[10] * wv[11]), p43 = (wv[12] * wv[13]) * (wv[14] * wv[15]);
                const float c01 = p40 * p41, c012 = c01 * p42, gl = c012 * p43;
                float grun = pw == 0 ? 1.f : pw == 1 ? p40 : pw == 2 ? c01 : c012;
#pragma unroll
                for (int e = 0; e < 4; ++e) { const int t1 = 4 * pw + e; const float gprev = grun; grun *= ow[e];
                    const float inv = __builtin_amdgcn_rcpf(fmaxf(__builtin_amdgcn_sqrtf((ssp[e][0] + ssp[e][1]) + (ssp[e][2] + ssp[e][3])), 1e-12f));
                    const float a = __uint_as_float(ra[e] << 16) * inv, bv = __uint_as_float(rb[e] << 16) * inv, kd = __uint_as_float(rk[e] << 16), rv = __uint_as_float(rr[e] << 16);
                    const float ig = __builtin_amdgcn_rcpf(grun); bt[e] = bv * ig; kt[e] = kd * ig;
                    *(LAS bf16_t*)(bufp + RB2_AT + t1 * RC_TT + ln * 2) = f2bf(gprev * a); *(LAS bf16_t*)(bufp + RB2_RT + t1 * RC_TT + ln * 2) = f2bf(grun * rv);
                    *(LAS bf16_t*)(bufp + RB2_BT + t1 * RC_TT + ln * 2) = f2bf(bt[e]); *(LAS bf16_t*)(bufp + RB2_KT + t1 * RC_TT + ln * 2) = f2bf(kt[e]); }
                *(LAS u32x2*)(bufp + RB2_BH + ln * RC_HS + pw * 8) = (u32x2){cvtpk(bt[0] * gl, bt[1] * gl), cvtpk(bt[2] * gl, bt[3] * gl)};
                *(LAS u32x2*)(bufp + RB2_KH + ln * RC_HS + pw * 8) = (u32x2){cvtpk(kt[0] * gl, kt[1] * gl), cvtpk(kt[2] * gl, kt[3] * gl)};
                if (pw == 0) *(LAS float*)(bufp + RB2_GL + ln * 4) = gl;
                RQD_END(3)
            }
        } else if (has_c) {
            RQD_BEGIN(4)
            yt = __builtin_amdgcn_mfma_f32_16x16x32_bf16(mk_frag(*(const LAS u32x2*)(bufc + RB2_NBR + c16 * RC_NS + g * 8), zz), ufr, yt, 0, 0, 0);
#pragma unroll
            for (int r = 0; r < 4; ++r) *(LAS bf16_t*)(lds + RQ_YO + (4 * g + r) * 128 + (16 * pw + c16) * 2) = f2bf_rne(yt[r]);
#pragma unroll
            for (int jb = 0; jb < 4; ++jb) { const f32x4 gl4 = *(const LAS f32x4*)(bufc + RB2_GL + (16 * jb + 4 * g) * 4); Sacc[jb] = Sacc[jb] * gl4;
                Sacc[jb] = __builtin_amdgcn_mfma_f32_16x16x32_bf16(mk_frag(*(const LAS u32x2*)(bufc + RB2_BH + (16 * jb + c16) * RC_HS + g * 8), zz), ufr, Sacc[jb], 0, 0, 0);
                Sacc[jb] = __builtin_amdgcn_mfma_f32_16x16x32_bf16(mk_frag(*(const LAS u32x2*)(bufc + RB2_KH + (16 * jb + c16) * RC_HS + g * 8), zz), vfr, Sacc[jb], 0, 0, 0); }
            if (cc == nchc - 1 && !uc.lat) { const unsigned sb = (unsigned)((((uc.b * 2 + uc.dir) * 32 + uc.head) * 64 + pw * 16 + c16) * 64 + 4 * g);
#pragma unroll
                for (int jb = 0; jb < 4; ++jb) *(f32x4*)((char*)p.out + ((unsigned)OUT_RWKV + sb + 16 * jb) * 4u) = Sacc[jb]; }
            RQD_END(4)
        }
        RQ_BAR();
        if (producer) {
            if (has_p) {
                RQD_BEGIN(5)
                const int xo = (pw & 1) ? RB2_KT : RB2_BT, yo = (pw & 2) ? RB2_RT : RB2_AT;
                f32x4 mm = (f32x4){0.f, 0.f, 0.f, 0.f};
#pragma unroll
                for (int ks = 0; ks < 2; ++ks) { const bf16x8 xf = *(const LAS bf16x8*)(bufp + xo + c16 * RC_TT + (32 * ks + 8 * g) * 2), yf = *(const LAS bf16x8*)(bufp + yo + c16 * RC_TT + (32 * ks + 8 * g) * 2);
                    mm = __builtin_amdgcn_mfma_f32_16x16x32_bf16(xf, yf, mm, 0, 0, 0); }
#pragma unroll
                for (int r = 0; r < 4; ++r) { const int s_ = 4 * g + r; const bool keep = (pw & 2) ? (s_ <= c16) : (s_ < c16); mm[r] = keep ? mm[r] : 0.f; }
                if (pw == 0) {
                    const int tb = c16 >> 2;
#pragma unroll
                    for (int r = 0; r < 4; ++r) *(LAS float*)(bufp + RB2_MAB + (4 * g + r) * RC_MS + c16 * 4) = g < tb ? mm[r] : 0.f;
                    if (g == tb) {
#pragma unroll
                        for (int r = 0; r < 4; ++r) *(LAS float*)(bufp + RB2_MD + (4 * g + r) * 16 + (c16 & 3) * 4) = mm[r]; } }
                else { u32x2 w; w.x = cvtpk(mm[0], mm[1]); w.y = cvtpk(mm[2], mm[3]); *(LAS u32x2*)(bufp + (pw == 1 ? RB2_MAK : pw == 2 ? RB2_NBR : RB2_NKR) + c16 * RC_NS + g * 8) = w; }
                RQD_END(5)
            }
        } else if (has_c && htid < 128) {
            const int tok = htid >> 3, c8 = (htid & 7) * 8, tau = cc * 16 + tok, t = uc.dir ? uc.L - 1 - tau : tau; const size_t row = (size_t)(uc.base + t);
            *(u32x4*)(YD + (size_t)uc.dir * MTOK * DM + row * DM + uc.head * 64 + c8) = *(const LAS u32x4*)(lds + RQ_YO + tok * 128 + c8 * 2);
        }
        if (producer) asm volatile("s_waitcnt vmcnt(9)" ::: "memory");
        RQ_BAR();
    }
}

#ifndef RQ3_DELAY
#define RQ3_DELAY 0
#endif
#define RQ3D_BEGIN(S) unsigned long long rq3_t0_##S = 0; if (RQ3_DELAY == S) rq3_t0_##S = clock64();
#define RQ3D_END(S) if (RQ3_DELAY == S) { asm volatile("s_waitcnt lgkmcnt(0)" ::: "memory"); const unsigned long long t1_ = clock64(), d_ = t1_ - rq3_t0_##S; while ((unsigned long long)clock64() - t1_ < d_) { } }
__device__ __forceinline__ void p9_rwkv_pipe3(const Params& p, LAS unsigned char* lds) {
    const int tid = tidx(), half = __builtin_amdgcn_readfirstlane(tid >> 8), htid = tid & 255, pw = __builtin_amdgcn_readfirstlane((tid >> 6) & 3), lane = tid & 63, c16 = lane & 15, g = lane >> 4, wg = blockIdx.x;
    const bool producer = half == 1;
    const bf16_t* W2T = (const bf16_t*)(p.ws + WS_W2T); const bf16_t* A2T = (const bf16_t*)(p.ws + WS_A2T);
    float* BON = (float*)(p.ws + WS_BON); bf16_t* YD = (bf16_t*)(p.out + OUT_Y);
    const float* w0p = pin(p, I_W0); const float* a0p = pin(p, I_A0); const float* kkp = pin(p, I_KK); const float* kap = pin(p, I_KA); const float* rkp = pin(p, I_RK); const float* srw = pin(p, I_SRWKV);
    constexpr int NCH = 256 + 4 * 16;
    const u32x2 zz = (u32x2){0u, 0u};
    f32x4 Sacc[4];
#pragma unroll
    for (int jb = 0; jb < 4; ++jb) Sacc[jb] = (f32x4){0.f, 0.f, 0.f, 0.f};
    if (producer) { rwkv_dma(p.ws, lds, wg, pw, lane, 0); rwkv_dma(p.ws, lds, wg, pw, lane, 1); rwkv_dma(p.ws, lds, wg, pw, lane, 2); rwkv_dma(p.ws, lds, wg, pw, lane, 3);
        { RwkvUnit UT; int c0, n0; rwkv_unit_of(0, wg, UT, c0, n0);
                for (int i = htid; i < 768; i += 256) { const int ch = i / 12, pc = i % 12; const size_t go = ((size_t)(UT.dir * 2048 + UT.head * 64 + ch) * 96 + pc * 8);
                    *(LAS u32x4*)(lds + RQ_W2 + ch * RC_TS + pc * 16) = *(const u32x4*)(W2T + go); *(LAS u32x4*)(lds + RQ_A2 + ch * RC_TS + pc * 16) = *(const u32x4*)(A2T + go); }
                if (htid < 64) { LAS float* cst = (LAS float*)(lds + RQ_CST); const int c = UT.head * 64 + htid;
                    cst[htid] = w0p[UT.dir * 2048 + c]; cst[64 + htid] = a0p[UT.dir * 2048 + c]; cst[128 + htid] = kkp[c]; cst[192 + htid] = kap[c]; cst[256 + htid] = rkp[c]; } }
        asm volatile("s_waitcnt vmcnt(0)" ::: "memory"); }
    RQ_BAR();
    if (producer) { const int ca = 0;
                const LAS unsigned char* slot = lds + RQ_RING + (ca & 3) * RQ_SLOT; LAS unsigned char* bufa = lds + (ca & 1) * RB2_SIZE;
                f32x4 dW = (f32x4){0.f, 0.f, 0.f, 0.f}, dA = (f32x4){0.f, 0.f, 0.f, 0.f};
#pragma unroll
                for (int ks = 0; ks < 3; ++ks) { const pg8::bf16x8 wf = *(const LAS pg8::bf16x8*)(lds + RQ_W2 + (16 * pw + c16) * RC_TS + (32 * ks + 8 * g) * 2), af = *(const LAS pg8::bf16x8*)(lds + RQ_A2 + (16 * pw + c16) * RC_TS + (32 * ks + 8 * g) * 2);
                    const pg8::bf16x8 tw = *(const LAS pg8::bf16x8*)(slot + c16 * 192 + (32 * ks + 8 * g) * 2), ta = *(const LAS pg8::bf16x8*)(slot + 3072 + c16 * 192 + (32 * ks + 8 * g) * 2);
                    dW = __builtin_amdgcn_mfma_f32_16x16x32_bf16(wf, tw, dW, 0, 0, 0); dA = __builtin_amdgcn_mfma_f32_16x16x32_bf16(af, ta, dA, 0, 0, 0); }
                const int rko = (c16 * 8 + ((2 * pw + (g >> 1)) ^ (c16 & 7))) * 16 + (g & 1) * 8;
                const u32x2 r2 = *(const LAS u32x2*)(slot + 6144 + rko), k2 = *(const LAS u32x2*)(slot + 8192 + rko), v2 = *(const LAS u32x2*)(slot + 10240 + rko); const LAS float* cst = (const LAS float*)(lds + RQ_CST) + 16 * pw + 4 * g;
                const f32x4 w0 = *(const LAS f32x4*)cst, a0 = *(const LAS f32x4*)(cst + 64), kkw = *(const LAS f32x4*)(cst + 128), kaw = *(const LAS f32x4*)(cst + 192), rkw = *(const LAS f32x4*)(cst + 256);
                const float rr[4] = {bflo(r2.x), bfhi(r2.x), bflo(r2.y), bfhi(r2.y)}, k0[4] = {bflo(k2.x), bfhi(k2.x), bflo(k2.y), bfhi(k2.y)};
                f32x4 oW; float kd[4], kk[4], kb[4], ss = 0.f, bon = 0.f;
#pragma unroll
                for (int j = 0; j < 4; ++j) {
                    const float xw = -(w0[j] + dW[j]);
                    const float sp = fmaxf(xw, 0.f) + 0.6931471806f * __builtin_amdgcn_logf(1.f + __builtin_amdgcn_exp2f(-1.4426950409f * fabsf(xw)));
                    oW[j] = __builtin_amdgcn_exp2f(-1.4426950409f * __builtin_amdgcn_exp2f(-1.4426950409f * (sp + 0.5f)));
                    const float a = __builtin_amdgcn_rcpf(1.f + __builtin_amdgcn_exp2f(-1.4426950409f * (a0[j] + dA[j])));
                    kk[j] = k0[j] * kkw[j]; ss += kk[j] * kk[j]; kb[j] = kk[j] * a;
                    kd[j] = k0[j] * (1.f + (a - 1.f) * kaw[j]); bon += rr[j] * kd[j] * rkw[j]; }
                const int eo = rw_sw(c16, 16 * pw + 4 * g);
                *(LAS f32x4*)(lds + RQ_W + eo * 4) = oW;
                *(LAS u32x2*)(lds + RQ_R + eo * 2) = r2; *(LAS u32x2*)(bufa + RB2_V + eo * 2) = v2;
                *(LAS u32x2*)(lds + RQ_KD + eo * 2) = (u32x2){cvtpk(kd[0], kd[1]), cvtpk(kd[2], kd[3])};
                *(LAS u32x2*)(lds + RQ_A + eo * 2) = (u32x2){cvtpk(-kk[0], -kk[1]), cvtpk(-kk[2], -kk[3])};
                *(LAS u32x2*)(lds + RQ_B + eo * 2) = (u32x2){cvtpk(kb[0], kb[1]), cvtpk(kb[2], kb[3])};
                ss = red4(ss); bon = red4(bon);
                if (g == 0) { *(LAS float*)(lds + RQ_SSP + (c16 * 4 + pw) * 4) = ss; *(LAS float*)(lds + RQ_BNP + (c16 * 4 + pw) * 4) = bon; }
    }
    RQ_BAR();
    for (int n = -1; n <= NCH; ++n) {
        const bool has_p = n + 1 < NCH, has_a = n + 2 < NCH, has_c = n >= 0 && n < NCH, has_w = n >= 1;
        RwkvUnit up, uc, ua, uw; int cp = 0, nchp = 0, cc = 0, nchc = 0, cia = 1, ncha = 0, cw = 0, nchw = 0;
        if (has_p) rwkv_unit_of(n + 1, wg, up, cp, nchp);
        if (has_c) rwkv_unit_of(n, wg, uc, cc, nchc);
        if (has_a) rwkv_unit_of(n + 2, wg, ua, cia, ncha);
        if (has_w) rwkv_unit_of(n - 1, wg, uw, cw, nchw);
        LAS unsigned char* bufp = lds + ((n + 1) & 1) * RB2_SIZE; LAS unsigned char* bufc = lds + (n & 1) * RB2_SIZE;
        bf16x8 ufr = __builtin_bit_cast(bf16x8, (u32x4){0u, 0u, 0u, 0u}), vfr = ufr; f32x4 yt = (f32x4){0.f, 0.f, 0.f, 0.f};
        if (producer) {
            if (has_p) {
                RQ3D_BEGIN(1)
                                const int ln = lane;
                float wv[16], ow[4], bt[4], kt[4]; unsigned ra[4], rb[4], rk[4], rr[4]; f32x4 ssp[4];
#pragma unroll
                for (int t1 = 0; t1 < 16; ++t1) wv[t1] = *(const LAS float*)(lds + RQ_W + rw_sw(t1, ln) * 4);
#pragma unroll
                for (int e = 0; e < 4; ++e) { const unsigned o = (unsigned)rw_sw(4 * pw + e, ln); ow[e] = *(const LAS float*)(lds + RQ_W + o * 4u);
                    ra[e] = *(const LAS bf16_t*)(lds + RQ_A + o * 2u); rb[e] = *(const LAS bf16_t*)(lds + RQ_B + o * 2u); rk[e] = *(const LAS bf16_t*)(lds + RQ_KD + o * 2u); rr[e] = *(const LAS bf16_t*)(lds + RQ_R + o * 2u);
                    ssp[e] = *(const LAS f32x4*)(lds + RQ_SSP + (4 * pw + e) * 16); }
                const f32x4 bnp = *(const LAS f32x4*)(lds + RQ_BNP + (4 * pw + (ln & 3)) * 16);
                __builtin_amdgcn_sched_barrier(0);
                if (ln < 4) { const int tau = cp * 16 + 4 * pw + ln, t = up.dir ? up.L - 1 - tau : tau; BON[((size_t)up.dir * MTOK + (size_t)(up.base + t)) * 32 + up.head] = (bnp[0] + bnp[1]) + (bnp[2] + bnp[3]); }
                const float p40 = (wv[0] * wv[1]) * (wv[2] * wv[3]), p41 = (wv[4] * wv[5]) * (wv[6] * wv[7]), p42 = (wv[8] * wv[9]) * (wv[10] * wv[11]), p43 = (wv[12] * wv[13]) * (wv[14] * wv[15]);
                const float c01 = p40 * p41, c012 = c01 * p42, gl = c012 * p43;
                float grun = pw == 0 ? 1.f : pw == 1 ? p40 : pw == 2 ? c01 : c012;
#pragma unroll
                for (int e = 0; e < 4; ++e) { const int t1 = 4 * pw + e; const float gprev = grun; grun *= ow[e];
                    const float inv = __builtin_amdgcn_rcpf(fmaxf(__builtin_amdgcn_sqrtf((ssp[e][0] + ssp[e][1]) + (ssp[e][2] + ssp[e][3])), 1e-12f));
                    const float a = __uint_as_float(ra[e] << 16) * inv, bv = __uint_as_float(rb[e] << 16) * inv, kd = __uint_as_float(rk[e] << 16), rv = __uint_as_float(rr[e] << 16);
                    const float ig = __builtin_amdgcn_rcpf(grun); bt[e] = bv * ig; kt[e] = kd * ig;
                    *(LAS bf16_t*)(bufp + RB2_AT + t1 * RC_TT + ln * 2) = f2bf(gprev * a); *(LAS bf16_t*)(bufp + RB2_RT + t1 * RC_TT + ln * 2) = f2bf(grun * rv);
                    *(LAS bf16_t*)(bufp + RB2_BT + t1 * RC_TT + ln * 2) = f2bf(bt[e]); *(LAS bf16_t*)(bufp + RB2_KT + t1 * RC_TT + ln * 2) = f2bf(kt[e]); }
                *(LAS u32x2*)(bufp + RB2_BH + ln * RC_HS + pw * 8) = (u32x2){cvtpk(bt[0] * gl, bt[1] * gl), cvtpk(bt[2] * gl, bt[3] * gl)};
                *(LAS u32x2*)(bufp + RB2_KH + ln * RC_HS + pw * 8) = (u32x2){cvtpk(kt[0] * gl, kt[1] * gl), cvtpk(kt[2] * gl, kt[3] * gl)};
                if (pw == 0) *(LAS float*)(bufp + RB2_GL + ln * 4) = gl;
                RQ3D_END(1)
            }
        } else {
            RQ3D_BEGIN(2)
            if (has_w && htid < 128) {
                const int tok = htid >> 3, c8 = (htid & 7) * 8, tau = cw * 16 + tok, t = uw.dir ? uw.L - 1 - tau : tau; const size_t row = (size_t)(uw.base + t);
                *(u32x4*)(YD + (size_t)uw.dir * MTOK * DM + row * DM + uw.head * 64 + c8) = *(const LAS u32x4*)(lds + RQ_YO + tok * 128 + c8 * 2); }
            if (has_c) {
            if (cc == 0) {
                const unsigned sb = (unsigned)((((uc.b * 2 + uc.dir) * 32 + uc.head) * 64 + pw * 16 + c16) * 64 + 4 * g);
#pragma unroll
                for (int jb = 0; jb < 4; ++jb) Sacc[jb] = (f32x4){0.f, 0.f, 0.f, 0.f};
                if (uc.lat) {
#pragma unroll
                    for (int jb = 0; jb < 4; ++jb) Sacc[jb] = *(const f32x4*)((const char*)srw + (sb + 16 * jb) * 4u); }
                __builtin_amdgcn_s_waitcnt(0x0F70);
            }
            bf16x8 sfr[2];
#pragma unroll
            for (int ks = 0; ks < 2; ++ks) { u32x4 s4; s4.x = cvtpk(Sacc[2 * ks][0], Sacc[2 * ks][1]); s4.y = cvtpk(Sacc[2 * ks][2], Sacc[2 * ks][3]);
                s4.z = cvtpk(Sacc[2 * ks + 1][0], Sacc[2 * ks + 1][1]); s4.w = cvtpk(Sacc[2 * ks + 1][2], Sacc[2 * ks + 1][3]); sfr[ks] = __builtin_bit_cast(bf16x8, s4); }
            { const LAS bf16_t* vp = (const LAS bf16_t*)(bufc + RB2_V); const int vi_ = 16 * pw + c16, vt_ = 4 * g;
              const unsigned v0 = vp[rw_sw(vt_, vi_)], v1 = vp[rw_sw(vt_ + 1, vi_)], v2 = vp[rw_sw(vt_ + 2, vi_)], v3 = vp[rw_sw(vt_ + 3, vi_)]; vfr = mk_frag((u32x2){v0 | (v1 << 16), v2 | (v3 << 16)}, zz); }
            f32x4 mx[12], md[3];
#pragma unroll
            for (int s1 = 0; s1 < 12; ++s1) mx[s1] = *(const LAS f32x4*)(bufc + RB2_MAB + s1 * RC_MS + g * 16);
#pragma unroll
            for (int e = 0; e < 3; ++e) md[e] = *(const LAS f32x4*)(bufc + RB2_MD + (4 * g + e) * 16);
            f32x4 xt = (f32x4){0.f, 0.f, 0.f, 0.f};
#pragma unroll
            for (int ks = 0; ks < 2; ++ks) {
                const LAS unsigned char* ap = bufc + RB2_AT + c16 * RC_TT + (32 * ks + 4 * g) * 2; const LAS unsigned char* rp = bufc + RB2_RT + c16 * RC_TT + (32 * ks + 4 * g) * 2;
                xt = __builtin_amdgcn_mfma_f32_16x16x32_bf16(mk_frag(*(const LAS u32x2*)ap, *(const LAS u32x2*)(ap + 32)), sfr[ks], xt, 0, 0, 0);
                yt = __builtin_amdgcn_mfma_f32_16x16x32_bf16(mk_frag(*(const LAS u32x2*)rp, *(const LAS u32x2*)(rp + 32)), sfr[ks], yt, 0, 0, 0); }
            xt = __builtin_amdgcn_mfma_f32_16x16x32_bf16(mk_frag(*(const LAS u32x2*)(bufc + RB2_MAK + c16 * RC_NS + g * 8), zz), vfr, xt, 0, 0, 0);
            yt = __builtin_amdgcn_mfma_f32_16x16x32_bf16(mk_frag(*(const LAS u32x2*)(bufc + RB2_NKR + c16 * RC_NS + g * 8), zz), vfr, yt, 0, 0, 0);
            float x[4] = {xt[0], xt[1], xt[2], xt[3]};
#pragma unroll
            for (int h = 0; h < 4; ++h) {
                if (g == h) { x[1] += x[0] * md[0][1]; x[2] += x[0] * md[0][2]; x[3] += x[0] * md[0][3]; x[2] += x[1] * md[1][2]; x[3] += x[1] * md[1][3]; x[3] += x[2] * md[2][3]; }
                if (h < 3) { float ub[4];
#pragma unroll
                    for (int e = 0; e < 4; ++e) { const unsigned xv = __float_as_uint(x[e]);
                        if (h == 2) { const auto r1 = __builtin_amdgcn_permlane16_swap(xv, xv, false, false); ub[e] = __uint_as_float(r1[0]); }
                        else { const auto r0 = __builtin_amdgcn_permlane32_swap(xv, xv, false, false); const auto r1 = __builtin_amdgcn_permlane16_swap(r0[0], r0[0], false, false); ub[e] = __uint_as_float(r1[h]); } }
#pragma unroll
                    for (int e2 = 0; e2 < 4; ++e2)
#pragma unroll
                        for (int e = 0; e < 4; ++e) x[e] += ub[e2] * mx[4 * h + e2][e]; } }
            ufr = mk_frag((u32x2){cvtpk(x[0], x[1]), cvtpk(x[2], x[3])}, zz);
            }
            RQ3D_END(2)
        }
        RQ_BAR();
        if (has_a && cia == 0) {
            if (producer) { const RwkvUnit UT = ua;
                for (int i = htid; i < 768; i += 256) { const int ch = i / 12, pc = i % 12; const size_t go = ((size_t)(UT.dir * 2048 + UT.head * 64 + ch) * 96 + pc * 8);
                    *(LAS u32x4*)(lds + RQ_W2 + ch * RC_TS + pc * 16) = *(const u32x4*)(W2T + go); *(LAS u32x4*)(lds + RQ_A2 + ch * RC_TS + pc * 16) = *(const u32x4*)(A2T + go); }
                if (htid < 64) { LAS float* cst = (LAS float*)(lds + RQ_CST); const int c = UT.head * 64 + htid;
                    cst[htid] = w0p[UT.dir * 2048 + c]; cst[64 + htid] = a0p[UT.dir * 2048 + c]; cst[128 + htid] = kkp[c]; cst[192 + htid] = kap[c]; cst[256 + htid] = rkp[c]; } }
            RQ_BAR();
        }
        if (producer) {
            RQ3D_BEGIN(3)
            if (has_p) {
                const int xo = (pw & 1) ? RB2_KT : RB2_BT, yo = (pw & 2) ? RB2_RT : RB2_AT;
                f32x4 mm = (f32x4){0.f, 0.f, 0.f, 0.f};
#pragma unroll
                for (int ks = 0; ks < 2; ++ks) { const bf16x8 xf = *(const LAS bf16x8*)(bufp + xo + c16 * RC_TT + (32 * ks + 8 * g) * 2), yf = *(const LAS bf16x8*)(bufp + yo + c16 * RC_TT + (32 * ks + 8 * g) * 2);
                    mm = __builtin_amdgcn_mfma_f32_16x16x32_bf16(xf, yf, mm, 0, 0, 0); }
#pragma unroll
                for (int r = 0; r < 4; ++r) { const int s_ = 4 * g + r; const bool keep = (pw & 2) ? (s_ <= c16) : (s_ < c16); mm[r] = keep ? mm[r] : 0.f; }
                if (pw == 0) {
                    const int tb = c16 >> 2;
#pragma unroll
                    for (int r = 0; r < 4; ++r) *(LAS float*)(bufp + RB2_MAB + (4 * g + r) * RC_MS + c16 * 4) = g < tb ? mm[r] : 0.f;
                    if (g == tb) {
#pragma unroll
                        for (int r = 0; r < 4; ++r) *(LAS float*)(bufp + RB2_MD + (4 * g + r) * 16 + (c16 & 3) * 4) = mm[r]; } }
                else { u32x2 w; w.x = cvtpk(mm[0], mm[1]); w.y = cvtpk(mm[2], mm[3]); *(LAS u32x2*)(bufp + (pw == 1 ? RB2_MAK : pw == 2 ? RB2_NBR : RB2_NKR) + c16 * RC_NS + g * 8) = w; }
            }
            if (has_a) { const int ca = n + 2;
                const LAS unsigned char* slot = lds + RQ_RING + (ca & 3) * RQ_SLOT; LAS unsigned char* bufa = lds + (ca & 1) * RB2_SIZE;
                f32x4 dW = (f32x4){0.f, 0.f, 0.f, 0.f}, dA = (f32x4){0.f, 0.f, 0.f, 0.f};
#pragma unroll
                for (int ks = 0; ks < 3; ++ks) { const pg8::bf16x8 wf = *(const LAS pg8::bf16x8*)(lds + RQ_W2 + (16 * pw + c16) * RC_TS + (32 * ks + 8 * g) * 2), af = *(const LAS pg8::bf16x8*)(lds + RQ_A2 + (16 * pw + c16) * RC_TS + (32 * ks + 8 * g) * 2);
                    const pg8::bf16x8 tw = *(const LAS pg8::bf16x8*)(slot + c16 * 192 + (32 * ks + 8 * g) * 2), ta = *(const LAS pg8::bf16x8*)(slot + 3072 + c16 * 192 + (32 * ks + 8 * g) * 2);
                    dW = __builtin_amdgcn_mfma_f32_16x16x32_bf16(wf, tw, dW, 0, 0, 0); dA = __builtin_amdgcn_mfma_f32_16x16x32_bf16(af, ta, dA, 0, 0, 0); }
                const int rko = (c16 * 8 + ((2 * pw + (g >> 1)) ^ (c16 & 7))) * 16 + (g & 1) * 8;
                const u32x2 r2 = *(const LAS u32x2*)(slot + 6144 + rko), k2 = *(const LAS u32x2*)(slot + 8192 + rko), v2 = *(const LAS u32x2*)(slot + 10240 + rko); const LAS float* cst = (const LAS float*)(lds + RQ_CST) + 16 * pw + 4 * g;
                const f32x4 w0 = *(const LAS f32x4*)cst, a0 = *(const LAS f32x4*)(cst + 64), kkw = *(const LAS f32x4*)(cst + 128), kaw = *(const LAS f32x4*)(cst + 192), rkw = *(const LAS f32x4*)(cst + 256);
                const float rr[4] = {bflo(r2.x), bfhi(r2.x), bflo(r2.y), bfhi(r2.y)}, k0[4] = {bflo(k2.x), bfhi(k2.x), bflo(k2.y), bfhi(k2.y)};
                f32x4 oW; float kd[4], kk[4], kb[4], ss = 0.f, bon = 0.f;
#pragma unroll
                for (int j = 0; j < 4; ++j) {
                    const float xw = -(w0[j] + dW[j]);
                    const float sp = fmaxf(xw, 0.f) + 0.6931471806f * __builtin_amdgcn_logf(1.f + __builtin_amdgcn_exp2f(-1.4426950409f * fabsf(xw)));
                    oW[j] = __builtin_amdgcn_exp2f(-1.4426950409f * __builtin_amdgcn_exp2f(-1.4426950409f * (sp + 0.5f)));
                    const float a = __builtin_amdgcn_rcpf(1.f + __builtin_amdgcn_exp2f(-1.4426950409f * (a0[j] + dA[j])));
                    kk[j] = k0[j] * kkw[j]; ss += kk[j] * kk[j]; kb[j] = kk[j] * a;
                    kd[j] = k0[j] * (1.f + (a - 1.f) * kaw[j]); bon += rr[j] * kd[j] * rkw[j]; }
                const int eo = rw_sw(c16, 16 * pw + 4 * g);
                *(LAS f32x4*)(lds + RQ_W + eo * 4) = oW;
                *(LAS u32x2*)(lds + RQ_R + eo * 2) = r2; *(LAS u32x2*)(bufa + RB2_V + eo * 2) = v2;
                *(LAS u32x2*)(lds + RQ_KD + eo * 2) = (u32x2){cvtpk(kd[0], kd[1]), cvtpk(kd[2], kd[3])};
                *(LAS u32x2*)(lds + RQ_A + eo * 2) = (u32x2){cvtpk(-kk[0], -kk[1]), cvtpk(-kk[2], -kk[3])};
                *(LAS u32x2*)(lds + RQ_B + eo * 2) = (u32x2){cvtpk(kb[0], kb[1]), cvtpk(kb[2], kb[3])};
                ss = red4(ss); bon = red4(bon);
                if (g == 0) { *(LAS float*)(lds + RQ_SSP + (c16 * 4 + pw) * 4) = ss; *(LAS float*)(lds + RQ_BNP + (c16 * 4 + pw) * 4) = bon; }
            }
            rwkv_dma(p.ws, lds, wg, pw, lane, n + 5);
            RQ3D_END(3)
            asm volatile("s_waitcnt vmcnt(8)" ::: "memory");
        } else if (has_c) {
            RQ3D_BEGIN(4)
            yt = __builtin_amdgcn_mfma_f32_16x16x32_bf16(mk_frag(*(const LAS u32x2*)(bufc + RB2_NBR + c16 * RC_NS + g * 8), zz), ufr, yt, 0, 0, 0);
#pragma unroll
            for (int r = 0; r < 4; ++r) *(LAS bf16_t*)(lds + RQ_YO + (4 * g + r) * 128 + (16 * pw + c16) * 2) = f2bf_rne(yt[r]);
#pragma unroll
            for (int jb = 0; jb < 4; ++jb) { const f32x4 gl4 = *(const LAS f32x4*)(bufc + RB2_GL + (16 * jb + 4 * g) * 4); Sacc[jb] = Sacc[jb] * gl4;
                Sacc[jb] = __builtin_amdgcn_mfma_f32_16x16x32_bf16(mk_frag(*(const LAS u32x2*)(bufc + RB2_BH + (16 * jb + c16) * RC_HS + g * 8), zz), ufr, Sacc[jb], 0, 0, 0);
                Sacc[jb] = __builtin_amdgcn_mfma_f32_16x16x32_bf16(mk_frag(*(const LAS u32x2*)(bufc + RB2_KH + (16 * jb + c16) * RC_HS + g * 8), zz), vfr, Sacc[jb], 0, 0, 0); }
            if (cc == nchc - 1 && !uc.lat) { const unsigned sb = (unsigned)((((uc.b * 2 + uc.dir) * 32 + uc.head) * 64 + pw * 16 + c16) * 64 + 4 * g);
#pragma unroll
                for (int jb = 0; jb < 4; ++jb) *(f32x4*)((char*)p.out + ((unsigned)OUT_RWKV + sb + 16 * jb) * 4u) = Sacc[jb]; }
            RQ3D_END(4)
        }
        RQ_BAR();
    }
}

constexpr int RS_GL = 0, RS_MAB = 256, RS_MD = 1536, RS_MAK = 1792, RS_NBR = 2432, RS_NKR = 3072, RS_AT = 3712, RS_RT = 6016, RS_BT = 8320, RS_KT = 10624, RS_BH = 12928, RS_KH = 15488, RD_SET = 18048;
constexpr int RD_INV = 2 * RD_SET, RD_SSP = RD_INV + 256, RD_BNP = RD_SSP + 256, RD_YO = RD_BNP + 256, RD_V = RD_YO + 4096, RD_CST = RD_V + 4096, RD_W2 = RD_CST + 1280, RD_A2 = RD_W2 + 13312, RD_HALF = RD_A2 + 13312;
static_assert(2 * RD_HALF <= LDS_BAR_OFF, "RWKV chunk2 LDS map");
template <int N> __device__ __forceinline__ float rw_shr1(float x) { return __int_as_float(__builtin_amdgcn_update_dpp(0x3f800000, __float_as_int(x), 0x110 + N, 0xf, 0xf, false)); }
__device__ __forceinline__ float rw_row15(float x) { return __int_as_float(__builtin_amdgcn_update_dpp(0, __float_as_int(x), 0x15F, 0xf, 0xf, false)); }

#ifndef RD_DELAY
#define RD_DELAY 0
#endif
#define RDD_BEGIN(S) unsigned long long rdd_t0_##S = 0; if (RD_DELAY == S) rdd_t0_##S = clock64();
#define RDD_END(S) if (RD_DELAY == S) { asm volatile("s_waitcnt lgkmcnt(0)" ::: "memory"); const unsigned long long t1_ = clock64(), d_ = t1_ - rdd_t0_##S; while ((unsigned long long)clock64() - t1_ < d_) { } }
__device__ __forceinline__ void p9_rwkv_chunk2(const Params& p, LAS unsigned char* lds) {
    const int tid = tidx(), half = tid >> 8, htid = tid & 255, hw = __builtin_amdgcn_readfirstlane((tid >> 6) & 3), lane = tid & 63, c16 = lane & 15, g = lane >> 4, wg = blockIdx.x, nwg = gridDim.x;
    LAS unsigned char* hl = lds + half * RD_HALF;
    const bf16_t* R = (const bf16_t*)(p.ws + WS_R); const bf16_t* K1 = (const bf16_t*)(p.ws + WS_K1); const bf16_t* V1 = (const bf16_t*)(p.ws + WS_V1); const bf16_t* LR = (const bf16_t*)(p.ws + WS_LR);
    const bf16_t* W2T = (const bf16_t*)(p.ws + WS_W2T); const bf16_t* A2T = (const bf16_t*)(p.ws + WS_A2T);
    float* BON = (float*)(p.ws + WS_BON); bf16_t* YD = (bf16_t*)(p.out + OUT_Y);
    const float* w0p = pin(p, I_W0); const float* a0p = pin(p, I_A0); const float* kkp = pin(p, I_KK); const float* kap = pin(p, I_KA); const float* rkp = pin(p, I_RK); const float* srw = pin(p, I_SRWKV);
    const int nun = half == 0 ? (256 - wg + nwg - 1) / nwg : (1024 - wg + nwg - 1) / nwg;
    const int bpu = half == 0 ? 128 : 8;
    const int my_steps = nun * bpu;
    const int n0 = (256 - wg + nwg - 1) / nwg * 128, n1 = (1024 - wg + nwg - 1) / nwg * 8;
    const int nsteps = n0 > n1 ? n0 : n1;
    f32x4 Sacc[4];
    int base = 0, L = 0, b = 0, head = 0, dir = 0; bool lat = false;
    const int m = c16, q = g;
    const u32x2 zz = (u32x2){0u, 0u};
    pg8::bf16x8 pftw[3], pfta[3]; u32x2 pfr[2], pfk[2], pfv[2];
#define RD_PREFETCH(bk) do { const int tau_ = (bk) * 32 + 16 * (hw & 1) + m, t_ = dir ? L - 1 - tau_ : tau_; const unsigned row_ = (unsigned)(base + t_); \
        _Pragma("unroll") for (int ks = 0; ks < 3; ++ks) { pftw[ks] = *(const pg8::bf16x8*)((const char*)LR + row_ * 768u + (unsigned)(dir * 192 + (32 * ks + 8 * q) * 2)); \
            pfta[ks] = *(const pg8::bf16x8*)((const char*)LR + row_ * 768u + (unsigned)(384 + dir * 192 + (32 * ks + 8 * q) * 2)); } \
        _Pragma("unroll") for (int mi = 0; mi < 2; ++mi) { const unsigned ch_ = (unsigned)(head * 64 + 16 * (2 * (hw >> 1) + mi) + 4 * q); \
            pfr[mi] = *(const u32x2*)((const char*)R + (row_ * 2048u + ch_) * 2u); pfk[mi] = *(const u32x2*)((const char*)K1 + (row_ * 2048u + ch_) * 2u); pfv[mi] = *(const u32x2*)((const char*)V1 + (row_ * 2048u + ch_) * 2u); } } while (0)
    for (int step = 0; step < nsteps; ++step) {
        const bool active = step < my_steps; const int blk = step % bpu;
        if (active && blk == 0) {
            const int un = wg + (step / bpu) * nwg; int s;
            if (half == 0) { s = 16 + (un >> 6); head = (un >> 1) & 31; dir = un & 1; } else { s = un >> 6; head = (un >> 1) & 31; dir = un & 1; }
            seq_info(s, base, L, b, lat);
            for (int i = htid; i < 768; i += 256) { const int ch = i / 12, pc = i % 12; const size_t go = ((size_t)(dir * 2048 + head * 64 + ch) * 96 + pc * 8);
                *(LAS u32x4*)(hl + RD_W2 + ch * RC_TS + pc * 16) = *(const u32x4*)(W2T + go); *(LAS u32x4*)(hl + RD_A2 + ch * RC_TS + pc * 16) = *(const u32x4*)(A2T + go); }
            if (htid < 64) { LAS float* cst = (LAS float*)(hl + RD_CST); const int c = head * 64 + htid;
                cst[htid] = w0p[dir * 2048 + c]; cst[64 + htid] = a0p[dir * 2048 + c]; cst[128 + htid] = kkp[c]; cst[192 + htid] = kap[c]; cst[256 + htid] = rkp[c]; }
            RD_PREFETCH(0);
            const unsigned sb = (unsigned)((((b * 2 + dir) * 32 + head) * 64 + hw * 16 + c16) * 64 + 4 * g);
#pragma unroll
            for (int jb = 0; jb < 4; ++jb) Sacc[jb] = lat ? *(const f32x4*)((const char*)srw + (sb + 16 * jb) * 4u) : (f32x4){0.f, 0.f, 0.f, 0.f};
            __builtin_amdgcn_s_waitcnt(0x0F70);
        }
        __syncthreads();
        RDD_BEGIN(1)
        if (active) {
            const int tok = 16 * (hw & 1) + m, mb0 = 2 * (hw >> 1);
            LAS unsigned char* ts = hl + (hw & 1) * RD_SET;
            f32x4 dW[2], dA[2];
#pragma unroll
            for (int mi = 0; mi < 2; ++mi) { dW[mi] = (f32x4){0.f, 0.f, 0.f, 0.f}; dA[mi] = (f32x4){0.f, 0.f, 0.f, 0.f}; }
#pragma unroll
            for (int ks = 0; ks < 3; ++ks) {
                const pg8::bf16x8 tw = pftw[ks], ta = pfta[ks];
#pragma unroll
                for (int mi = 0; mi < 2; ++mi) { const pg8::bf16x8 wf = *(const LAS pg8::bf16x8*)(hl + RD_W2 + (16 * (mb0 + mi) + m) * RC_TS + (32 * ks + 8 * q) * 2), af = *(const LAS pg8::bf16x8*)(hl + RD_A2 + (16 * (mb0 + mi) + m) * RC_TS + (32 * ks + 8 * q) * 2);
                    dW[mi] = __builtin_amdgcn_mfma_f32_16x16x32_bf16(wf, tw, dW[mi], 0, 0, 0); dA[mi] = __builtin_amdgcn_mfma_f32_16x16x32_bf16(af, ta, dA[mi], 0, 0, 0); } }
            float ss = 0.f, bon = 0.f;
#pragma unroll
            for (int mi = 0; mi < 2; ++mi) { const int mb = mb0 + mi, ch0 = 16 * mb + 4 * q;
                const u32x2 r2 = pfr[mi], k2 = pfk[mi], v2 = pfv[mi]; const LAS float* cst = (const LAS float*)(hl + RD_CST) + ch0;
                const f32x4 w0 = *(const LAS f32x4*)cst, a0 = *(const LAS f32x4*)(cst + 64), kkw = *(const LAS f32x4*)(cst + 128), kaw = *(const LAS f32x4*)(cst + 192), rkw = *(const LAS f32x4*)(cst + 256);
                const float rr[4] = {bflo(r2.x), bfhi(r2.x), bflo(r2.y), bfhi(r2.y)}, k0[4] = {bflo(k2.x), bfhi(k2.x), bflo(k2.y), bfhi(k2.y)};
                float at[4], rt[4], bt[4], kt[4], bh[4], kh[4]; f32x4 g15;
#pragma unroll
                for (int j = 0; j < 4; ++j) {
                    const float wdec = __builtin_amdgcn_exp2f(-0.8750387749f * __builtin_amdgcn_rcpf(1.f + __builtin_amdgcn_exp2f(-1.4426950409f * (w0[j] + dW[mi][j]))));
                    const float a = __builtin_amdgcn_rcpf(1.f + __builtin_amdgcn_exp2f(-1.4426950409f * (a0[j] + dA[mi][j])));
                    const float kk = k0[j] * kkw[j], kb = kk * a, kd = k0[j] * (1.f + (a - 1.f) * kaw[j]);
                    ss += kk * kk; bon += rr[j] * kd * rkw[j];
                    float gi = wdec; gi *= rw_shr1<1>(gi); gi *= rw_shr1<2>(gi); gi *= rw_shr1<4>(gi); gi *= rw_shr1<8>(gi);
                    const float gp = rw_shr1<1>(gi), gl = rw_row15(gi), ig = __builtin_amdgcn_rcpf(gi);
                    at[j] = -kk * gp; rt[j] = rr[j] * gi; bt[j] = kb * ig; kt[j] = kd * ig; bh[j] = bt[j] * gl; kh[j] = kt[j] * gl; g15[j] = gl; }
                *(LAS u32x2*)(ts + RS_AT + m * RC_TT + ch0 * 2) = (u32x2){cvtpk(at[0], at[1]), cvtpk(at[2], at[3])}; *(LAS u32x2*)(ts + RS_RT + m * RC_TT + ch0 * 2) = (u32x2){cvtpk(rt[0], rt[1]), cvtpk(rt[2], rt[3])};
                *(LAS u32x2*)(ts + RS_BT + m * RC_TT + ch0 * 2) = (u32x2){cvtpk(bt[0], bt[1]), cvtpk(bt[2], bt[3])}; *(LAS u32x2*)(ts + RS_KT + m * RC_TT + ch0 * 2) = (u32x2){cvtpk(kt[0], kt[1]), cvtpk(kt[2], kt[3])};
#pragma unroll
                for (int j = 0; j < 4; ++j) { *(LAS bf16_t*)(ts + RS_BH + (ch0 + j) * RC_HS + m * 2) = f2bf(bh[j]); *(LAS bf16_t*)(ts + RS_KH + (ch0 + j) * RC_HS + m * 2) = f2bf(kh[j]); }
                if (m == 15) *(LAS f32x4*)(ts + RS_GL + ch0 * 4) = g15;
                *(LAS u32x2*)(hl + RD_V + rw_sw(tok, ch0) * 2) = v2; }
            ss = red4(ss); bon = red4(bon);
            if (q == 0) { *(LAS float*)(hl + RD_SSP + (tok * 2 + (hw >> 1)) * 4) = ss; *(LAS float*)(hl + RD_BNP + (tok * 2 + (hw >> 1)) * 4) = bon; }
        }
        RDD_END(1)
        __syncthreads();
        if (active && blk + 1 < bpu) RD_PREFETCH(blk + 1);
        RDD_BEGIN(2)
        if (active) {
            const int xo = (hw & 1) ? RS_KT : RS_BT, yo = (hw & 2) ? RS_RT : RS_AT;
#pragma unroll
            for (int c2 = 0; c2 < 2; ++c2) { LAS unsigned char* ts = hl + c2 * RD_SET;
                f32x4 mm = (f32x4){0.f, 0.f, 0.f, 0.f};
#pragma unroll
                for (int ks = 0; ks < 2; ++ks) { const bf16x8 xf = *(const LAS bf16x8*)(ts + xo + c16 * RC_TT + (32 * ks + 8 * g) * 2), yf = *(const LAS bf16x8*)(ts + yo + c16 * RC_TT + (32 * ks + 8 * g) * 2);
                    mm = __builtin_amdgcn_mfma_f32_16x16x32_bf16(xf, yf, mm, 0, 0, 0); }
                const f32x2v st = *(const LAS f32x2v*)(hl + RD_SSP + (16 * c2 + c16) * 8);
                const float invt = __builtin_amdgcn_rcpf(fmaxf(__builtin_amdgcn_sqrtf(st.x + st.y), 1e-12f));
#pragma unroll
                for (int r = 0; r < 4; ++r) { const int s_ = 4 * g + r; const bool keep = (hw & 2) ? (s_ <= c16) : (s_ < c16); mm[r] = keep ? mm[r] : 0.f; }
                if (hw == 0) {
                    const int tb = c16 >> 2;
#pragma unroll
                    for (int r = 0; r < 4; ++r) { const f32x2v sr = *(const LAS f32x2v*)(hl + RD_SSP + (16 * c2 + 4 * g + r) * 8);
                        const float v = mm[r] * invt * __builtin_amdgcn_rcpf(fmaxf(__builtin_amdgcn_sqrtf(sr.x + sr.y), 1e-12f));
                        *(LAS float*)(ts + RS_MAB + (4 * g + r) * RC_MS + c16 * 4) = g < tb ? v : 0.f;
                        if (g == tb) *(LAS float*)(ts + RS_MD + (4 * g + r) * 16 + (c16 & 3) * 4) = v; } }
                else { if (hw == 1) mm = mm * invt;
                    u32x2 w; w.x = cvtpk(mm[0], mm[1]); w.y = cvtpk(mm[2], mm[3]); *(LAS u32x2*)(ts + (hw == 1 ? RS_MAK : hw == 2 ? RS_NBR : RS_NKR) + c16 * RC_NS + g * 8) = w; }
                if (hw == 3 && g == 0) { *(LAS float*)(hl + RD_INV + (16 * c2 + c16) * 4) = invt;
                    const f32x2v bn = *(const LAS f32x2v*)(hl + RD_BNP + (16 * c2 + c16) * 8); const int tau = blk * 32 + 16 * c2 + c16, t = dir ? L - 1 - tau : tau;
                    BON[((size_t)dir * MTOK + (size_t)(base + t)) * 32 + head] = bn.x + bn.y; } }
        }
        RDD_END(2)
        __syncthreads();
        RDD_BEGIN(3)
        if (active) {
#pragma unroll
            for (int cc = 0; cc < 2; ++cc) { const int cb = 16 * cc; LAS unsigned char* ts = hl + cc * RD_SET;
                bf16x8 sfr[2];
#pragma unroll
                for (int ks = 0; ks < 2; ++ks) { u32x4 s4; s4.x = cvtpk(Sacc[2 * ks][0], Sacc[2 * ks][1]); s4.y = cvtpk(Sacc[2 * ks][2], Sacc[2 * ks][3]);
                    s4.z = cvtpk(Sacc[2 * ks + 1][0], Sacc[2 * ks + 1][1]); s4.w = cvtpk(Sacc[2 * ks + 1][2], Sacc[2 * ks + 1][3]); sfr[ks] = __builtin_bit_cast(bf16x8, s4); }
                bf16x8 vfr;
                { const LAS bf16_t* vp = (const LAS bf16_t*)(hl + RD_V); const int vi_ = 16 * hw + c16, vt_ = cb + 4 * g;
                  const unsigned v0 = vp[rw_sw(vt_, vi_)], v1 = vp[rw_sw(vt_ + 1, vi_)], v2 = vp[rw_sw(vt_ + 2, vi_)], v3 = vp[rw_sw(vt_ + 3, vi_)]; vfr = mk_frag((u32x2){v0 | (v1 << 16), v2 | (v3 << 16)}, zz); }
                f32x4 mx[12], md[3];
#pragma unroll
                for (int s1 = 0; s1 < 12; ++s1) mx[s1] = *(const LAS f32x4*)(ts + RS_MAB + s1 * RC_MS + g * 16);
#pragma unroll
                for (int e = 0; e < 3; ++e) md[e] = *(const LAS f32x4*)(ts + RS_MD + (4 * g + e) * 16);
                const f32x4 inv4 = *(const LAS f32x4*)(hl + RD_INV + (cb + 4 * g) * 4);
                f32x4 xt = (f32x4){0.f, 0.f, 0.f, 0.f}, yt = (f32x4){0.f, 0.f, 0.f, 0.f};
#pragma unroll
                for (int ks = 0; ks < 2; ++ks) {
                    const LAS unsigned char* ap = ts + RS_AT + c16 * RC_TT + (32 * ks + 4 * g) * 2; const LAS unsigned char* rp = ts + RS_RT + c16 * RC_TT + (32 * ks + 4 * g) * 2;
                    xt = __builtin_amdgcn_mfma_f32_16x16x32_bf16(mk_frag(*(const LAS u32x2*)ap, *(const LAS u32x2*)(ap + 32)), sfr[ks], xt, 0, 0, 0);
                    yt = __builtin_amdgcn_mfma_f32_16x16x32_bf16(mk_frag(*(const LAS u32x2*)rp, *(const LAS u32x2*)(rp + 32)), sfr[ks], yt, 0, 0, 0); }
                xt = xt * inv4;
                xt = __builtin_amdgcn_mfma_f32_16x16x32_bf16(mk_frag(*(const LAS u32x2*)(ts + RS_MAK + c16 * RC_NS + g * 8), zz), vfr, xt, 0, 0, 0);
                yt = __builtin_amdgcn_mfma_f32_16x16x32_bf16(mk_frag(*(const LAS u32x2*)(ts + RS_NKR + c16 * RC_NS + g * 8), zz), vfr, yt, 0, 0, 0);
                float x[4] = {xt[0], xt[1], xt[2], xt[3]};
#pragma unroll
                for (int h = 0; h < 4; ++h) {
                    if (g == h) { x[1] += x[0] * md[0][1]; x[2] += x[0] * md[0][2]; x[3] += x[0] * md[0][3]; x[2] += x[1] * md[1][2]; x[3] += x[1] * md[1][3]; x[3] += x[2] * md[2][3]; }
                    if (h < 3) { float ub[4];
#pragma unroll
                        for (int e = 0; e < 4; ++e) { const unsigned xv = __float_as_uint(x[e]);
                            if (h == 2) { const auto r1 = __builtin_amdgcn_permlane16_swap(xv, xv, false, false); ub[e] = __uint_as_float(r1[0]); }
                            else { const auto r0 = __builtin_amdgcn_permlane32_swap(xv, xv, false, false); const auto r1 = __builtin_amdgcn_permlane16_swap(r0[0], r0[0], false, false); ub[e] = __uint_as_float(r1[h]); } }
#pragma unroll
                        for (int e2 = 0; e2 < 4; ++e2)
#pragma unroll
                            for (int e = 0; e < 4; ++e) x[e] += ub[e2] * mx[4 * h + e2][e]; } }
                const bf16x8 ufr = mk_frag((u32x2){cvtpk(x[0] * inv4[0], x[1] * inv4[1]), cvtpk(x[2] * inv4[2], x[3] * inv4[3])}, zz);
                yt = __builtin_amdgcn_mfma_f32_16x16x32_bf16(mk_frag(*(const LAS u32x2*)(ts + RS_NBR + c16 * RC_NS + g * 8), zz), ufr, yt, 0, 0, 0);
#pragma unroll
                for (int r = 0; r < 4; ++r) *(LAS bf16_t*)(hl + RD_YO + (cb + 4 * g + r) * 128 + (16 * hw + c16) * 2) = f2bf_rne(yt[r]);
#pragma unroll
                for (int jb = 0; jb < 4; ++jb) { const f32x4 gl4 = *(const LAS f32x4*)(ts + RS_GL + (16 * jb + 4 * g) * 4); Sacc[jb] = Sacc[jb] * gl4;
                    Sacc[jb] = __builtin_amdgcn_mfma_f32_16x16x32_bf16(mk_frag(*(const LAS u32x2*)(ts + RS_BH + (16 * jb + c16) * RC_HS + g * 8), zz), ufr, Sacc[jb], 0, 0, 0);
                    Sacc[jb] = __builtin_amdgcn_mfma_f32_16x16x32_bf16(mk_frag(*(const LAS u32x2*)(ts + RS_KH + (16 * jb + c16) * RC_HS + g * 8), zz), vfr, Sacc[jb], 0, 0, 0); }
            }
            if (blk == bpu - 1 && !lat) { const unsigned sb = (unsigned)((((b * 2 + dir) * 32 + head) * 64 + hw * 16 + c16) * 64 + 4 * g);
#pragma unroll
                for (int jb = 0; jb < 4; ++jb) *(f32x4*)((char*)p.out + ((unsigned)OUT_RWKV + sb + 16 * jb) * 4u) = Sacc[jb]; }
        }
        RDD_END(3)
        __syncthreads();
        if (active) {
            const int tok = htid >> 3, c8 = (htid & 7) * 8, tau = blk * 32 + tok, t = dir ? L - 1 - tau : tau; const size_t row = (size_t)(base + t);
            *(u32x4*)(YD + (size_t)dir * MTOK * DM + row * DM + head * 64 + c8) = *(const LAS u32x4*)(hl + RD_YO + tok * 128 + c8 * 2);
        }
    }
#undef RD_PREFETCH
}

__device__ __forceinline__ void rwkv_main_chunk(LAS unsigned char* rg, int cc, int hw, int c16, int g, f32x4 (&Sacc)[4]) {
                const int cb = 16 * cc; LAS unsigned char* ts = rg + cc * RD_SET; const u32x2 zz = (u32x2){0u, 0u};
                bf16x8 sfr[2];
#pragma unroll
                for (int ks = 0; ks < 2; ++ks) { u32x4 s4; s4.x = cvtpk(Sacc[2 * ks][0], Sacc[2 * ks][1]); s4.y = cvtpk(Sacc[2 * ks][2], Sacc[2 * ks][3]);
                    s4.z = cvtpk(Sacc[2 * ks + 1][0], Sacc[2 * ks + 1][1]); s4.w = cvtpk(Sacc[2 * ks + 1][2], Sacc[2 * ks + 1][3]); sfr[ks] = __builtin_bit_cast(bf16x8, s4); }
                bf16x8 vfr;
                { const LAS bf16_t* vp = (const LAS bf16_t*)(rg + RD_V); const int vi_ = 16 * hw + c16, vt_ = cb + 4 * g;
                  const unsigned v0 = vp[rw_sw(vt_, vi_)], v1 = vp[rw_sw(vt_ + 1, vi_)], v2 = vp[rw_sw(vt_ + 2, vi_)], v3 = vp[rw_sw(vt_ + 3, vi_)]; vfr = mk_frag((u32x2){v0 | (v1 << 16), v2 | (v3 << 16)}, zz); }
                f32x4 mx[12], md[3];
#pragma unroll
                for (int s1 = 0; s1 < 12; ++s1) mx[s1] = *(const LAS f32x4*)(ts + RS_MAB + s1 * RC_MS + g * 16);
#pragma unroll
                for (int e = 0; e < 3; ++e) md[e] = *(const LAS f32x4*)(ts + RS_MD + (4 * g + e) * 16);
                const f32x4 inv4 = *(const LAS f32x4*)(rg + RD_INV + (cb + 4 * g) * 4);
                f32x4 xt = (f32x4){0.f, 0.f, 0.f, 0.f}, yt = (f32x4){0.f, 0.f, 0.f, 0.f};
#pragma unroll
                for (int ks = 0; ks < 2; ++ks) {
                    const LAS unsigned char* ap = ts + RS_AT + c16 * RC_TT + (32 * ks + 4 * g) * 2; const LAS unsigned char* rp = ts + RS_RT + c16 * RC_TT + (32 * ks + 4 * g) * 2;
                    xt = __builtin_amdgcn_mfma_f32_16x16x32_bf16(mk_frag(*(const LAS u32x2*)ap, *(const LAS u32x2*)(ap + 32)), sfr[ks], xt, 0, 0, 0);
                    yt = __builtin_amdgcn_mfma_f32_16x16x32_bf16(mk_frag(*(const LAS u32x2*)rp, *(const LAS u32x2*)(rp + 32)), sfr[ks], yt, 0, 0, 0); }
                xt = xt * inv4;
                xt = __builtin_amdgcn_mfma_f32_16x16x32_bf16(mk_frag(*(const LAS u32x2*)(ts + RS_MAK + c16 * RC_NS + g * 8), zz), vfr, xt, 0, 0, 0);
                yt = __builtin_amdgcn_mfma_f32_16x16x32_bf16(mk_frag(*(const LAS u32x2*)(ts + RS_NKR + c16 * RC_NS + g * 8), zz), vfr, yt, 0, 0, 0);
                float x[4] = {xt[0], xt[1], xt[2], xt[3]};
#pragma unroll
                for (int h = 0; h < 4; ++h) {
                    if (g == h) { x[1] += x[0] * md[0][1]; x[2] += x[0] * md[0][2]; x[3] += x[0] * md[0][3]; x[2] += x[1] * md[1][2]; x[3] += x[1] * md[1][3]; x[3] += x[2] * md[2][3]; }
                    if (h < 3) { float ub[4];
#pragma unroll
                        for (int e = 0; e < 4; ++e) ub[e] = __int_as_float(__builtin_amdgcn_ds_bpermute((h * 16 + c16) * 4, __float_as_int(x[e])));
#pragma unroll
                        for (int e2 = 0; e2 < 4; ++e2)
#pragma unroll
                            for (int e = 0; e < 4; ++e) x[e] += ub[e2] * mx[4 * h + e2][e]; } }
                const bf16x8 ufr = mk_frag((u32x2){cvtpk(x[0] * inv4[0], x[1] * inv4[1]), cvtpk(x[2] * inv4[2], x[3] * inv4[3])}, zz);
                yt = __builtin_amdgcn_mfma_f32_16x16x32_bf16(mk_frag(*(const LAS u32x2*)(ts + RS_NBR + c16 * RC_NS + g * 8), zz), ufr, yt, 0, 0, 0);
#pragma unroll
                for (int r = 0; r < 4; ++r) *(LAS bf16_t*)(rg + RD_YO + (cb + 4 * g + r) * 128 + (16 * hw + c16) * 2) = f2bf_rne(yt[r]);
#pragma unroll
                for (int jb = 0; jb < 4; ++jb) { const f32x4 gl4 = *(const LAS f32x4*)(ts + RS_GL + (16 * jb + 4 * g) * 4); Sacc[jb] = Sacc[jb] * gl4;
                    Sacc[jb] = __builtin_amdgcn_mfma_f32_16x16x32_bf16(mk_frag(*(const LAS u32x2*)(ts + RS_BH + (16 * jb + c16) * RC_HS + g * 8), zz), ufr, Sacc[jb], 0, 0, 0);
                    Sacc[jb] = __builtin_amdgcn_mfma_f32_16x16x32_bf16(mk_frag(*(const LAS u32x2*)(ts + RS_KH + (16 * jb + c16) * RC_HS + g * 8), zz), vfr, Sacc[jb], 0, 0, 0); }
}

__device__ __forceinline__ void p9_rwkv_chunk3(const Params& p, LAS unsigned char* lds) {
    const int tid = tidx(), half = __builtin_amdgcn_readfirstlane(tid >> 8), htid = tid & 255, hw = __builtin_amdgcn_readfirstlane((tid >> 6) & 3), lane = tid & 63, c16 = lane & 15, g = lane >> 4, wg = blockIdx.x;
    LAS unsigned char* hl = lds + half * RD_HALF;
    const bf16_t* R = (const bf16_t*)(p.ws + WS_R); const bf16_t* K1 = (const bf16_t*)(p.ws + WS_K1); const bf16_t* V1 = (const bf16_t*)(p.ws + WS_V1); const bf16_t* LR = (const bf16_t*)(p.ws + WS_LR);
    const bf16_t* W2T = (const bf16_t*)(p.ws + WS_W2T); const bf16_t* A2T = (const bf16_t*)(p.ws + WS_A2T);
    float* BON = (float*)(p.ws + WS_BON); bf16_t* YD = (bf16_t*)(p.out + OUT_Y);
    const float* w0p = pin(p, I_W0); const float* a0p = pin(p, I_A0); const float* kkp = pin(p, I_KK); const float* kap = pin(p, I_KA); const float* rkp = pin(p, I_RK); const float* srw = pin(p, I_SRWKV);
    if (half == 1) __builtin_amdgcn_s_setprio(1);
    constexpr int NLAT = 128, NCTX = 32, PIPE0 = NCTX + 1;
    f32x4 Sacc[4];
    int base = 0, L = 0, b = 0, head = 0, dir = 0; bool lat = false;
    const int m = c16, q = g;
    pg8::bf16x8 pftw[3], pfta[3]; u32x2 pfr[2], pfk[2], pfv[2];
#define RD_PREFETCH(bk) do { const int tau_ = (bk) * 32 + 16 * (hw & 1) + m, t_ = dir ? L - 1 - tau_ : tau_; const unsigned row_ = (unsigned)(base + t_); \
        _Pragma("unroll") for (int ks = 0; ks < 3; ++ks) { pftw[ks] = *(const pg8::bf16x8*)((const char*)LR + row_ * 768u + (unsigned)(dir * 192 + (32 * ks + 8 * q) * 2)); \
            pfta[ks] = *(const pg8::bf16x8*)((const char*)LR + row_ * 768u + (unsigned)(384 + dir * 192 + (32 * ks + 8 * q) * 2)); } \
        _Pragma("unroll") for (int mi = 0; mi < 2; ++mi) { const unsigned ch_ = (unsigned)(head * 64 + 16 * (2 * (hw >> 1) + mi) + 4 * q); \
            pfr[mi] = *(const u32x2*)((const char*)R + (row_ * 2048u + ch_) * 2u); pfk[mi] = *(const u32x2*)((const char*)K1 + (row_ * 2048u + ch_) * 2u); pfv[mi] = *(const u32x2*)((const char*)V1 + (row_ * 2048u + ch_) * 2u); } } while (0)
#define RD_PREFETCH_LR(bk) do { const int tau_ = (bk) * 32 + 16 * (hw & 1) + m, t_ = dir ? L - 1 - tau_ : tau_; const unsigned row_ = (unsigned)(base + t_); \
        _Pragma("unroll") for (int ks = 0; ks < 3; ++ks) { pftw[ks] = *(const pg8::bf16x8*)((const char*)LR + row_ * 768u + (unsigned)(dir * 192 + (32 * ks + 8 * q) * 2)); \
            pfta[ks] = *(const pg8::bf16x8*)((const char*)LR + row_ * 768u + (unsigned)(384 + dir * 192 + (32 * ks + 8 * q) * 2)); } } while (0)
#define RD_PREFETCH_RKV(bk, mi) do { const int tau_ = (bk) * 32 + 16 * (hw & 1) + m, t_ = dir ? L - 1 - tau_ : tau_; const unsigned row_ = (unsigned)(base + t_); \
        const unsigned ch_ = (unsigned)(head * 64 + 16 * (2 * (hw >> 1) + (mi)) + 4 * q); \
        pfr[mi] = *(const u32x2*)((const char*)R + (row_ * 2048u + ch_) * 2u); pfk[mi] = *(const u32x2*)((const char*)K1 + (row_ * 2048u + ch_) * 2u); pfv[mi] = *(const u32x2*)((const char*)V1 + (row_ * 2048u + ch_) * 2u); } while (0)
    for (int step = 0; step <= NLAT; ++step) {
        const bool prod1 = half == 1 && step >= NCTX;
        const bool cons0 = half == 0 && step >= PIPE0;
        const bool normal = (half == 0 && step < PIPE0) || (half == 1 && step < NCTX);
        const int ablk = prod1 ? step + 1 : (half == 0 ? step : (step & 7));
        const bool doA = (normal && step < NLAT) || (prod1 && step + 1 < NLAT);
        LAS unsigned char* tg = prod1 ? lds + ((step + 1) & 1) * RD_HALF : hl;
        LAS unsigned char* rg = cons0 ? lds + (step & 1) * RD_HALF : hl;
        const bool unit_start = (half == 0 && step == 0) || (half == 1 && step < NCTX && (step & 7) == 0) || (half == 1 && step == NCTX);
        if (unit_start) {
            const int un = (half == 0 || step == NCTX) ? wg : wg + (step >> 3) * 256; int s;
            if (half == 0 || step == NCTX) { s = 16 + (un >> 6); } else { s = un >> 6; }
            head = (un >> 1) & 31; dir = un & 1;
            seq_info(s, base, L, b, lat);
            for (int i = htid; i < 768; i += 256) { const int ch = i / 12, pc = i % 12; const size_t go = ((size_t)(dir * 2048 + head * 64 + ch) * 96 + pc * 8);
                *(LAS u32x4*)(hl + RD_W2 + ch * RC_TS + pc * 16) = *(const u32x4*)(W2T + go); *(LAS u32x4*)(hl + RD_A2 + ch * RC_TS + pc * 16) = *(const u32x4*)(A2T + go); }
            if (htid < 64) { LAS float* cst = (LAS float*)(hl + RD_CST); const int c = head * 64 + htid;
                cst[htid] = w0p[dir * 2048 + c]; cst[64 + htid] = a0p[dir * 2048 + c]; cst[128 + htid] = kkp[c]; cst[192 + htid] = kap[c]; cst[256 + htid] = rkp[c]; }
            RD_PREFETCH(ablk);
            if (!prod1) {
                const unsigned sb = (unsigned)((((b * 2 + dir) * 32 + head) * 64 + hw * 16 + c16) * 64 + 4 * g);
#pragma unroll
                for (int jb = 0; jb < 4; ++jb) Sacc[jb] = lat ? *(const f32x4*)((const char*)srw + (sb + 16 * jb) * 4u) : (f32x4){0.f, 0.f, 0.f, 0.f}; }
            __builtin_amdgcn_s_waitcnt(0x0F70);
        }
        __syncthreads();
        if (cons0) {
            if (step > PIPE0) { const int tok = htid >> 3, c8 = (htid & 7) * 8, tau = (step - 1) * 32 + tok, t = dir ? L - 1 - tau : tau; const size_t row = (size_t)(base + t);
              *(u32x4*)(YD + (size_t)dir * MTOK * DM + row * DM + head * 64 + c8) = *(const LAS u32x4*)(lds + ((step - 1) & 1) * RD_HALF + RD_YO + tok * 128 + c8 * 2); }
            if (step < NLAT) rwkv_main_chunk(rg, 0, hw, c16, g, Sacc);
        }
        if (doA) {
            const int tok = 16 * (hw & 1) + m, mb0 = 2 * (hw >> 1);
            LAS unsigned char* ts = tg + (hw & 1) * RD_SET;
            f32x4 dW[2], dA[2];
#pragma unroll
            for (int mi = 0; mi < 2; ++mi) { dW[mi] = (f32x4){0.f, 0.f, 0.f, 0.f}; dA[mi] = (f32x4){0.f, 0.f, 0.f, 0.f}; }
#pragma unroll
            for (int ks = 0; ks < 3; ++ks) {
                const pg8::bf16x8 tw = pftw[ks], ta = pfta[ks];
#pragma unroll
                for (int mi = 0; mi < 2; ++mi) { const pg8::bf16x8 wf = *(const LAS pg8::bf16x8*)(hl + RD_W2 + (16 * (mb0 + mi) + m) * RC_TS + (32 * ks + 8 * q) * 2), af = *(const LAS pg8::bf16x8*)(hl + RD_A2 + (16 * (mb0 + mi) + m) * RC_TS + (32 * ks + 8 * q) * 2);
                    dW[mi] = __builtin_amdgcn_mfma_f32_16x16x32_bf16(wf, tw, dW[mi], 0, 0, 0); dA[mi] = __builtin_amdgcn_mfma_f32_16x16x32_bf16(af, ta, dA[mi], 0, 0, 0); } }
            const bool pfnext = half == 0 ? step + 1 < PIPE0 : ablk + 1 < (prod1 ? NLAT : 8);
            if (pfnext) RD_PREFETCH_LR(ablk + 1);
            float ss = 0.f, bon = 0.f;
#pragma unroll
            for (int mi = 0; mi < 2; ++mi) { const int mb = mb0 + mi, ch0 = 16 * mb + 4 * q;
                const u32x2 r2 = pfr[mi], k2 = pfk[mi], v2 = pfv[mi]; const LAS float* cst = (const LAS float*)(hl + RD_CST) + ch0;
                if (pfnext) RD_PREFETCH_RKV(ablk + 1, mi);
                const f32x4 w0 = *(const LAS f32x4*)cst, a0 = *(const LAS f32x4*)(cst + 64), kkw = *(const LAS f32x4*)(cst + 128), kaw = *(const LAS f32x4*)(cst + 192), rkw = *(const LAS f32x4*)(cst + 256);
                const float rr[4] = {bflo(r2.x), bfhi(r2.x), bflo(r2.y), bfhi(r2.y)}, k0[4] = {bflo(k2.x), bfhi(k2.x), bflo(k2.y), bfhi(k2.y)};
                float at[4], rt[4], bt[4], kt[4], bh[4], kh[4]; f32x4 g15;
#pragma unroll
                for (int j = 0; j < 4; ++j) {
                    const float wdec = __builtin_amdgcn_exp2f(-0.8750387749f * __builtin_amdgcn_rcpf(1.f + __builtin_amdgcn_exp2f(-1.4426950409f * (w0[j] + dW[mi][j]))));
                    const float a = __builtin_amdgcn_rcpf(1.f + __builtin_amdgcn_exp2f(-1.4426950409f * (a0[j] + dA[mi][j])));
                    const float kk = k0[j] * kkw[j], kb = kk * a, kd = k0[j] * (1.f + (a - 1.f) * kaw[j]);
                    ss += kk * kk; bon += rr[j] * kd * rkw[j];
                    float gi = wdec; gi *= rw_shr1<1>(gi); gi *= rw_shr1<2>(gi); gi *= rw_shr1<4>(gi); gi *= rw_shr1<8>(gi);
                    const float gp = rw_shr1<1>(gi), gl = rw_row15(gi), ig = __builtin_amdgcn_rcpf(gi);
                    at[j] = -kk * gp; rt[j] = rr[j] * gi; bt[j] = kb * ig; kt[j] = kd * ig; bh[j] = bt[j] * gl; kh[j] = kt[j] * gl; g15[j] = gl; }
                *(LAS u32x2*)(ts + RS_AT + m * RC_TT + ch0 * 2) = (u32x2){cvtpk(at[0], at[1]), cvtpk(at[2], at[3])}; *(LAS u32x2*)(ts + RS_RT + m * RC_TT + ch0 * 2) = (u32x2){cvtpk(rt[0], rt[1]), cvtpk(rt[2], rt[3])};
                *(LAS u32x2*)(ts + RS_BT + m * RC_TT + ch0 * 2) = (u32x2){cvtpk(bt[0], bt[1]), cvtpk(bt[2], bt[3])}; *(LAS u32x2*)(ts + RS_KT + m * RC_TT + ch0 * 2) = (u32x2){cvtpk(kt[0], kt[1]), cvtpk(kt[2], kt[3])};
#pragma unroll
                for (int j = 0; j < 4; ++j) { *(LAS bf16_t*)(ts + RS_BH + (ch0 + j) * RC_HS + m * 2) = f2bf(bh[j]); *(LAS bf16_t*)(ts + RS_KH + (ch0 + j) * RC_HS + m * 2) = f2bf(kh[j]); }
                if (m == 15) *(LAS f32x4*)(ts + RS_GL + ch0 * 4) = g15;
                *(LAS u32x2*)(tg + RD_V + rw_sw(tok, ch0) * 2) = v2; }
            ss = red4(ss); bon = red4(bon);
            if (q == 0) { *(LAS float*)(tg + RD_SSP + (tok * 2 + (hw >> 1)) * 4) = ss; *(LAS float*)(tg + RD_BNP + (tok * 2 + (hw >> 1)) * 4) = bon; }
        }
        __syncthreads();
        if (cons0 && step < NLAT) rwkv_main_chunk(rg, 1, hw, c16, g, Sacc);
        if (doA) {
            const int xo = (hw & 1) ? RS_KT : RS_BT, yo = (hw & 2) ? RS_RT : RS_AT;
#pragma unroll
            for (int c2 = 0; c2 < 2; ++c2) { LAS unsigned char* ts = tg + c2 * RD_SET;
                f32x4 mm = (f32x4){0.f, 0.f, 0.f, 0.f};
#pragma unroll
                for (int ks = 0; ks < 2; ++ks) { const bf16x8 xf = *(const LAS bf16x8*)(ts + xo + c16 * RC_TT + (32 * ks + 8 * g) * 2), yf = *(const LAS bf16x8*)(ts + yo + c16 * RC_TT + (32 * ks + 8 * g) * 2);
                    mm = __builtin_amdgcn_mfma_f32_16x16x32_bf16(xf, yf, mm, 0, 0, 0); }
                const f32x2v st = *(const LAS f32x2v*)(tg + RD_SSP + (16 * c2 + c16) * 8);
                const float invt = __builtin_amdgcn_rcpf(fmaxf(__builtin_amdgcn_sqrtf(st.x + st.y), 1e-12f));
#pragma unroll
                for (int r = 0; r < 4; ++r) { const int s_ = 4 * g + r; const bool keep = (hw & 2) ? (s_ <= c16) : (s_ < c16); mm[r] = keep ? mm[r] : 0.f; }
                if (hw == 0) {
                    const int tb = c16 >> 2;
#pragma unroll
                    for (int r = 0; r < 4; ++r) { const f32x2v sr = *(const LAS f32x2v*)(tg + RD_SSP + (16 * c2 + 4 * g + r) * 8);
                        const float v = mm[r] * invt * __builtin_amdgcn_rcpf(fmaxf(__builtin_amdgcn_sqrtf(sr.x + sr.y), 1e-12f));
                        *(LAS float*)(ts + RS_MAB + (4 * g + r) * RC_MS + c16 * 4) = g < tb ? v : 0.f;
                        if (g == tb) *(LAS float*)(ts + RS_MD + (4 * g + r) * 16 + (c16 & 3) * 4) = v; } }
                else { if (hw == 1) mm = mm * invt;
                    u32x2 w; w.x = cvtpk(mm[0], mm[1]); w.y = cvtpk(mm[2], mm[3]); *(LAS u32x2*)(ts + (hw == 1 ? RS_MAK : hw == 2 ? RS_NBR : RS_NKR) + c16 * RC_NS + g * 8) = w; }
                if (hw == 3 && g == 0) { *(LAS float*)(tg + RD_INV + (16 * c2 + c16) * 4) = invt;
                    const f32x2v bn = *(const LAS f32x2v*)(tg + RD_BNP + (16 * c2 + c16) * 8); const int tau = ablk * 32 + 16 * c2 + c16, t = dir ? L - 1 - tau : tau;
                    BON[((size_t)dir * MTOK + (size_t)(base + t)) * 32 + head] = bn.x + bn.y; } }
        }
        __syncthreads();
        if (normal && step < NLAT) {
            rwkv_main_chunk(rg, 0, hw, c16, g, Sacc); rwkv_main_chunk(rg, 1, hw, c16, g, Sacc);
            if (half == 1 && (step & 7) == 7) { const unsigned sb = (unsigned)((((b * 2 + dir) * 32 + head) * 64 + hw * 16 + c16) * 64 + 4 * g);
#pragma unroll
                for (int jb = 0; jb < 4; ++jb) *(f32x4*)((char*)p.out + ((unsigned)OUT_RWKV + sb + 16 * jb) * 4u) = Sacc[jb]; }
        }
        if (step < PIPE0) __syncthreads();
        if (normal && step < NLAT) {
            const int blk = half == 0 ? step : (step & 7);
            const int tok = htid >> 3, c8 = (htid & 7) * 8, tau = blk * 32 + tok, t = dir ? L - 1 - tau : tau; const size_t row = (size_t)(base + t);
            *(u32x4*)(YD + (size_t)dir * MTOK * DM + row * DM + head * 64 + c8) = *(const LAS u32x4*)(hl + RD_YO + tok * 128 + c8 * 2);
        }
    }
    __builtin_amdgcn_s_setprio(0);
#undef RD_PREFETCH
#undef RD_PREFETCH_LR
#undef RD_PREFETCH_RKV
}

__device__ __forceinline__ void p9_rwkv_chunk4(const Params& p, LAS unsigned char* lds) {
    const int tid = tidx(), half = __builtin_amdgcn_readfirstlane(tid >> 8), htid = tid & 255, hw = __builtin_amdgcn_readfirstlane((tid >> 6) & 3), lane = tid & 63, c16 = lane & 15, g = lane >> 4, wg = blockIdx.x;
    LAS unsigned char* hl = lds + RD_HALF;
    const bf16_t* R = (const bf16_t*)(p.ws + WS_R); const bf16_t* K1 = (const bf16_t*)(p.ws + WS_K1); const bf16_t* V1 = (const bf16_t*)(p.ws + WS_V1); const bf16_t* LR = (const bf16_t*)(p.ws + WS_LR);
    const bf16_t* W2T = (const bf16_t*)(p.ws + WS_W2T); const bf16_t* A2T = (const bf16_t*)(p.ws + WS_A2T);
    float* BON = (float*)(p.ws + WS_BON); bf16_t* YD = (bf16_t*)(p.out + OUT_Y);
    const float* w0p = pin(p, I_W0); const float* a0p = pin(p, I_A0); const float* kkp = pin(p, I_KK); const float* kap = pin(p, I_KA); const float* rkp = pin(p, I_RK); const float* srw = pin(p, I_SRWKV);
    constexpr int NLAT = 128, NB = NLAT + 4 * 8;
    const bool prod = half == 1;
    auto first_of = [](int B) { return B == 0 || (B >= NLAT && ((B - NLAT) & 7) == 0); };
    f32x4 Sacc[4];
#pragma unroll
    for (int jb = 0; jb < 4; ++jb) Sacc[jb] = (f32x4){0.f, 0.f, 0.f, 0.f};
    int base = 0, L = 0, b = 0, head = 0, dir = 0; bool lat = false;
    const int m = c16, q = g;
    pg8::bf16x8 pftw[3], pfta[3]; u32x2 pfr[2], pfk[2], pfv[2];
#define RD_PREFETCH(bk) do { const int tau_ = (bk) * 32 + 16 * (hw & 1) + m, t_ = dir ? L - 1 - tau_ : tau_; const unsigned row_ = (unsigned)(base + t_); \
        _Pragma("unroll") for (int ks = 0; ks < 3; ++ks) { pftw[ks] = *(const pg8::bf16x8*)((const char*)LR + row_ * 768u + (unsigned)(dir * 192 + (32 * ks + 8 * q) * 2)); \
            pfta[ks] = *(const pg8::bf16x8*)((const char*)LR + row_ * 768u + (unsigned)(384 + dir * 192 + (32 * ks + 8 * q) * 2)); } \
        _Pragma("unroll") for (int mi = 0; mi < 2; ++mi) { const unsigned ch_ = (unsigned)(head * 64 + 16 * (2 * (hw >> 1) + mi) + 4 * q); \
            pfr[mi] = *(const u32x2*)((const char*)R + (row_ * 2048u + ch_) * 2u); pfk[mi] = *(const u32x2*)((const char*)K1 + (row_ * 2048u + ch_) * 2u); pfv[mi] = *(const u32x2*)((const char*)V1 + (row_ * 2048u + ch_) * 2u); } } while (0)
#define RD_PREFETCH_LR(bk) do { const int tau_ = (bk) * 32 + 16 * (hw & 1) + m, t_ = dir ? L - 1 - tau_ : tau_; const unsigned row_ = (unsigned)(base + t_); \
        _Pragma("unroll") for (int ks = 0; ks < 3; ++ks) { pftw[ks] = *(const pg8::bf16x8*)((const char*)LR + row_ * 768u + (unsigned)(dir * 192 + (32 * ks + 8 * q) * 2)); \
            pfta[ks] = *(const pg8::bf16x8*)((const char*)LR + row_ * 768u + (unsigned)(384 + dir * 192 + (32 * ks + 8 * q) * 2)); } } while (0)
#define RD_PREFETCH_RKV(bk, mi) do { const int tau_ = (bk) * 32 + 16 * (hw & 1) + m, t_ = dir ? L - 1 - tau_ : tau_; const unsigned row_ = (unsigned)(base + t_); \
        const unsigned ch_ = (unsigned)(head * 64 + 16 * (2 * (hw >> 1) + (mi)) + 4 * q); \
        pfr[mi] = *(const u32x2*)((const char*)R + (row_ * 2048u + ch_) * 2u); pfk[mi] = *(const u32x2*)((const char*)K1 + (row_ * 2048u + ch_) * 2u); pfv[mi] = *(const u32x2*)((const char*)V1 + (row_ * 2048u + ch_) * 2u); } while (0)
    for (int s = 0; s <= NB + 1; ++s) {
        const int pB = s, cB = s - 1, wB = s - 2;
        if (!prod && wB >= 0) {
            const int blkw = wB < NLAT ? wB : ((wB - NLAT) & 7);
            const int tok = htid >> 3, c8 = (htid & 7) * 8, tau = blkw * 32 + tok, t = dir ? L - 1 - tau : tau; const size_t row = (size_t)(base + t);
            *(u32x4*)(YD + (size_t)dir * MTOK * DM + row * DM + head * 64 + c8) = *(const LAS u32x4*)(lds + (wB & 1) * RD_HALF + RD_YO + tok * 128 + c8 * 2); }
        const bool pstart = pB < NB && first_of(pB), cstart = cB >= 0 && cB < NB && first_of(cB);
        if (prod ? pstart : cstart) {
            const int B = prod ? pB : cB; const int un = B < NLAT ? wg : wg + ((B - NLAT) >> 3) * 256; const int sq = B < NLAT ? 16 + (un >> 6) : (un >> 6);
            head = (un >> 1) & 31; dir = un & 1; seq_info(sq, base, L, b, lat);
            if (prod) {
                for (int i = htid; i < 768; i += 256) { const int ch = i / 12, pc = i % 12; const size_t go = ((size_t)(dir * 2048 + head * 64 + ch) * 96 + pc * 8);
                    *(LAS u32x4*)(hl + RD_W2 + ch * RC_TS + pc * 16) = *(const u32x4*)(W2T + go); *(LAS u32x4*)(hl + RD_A2 + ch * RC_TS + pc * 16) = *(const u32x4*)(A2T + go); }
                if (htid < 64) { LAS float* cst = (LAS float*)(hl + RD_CST); const int c = head * 64 + htid;
                    cst[htid] = w0p[dir * 2048 + c]; cst[64 + htid] = a0p[dir * 2048 + c]; cst[128 + htid] = kkp[c]; cst[192 + htid] = kap[c]; cst[256 + htid] = rkp[c]; }
                RD_PREFETCH(0);
            } else {
                const unsigned sb = (unsigned)((((b * 2 + dir) * 32 + head) * 64 + hw * 16 + c16) * 64 + 4 * g);
#pragma unroll
                for (int jb = 0; jb < 4; ++jb) Sacc[jb] = lat ? *(const f32x4*)((const char*)srw + (sb + 16 * jb) * 4u) : (f32x4){0.f, 0.f, 0.f, 0.f}; }
            __builtin_amdgcn_s_waitcnt(0x0F70);
        }
        if (pstart || s == 0) __syncthreads();
        const int ablk = pB < NLAT ? pB : ((pB - NLAT) & 7);
        LAS unsigned char* tg = lds + (pB & 1) * RD_HALF;
        LAS unsigned char* rg = lds + (cB & 1) * RD_HALF;
        const bool doA = prod && pB < NB, doC = !prod && cB >= 0 && cB < NB;
        if (doC) rwkv_main_chunk(rg, 0, hw, c16, g, Sacc);
        if (doA) {
            const int tok = 16 * (hw & 1) + m, mb0 = 2 * (hw >> 1);
            LAS unsigned char* ts = tg + (hw & 1) * RD_SET;
            f32x4 dW[2], dA[2];
#pragma unroll
            for (int mi = 0; mi < 2; ++mi) { dW[mi] = (f32x4){0.f, 0.f, 0.f, 0.f}; dA[mi] = (f32x4){0.f, 0.f, 0.f, 0.f}; }
#pragma unroll
            for (int ks = 0; ks < 3; ++ks) {
                const pg8::bf16x8 tw = pftw[ks], ta = pfta[ks];
#pragma unroll
                for (int mi = 0; mi < 2; ++mi) { const pg8::bf16x8 wf = *(const LAS pg8::bf16x8*)(hl + RD_W2 + (16 * (mb0 + mi) + m) * RC_TS + (32 * ks + 8 * q) * 2), af = *(const LAS pg8::bf16x8*)(hl + RD_A2 + (16 * (mb0 + mi) + m) * RC_TS + (32 * ks + 8 * q) * 2);
                    dW[mi] = __builtin_amdgcn_mfma_f32_16x16x32_bf16(wf, tw, dW[mi], 0, 0, 0); dA[mi] = __builtin_amdgcn_mfma_f32_16x16x32_bf16(af, ta, dA[mi], 0, 0, 0); } }
            const bool pfnext = pB + 1 < NB && !first_of(pB + 1);
            if (pfnext) RD_PREFETCH_LR(ablk + 1);
            float ss = 0.f, bon = 0.f;
#pragma unroll
            for (int mi = 0; mi < 2; ++mi) { const int mb = mb0 + mi, ch0 = 16 * mb + 4 * q;
                const u32x2 r2 = pfr[mi], k2 = pfk[mi], v2 = pfv[mi]; const LAS float* cst = (const LAS float*)(hl + RD_CST) + ch0;
                if (pfnext) RD_PREFETCH_RKV(ablk + 1, mi);
                const f32x4 w0 = *(const LAS f32x4*)cst, a0 = *(const LAS f32x4*)(cst + 64), kkw = *(const LAS f32x4*)(cst + 128), kaw = *(const LAS f32x4*)(cst + 192), rkw = *(const LAS f32x4*)(cst + 256);
                const float rr[4] = {bflo(r2.x), bfhi(r2.x), bflo(r2.y), bfhi(r2.y)}, k0[4] = {bflo(k2.x), bfhi(k2.x), bflo(k2.y), bfhi(k2.y)};
                float at[4], rt[4], bt[4], kt[4], bh[4], kh[4]; f32x4 g15;
#pragma unroll
                for (int j = 0; j < 4; ++j) {
                    const float wdec = __builtin_amdgcn_exp2f(-0.8750387749f * __builtin_amdgcn_rcpf(1.f + __builtin_amdgcn_exp2f(-1.4426950409f * (w0[j] + dW[mi][j]))));
                    const float a = __builtin_amdgcn_rcpf(1.f + __builtin_amdgcn_exp2f(-1.4426950409f * (a0[j] + dA[mi][j])));
                    const float kk = k0[j] * kkw[j], kb = kk * a, kd = k0[j] * (1.f + (a - 1.f) * kaw[j]);
                    ss += kk * kk; bon += rr[j] * kd * rkw[j];
                    float gi = wdec; gi *= rw_shr1<1>(gi); gi *= rw_shr1<2>(gi); gi *= rw_shr1<4>(gi); gi *= rw_shr1<8>(gi);
                    const float gp = rw_shr1<1>(gi), gl = rw_row15(gi), ig = __builtin_amdgcn_rcpf(gi);
                    at[j] = -kk * gp; rt[j] = rr[j] * gi; bt[j] = kb * ig; kt[j] = kd * ig; bh[j] = bt[j] * gl; kh[j] = kt[j] * gl; g15[j] = gl; }
                *(LAS u32x2*)(ts + RS_AT + m * RC_TT + ch0 * 2) = (u32x2){cvtpk(at[0], at[1]), cvtpk(at[2], at[3])}; *(LAS u32x2*)(ts + RS_RT + m * RC_TT + ch0 * 2) = (u32x2){cvtpk(rt[0], rt[1]), cvtpk(rt[2], rt[3])};
                *(LAS u32x2*)(ts + RS_BT + m * RC_TT + ch0 * 2) = (u32x2){cvtpk(bt[0], bt[1]), cvtpk(bt[2], bt[3])}; *(LAS u32x2*)(ts + RS_KT + m * RC_TT + ch0 * 2) = (u32x2){cvtpk(kt[0], kt[1]), cvtpk(kt[2], kt[3])};
#pragma unroll
                for (int j = 0; j < 4; ++j) { *(LAS bf16_t*)(ts + RS_BH + (ch0 + j) * RC_HS + m * 2) = f2bf(bh[j]); *(LAS bf16_t*)(ts + RS_KH + (ch0 + j) * RC_HS + m * 2) = f2bf(kh[j]); }
                if (m == 15) *(LAS f32x4*)(ts + RS_GL + ch0 * 4) = g15;
                *(LAS u32x2*)(tg + RD_V + rw_sw(tok, ch0) * 2) = v2; }
            ss = red4(ss); bon = red4(bon);
            if (q == 0) { *(LAS float*)(tg + RD_SSP + (tok * 2 + (hw >> 1)) * 4) = ss; *(LAS float*)(tg + RD_BNP + (tok * 2 + (hw >> 1)) * 4) = bon; }
        }
        __syncthreads();
        if (doC) { rwkv_main_chunk(rg, 1, hw, c16, g, Sacc);
            if (cB >= NLAT && ((cB - NLAT) & 7) == 7) { const unsigned sb = (unsigned)((((b * 2 + dir) * 32 + head) * 64 + hw * 16 + c16) * 64 + 4 * g);
#pragma unroll
                for (int jb = 0; jb < 4; ++jb) *(f32x4*)((char*)p.out + ((unsigned)OUT_RWKV + sb + 16 * jb) * 4u) = Sacc[jb]; } }
        if (doA) {
            const int xo = (hw & 1) ? RS_KT : RS_BT, yo = (hw & 2) ? RS_RT : RS_AT;
#pragma unroll
            for (int c2 = 0; c2 < 2; ++c2) { LAS unsigned char* ts = tg + c2 * RD_SET;
                f32x4 mm = (f32x4){0.f, 0.f, 0.f, 0.f};
#pragma unroll
                for (int ks = 0; ks < 2; ++ks) { const bf16x8 xf = *(const LAS bf16x8*)(ts + xo + c16 * RC_TT + (32 * ks + 8 * g) * 2), yf = *(const LAS bf16x8*)(ts + yo + c16 * RC_TT + (32 * ks + 8 * g) * 2);
                    mm = __builtin_amdgcn_mfma_f32_16x16x32_bf16(xf, yf, mm, 0, 0, 0); }
                const f32x2v st = *(const LAS f32x2v*)(tg + RD_SSP + (16 * c2 + c16) * 8);
                const float invt = __builtin_amdgcn_rcpf(fmaxf(__builtin_amdgcn_sqrtf(st.x + st.y), 1e-12f));
#pragma unroll
                for (int r = 0; r < 4; ++r) { const int s_ = 4 * g + r; const bool keep = (hw & 2) ? (s_ <= c16) : (s_ < c16); mm[r] = keep ? mm[r] : 0.f; }
                if (hw == 0) {
                    const int tb = c16 >> 2;
#pragma unroll
                    for (int r = 0; r < 4; ++r) { const f32x2v sr = *(const LAS f32x2v*)(tg + RD_SSP + (16 * c2 + 4 * g + r) * 8);
                        const float v = mm[r] * invt * __builtin_amdgcn_rcpf(fmaxf(__builtin_amdgcn_sqrtf(sr.x + sr.y), 1e-12f));
                        *(LAS float*)(ts + RS_MAB + (4 * g + r) * RC_MS + c16 * 4) = g < tb ? v : 0.f;
                        if (g == tb) *(LAS float*)(ts + RS_MD + (4 * g + r) * 16 + (c16 & 3) * 4) = v; } }
                else { if (hw == 1) mm = mm * invt;
                    u32x2 w; w.x = cvtpk(mm[0], mm[1]); w.y = cvtpk(mm[2], mm[3]); *(LAS u32x2*)(ts + (hw == 1 ? RS_MAK : hw == 2 ? RS_NBR : RS_NKR) + c16 * RC_NS + g * 8) = w; }
                if (hw == 3 && g == 0) { *(LAS float*)(tg + RD_INV + (16 * c2 + c16) * 4) = invt;
                    const f32x2v bn = *(const LAS f32x2v*)(tg + RD_BNP + (16 * c2 + c16) * 8); const int tau = ablk * 32 + 16 * c2 + c16, t = dir ? L - 1 - tau : tau;
                    BON[((size_t)dir * MTOK + (size_t)(base + t)) * 32 + head] = bn.x + bn.y; } }
        }
        __syncthreads();
    }
#undef RD_PREFETCH
#undef RD_PREFETCH_LR
#undef RD_PREFETCH_RKV
}
__device__ __forceinline__ void p10_combine(const Params& p) {
    const int lane = tidx() & 63, gw = blockIdx.x * 8 + (tidx() >> 6), nw = gridDim.x * 8;
    const bf16_t* YF = (const bf16_t*)(p.out + OUT_Y); const bf16_t* YB = YF + (size_t)MTOK * DM; const bf16_t* V1 = (const bf16_t*)(p.ws + WS_V1); const bf16_t* G1 = (const bf16_t*)(p.ws + WS_G1);
    const float* BON = (const float*)(p.ws + WS_BON); bf16_t* O1 = (bf16_t*)(p.ws + WS_R);
    for (int row = gw; row < MTOK; row += nw) {
        u32x4 f4[4], b4[4], v4[4], g4[4]; float bn[4];
#pragma unroll
        for (int it = 0; it < 4; ++it) { const int ch = it * 512 + lane * 8, head = ch >> 6; const size_t e = (size_t)row * DM + ch;
            f4[it] = *(const u32x4*)(YF + e); b4[it] = *(const u32x4*)(YB + e); v4[it] = *(const u32x4*)(V1 + e); g4[it] = *(const u32x4*)(G1 + e);
            bn[it] = BON[(size_t)row * 32 + head] + BON[((size_t)MTOK + row) * 32 + head]; }
#pragma unroll
        for (int it = 0; it < 4; ++it) { const int ch = it * 512 + lane * 8; const size_t e = (size_t)row * DM + ch;
            float y[8], vv[8], gg[8];
#pragma unroll
            for (int j = 0; j < 4; ++j) { y[2 * j] = bflo(f4[it][j]) + bflo(b4[it][j]); y[2 * j + 1] = bfhi(f4[it][j]) + bfhi(b4[it][j]); vv[2 * j] = bflo(v4[it][j]); vv[2 * j + 1] = bfhi(v4[it][j]); gg[2 * j] = bflo(g4[it][j]); gg[2 * j + 1] = bfhi(g4[it][j]); }
            float s = ((y[0] + y[1]) + (y[2] + y[3])) + ((y[4] + y[5]) + (y[6] + y[7])); s += __shfl_xor(s, 1); s += __shfl_xor(s, 2); s += __shfl_xor(s, 4);
            const float mean = s * (1.f / 64.f); float v = 0.f;
#pragma unroll
            for (int j = 0; j < 8; ++j) { y[j] -= mean; v += y[j] * y[j]; }
            v += __shfl_xor(v, 1); v += __shfl_xor(v, 2); v += __shfl_xor(v, 4);
            const float rstd = rsqrtf(v * (1.f / 64.f) + 64e-5f);
            const f32x4 lw0 = *(const f32x4*)(pin(p, I_LNXW) + ch), lw1 = *(const f32x4*)(pin(p, I_LNXW) + ch + 4), lb0 = *(const f32x4*)(pin(p, I_LNXB) + ch), lb1 = *(const f32x4*)(pin(p, I_LNXB) + ch + 4);
            float o[8];
#pragma unroll
            for (int j = 0; j < 8; ++j) o[j] = (y[j] * rstd * (j < 4 ? lw0[j] : lw1[j - 4]) + (j < 4 ? lb0[j] : lb1[j - 4]) + bn[it] * vv[j]) * silu(gg[j]);
            u32x4 w; w.x = cvtpk(o[0], o[1]); w.y = cvtpk(o[2], o[3]); w.z = cvtpk(o[4], o[5]); w.w = cvtpk(o[6], o[7]); *(u32x4*)(O1 + e) = w; }
    }
}
__device__ __forceinline__ void p12_final(const Params& p) {
    const int lane = tidx() & 63, gw = blockIdx.x * 8 + (tidx() >> 6), nw = gridDim.x * 8; const float* fw = pin(p, I_FNW);
    for (int row0 = gw; row0 < MTOK; row0 += 2 * nw) {
        f32x4 x[2][8]; float ss[2] = {0.f, 0.f}; const bool ok1 = row0 + nw < MTOK;
#pragma unroll
        for (int k = 0; k < 2; ++k) { const float* xr = p.out + OUT_Y + (size_t)((k && ok1) ? row0 + nw : row0) * DM;
#pragma unroll
            for (int it = 0; it < 8; ++it) x[k][it] = *(const f32x4*)(xr + it * 256 + lane * 4); }
#pragma unroll
        for (int k = 0; k < 2; ++k) {
#pragma unroll
            for (int it = 0; it < 8; ++it)
#pragma unroll
                for (int j = 0; j < 4; ++j) ss[k] += x[k][it][j] * x[k][it][j];
            ss[k] = wave_sum(ss[k]); }
#pragma unroll
        for (int k = 0; k < 2; ++k) { if (k && !ok1) break; float* xr = p.out + OUT_Y + (size_t)(row0 + k * nw) * DM; const float rstd = rsqrtf(ss[k] * (1.f / 2048.f) + 1e-6f);
#pragma unroll
            for (int it = 0; it < 8; ++it) { const f32x4 w = *(const f32x4*)(fw + it * 256 + lane * 4); *(f32x4*)(xr + it * 256 + lane * 4) = x[k][it] * rstd * w; } }
    }
}

constexpr int NPHASE = 15;
__global__ void __launch_bounds__(512, 2) mk_fwd(Params p) {
    extern __shared__ __attribute__((aligned(16))) unsigned char shm[];
    LAS unsigned char* lds = (LAS unsigned char*)shm;
    const int lo = p.ph_lo, hi = p.ph_hi;
    volatile LAS unsigned* st = (volatile LAS unsigned*)(lds + LDS_BAR_OFF);
    if (tidx() == 0) { st[0] = 0u; st[1] = 0u; st[2] = 0u; st[3] = 0u; }
    __syncthreads();
    XcdBarrier bar; bar.bar = (unsigned*)(p.ws + WS_BAR); bar.x = 0; bar.st = st;
    if (hi - lo > 1) bar = xcd_barrier_post((unsigned*)(p.ws + WS_BAR), st);
#ifndef PHMASK
#define PHMASK 0x7fff
#endif
#define IN(k) (((PHMASK >> (k)) & 1) && lo <= (k) && (k) < hi)
#define SEAM(k) do { if (IN((k) + 1)) xcd_barrier(bar); } while (0)
    unsigned char* ws = p.ws;
#ifndef DUPMASK
#define DUPMASK 0
#endif
#ifndef SPLIT_TAIL
#define SPLIT_TAIL 1
#endif
#define RUN(k, ...) do { if (IN(k)) { __VA_ARGS__; if ((DUPMASK >> (k)) & 1) { xcd_barrier(bar); __VA_ARGS__; } SEAM(k); } } while (0)
    RUN(0, p0_prologue(p, lds));
    RUN(1, p1_h0(p));
    RUN(2, { pg8::Gemm g{(const bf16_t*)(p.out + OUT_GLA), (const bf16_t*)(ws + WS_WT_E_IN), MTOK, 11264, 2048}; pg8::StaticOrder S; S.init(MTOK, 11264, gridDim.x, blockIdx.x);
        EpiProj0 E{ws}; pg8::gemm_phase<EpiProj0, pg8::StaticOrder>(lds, g, S, E, nullptr); });
    RUN(3, p_s5_passA(p, lds));
    RUN(4, { p_s5_passC_ctx(p); xcd_barrier(bar); p_s5_passC_lat(p, lds); xcd_barrier(bar); p_s5_gelu(p); });
    RUN(5, { pg8::Gemm g{(const bf16_t*)(ws + WS_U), (const bf16_t*)(ws + WS_WT_GLU), MTOK, 1024, 1024}; pg8::StaticOrder S; S.init(MTOK, 1024, gridDim.x, blockIdx.x);
        EpiGlu E{(const bf16_t*)(ws + WS_U), (const bf16_t*)(ws + WS_SG), pin(p, I_GLUB), (bf16_t*)(p.out + OUT_Y)}; pg8::gemm_phase<EpiGlu, pg8::StaticOrder>(lds, g, S, E, nullptr);
        { pg8::Gemm g2{(const bf16_t*)(p.out + OUT_GLA), (const bf16_t*)(ws + WS_WT_E_IN) + (size_t)11264 * 2048, MTOK, 256, 2048}; pg8::StaticOrder S2; S2.init(MTOK, 256, gridDim.x, (int)((blockIdx.x + 128u) & 255u));
          EpiDlr E2{ws}; pg8::gemm_phase<EpiDlr, pg8::StaticOrder>(lds, g2, S2, E2, nullptr); } });
    RUN(6, p_gla_chunk(p, lds));
    RUN(7, p_gla_norm2(p));
    RUN(8, { pg8::Gemm g{(const bf16_t*)(p.out + OUT_Y), (const bf16_t*)(ws + WS_WT_E_OUT), MTOK, 2048, 4096}; pg8::StaticOrder S; S.init(MTOK, 2048, gridDim.x, blockIdx.x);
        if (SPLIT_TAIL) S.set_split(2, 4096, (pg8::f32x4*)(ws + WS_V), (unsigned*)(ws + WS_BAR) + XCD_BAR_WORDS);
        EpiRes E{pin(p, I_XP), pin(p, I_XS), P_POSTAB(p), P_MOD(p) + 4096, nullptr, 0, (float*)(ws + WS_X1)}; pg8::gemm_phase<EpiRes, pg8::StaticOrder>(lds, g, S, E, nullptr); });
    RUN(9, p7_xs(p, lds));
    RUN(10, { pg8::Gemm g{(const bf16_t*)(p.out + OUT_Y), (const bf16_t*)((unsigned char*)(p.out + OUT_Y) + OY_WT_O_IN_B), MTOK, 8704, 2048}; pg8::StaticOrder S; S.init(MTOK, 8704, gridDim.x, blockIdx.x);
        EpiProj1 E{ws}; pg8::gemm_phase<EpiProj1, pg8::StaticOrder>(lds, g, S, E, nullptr); });
#if defined(RWKV_OLD)
    RUN(11, p9_rwkv(p, lds));
#elif defined(RWKV_PIPE)
    RUN(11, p9_rwkv_pipe(p, lds));
#elif defined(RWKV_PIPE2)
    RUN(11, p9_rwkv_pipe2(p, lds));
#elif defined(RWKV_PIPE3)
    RUN(11, p9_rwkv_pipe3(p, lds));
#elif defined(RWKV_CHUNK4)
    RUN(11, p9_rwkv_chunk4(p, lds));
#elif defined(RWKV_CHUNK2)
    RUN(11, p9_rwkv_chunk2(p, lds));
#elif defined(RWKV_CHUNK1)
    RUN(11, p9_rwkv_chunk(p, lds));
#else
    RUN(11, p9_rwkv_chunk3(p, lds));
#endif
    RUN(12, p10_combine(p));
    RUN(13, { pg8::Gemm g{(const bf16_t*)(ws + WS_R), (const bf16_t*)(ws + WS_WT_O_OUT), MTOK, 2048, 2048}; pg8::StaticOrder S; S.init(MTOK, 2048, gridDim.x, blockIdx.x);
        if (SPLIT_TAIL & 2) S.set_split(2, 2048, (pg8::f32x4*)(ws + WS_K1), (unsigned*)(ws + WS_BAR) + XCD_BAR_WORDS + 128);
        EpiRes E{nullptr, nullptr, nullptr, P_MOD(p) + 5 * 6144 + 4096, (const float*)(ws + WS_X1), 1, p.out + OUT_Y}; pg8::gemm_phase<EpiRes, pg8::StaticOrder>(lds, g, S, E, nullptr); });
    if (IN(14)) { p12_final(p); }
#undef RUN
#undef IN
#undef SEAM
}

#ifndef MK_FUSED
#define MK_FUSED 1
#endif
extern "C" void kernel_launch(void* const* d_in, const int* in_sizes, int n_in, void* d_out, int out_size, void* d_ws, size_t ws_size, hipStream_t stream) {
    static int grid = 0;
    if (grid == 0) {
        if (n_in != N_IN || out_size != (int)OUT_TOTAL || ws_size < WS_END) { fprintf(stderr, "kernel_launch: unexpected shapes: n_in %d out %d ws %zu; nothing launched\n", n_in, out_size, ws_size); grid = -1; return; }
        int dev = 0, cus = 0, per_cu = 0;
        if (hipGetDevice(&dev) != hipSuccess || hipDeviceGetAttribute(&cus, hipDeviceAttributeMultiprocessorCount, dev) != hipSuccess) { grid = -1; return; }
        if (hipFuncSetAttribute((const void*)mk_fwd, hipFuncAttributeMaxDynamicSharedMemorySize, LDS_BYTES) != hipSuccess) { fprintf(stderr, "kernel_launch: hipFuncSetAttribute failed\n"); grid = -1; return; }
        if (hipOccupancyMaxActiveBlocksPerMultiprocessor(&per_cu, (const void*)mk_fwd, 512, LDS_BYTES) != hipSuccess || per_cu < 1) fprintf(stderr, "kernel_launch: occupancy query reports %d per CU\n", per_cu);
        (void)hipGetLastError();
        if (cus != 256) { fprintf(stderr, "kernel_launch: built for 256 CUs, device has %d; nothing launched\n", cus); grid = -1; return; }
        grid = 256;
    }
    if (grid < 0) return;
    Params p; memset(&p, 0, sizeof(p));
    for (int i = 0; i < N_IN; ++i) p.in[i] = (const float*)d_in[i];
    p.out = (float*)d_out; p.ws = (unsigned char*)d_ws;
#if MK_FUSED
    (void)hipMemsetAsync((unsigned char*)d_ws + WS_BAR, 0, 16384, stream);
    p.ph_lo = 0; p.ph_hi = NPHASE;
    hipLaunchKernelGGL(mk_fwd, dim3(grid), dim3(512), LDS_BYTES, stream, p);
#else
    for (int k = 0; k < NPHASE; ++k) { p.ph_lo = k; p.ph_hi = k + 1; hipLaunchKernelGGL(mk_fwd, dim3(grid), dim3(512), LDS_BYTES, stream, p); }
#endif
}
```
